# Optimizing an MI355X kernel written in HIP

```python
import jax, jax.numpy as jnp
from jax import lax
import numpy as np

D_MODEL = 2048
BATCH = 4
SEQ = 4096
DEPTH = 4

CHUNK = 64
Q_BLOCK = 128
N_MIXERS = 3
ROPE_THETA = 10000.0
NORM_EPS = 1e-6
D_FF = -(-(8 * D_MODEL) // (3 * 256)) * 256

DSA_HEADS = 16
DSA_HEAD_DIM = D_MODEL // DSA_HEADS
DSA_KV_HEADS = 4
DSA_GROUP = DSA_HEADS // DSA_KV_HEADS
IDX_HEADS = 16
IDX_DIM = 128
IDX_ROPE_DIM = 64
TOPK_MAX = 256

MLA_HEADS = 16
MLA_Q_RANK = 512
MLA_KV_RANK = 512
MLA_NOPE_DIM = 128
MLA_ROPE_DIM = 64
MLA_V_DIM = 128

SB_HEADS = 16
SB_HEAD_DIM = D_MODEL // SB_HEADS

kernel_name = 'hybrid_dsa_mla_stickbreaking_trunk'

F32 = jnp.float32


def rms_norm(x, g):
    xf = x.astype(F32)
    y = xf * lax.rsqrt(jnp.mean(xf * xf, axis=-1, keepdims=True) + NORM_EPS)
    return (y * g.astype(F32)).astype(x.dtype)


def rope(x, pos):
    d = x.shape[-1]
    inv_freq = ROPE_THETA ** (-jnp.arange(0, d, 2, dtype=F32) / d)
    ang = pos.astype(F32)[:, None] * inv_freq[None, :]
    ang = ang.reshape(ang.shape[0], *([1] * (x.ndim - 3)), d // 2)
    cos, sin = jnp.cos(ang), jnp.sin(ang)
    xf = x.astype(F32)
    x1, x2 = xf[..., : d // 2], xf[..., d // 2:]
    return jnp.concatenate([x1 * cos - x2 * sin, x2 * cos + x1 * sin], axis=-1).astype(x.dtype)


def _split_cols(a, sizes):
    points, acc = [], 0
    for s in sizes[:-1]:
        acc += s
        points.append(acc)
    return jnp.split(a, points, axis=-1)


def _sweep_query_blocks(fn, arrays):
    seq = arrays[0].shape[1]
    n_blocks = seq // Q_BLOCK

    def split(a):
        return jnp.moveaxis(a.reshape(a.shape[0], n_blocks, Q_BLOCK, *a.shape[2:]), 1, 0)

    starts = jnp.arange(n_blocks, dtype=jnp.int32) * Q_BLOCK
    out = lax.map(lambda xs: fn(xs[0], *xs[1]), (starts, tuple(split(a) for a in arrays)))
    out = jnp.moveaxis(out, 0, 1)
    return out.reshape(out.shape[0], seq, *out.shape[3:])


def dsa_mixer(h, w_in, w_out, pos):
    b, s, _ = h.shape
    top_k = min(TOPK_MAX, s // 4)
    q, k, v, iq, ik, iw = _split_cols(h @ w_in, [
        DSA_HEADS * DSA_HEAD_DIM, DSA_KV_HEADS * DSA_HEAD_DIM, DSA_KV_HEADS * DSA_HEAD_DIM,
        IDX_HEADS * IDX_DIM, IDX_DIM, IDX_HEADS])
    q = rope(q.reshape(b, s, DSA_KV_HEADS, DSA_GROUP, DSA_HEAD_DIM), pos)
    k = rope(k.reshape(b, s, DSA_KV_HEADS, DSA_HEAD_DIM), pos)
    v = v.reshape(b, s, DSA_KV_HEADS, DSA_HEAD_DIM)
    iq = iq.reshape(b, s, IDX_HEADS, IDX_DIM)
    iq = jnp.concatenate([rope(iq[..., :IDX_ROPE_DIM], pos), iq[..., IDX_ROPE_DIM:]], axis=-1)
    ik = jnp.concatenate([rope(ik[..., :IDX_ROPE_DIM], pos), ik[..., IDX_ROPE_DIM:]], axis=-1)
    key_chunk = pos // CHUNK
    gather = jax.vmap(lambda table, idx: table[idx])

    def block(start, q_b, iq_b, iw_b):
        q_chunk = (start + jnp.arange(Q_BLOCK, dtype=jnp.int32)) // CHUNK
        visible = key_chunk[None, :] <= q_chunk[:, None]
        rel = jax.nn.relu(jnp.einsum('bqhd,bsd->bqhs', iq_b, ik).astype(F32) * IDX_DIM ** -0.5)
        score = jnp.einsum('bqhs,bqh->bqs', rel, iw_b.astype(F32) * IDX_HEADS ** -0.5)
        score = jnp.where(visible[None], score, -jnp.inf)
        _, sel = lax.top_k(score, top_k)
        sel_ok = (sel // CHUNK) <= q_chunk[None, :, None]
        k_sel = gather(k, sel)
        v_sel = gather(v, sel)
        logits = jnp.einsum('bqgrd,bqkgd->bqgrk', q_b, k_sel).astype(F32) * DSA_HEAD_DIM ** -0.5
        logits = jnp.where(sel_ok[:, :, None, None, :], logits, -jnp.inf)
        p = jax.nn.softmax(logits, axis=-1).astype(v.dtype)
        o = jnp.einsum('bqgrk,bqkgd->bqgrd', p, v_sel)
        return o.reshape(o.shape[0], Q_BLOCK, DSA_HEADS * DSA_HEAD_DIM)

    o = _sweep_query_blocks(block, (q, iq, iw))
    return o @ w_out


def mla_mixer(h, w_down, q_norm, kv_norm, w_uq, w_ukv, w_out, pos):
    b, s, _ = h.shape
    cq, ckv, k_rope = _split_cols(h @ w_down, [MLA_Q_RANK, MLA_KV_RANK, MLA_ROPE_DIM])
    cq = rms_norm(cq, q_norm)
    ckv = rms_norm(ckv, kv_norm)
    q = (cq @ w_uq).reshape(b, s, MLA_HEADS, MLA_NOPE_DIM + MLA_ROPE_DIM)
    q_nope, q_rope = q[..., :MLA_NOPE_DIM], rope(q[..., MLA_NOPE_DIM:], pos)
    kv = (ckv @ w_ukv).reshape(b, s, MLA_HEADS, MLA_NOPE_DIM + MLA_V_DIM)
    k_nope, v = kv[..., :MLA_NOPE_DIM], kv[..., MLA_NOPE_DIM:]
    k_rope = rope(k_rope, pos)
    scale = (MLA_NOPE_DIM + MLA_ROPE_DIM) ** -0.5
    key_chunk = pos // CHUNK

    def block(start, qn_b, qr_b):
        q_chunk = (start + jnp.arange(Q_BLOCK, dtype=jnp.int32)) // CHUNK
        visible = key_chunk[None, :] <= q_chunk[:, None]
        logits = (jnp.einsum('bqhd,bshd->bhqs', qn_b, k_nope)
                  + jnp.einsum('bqhd,bsd->bhqs', qr_b, k_rope)).astype(F32) * scale
        logits = jnp.where(visible[None, None], logits, -jnp.inf)
        p = jax.nn.softmax(logits, axis=-1).astype(v.dtype)
        o = jnp.einsum('bhqs,bshd->bqhd', p, v)
        return o.reshape(o.shape[0], Q_BLOCK, MLA_HEADS * MLA_V_DIM)

    o = _sweep_query_blocks(block, (q_nope, q_rope))
    return o @ w_out


def stick_breaking_mixer(h, w_in, w_out, pos):
    b, s, _ = h.shape
    q, k, v = [a.reshape(b, s, SB_HEADS, SB_HEAD_DIM) for a in jnp.split(h @ w_in, 3, axis=-1)]

    def block(start, q_b):
        q_pos = start + jnp.arange(Q_BLOCK, dtype=jnp.int32)
        before = pos[None, :] < q_pos[:, None]
        z = jnp.einsum('bqhd,bshd->bhqs', q_b, k).astype(F32) * SB_HEAD_DIM ** -0.5
        log_beta = jax.nn.log_sigmoid(z)
        log_keep = jnp.where(before, jax.nn.log_sigmoid(-z), 0.0)
        later_keep = lax.cumsum(log_keep, axis=3, reverse=True) - log_keep
        a = jnp.where(before, jnp.exp(log_beta + later_keep), 0.0).astype(v.dtype)
        o = jnp.einsum('bhqs,bshd->bqhd', a, v)
        return o.reshape(o.shape[0], Q_BLOCK, SB_HEADS * SB_HEAD_DIM)

    o = _sweep_query_blocks(block, (q,))
    return o @ w_out


def swiglu(h, w_in, w_out):
    gate, up = jnp.split(h @ w_in, 2, axis=-1)
    return (jax.nn.silu(gate) * up) @ w_out


def adaln(c, w, b):
    mod = jax.nn.silu(c) @ w + b
    return jnp.split(mod[:, None, :], 6, axis=-1)


def setup_inputs(seed: int = 0) -> dict:
    key = jax.random.key(seed)
    keys = iter(jax.random.split(key, 80))

    def dense(fan_in, fan_out):
        return jax.random.normal(next(keys), (fan_in, fan_out), F32) * fan_in ** -0.5

    def gain(n):
        return 1.0 + 0.05 * jax.random.normal(next(keys), (n,), F32)

    def bias(n):
        return 0.02 * jax.random.normal(next(keys), (n,), F32)

    inputs = {}
    inputs['x'] = jax.random.normal(next(keys), (BATCH, SEQ, D_MODEL), F32)
    inputs['c'] = jax.random.normal(next(keys), (BATCH, D_MODEL), F32)
    dsa_in = (DSA_HEADS + 2 * DSA_KV_HEADS) * DSA_HEAD_DIM + IDX_HEADS * IDX_DIM + IDX_DIM + IDX_HEADS
    for i in range(DEPTH):
        inputs[f'ada_w_{i}'] = dense(D_MODEL, 6 * D_MODEL)
        inputs[f'ada_b_{i}'] = bias(6 * D_MODEL)
        inputs[f'norm_mix_{i}'] = gain(D_MODEL)
        inputs[f'norm_ffn_{i}'] = gain(D_MODEL)
        kind = i % N_MIXERS
        if kind == 0:
            inputs[f'dsa_w_in_{i}'] = dense(D_MODEL, dsa_in)
            inputs[f'dsa_w_out_{i}'] = dense(DSA_HEADS * DSA_HEAD_DIM, D_MODEL)
        elif kind == 1:
            inputs[f'mla_w_down_{i}'] = dense(D_MODEL, MLA_Q_RANK + MLA_KV_RANK + MLA_ROPE_DIM)
            inputs[f'mla_q_norm_{i}'] = gain(MLA_Q_RANK)
            inputs[f'mla_kv_norm_{i}'] = gain(MLA_KV_RANK)
            inputs[f'mla_w_uq_{i}'] = dense(MLA_Q_RANK, MLA_HEADS * (MLA_NOPE_DIM + MLA_ROPE_DIM))
            inputs[f'mla_w_ukv_{i}'] = dense(MLA_KV_RANK, MLA_HEADS * (MLA_NOPE_DIM + MLA_V_DIM))
            inputs[f'mla_w_out_{i}'] = dense(MLA_HEADS * MLA_V_DIM, D_MODEL)
        else:
            inputs[f'sb_w_in_{i}'] = dense(D_MODEL, 3 * SB_HEADS * SB_HEAD_DIM)
            inputs[f'sb_w_out_{i}'] = dense(SB_HEADS * SB_HEAD_DIM, D_MODEL)
        inputs[f'ffn_w_in_{i}'] = dense(D_MODEL, 2 * D_FF)
        inputs[f'ffn_w_out_{i}'] = dense(D_FF, D_MODEL)
    inputs['final_norm'] = gain(D_MODEL)
    return inputs


def reference(x, c,
              ada_w_0, ada_b_0, norm_mix_0, norm_ffn_0, dsa_w_in_0, dsa_w_out_0, ffn_w_in_0, ffn_w_out_0,
              ada_w_1, ada_b_1, norm_mix_1, norm_ffn_1, mla_w_down_1, mla_q_norm_1, mla_kv_norm_1,
              mla_w_uq_1, mla_w_ukv_1, mla_w_out_1, ffn_w_in_1, ffn_w_out_1,
              ada_w_2, ada_b_2, norm_mix_2, norm_ffn_2, sb_w_in_2, sb_w_out_2, ffn_w_in_2, ffn_w_out_2,
              ada_w_3, ada_b_3, norm_mix_3, norm_ffn_3, dsa_w_in_3, dsa_w_out_3, ffn_w_in_3, ffn_w_out_3,
              final_norm):
    pos = jnp.arange(x.shape[1], dtype=jnp.int32)
    mixers = (dsa_mixer, mla_mixer, stick_breaking_mixer)
    layers = (
        (ada_w_0, ada_b_0, norm_mix_0, norm_ffn_0, (dsa_w_in_0, dsa_w_out_0), ffn_w_in_0, ffn_w_out_0),
        (ada_w_1, ada_b_1, norm_mix_1, norm_ffn_1,
         (mla_w_down_1, mla_q_norm_1, mla_kv_norm_1, mla_w_uq_1, mla_w_ukv_1, mla_w_out_1),
         ffn_w_in_1, ffn_w_out_1),
        (ada_w_2, ada_b_2, norm_mix_2, norm_ffn_2, (sb_w_in_2, sb_w_out_2), ffn_w_in_2, ffn_w_out_2),
        (ada_w_3, ada_b_3, norm_mix_3, norm_ffn_3, (dsa_w_in_3, dsa_w_out_3), ffn_w_in_3, ffn_w_out_3),
    )
    for i in range(DEPTH):
        ada_w, ada_b, g_mix, g_ffn, mix_params, w_ff_in, w_ff_out = layers[i]
        sh1, sc1, gt1, sh2, sc2, gt2 = adaln(c, ada_w, ada_b)
        h = rms_norm(x, g_mix) * (1 + sc1) + sh1
        x = x + gt1 * mixers[i % N_MIXERS](h, *mix_params, pos)
        h = rms_norm(x, g_ffn) * (1 + sc2) + sh2
        x = x + gt2 * swiglu(h, w_ff_in, w_ff_out)
    return rms_norm(x, final_norm)
```

```cpp
#include <hip/hip_runtime.h>
#include <cstdio>
#include <cstdint>
namespace pg8 {
#define PG8_LAS __attribute__((address_space(3)))
typedef unsigned short bf16_t;
typedef short bf16x8 __attribute__((ext_vector_type(8)));
typedef float f32x4 __attribute__((ext_vector_type(4)));
typedef unsigned u32x4 __attribute__((ext_vector_type(4)));
constexpr int BM = 256, BK = 64, HALF = 128, HTB = HALF * BK * 2  , STAGE_BYTES = 8 * HTB, NXCD = 8, WGM = 8;

__host__ __device__ __forceinline__ int lds_byte(int r, int c) { const int st = (r >> 4) * 2 + (c >> 5), rr = r & 15, cc = c & 31, ob = rr * 64 + cc * 2; return st * 1024 + (ob ^ (((ob >> 9) & 1) << 5)); }
__host__ __device__ __forceinline__ void stage_rc(int b, int& R, int& C) { const int st = b / 1024, sb = b % 1024, swz = sb ^ (((sb >> 9) & 1) << 5); R = (st >> 1) * 16 + swz / 64; C = (st & 1) * 32 + (swz % 64) / 2; }
__host__ __device__ __forceinline__ int perm32(int rho) { const int n = rho >> 4, i = rho & 15; return 8 * (i >> 2) + 4 * n + (i & 3); }

struct Unit { int pm, pn; };
struct Gemm { const bf16_t* A; const bf16_t* Bt; int M, N, K; };

struct StaticOrder {
    int nM, nN, nwg, G, c;
    __host__ __device__ void init(int M, int N, int G_, int c_) { nM = M / BM; nN = N / BM; nwg = nM * nN; G = G_; c = c_; }
    __host__ __device__ bool next(int i, Unit& u) const {
        const long L = (long)i * G + c; if (L >= nwg) return false;
        int wgid = (int)L; { const int q = nwg / NXCD, r = nwg % NXCD, xcd = wgid % NXCD, off = wgid / NXCD; wgid = (xcd < r ? xcd * (q + 1) : r * (q + 1) + (xcd - r) * q) + off; }
        const int nig = WGM * nN, gid = wgid / nig, fm = gid * WGM, gsz = (nM - fm) < WGM ? (nM - fm) : WGM;
        u.pm = fm + ((wgid % nig) % gsz); u.pn = (wgid % nig) / gsz; return true;
    }
    __device__ __forceinline__ void a_ready(const Unit&) const {}
    __device__ __forceinline__ void done(const Unit&) const {}
};

__device__ __forceinline__ unsigned cvt_pk_bf16(float lo, float hi) { unsigned r; asm volatile("v_cvt_pk_bf16_f32 %0, %1, %2" : "=v"(r) : "v"(lo), "v"(hi)); return r; }
typedef float f32x2 __attribute__((ext_vector_type(2)));
__device__ __forceinline__ u32x4 pack8(const f32x4 v0, const f32x4 v1) { u32x4 w; w.x = cvt_pk_bf16(v0[0], v0[1]); w.y = cvt_pk_bf16(v0[2], v0[3]); w.z = cvt_pk_bf16(v1[0], v1[1]); w.w = cvt_pk_bf16(v1[2], v1[3]); return w; }
__device__ __forceinline__ void rope8(const float* cs, const f32x4 a0, const f32x4 a1, const f32x4 b0, const f32x4 b1, u32x4& o1, u32x4& o2) {
    const f32x4 t0 = *(const f32x4*)(cs), t1 = *(const f32x4*)(cs + 4), t2 = *(const f32x4*)(cs + 8), t3 = *(const f32x4*)(cs + 12);
    f32x4 c0 = {t0[0], t0[2], t1[0], t1[2]}, s0 = {t0[1], t0[3], t1[1], t1[3]}, c1 = {t2[0], t2[2], t3[0], t3[2]}, s1 = {t2[1], t2[3], t3[1], t3[3]};
    const f32x4 p0 = a0 * c0 - b0 * s0, p1 = a1 * c1 - b1 * s1, q0 = b0 * c0 + a0 * s0, q1 = b1 * c1 + a1 * s1;
    o1 = pack8(p0, p1); o2 = pack8(q0, q1);
}
struct EpiResid {
    static constexpr bool PERM = false, AFTER_DRAIN = false;
    const float* xin; float* xout; const float* gate;
    __device__ __forceinline__ void operator()(const f32x4 (&acc)[2][2][4][2], const Unit& u, int wr, int wc, int fr, int fq) const {
        const int row0 = u.pm * BM + wr * 64 + fr, col0 = u.pn * BM + wc * 32 + 4 * fq;
        const float* gb = gate + (size_t)(u.pm >> 4) * 12288 + col0;
        f32x4 gv[2][2];
#pragma unroll
        for (int bj = 0; bj < 2; ++bj)
#pragma unroll
            for (int n = 0; n < 2; ++n) gv[bj][n] = *(const f32x4*)(gb + bj * HALF + n * 16);
#pragma unroll
        for (int ai = 0; ai < 2; ++ai)
#pragma unroll
            for (int m = 0; m < 4; ++m) { const size_t off = (size_t)(row0 + ai * HALF + m * 16) * 2048 + col0;
#pragma unroll
                for (int bj = 0; bj < 2; ++bj)
#pragma unroll
                    for (int n = 0; n < 2; ++n) { const f32x4 xi = *(const f32x4*)(xin + off + bj * HALF + n * 16); *(f32x4*)(xout + off + bj * HALF + n * 16) = xi + gv[bj][n] * acc[ai][bj][m][n]; } }
    }
};
struct EpiSwiglu {
    static constexpr bool PERM = true, AFTER_DRAIN = false;
    bf16_t* act;
    __device__ __forceinline__ void operator()(const f32x4 (&acc)[2][2][4][2], const Unit& u, int wr, int wc, int fr, int fq) const {
        const int row0 = u.pm * BM + wr * 64 + fr, col0 = u.pn * 128 + wc * 32 + 8 * fq;
#pragma unroll
        for (int ai = 0; ai < 2; ++ai)
#pragma unroll
            for (int m = 0; m < 4; ++m) { f32x4 r[2];
#pragma unroll
                for (int n = 0; n < 2; ++n)
#pragma unroll
                    for (int i = 0; i < 4; ++i) { const float g = acc[ai][0][m][n][i], up = acc[ai][1][m][n][i];
                        r[n][i] = g * __builtin_amdgcn_rcpf(1.0f + __builtin_amdgcn_exp2f(-1.4426950408889634f * g)) * up; }
                *(u32x4*)(act + (size_t)(row0 + ai * HALF + m * 16) * 5632 + col0) = pack8(r[0], r[1]); }
    }
};
struct EpiSplit3 {
    static constexpr bool PERM = true, AFTER_DRAIN = false;
    bf16_t* O0; size_t stride;
    __device__ __forceinline__ void operator()(const f32x4 (&acc)[2][2][4][2], const Unit& u, int wr, int wc, int fr, int fq) const {
        const int t = u.pn >> 3; bf16_t* base = O0 + (size_t)t * stride;
        const int row0 = u.pm * BM + wr * 64 + fr, col0 = (u.pn & 7) * 256 + wc * 32 + 8 * fq;
#pragma unroll
        for (int ai = 0; ai < 2; ++ai)
#pragma unroll
            for (int m = 0; m < 4; ++m) { bf16_t* rowp = base + (size_t)(row0 + ai * HALF + m * 16) * 2048 + col0;
#pragma unroll
                for (int bj = 0; bj < 2; ++bj) *(u32x4*)(rowp + bj * HALF) = pack8(acc[ai][bj][m][0], acc[ai][bj][m][1]); }
    }
};
struct EpiDsaIn {
    static constexpr bool PERM = true, AFTER_DRAIN = false;
    bf16_t *Q, *K, *V, *IQ, *IK; float* IW; const float* cs128; const float* cs64;
    __device__ __forceinline__ void operator()(const f32x4 (&acc)[2][2][4][2], const Unit& u, int wr, int wc, int fr, int fq) const {
        const int pn = u.pn, row0 = u.pm * BM + wr * 64 + fr;
        if (pn < 10) {
            bf16_t* base; int ld, hcol;
            if (pn < 8) { base = Q; ld = 2048; hcol = (2 * pn + (wc >> 1)) * 128; } else { base = K; ld = 512; hcol = (2 * (pn - 8) + (wc >> 1)) * 128; }
            const int dd0 = 32 * (wc & 1) + 8 * fq;
#pragma unroll
            for (int ai = 0; ai < 2; ++ai)
#pragma unroll
                for (int m = 0; m < 4; ++m) { const int row = row0 + ai * HALF + m * 16, pos = row & 4095; u32x4 o1, o2;
                    rope8(cs128 + ((size_t)pos * 64 + dd0) * 2, acc[ai][0][m][0], acc[ai][0][m][1], acc[ai][1][m][0], acc[ai][1][m][1], o1, o2);
                    bf16_t* p = base + (size_t)row * ld + hcol + dd0; *(u32x4*)p = o1; *(u32x4*)(p + 64) = o2; }
        } else if (pn < 12) {
            const int col0 = (pn - 10) * 256 + wc * 32 + 8 * fq;
#pragma unroll
            for (int ai = 0; ai < 2; ++ai)
#pragma unroll
                for (int m = 0; m < 4; ++m) { bf16_t* rowp = V + (size_t)(row0 + ai * HALF + m * 16) * 512 + col0;
#pragma unroll
                    for (int bj = 0; bj < 2; ++bj) *(u32x4*)(rowp + bj * HALF) = pack8(acc[ai][bj][m][0], acc[ai][bj][m][1]); }
        } else {
            bf16_t* base; int ld, hcol;
            if (pn < 20) { base = IQ; ld = 2048; hcol = (2 * (pn - 12) + (wc >> 1)) * 128; } else { base = IK; ld = 128; hcol = 0; }
            const int sub = (pn < 20) ? (wc & 1) : wc;
            if (sub == 0) {
                const int dd0 = 8 * fq;
#pragma unroll
                for (int ai = 0; ai < 2; ++ai)
#pragma unroll
                    for (int m = 0; m < 4; ++m) { const int row = row0 + ai * HALF + m * 16, pos = row & 4095; u32x4 o1, o2;
                        rope8(cs64 + ((size_t)pos * 32 + dd0) * 2, acc[ai][0][m][0], acc[ai][0][m][1], acc[ai][1][m][0], acc[ai][1][m][1], o1, o2);
                        bf16_t* p = base + (size_t)row * ld + hcol + dd0; *(u32x4*)p = o1; *(u32x4*)(p + 32) = o2; }
            } else if (sub == 1) {
#pragma unroll
                for (int ai = 0; ai < 2; ++ai)
#pragma unroll
                    for (int m = 0; m < 4; ++m) { bf16_t* p = base + (size_t)(row0 + ai * HALF + m * 16) * ld + hcol + 64 + 8 * fq;
                        *(u32x4*)p = pack8(acc[ai][0][m][0], acc[ai][0][m][1]); *(u32x4*)(p + 32) = pack8(acc[ai][1][m][0], acc[ai][1][m][1]); }
            } else if (sub == 2 && pn == 20) {
                if (fq < 2) {
#pragma unroll
                    for (int ai = 0; ai < 2; ++ai)
#pragma unroll
                        for (int m = 0; m < 4; ++m) { float* p = IW + (size_t)(row0 + ai * HALF + m * 16) * 16 + 8 * fq; *(f32x4*)p = acc[ai][0][m][0]; *(f32x4*)(p + 4) = acc[ai][0][m][1]; }
                }
            }
        }
    }
};
struct EpiMlaDown {
    static constexpr bool PERM = true, AFTER_DRAIN = false;
    bf16_t *CQ, *CKV, *KR; float* ssq; const float* cs64;
    __device__ __forceinline__ void operator()(const f32x4 (&acc)[2][2][4][2], const Unit& u, int wr, int wc, int fr, int fq) const {
        const int pn = u.pn, row0 = u.pm * BM + wr * 64 + fr;
        if (pn < 4) {
            bf16_t* base = pn < 2 ? CQ : CKV; const int col0 = (pn & 1) * 256 + wc * 32 + 8 * fq;
#pragma unroll
            for (int ai = 0; ai < 2; ++ai)
#pragma unroll
                for (int m = 0; m < 4; ++m) { const int row = row0 + ai * HALF + m * 16; float s = 0.f;
#pragma unroll
                    for (int bj = 0; bj < 2; ++bj) { const f32x4 v0 = acc[ai][bj][m][0], v1 = acc[ai][bj][m][1];
                        s += (v0[0] * v0[0] + v0[1] * v0[1]) + (v0[2] * v0[2] + v0[3] * v0[3]) + (v1[0] * v1[0] + v1[1] * v1[1]) + (v1[2] * v1[2] + v1[3] * v1[3]);
                        *(u32x4*)(base + (size_t)row * 512 + col0 + bj * HALF) = pack8(v0, v1); }
                    s += __shfl_xor(s, 16); s += __shfl_xor(s, 32);
                    if (fq == 0) ssq[(size_t)row * 16 + pn * 4 + wc] = s; }
        } else if (wc == 0) {
            const int dd0 = 8 * fq;
#pragma unroll
            for (int ai = 0; ai < 2; ++ai)
#pragma unroll
                for (int m = 0; m < 4; ++m) { const int row = row0 + ai * HALF + m * 16, pos = row & 4095; u32x4 o1, o2;
                    rope8(cs64 + ((size_t)pos * 32 + dd0) * 2, acc[ai][0][m][0], acc[ai][0][m][1], acc[ai][1][m][0], acc[ai][1][m][1], o1, o2);
                    bf16_t* p = KR + (size_t)row * 64 + dd0; *(u32x4*)p = o1; *(u32x4*)(p + 32) = o2; }
        }
    }
};
struct EpiMlaUq {
    static constexpr bool PERM = true, AFTER_DRAIN = false;
    bf16_t *QN, *QR; const float* ssq; const float* cs64;
    __device__ __forceinline__ void operator()(const f32x4 (&acc)[2][2][4][2], const Unit& u, int wr, int wc, int fr, int fq) const {
        const int pn = u.pn, row0 = u.pm * BM + wr * 64 + fr;
#pragma unroll
        for (int ai = 0; ai < 2; ++ai)
#pragma unroll
            for (int m = 0; m < 4; ++m) { const int row = row0 + ai * HALF + m * 16, pos = row & 4095;
                const f32x4 sa = *(const f32x4*)(ssq + (size_t)row * 16), sb = *(const f32x4*)(ssq + (size_t)row * 16 + 4);
                const float rstd = 1.0f / sqrtf((((sa[0] + sa[1]) + (sa[2] + sa[3])) + ((sb[0] + sb[1]) + (sb[2] + sb[3]))) * (1.0f / 512.0f) + 1e-6f);
                if (pn < 8) { bf16_t* rowp = QN + (size_t)row * 2048 + pn * 256 + wc * 32 + 8 * fq;
#pragma unroll
                    for (int bj = 0; bj < 2; ++bj) *(u32x4*)(rowp + bj * HALF) = pack8(acc[ai][bj][m][0] * rstd, acc[ai][bj][m][1] * rstd);
                } else { u32x4 o1, o2; const int dd0 = 8 * fq;
                    rope8(cs64 + ((size_t)pos * 32 + dd0) * 2, acc[ai][0][m][0] * rstd, acc[ai][0][m][1] * rstd, acc[ai][1][m][0] * rstd, acc[ai][1][m][1] * rstd, o1, o2);
                    bf16_t* p = QR + (size_t)row * 1024 + (4 * (pn - 8) + wc) * 64 + dd0; *(u32x4*)p = o1; *(u32x4*)(p + 32) = o2; } }
    }
};
struct EpiMlaUkv {
    static constexpr bool PERM = true, AFTER_DRAIN = false;
    bf16_t *KN, *V; const float* ssq;
    __device__ __forceinline__ void operator()(const f32x4 (&acc)[2][2][4][2], const Unit& u, int wr, int wc, int fr, int fq) const {
        const int row0 = u.pm * BM + wr * 64 + fr, col0 = u.pn * 128 + wc * 32 + 8 * fq;
#pragma unroll
        for (int ai = 0; ai < 2; ++ai)
#pragma unroll
            for (int m = 0; m < 4; ++m) { const int row = row0 + ai * HALF + m * 16;
                const f32x4 sa = *(const f32x4*)(ssq + (size_t)row * 16 + 8), sb = *(const f32x4*)(ssq + (size_t)row * 16 + 12);
                const float rstd = 1.0f / sqrtf((((sa[0] + sa[1]) + (sa[2] + sa[3])) + ((sb[0] + sb[1]) + (sb[2] + sb[3]))) * (1.0f / 512.0f) + 1e-6f);
                *(u32x4*)(KN + (size_t)row * 2048 + col0) = pack8(acc[ai][0][m][0] * rstd, acc[ai][0][m][1] * rstd);
                *(u32x4*)(V + (size_t)row * 2048 + col0) = pack8(acc[ai][1][m][0] * rstd, acc[ai][1][m][1] * rstd); }
    }
};

template <class Epi, class Sched, bool ALIGN_EPI = false, bool SP2 = false>
__device__ __forceinline__ void gemm_phase(PG8_LAS unsigned char* lds, const Gemm g, const Sched& S, const Epi& E) {
    const int tid = threadIdx.x, wid = __builtin_amdgcn_readfirstlane(tid >> 6), lane = tid & 63, wr = wid >> 2, wc = wid & 3, fr = lane & 15, fq = lane >> 4;
    const int K = g.K, nt = K / BK;
    unsigned voffA[2], voffB[2];
#pragma unroll
    for (int i = 0; i < 2; ++i) { int R, C; stage_rc(tid * 16 + i * 8192, R, C); const int Rb = Epi::PERM ? ((R & ~31) + perm32(R & 31)) : R;
        voffA[i] = (unsigned)(R * K + C) * 2u; voffB[i] = (unsigned)(Rb * K + C) * 2u; }
    const size_t kstep = (size_t)(BK * 2);
    const size_t hstep = (size_t)HALF * K * 2;
    const size_t tstep = 2 * hstep;
    const unsigned ldsw = (unsigned)wid * 1024u;
    const int aoff = lds_byte(wr * 64 + fr, fq * 8), boff = lds_byte(wc * 32 + fr, fq * 8);
#define PG8_SA(b, h) (((b) * 2 + (h)) * HTB)
#define PG8_SB(b, h) ((4 + (b) * 2 + (h)) * HTB)
#define PG8_STAGE(bufoff, gbase, voff) do { _Pragma("unroll") for (int _i = 0; _i < 2; ++_i) \
        __builtin_amdgcn_global_load_lds((const unsigned*)((const char*)(gbase) + (voff)[_i]), (PG8_LAS unsigned*)(lds + (bufoff) + ldsw + _i * 8192), 16, 0, 0); } while (0)
#define PG8_LDA(dst, b, h) do { _Pragma("unroll") for (int m = 0; m < 4; ++m) _Pragma("unroll") for (int k = 0; k < 2; ++k) dst[m][k] = *(const PG8_LAS bf16x8*)(lds + PG8_SA(b, h) + aoff + m * 2048 + k * 1024); } while (0)
#define PG8_LDB(dst, b, h) do { _Pragma("unroll") for (int n = 0; n < 2; ++n) _Pragma("unroll") for (int k = 0; k < 2; ++k) dst[n][k] = *(const PG8_LAS bf16x8*)(lds + PG8_SB(b, h) + boff + n * 2048 + k * 1024); } while (0)
#define PG8_MMA(ai, bj, At, Bt) do { __builtin_amdgcn_s_setprio(1); _Pragma("unroll") for (int m = 0; m < 4; ++m) _Pragma("unroll") for (int n = 0; n < 2; ++n) _Pragma("unroll") for (int k = 0; k < 2; ++k) \
        acc[ai][bj][m][n] = __builtin_amdgcn_mfma_f32_16x16x32_bf16(Bt[n][k], At[m][k], acc[ai][bj][m][n], 0, 0, 0); __builtin_amdgcn_s_setprio(0); } while (0)
#define PG8_WAIT_V(n) asm volatile("s_waitcnt vmcnt(" #n ")" ::: "memory")
#define PG8_WAIT_L(n) asm volatile("s_waitcnt lgkmcnt(" #n ")" ::: "memory")
#define PG8_BAR __builtin_amdgcn_s_barrier()
#define PG8_SCHED __builtin_amdgcn_sched_barrier(0)
    Unit cur, nxt; int ui = 0;
    if (!S.next(0, cur)) return;
    f32x4 acc[2][2][4][2];
#pragma unroll
    for (int a = 0; a < 2; ++a)
#pragma unroll
        for (int b = 0; b < 2; ++b)
#pragma unroll
            for (int m = 0; m < 4; ++m)
#pragma unroll
                for (int n = 0; n < 2; ++n) acc[a][b][m][n] = (f32x4){0.f, 0.f, 0.f, 0.f};
    bf16x8 At[4][2], B0[2][2], B1[2][2];
    const char* cA = (const char*)g.A + (size_t)cur.pm * tstep; const char* cB = (const char*)g.Bt + (size_t)cur.pn * tstep;
    S.a_ready(cur);
    if constexpr (SP2) {
        PG8_STAGE(PG8_SB(0, 0), cB, voffB); PG8_STAGE(PG8_SB(0, 1), cB + hstep, voffB); PG8_STAGE(PG8_SA(0, 0), cA, voffA); PG8_STAGE(PG8_SA(0, 1), cA + hstep, voffA);
        if (wr == 1) PG8_BAR;
        PG8_WAIT_V(2); PG8_BAR;
        PG8_STAGE(PG8_SB(1, 0), cB + kstep, voffB); PG8_STAGE(PG8_SA(1, 0), cA + kstep, voffA); PG8_STAGE(PG8_SB(1, 1), cB + hstep + kstep, voffB);
        PG8_WAIT_V(6); PG8_BAR;
    } else {
        PG8_STAGE(PG8_SB(0, 0), cB, voffB); PG8_STAGE(PG8_SA(0, 0), cA, voffA); PG8_STAGE(PG8_SB(0, 1), cB + hstep, voffB); PG8_STAGE(PG8_SA(0, 1), cA + hstep, voffA);
        if (wr == 1) PG8_BAR;
        PG8_WAIT_V(4); PG8_BAR;
        PG8_STAGE(PG8_SB(1, 0), cB + kstep, voffB); PG8_STAGE(PG8_SA(1, 0), cA + kstep, voffA); PG8_STAGE(PG8_SB(1, 1), cB + hstep + kstep, voffB);
        PG8_WAIT_V(6); PG8_BAR;
    }
    for (;;) {
        const bool has_next = S.next(ui + 1, nxt);
        const char* nA = has_next ? (const char*)g.A + (size_t)nxt.pm * tstep : cA; const char* nB = has_next ? (const char*)g.Bt + (size_t)nxt.pn * tstep : cB;
        for (int t = 0; t < nt; t += 2) {
            const bool last = (t == nt - 2);
            const char* a1 = cA + (size_t)(t + 1) * kstep;
            const char* a2 = last ? nA : cA + (size_t)(t + 2) * kstep; const char* b2 = last ? nB : cB + (size_t)(t + 2) * kstep;
            const char* a3 = a2 + kstep; const char* b3 = b2 + kstep;
            if (last && has_next) S.a_ready(nxt);
            if constexpr (SP2) {
            PG8_LDB(B0, 0, 0); PG8_LDB(B1, 0, 1); PG8_SCHED; PG8_LDA(At, 0, 0); PG8_STAGE(PG8_SA(1, 1), a1 + hstep, voffA);
            PG8_WAIT_V(8); PG8_WAIT_L(0); PG8_BAR; PG8_MMA(0, 0, At, B0); PG8_MMA(0, 1, At, B1); PG8_BAR; PG8_SCHED;
            PG8_LDA(At, 0, 1); PG8_STAGE(PG8_SB(0, 0), b2, voffB); PG8_STAGE(PG8_SB(0, 1), b2 + hstep, voffB); PG8_STAGE(PG8_SA(0, 0), a2, voffA);
            PG8_WAIT_V(8); PG8_WAIT_L(0); PG8_BAR; PG8_MMA(1, 0, At, B0); PG8_MMA(1, 1, At, B1); PG8_BAR; PG8_SCHED;
            PG8_LDB(B0, 1, 0); PG8_LDB(B1, 1, 1); PG8_SCHED; PG8_LDA(At, 1, 0); PG8_STAGE(PG8_SA(0, 1), a2 + hstep, voffA);
            PG8_WAIT_V(8); PG8_WAIT_L(0); PG8_BAR; PG8_MMA(0, 0, At, B0); PG8_MMA(0, 1, At, B1); PG8_BAR; PG8_SCHED;
            PG8_LDA(At, 1, 1); PG8_STAGE(PG8_SB(1, 0), b3, voffB); PG8_STAGE(PG8_SB(1, 1), b3 + hstep, voffB); PG8_STAGE(PG8_SA(1, 0), a3, voffA);
            PG8_WAIT_V(8); PG8_WAIT_L(0); PG8_BAR; PG8_MMA(1, 0, At, B0); PG8_MMA(1, 1, At, B1); PG8_BAR; PG8_SCHED;
            } else {
            PG8_LDB(B0, 0, 0); PG8_SCHED; PG8_LDA(At, 0, 0); PG8_STAGE(PG8_SA(1, 1), a1 + hstep, voffA);
            PG8_WAIT_L(8); PG8_BAR; PG8_WAIT_L(0); PG8_MMA(0, 0, At, B0); PG8_BAR; PG8_SCHED;
            PG8_LDB(B1, 0, 1); PG8_STAGE(PG8_SB(0, 0), b2, voffB);
            PG8_BAR; PG8_WAIT_L(0); PG8_MMA(0, 1, At, B1); PG8_BAR;
            PG8_LDA(At, 0, 1); PG8_STAGE(PG8_SA(0, 0), a2, voffA);
            PG8_BAR; PG8_WAIT_L(0); PG8_MMA(1, 0, At, B0); PG8_BAR; PG8_SCHED;
            PG8_STAGE(PG8_SB(0, 1), b2 + hstep, voffB);
            PG8_WAIT_V(6); PG8_BAR; PG8_MMA(1, 1, At, B1); PG8_BAR;
            PG8_LDB(B0, 1, 0); PG8_SCHED; PG8_LDA(At, 1, 0); PG8_STAGE(PG8_SA(0, 1), a2 + hstep, voffA);
            PG8_WAIT_L(8); PG8_BAR; PG8_WAIT_L(0); PG8_MMA(0, 0, At, B0); PG8_BAR; PG8_SCHED;
            PG8_LDB(B1, 1, 1); PG8_STAGE(PG8_SB(1, 0), b3, voffB);
            PG8_BAR; PG8_WAIT_L(0); PG8_MMA(0, 1, At, B1); PG8_BAR;
            PG8_LDA(At, 1, 1); PG8_STAGE(PG8_SA(1, 0), a3, voffA);
            PG8_BAR; PG8_WAIT_L(0); PG8_MMA(1, 0, At, B0); PG8_BAR; PG8_SCHED;
            PG8_STAGE(PG8_SB(1, 1), b3 + hstep, voffB);
            PG8_WAIT_V(6); PG8_BAR; PG8_MMA(1, 1, At, B1); PG8_BAR;
            }
        }
        if constexpr (ALIGN_EPI) { if (wr == 0) PG8_BAR; }
        if constexpr (!Epi::AFTER_DRAIN) { E(acc, cur, wr, wc, fr, fq); S.done(cur); }
        if (!has_next) break;
#pragma unroll
        for (int a = 0; a < 2; ++a)
#pragma unroll
            for (int b = 0; b < 2; ++b)
#pragma unroll
                for (int m = 0; m < 4; ++m)
#pragma unroll
                    for (int n = 0; n < 2; ++n) acc[a][b][m][n] = (f32x4){0.f, 0.f, 0.f, 0.f};
        cur = nxt; cA = nA; cB = nB; ++ui;
        if constexpr (ALIGN_EPI) { if (wr == 1) PG8_BAR; }
    }
    PG8_WAIT_V(0);
    if constexpr (!ALIGN_EPI) { if (wr == 0) PG8_BAR; }
    PG8_BAR;
    if constexpr (Epi::AFTER_DRAIN) { E.fused(acc, cur, wr, wc, fr, fq, lds, wid, lane); S.done(cur); }
#undef PG8_SA
#undef PG8_SB
#undef PG8_STAGE
#undef PG8_LDA
#undef PG8_LDB
#undef PG8_MMA
#undef PG8_WAIT_V
#undef PG8_WAIT_L
#undef PG8_BAR
#undef PG8_SCHED
}
}
namespace att {
typedef unsigned short bf16_t;
using bf16x8 = __attribute__((ext_vector_type(8))) short;
using s16x4  = __attribute__((ext_vector_type(4))) short;
using f32x16 = __attribute__((ext_vector_type(16))) float;
using f32x4  = __attribute__((ext_vector_type(4))) float;
using u32x4  = __attribute__((ext_vector_type(4))) unsigned;
#define KSWZ(row, colB) ((row) * 256 + ((colB) ^ (((row) & 7) << 4)))
#define ATT_SBAR() __builtin_amdgcn_sched_barrier(0)
constexpr int SHM_KV = 16384;
__device__ __forceinline__ int crow(int r, int hi) { return (r & 3) + 8 * (r >> 2) + 4 * hi; }
__device__ __forceinline__ unsigned cvtpk(float lo, float hi) { unsigned r; asm volatile("v_cvt_pk_bf16_f32 %0, %1, %2" : "=v"(r) : "v"(lo), "v"(hi)); return r; }
template <int SC1E9> __device__ __forceinline__ void partialSM(f32x16& p0, f32x16& p1, float& m_reg, float& mn, float& alpha) {
  constexpr float SCALE = (float)(SC1E9 * 1e-9), THR = 8.f, C = SCALE * 1.4426950408889634f;
  float pmax = p0[0];
#pragma unroll
  for (int r = 1; r < 16; ++r) pmax = fmaxf(pmax, p0[r]);
#pragma unroll
  for (int r = 0; r < 16; ++r) pmax = fmaxf(pmax, p1[r]);
  { auto rr = __builtin_amdgcn_permlane32_swap(__float_as_uint(pmax), __float_as_uint(pmax), false, false);
    pmax = fmaxf(__uint_as_float(rr[0]), __uint_as_float(rr[1])); }
  if (__builtin_expect(__all(pmax - m_reg <= THR / SCALE), 1)) { mn = m_reg; alpha = 1.f; }
  else { mn = fmaxf(m_reg, pmax); alpha = __builtin_amdgcn_exp2f((m_reg - mn) * C); m_reg = mn; }
  const float mnC = -mn * C;
#pragma unroll
  for (int r = 0; r < 16; ++r) p0[r] = fmaf(p0[r], C, mnC);
#pragma unroll
  for (int r = 0; r < 16; ++r) p1[r] = fmaf(p1[r], C, mnC);
#pragma unroll
  for (int r = 0; r < 16; ++r) p0[r] = __builtin_amdgcn_exp2f(p0[r]);
}
__device__ __forceinline__ void packP(const f32x16& p0, const f32x16& p1, bf16x8& pa0, bf16x8& pa1, bf16x8& pa2, bf16x8& pa3) {
#define PK4(P, BASE, OUT) do { unsigned a0 = cvtpk(P[BASE + 0], P[BASE + 1]), a1 = cvtpk(P[BASE + 2], P[BASE + 3]);   \
    unsigned b0 = cvtpk(P[BASE + 4], P[BASE + 5]), b1 = cvtpk(P[BASE + 6], P[BASE + 7]);                              \
    auto r0 = __builtin_amdgcn_permlane32_swap(a0, b0, false, false); auto r1 = __builtin_amdgcn_permlane32_swap(a1, b1, false, false); \
    u32x4 w = {r0[0], r1[0], r0[1], r1[1]}; OUT = *reinterpret_cast<bf16x8*>(&w); } while (0)
  PK4(p0, 0, pa0); PK4(p0, 8, pa1); PK4(p1, 0, pa2); PK4(p1, 8, pa3);
#undef PK4
}
__device__ __forceinline__ void finishSM(f32x16& p0, f32x16& p1, float alpha, float& l_reg, bf16x8& pa0, bf16x8& pa1, bf16x8& pa2, bf16x8& pa3) {
#pragma unroll
  for (int r = 0; r < 16; ++r) p1[r] = __builtin_amdgcn_exp2f(p1[r]);
  float ps = 0;
#pragma unroll
  for (int r = 0; r < 16; ++r) ps += p0[r];
#pragma unroll
  for (int r = 0; r < 16; ++r) ps += p1[r];
  { auto rr = __builtin_amdgcn_permlane32_swap(__float_as_uint(ps), __float_as_uint(ps), false, false);
    ps = __uint_as_float(rr[0]) + __uint_as_float(rr[1]); }
  l_reg = l_reg * alpha + ps;
  packP(p0, p1, pa0, pa1, pa2, pa3);
}
__device__ __forceinline__ void qkt(f32x16& p0, f32x16& p1, const char* Ks, const bf16x8* qr, int r32, int hi) {
  p0 = f32x16{}; p1 = f32x16{};
#pragma unroll
  for (int d0 = 0; d0 < 8; ++d0) { const int cb = (d0 * 16 + hi * 8) * 2;
    const bf16x8 b0 = *reinterpret_cast<const bf16x8*>(Ks + KSWZ(r32, cb));
    const bf16x8 b1 = *reinterpret_cast<const bf16x8*>(Ks + KSWZ(32 + r32, cb));
    p0 = __builtin_amdgcn_mfma_f32_32x32x16_bf16(b0, qr[d0], p0, 0, 0, 0);
    p1 = __builtin_amdgcn_mfma_f32_32x32x16_bf16(b1, qr[d0], p1, 0, 0, 0); }
}
__device__ __forceinline__ void qkt_rope(f32x16& p0, f32x16& p1, const char* Kr, const bf16x8* qr, int r32, int hi) {
#pragma unroll
  for (int d0 = 0; d0 < 4; ++d0) { const int cb = ((d0 * 16 + hi * 8) * 2) ^ ((r32 & 7) << 4);
    const bf16x8 b0 = *reinterpret_cast<const bf16x8*>(Kr + r32 * 128 + cb);
    const bf16x8 b1 = *reinterpret_cast<const bf16x8*>(Kr + (32 + r32) * 128 + cb);
    p0 = __builtin_amdgcn_mfma_f32_32x32x16_bf16(b0, qr[d0], p0, 0, 0, 0);
    p1 = __builtin_amdgcn_mfma_f32_32x32x16_bf16(b1, qr[d0], p1, 0, 0, 0); }
}
__device__ __forceinline__ int v_st(int k, int c) { const int kk = (k & ~0xC) | ((k & 4) << 1) | ((k & 8) >> 1); return ((kk >> 3) * 4 + (c >> 5)) * 512 + ((kk & 7) * 32 + (c & 31)) * 2; }
__device__ __forceinline__ int v_rd_base(int lane) { return ((lane & 3) << 3) | (((lane >> 2) & 3) << 6) | (((lane >> 4) & 1) << 5) | (((lane >> 5) & 1) << 8); }
constexpr int v_rd_off(int d0, int ks, int half) { return d0 * 512 + ks * 4096 + half * 2048; }
template <int OFF> __device__ __forceinline__ s16x4 tr_read(int vb) {
  s16x4 r; asm volatile("ds_read_b64_tr_b16 %0, %1 offset:%2" : "=&v"(r) : "v"(vb), "i"(OFF) : "memory"); return r;
}
template <int D0> __device__ __forceinline__ void pv_one(f32x16& od, int vb, bf16x8 pa0, bf16x8 pa1, bf16x8 pa2, bf16x8 pa3) {
  const s16x4 l0 = tr_read<v_rd_off(D0, 0, 0)>(vb), h0 = tr_read<v_rd_off(D0, 0, 1)>(vb), l1 = tr_read<v_rd_off(D0, 1, 0)>(vb), h1 = tr_read<v_rd_off(D0, 1, 1)>(vb);
  const s16x4 l2 = tr_read<v_rd_off(D0, 2, 0)>(vb), h2 = tr_read<v_rd_off(D0, 2, 1)>(vb), l3 = tr_read<v_rd_off(D0, 3, 0)>(vb), h3 = tr_read<v_rd_off(D0, 3, 1)>(vb);
  asm volatile("s_waitcnt lgkmcnt(0)" ::: "memory"); ATT_SBAR();
#define PK(L, H) (bf16x8){L[0], L[1], L[2], L[3], H[0], H[1], H[2], H[3]}
  od = __builtin_amdgcn_mfma_f32_32x32x16_bf16(pa0, PK(l0, h0), od, 0, 0, 0);
  od = __builtin_amdgcn_mfma_f32_32x32x16_bf16(pa1, PK(l1, h1), od, 0, 0, 0);
  od = __builtin_amdgcn_mfma_f32_32x32x16_bf16(pa2, PK(l2, h2), od, 0, 0, 0);
  od = __builtin_amdgcn_mfma_f32_32x32x16_bf16(pa3, PK(l3, h3), od, 0, 0, 0);
#undef PK
}
__device__ __forceinline__ void pv_d0(f32x16* o, int vb, bf16x8 pa0, bf16x8 pa1, bf16x8 pa2, bf16x8 pa3) {
  pv_one<0>(o[0], vb, pa0, pa1, pa2, pa3); pv_one<1>(o[1], vb, pa0, pa1, pa2, pa3); pv_one<2>(o[2], vb, pa0, pa1, pa2, pa3); pv_one<3>(o[3], vb, pa0, pa1, pa2, pa3);
}
#define ATT_RESC(a) do { if (__any((a) < 1.f)) { if (hi == 0) al_l[r32] = (a); asm volatile("s_waitcnt lgkmcnt(0)" ::: "memory"); \
    _Pragma("unroll") for (int d = 0; d < 4; ++d) _Pragma("unroll") for (int r = 0; r < 16; ++r) o[d][r] *= al_l[crow(r, hi)]; } } while (0)
__device__ __forceinline__ void store_o(const f32x16* o, const float* rli, bf16_t* stg, bf16_t* Og  , int ldo, int lane, int r32, int hi) {
#pragma unroll
  for (int r = 0; r < 16; ++r) { const int orow = crow(r, hi);
#pragma unroll
    for (int d0 = 0; d0 < 4; ++d0) stg[orow * 128 + d0 * 32 + r32] = (bf16_t)(cvtpk(o[d0][r] * rli[r], 0.f) & 0xffffu); }
  asm volatile("s_waitcnt lgkmcnt(0)" ::: "memory");
#pragma unroll
  for (int i = 0; i < 8; ++i) { const int row = i * 4 + (lane >> 4), ch = lane & 15; const u32x4 v = *(const u32x4*)(stg + row * 128 + ch * 8); *(u32x4*)(Og + (size_t)row * ldo + ch * 8) = v; }
}

__device__ __forceinline__ void dsa_attn_unit(int b, int g, int c, const bf16_t* __restrict__ Q, const bf16_t* __restrict__ K, const bf16_t* __restrict__ V,
                                              const unsigned long long* __restrict__ MASK, bf16_t* __restrict__ O, char* lds) {
  const int tid = threadIdx.x, wid = __builtin_amdgcn_readfirstlane(tid >> 6), lane = tid & 63, r32 = lane & 31, hi = lane >> 5;
  char* V_lds = lds; char* K_lds = lds + 2 * SHM_KV;
  float* ws = (float*)(lds + 4 * SHM_KV) + wid * 64; float* li_l = ws; float* al_l = ws + 32;
  const int head = 4 * g + (wid >> 1);
  const long qrow0 = (long)b * 4096 + 64 * c + 32 * (wid & 1), qrow = qrow0 + r32;
  bf16x8 qr[8];
  { const bf16_t* Qw = Q + qrow * 2048 + head * 128 + hi * 8;
#pragma unroll
    for (int d0 = 0; d0 < 8; ++d0) qr[d0] = *reinterpret_cast<const bf16x8*>(Qw + d0 * 16); }
  const int sr = tid >> 4, sc = (tid & 15) * 8, vst0 = v_st(sr, sc), vst1 = v_st(32 + sr, sc);
  const int vb0 = (int)(uintptr_t)V_lds + v_rd_base(lane);
  const bf16_t* Kh = K + (long)b * 4096 * 512 + g * 128; const bf16_t* Vh = V + (long)b * 4096 * 512 + g * 128;
  bf16x8 vs0, vs1, ks0, ks1;
#define SLOAD(k0) do { vs0 = *reinterpret_cast<const bf16x8*>(Vh + (long)((k0) + sr) * 512 + sc); vs1 = *reinterpret_cast<const bf16x8*>(Vh + (long)((k0) + 32 + sr) * 512 + sc); \
    ks0 = *reinterpret_cast<const bf16x8*>(Kh + (long)((k0) + sr) * 512 + sc); ks1 = *reinterpret_cast<const bf16x8*>(Kh + (long)((k0) + 32 + sr) * 512 + sc); } while (0)
#define SWRITE(bf) do { *(bf16x8*)(V_lds + (bf) * SHM_KV + vst0) = vs0; *(bf16x8*)(V_lds + (bf) * SHM_KV + vst1) = vs1; \
    *(bf16x8*)(K_lds + (bf) * SHM_KV + KSWZ(sr, sc * 2)) = ks0; *(bf16x8*)(K_lds + (bf) * SHM_KV + KSWZ(32 + sr, sc * 2)) = ks1; } while (0)
  const int NT = c + 1;
  float m_reg = -1e30f, l_reg = 0.f; f32x16 o[4];
#pragma unroll
  for (int d = 0; d < 4; ++d) o[d] = f32x16{};
  const unsigned long long* mrow = MASK + qrow * 64;
  SLOAD(0); SWRITE(0); if (NT > 1) SLOAD(64);
  unsigned long long mw = mrow[0];
  for (int j = 0; j < NT; ++j) {
    __syncthreads();
    if (j + 1 < NT) SWRITE((j + 1) & 1);
    if (j + 2 < NT) SLOAD((j + 2) * 64);
    const unsigned long long mw_next = (j + 1 < NT) ? mrow[j + 1] : 0ull;
    f32x16 p0, p1; qkt(p0, p1, K_lds + (j & 1) * SHM_KV, qr, r32, hi);
    { const unsigned mlo = (unsigned)mw >> (4 * hi), mhi = (unsigned)(mw >> 32) >> (4 * hi);
#pragma unroll
      for (int r = 0; r < 16; ++r) { const int cb = (r & 3) + 8 * (r >> 2);
        p0[r] = ((mlo >> cb) & 1u) ? p0[r] : -INFINITY; p1[r] = ((mhi >> cb) & 1u) ? p1[r] : -INFINITY; } }
    float mn, alpha; partialSM<88388348>(p0, p1, m_reg, mn, alpha);
    bf16x8 pa0, pa1, pa2, pa3; finishSM(p0, p1, alpha, l_reg, pa0, pa1, pa2, pa3);
    ATT_RESC(alpha);
    pv_d0(o, vb0 + (j & 1) * SHM_KV, pa0, pa1, pa2, pa3);
    mw = mw_next;
  }
  if (hi == 0) li_l[r32] = l_reg; asm volatile("s_waitcnt lgkmcnt(0)" ::: "memory");
  float rli[16];
#pragma unroll
  for (int r = 0; r < 16; ++r) rli[r] = __builtin_amdgcn_rcpf(li_l[crow(r, hi)]);
  __syncthreads();
  store_o(o, rli, (bf16_t*)(lds + wid * 8192), O + qrow0 * 2048 + head * 128, 2048, lane, r32, hi);
  __syncthreads();
#undef SLOAD
#undef SWRITE
}

__device__ __forceinline__ void mla_attn_unit(int b, int h, int qb, const bf16_t* __restrict__ QN, const bf16_t* __restrict__ QR, const bf16_t* __restrict__ KN, const bf16_t* __restrict__ KR,
                                              const bf16_t* __restrict__ V, bf16_t* __restrict__ O, char* lds) {
  const int tid = threadIdx.x, wid = __builtin_amdgcn_readfirstlane(tid >> 6), lane = tid & 63, r32 = lane & 31, hi = lane >> 5;
  char* V_lds = lds; char* K_lds = lds + 2 * SHM_KV; char* R_lds = lds + 4 * SHM_KV;
  float* ws = (float*)(lds + 4 * SHM_KV + 16384) + wid * 64; float* li_l = ws; float* al_l = ws + 32;
  const long qrow0 = (long)b * 4096 + 256 * qb + 32 * wid, qrow = qrow0 + r32;
  bf16x8 qr[12];
  { const bf16_t* Qw = QN + qrow * 2048 + h * 128 + hi * 8;
#pragma unroll
    for (int d0 = 0; d0 < 8; ++d0) qr[d0] = *reinterpret_cast<const bf16x8*>(Qw + d0 * 16);
    const bf16_t* Qx = QR + qrow * 1024 + h * 64 + hi * 8;
#pragma unroll
    for (int d0 = 0; d0 < 4; ++d0) qr[8 + d0] = *reinterpret_cast<const bf16x8*>(Qx + d0 * 16); }
  const int sr = tid >> 4, sc = (tid & 15) * 8, vst0 = v_st(sr, sc), vst1 = v_st(32 + sr, sc);
  const int rr_ = tid >> 3, rc = (tid & 7) * 8, rst = rr_ * 128 + ((rc * 2) ^ ((rr_ & 7) << 4));
  const int vb0 = (int)(uintptr_t)V_lds + v_rd_base(lane);
  const bf16_t* Kh = KN + (long)b * 4096 * 2048 + h * 128; const bf16_t* Vh = V + (long)b * 4096 * 2048 + h * 128; const bf16_t* Rh = KR + (long)b * 4096 * 64;
  bf16x8 vs0, vs1, ks0, ks1, rs0;
#define SLOAD(k0) do { vs0 = *reinterpret_cast<const bf16x8*>(Vh + (long)((k0) + sr) * 2048 + sc); vs1 = *reinterpret_cast<const bf16x8*>(Vh + (long)((k0) + 32 + sr) * 2048 + sc); \
    ks0 = *reinterpret_cast<const bf16x8*>(Kh + (long)((k0) + sr) * 2048 + sc); ks1 = *reinterpret_cast<const bf16x8*>(Kh + (long)((k0) + 32 + sr) * 2048 + sc); \
    rs0 = *reinterpret_cast<const bf16x8*>(Rh + (long)((k0) + rr_) * 64 + rc); } while (0)
#define SWRITE(bf) do { *(bf16x8*)(V_lds + (bf) * SHM_KV + vst0) = vs0; *(bf16x8*)(V_lds + (bf) * SHM_KV + vst1) = vs1; \
    *(bf16x8*)(K_lds + (bf) * SHM_KV + KSWZ(sr, sc * 2)) = ks0; *(bf16x8*)(K_lds + (bf) * SHM_KV + KSWZ(32 + sr, sc * 2)) = ks1; \
    *(bf16x8*)(R_lds + (bf) * 8192 + rst) = rs0; } while (0)
  const int NT = 4 * qb + 4, NTw = 4 * qb + (wid >> 1) + 1;
  float m_reg = -1e30f, l_reg = 0.f; f32x16 o[4];
#pragma unroll
  for (int d = 0; d < 4; ++d) o[d] = f32x16{};
  SLOAD(0); SWRITE(0); SLOAD(64);
  for (int j = 0; j < NT; ++j) {
    __syncthreads();
    if (j + 1 < NT) SWRITE((j + 1) & 1);
    if (j + 2 < NT) SLOAD((j + 2) * 64);
    if (j < NTw) {
      f32x16 p0, p1; qkt(p0, p1, K_lds + (j & 1) * SHM_KV, qr, r32, hi); qkt_rope(p0, p1, R_lds + (j & 1) * 8192, qr + 8, r32, hi);
      float mn, alpha; partialSM<72168784>(p0, p1, m_reg, mn, alpha);
      bf16x8 pa0, pa1, pa2, pa3; finishSM(p0, p1, alpha, l_reg, pa0, pa1, pa2, pa3);
      ATT_RESC(alpha);
      pv_d0(o, vb0 + (j & 1) * SHM_KV, pa0, pa1, pa2, pa3);
    }
  }
  if (hi == 0) li_l[r32] = l_reg; asm volatile("s_waitcnt lgkmcnt(0)" ::: "memory");
  float rli[16];
#pragma unroll
  for (int r = 0; r < 16; ++r) rli[r] = __builtin_amdgcn_rcpf(li_l[crow(r, hi)]);
  __syncthreads();
  store_o(o, rli, (bf16_t*)(lds + wid * 8192), O + qrow0 * 2048 + h * 128, 2048, lane, r32, hi);
  __syncthreads();
#undef SLOAD
#undef SWRITE
}

__device__ __forceinline__ void sb_attn_unit(int b, int h, int qb, const bf16_t* __restrict__ Q, const bf16_t* __restrict__ K, const bf16_t* __restrict__ V, bf16_t* __restrict__ O, char* lds) {
  const int tid = threadIdx.x, wid = __builtin_amdgcn_readfirstlane(tid >> 6), lane = tid & 63, r32 = lane & 31, hi = lane >> 5;
  char* V_lds = lds; char* K_lds = lds + 2 * SHM_KV;
  volatile __attribute__((address_space(3))) int* fl = (volatile __attribute__((address_space(3))) int*)(lds + 4 * SHM_KV + 2048);
  const int tw0 = 256 * qb + 32 * wid, t = tw0 + r32;
  const long qrow0 = (long)b * 4096 + tw0, qrow = qrow0 + r32;
  bf16x8 qr[8];
  { const bf16_t* Qw = Q + qrow * 2048 + h * 128 + hi * 8;
#pragma unroll
    for (int d0 = 0; d0 < 8; ++d0) qr[d0] = *reinterpret_cast<const bf16x8*>(Qw + d0 * 16); }
  const int sr = tid >> 4, sc = (tid & 15) * 8, vst0 = v_st(sr, sc), vst1 = v_st(32 + sr, sc);
  const int vb0 = (int)(uintptr_t)V_lds + v_rd_base(lane);
  const bf16_t* Kh = K + (long)b * 4096 * 2048 + h * 128; const bf16_t* Vh = V + (long)b * 4096 * 2048 + h * 128;
  bf16x8 vs0, vs1, ks0, ks1;
#define SLOAD(k0) do { vs0 = *reinterpret_cast<const bf16x8*>(Vh + (long)((k0) + sr) * 2048 + sc); vs1 = *reinterpret_cast<const bf16x8*>(Vh + (long)((k0) + 32 + sr) * 2048 + sc); \
    ks0 = *reinterpret_cast<const bf16x8*>(Kh + (long)((k0) + sr) * 2048 + sc); ks1 = *reinterpret_cast<const bf16x8*>(Kh + (long)((k0) + 32 + sr) * 2048 + sc); } while (0)
#define SWRITE(bf) do { *(bf16x8*)(V_lds + (bf) * SHM_KV + vst0) = vs0; *(bf16x8*)(V_lds + (bf) * SHM_KV + vst1) = vs1; \
    *(bf16x8*)(K_lds + (bf) * SHM_KV + KSWZ(sr, sc * 2)) = ks0; *(bf16x8*)(K_lds + (bf) * SHM_KV + KSWZ(32 + sr, sc * 2)) = ks1; } while (0)
  const int NT = 4 * qb + 4;
  constexpr float C = 0.08838834764831845f * 1.4426950408889634f;
  float Rp = 1.f; bool wdone = false; f32x16 o[4];
#pragma unroll
  for (int d = 0; d < 4; ++d) o[d] = f32x16{};
  SLOAD((NT - 1) * 64); SWRITE(0); SLOAD((NT - 2) * 64);
  for (int j = 0; j < NT; ++j) {
    __syncthreads();
    if (j > 0) { int all = 1;
#pragma unroll
      for (int w = 0; w < 8; ++w) all &= fl[((j - 1) & 1) * 8 + w];
      if (all) break; }
    if (j + 1 < NT) SWRITE((j + 1) & 1);
    if (j + 2 < NT) SLOAD((NT - 3 - j) * 64);
    const int T = NT - 1 - j;
    if (64 * T <= tw0 + 30 && !wdone) {
      f32x16 p0, p1; qkt(p0, p1, K_lds + (j & 1) * SHM_KV, qr, r32, hi);
      f32x16 k0, k1;
      const bool needmask = (64 * T + 63 >= tw0);
#pragma unroll
      for (int r = 0; r < 16; ++r) {
        { const float z = p0[r] * C, e = __builtin_amdgcn_exp2f(-fabsf(z)), big = __builtin_amdgcn_rcpf(1.f + e), sml = e * big; float be = z >= 0.f ? big : sml, ke = z >= 0.f ? sml : big;
          if (needmask && (64 * T + crow(r, hi) >= t)) { be = 0.f; ke = 1.f; } p0[r] = be; k0[r] = ke; }
        { const float z = p1[r] * C, e = __builtin_amdgcn_exp2f(-fabsf(z)), big = __builtin_amdgcn_rcpf(1.f + e), sml = e * big; float be = z >= 0.f ? big : sml, ke = z >= 0.f ? sml : big;
          if (needmask && (64 * T + 32 + crow(r, hi) >= t)) { be = 0.f; ke = 1.f; } p1[r] = be; k1[r] = ke; }
      }
      float GP[16];
#pragma unroll
      for (int q = 0; q < 4; ++q) {
        const float g0 = (k0[4 * q] * k0[4 * q + 1]) * (k0[4 * q + 2] * k0[4 * q + 3]), g1 = (k1[4 * q] * k1[4 * q + 1]) * (k1[4 * q + 2] * k1[4 * q + 3]);
        auto x0 = __builtin_amdgcn_permlane32_swap(__float_as_uint(g0), __float_as_uint(g0), false, false);
        auto x1 = __builtin_amdgcn_permlane32_swap(__float_as_uint(g1), __float_as_uint(g1), false, false);
        GP[2 * q] = __uint_as_float(x0[0]); GP[2 * q + 1] = __uint_as_float(x0[1]); GP[8 + 2 * q] = __uint_as_float(x1[0]); GP[8 + 2 * q + 1] = __uint_as_float(x1[1]);
      }
      float SG[16]; SG[15] = 1.f;
#pragma unroll
      for (int g = 14; g >= 0; --g) SG[g] = SG[g + 1] * GP[g + 1];
      const float tileprod = SG[0] * GP[0];
#pragma unroll
      for (int q = 0; q < 4; ++q) {
        { const float base = Rp * (hi ? SG[2 * q + 1] : SG[2 * q]); const float w2 = k0[4 * q + 3], w1 = w2 * k0[4 * q + 2], w0 = w1 * k0[4 * q + 1];
          p0[4 * q + 3] *= base; p0[4 * q + 2] *= base * w2; p0[4 * q + 1] *= base * w1; p0[4 * q] *= base * w0; }
        { const float base = Rp * (hi ? SG[8 + 2 * q + 1] : SG[8 + 2 * q]); const float w2 = k1[4 * q + 3], w1 = w2 * k1[4 * q + 2], w0 = w1 * k1[4 * q + 1];
          p1[4 * q + 3] *= base; p1[4 * q + 2] *= base * w2; p1[4 * q + 1] *= base * w1; p1[4 * q] *= base * w0; }
      }
      Rp *= tileprod;
      bf16x8 pa0, pa1, pa2, pa3; packP(p0, p1, pa0, pa1, pa2, pa3);
      pv_d0(o, vb0 + (j & 1) * SHM_KV, pa0, pa1, pa2, pa3);
      wdone = __all(Rp == 0.f);
    }
    if (lane == 0) fl[(j & 1) * 8 + wid] = wdone ? 1 : 0;
  }
  float rli[16];
#pragma unroll
  for (int r = 0; r < 16; ++r) rli[r] = 1.f;
  __syncthreads();
  store_o(o, rli, (bf16_t*)(lds + wid * 8192), O + qrow0 * 2048 + h * 128, 2048, lane, r32, hi);
  __syncthreads();
#undef SLOAD
#undef SWRITE
}

__device__ __forceinline__ void idx_unit(int b, int qq, const bf16_t* __restrict__ IQ, const bf16_t* __restrict__ IK, const float* __restrict__ IW, float* __restrict__ SC, char* lds) {
  const int tid = threadIdx.x, wid = __builtin_amdgcn_readfirstlane(tid >> 6), lane = tid & 63, r32 = lane & 31, hi = lane >> 5;
  char* K_lds = lds;
  const int c = qq >> 1, NT = c + 1;
  const long t0 = (long)b * 4096 + 32 * qq + 4 * wid;
  bf16x8 a[2][8]; float wgt[2][16];
#pragma unroll
  for (int rt = 0; rt < 2; ++rt) {
    const long qa = t0 + 2 * rt + ((r32 >> 2) & 1); const int ha = (r32 & 3) + 4 * (r32 >> 3);
    const bf16_t* p = IQ + qa * 2048 + ha * 128 + hi * 8;
#pragma unroll
    for (int ks = 0; ks < 8; ++ks) a[rt][ks] = *reinterpret_cast<const bf16x8*>(p + ks * 16);
    const float* wp = IW + (t0 + 2 * rt + hi) * 16;
#pragma unroll
    for (int i4 = 0; i4 < 4; ++i4) { const f32x4 w4 = *(const f32x4*)(wp + 4 * i4); wgt[rt][4 * i4] = w4[0]; wgt[rt][4 * i4 + 1] = w4[1]; wgt[rt][4 * i4 + 2] = w4[2]; wgt[rt][4 * i4 + 3] = w4[3]; }
  }
  const int sr = tid >> 4, sc = (tid & 15) * 8;
  const bf16_t* Kb = IK + (long)b * 4096 * 128;
  bf16x8 ks0, ks1;
#define SLOAD(k0) do { ks0 = *reinterpret_cast<const bf16x8*>(Kb + (long)((k0) + sr) * 128 + sc); ks1 = *reinterpret_cast<const bf16x8*>(Kb + (long)((k0) + 32 + sr) * 128 + sc); } while (0)
#define SWRITE(bf) do { *(bf16x8*)(K_lds + (bf) * SHM_KV + KSWZ(sr, sc * 2)) = ks0; *(bf16x8*)(K_lds + (bf) * SHM_KV + KSWZ(32 + sr, sc * 2)) = ks1; } while (0)
  SLOAD(0); SWRITE(0); if (NT > 1) SLOAD(64);
  for (int j = 0; j < NT; ++j) {
    __syncthreads();
    if (j + 1 < NT) SWRITE((j + 1) & 1);
    if (j + 2 < NT) SLOAD((j + 2) * 64);
    const char* Kt = K_lds + (j & 1) * SHM_KV;
#pragma unroll
    for (int kh = 0; kh < 2; ++kh) {
      bf16x8 bfr[8];
#pragma unroll
      for (int ks = 0; ks < 8; ++ks) bfr[ks] = *reinterpret_cast<const bf16x8*>(Kt + KSWZ(32 * kh + r32, (ks * 16 + hi * 8) * 2));
#pragma unroll
      for (int rt = 0; rt < 2; ++rt) {
        f32x16 acc = f32x16{};
#pragma unroll
        for (int ks = 0; ks < 8; ++ks) acc = __builtin_amdgcn_mfma_f32_32x32x16_bf16(a[rt][ks], bfr[ks], acc, 0, 0, 0);
        float s = 0.f;
#pragma unroll
        for (int i = 0; i < 16; ++i) s += wgt[rt][i] * fmaxf(acc[i], 0.f);
        SC[(t0 + 2 * rt + hi) * 4096 + 64 * j + 32 * kh + r32] = s;
      }
    }
  }
  __syncthreads();
#undef SLOAD
#undef SWRITE
}

__device__ __forceinline__ int wave_sum_i(int v) {
#pragma unroll
  for (int o = 1; o < 64; o <<= 1) v += __shfl_xor(v, o);
  return v;
}
__device__ __forceinline__ void topk_row(const float* __restrict__ sc_row, int c, unsigned long long* __restrict__ mask_row, int lane) {
  unsigned key[64];
#pragma unroll
  for (int j = 0; j < 64; ++j) { unsigned k = 0u;
    if (j <= c) { const unsigned u = __float_as_uint(sc_row[j * 64 + lane]); k = (u & 0x80000000u) ? ~u : (u | 0x80000000u); }
    key[j] = k; }
  unsigned long long mine = 0ull;
  if (c < 4) {
    mine = (lane <= c) ? ~0ull : 0ull;
  } else {
    unsigned T = 0u; bool exact = false;
    for (int bit = 31; bit >= 0; --bit) {
      const unsigned cand = T | (1u << bit); int cnt = 0;
#pragma unroll
      for (int j = 0; j < 64; ++j) cnt += (key[j] >= cand) ? 1 : 0;
      cnt = wave_sum_i(cnt);
      if (cnt >= 256) { T = cand; if (cnt == 256) { exact = true; break; } }
    }
    if (exact) {
#pragma unroll
      for (int j = 0; j < 64; ++j) { const unsigned long long m = __ballot(key[j] >= T); if (lane == j) mine = m; ATT_SBAR(); }
    } else {
      int gt = 0;
#pragma unroll
      for (int j = 0; j < 64; ++j) gt += (key[j] > T) ? 1 : 0;
      int need = 256 - wave_sum_i(gt);
#pragma unroll
      for (int j = 0; j < 64; ++j) {
        const unsigned long long g = __ballot(key[j] > T); unsigned long long e = __ballot(key[j] == T), take = 0ull;
        const int pe = __popcll(e);
        if (pe <= need) { take = e; need -= pe; } else { while (need > 0) { const unsigned long long lowb = e & (~e + 1ull); take |= lowb; e ^= lowb; --need; } }
        if (lane == j) mine = g | take;
        ATT_SBAR();
      }
    }
  }
  mask_row[lane] = mine;
}
#undef KSWZ
}

constexpr int NWAVES = 8;
constexpr int BATCH = 4, SEQ = 4096, DM = 2048, DFF = 5632, M = BATCH * SEQ;
constexpr int DSA_NP = 5376, MLA_DOWN_NP = 1280;
constexpr int NPH = 35;
#ifndef MK_ONE_LAUNCH
#define MK_ONE_LAUNCH 0
#endif
constexpr size_t MiB = 1u << 20;
constexpr size_t WS_CTL = 0, CTL_ZERO_BYTES = 1 * MiB;
constexpr size_t WS_MODS = 1 * MiB;
constexpr size_t WS_CS128 = 2 * MiB;
constexpr size_t WS_CS64 = 4 * MiB;
constexpr size_t WS_SSQ = 5 * MiB;
constexpr size_t WS_W = 6 * MiB;
constexpr size_t WL_STRIDE = 74 * MiB, WL_FFN1 = 0, WL_FFN2 = 44 * MiB, WL_OUT = 66 * MiB;
constexpr size_t WS_WDSA = WS_W + 4 * WL_STRIDE, WDSA_STRIDE = 21 * MiB;
constexpr size_t WS_WMLA = WS_WDSA + 2 * WDSA_STRIDE, WMLA_DOWN = 0, WMLA_UQ = 5 * MiB, WMLA_UKV = 8 * MiB;
constexpr size_t WS_WSB = WS_WMLA + 12 * MiB;
constexpr size_t WS_H = WS_WSB + 24 * MiB;
constexpr size_t WS_O = WS_H + 64 * MiB;
constexpr size_t WS_MIX = WS_O + 64 * MiB;
constexpr size_t MX_ACT = 0;
constexpr size_t MX_DQ = 0, MX_DK = 64 * MiB, MX_DV = 80 * MiB, MX_DIQ = 96 * MiB, MX_DIK = 160 * MiB, MX_DIW = 164 * MiB, MX_DMASK = 165 * MiB, MX_DSC = 176 * MiB;
constexpr size_t MX_MCQ = 0, MX_MCKV = 16 * MiB, MX_MKR = 32 * MiB, MX_MQN = 34 * MiB, MX_MQR = 98 * MiB, MX_MKN = 130 * MiB, MX_MV = 194 * MiB;
constexpr size_t MX_SQ = 0, MX_SK = 64 * MiB, MX_SV = 128 * MiB;
constexpr size_t WS_END = WS_MIX + 432 * MiB;
static_assert(WS_W + 380 * MiB - 6 * MiB == WS_H, "weight map");
constexpr int CW_TMO = 0, CW_BAR = 4096;
constexpr int RING_BYTES = 131072, LDSCTL_OFF = RING_BYTES, MISC_OFF = LDSCTL_OFF + 320, LDS_BYTES = 147456;

#define GAS __attribute__((address_space(1)))
#define LAS __attribute__((address_space(3)))
typedef unsigned short bf16;
typedef unsigned v4u __attribute__((ext_vector_type(4)));
typedef float f32x4 __attribute__((ext_vector_type(4)));
typedef GAS unsigned gu32;
#define RLX_AGENT __ATOMIC_RELAXED, __HIP_MEMORY_SCOPE_AGENT
#define LDS_WAIT() asm volatile("s_waitcnt lgkmcnt(0)" ::: "memory")
__device__ __forceinline__ unsigned f2bf(float f) { unsigned u = __builtin_bit_cast(unsigned, f); return (u + 0x7fffu + ((u >> 16) & 1u)) >> 16; }
__device__ __forceinline__ unsigned pk2(float lo, float hi) { return f2bf(lo) | (f2bf(hi) << 16); }

#define XB_TMO      128
#define XB_XCNT(j)  (256  + 64 * (j))
#define XB_XSUB(j)  (1280 + 64 * (j))
#define XB_XGEN(j)  (2304 + 64 * (j))
#define XB_TOP      3328
#define XB_TOPGEN   3392
#define XCD_BAR_WORDS 3456
#define XB_SPIN_CAP (1u << 18)

__device__ __forceinline__ unsigned xb_ld(unsigned* p)              { return __hip_atomic_load(p, __ATOMIC_RELAXED, __HIP_MEMORY_SCOPE_AGENT); }
__device__ __forceinline__ unsigned xb_add(unsigned* p, unsigned v) { return __hip_atomic_fetch_add(p, v, __ATOMIC_RELAXED, __HIP_MEMORY_SCOPE_AGENT); }
__device__ __forceinline__ unsigned xb_xcc_id() { return (unsigned)__builtin_amdgcn_s_getreg((3 << 11) | 20) & 0xFu; }
#define XB_SPIN(cond, bar) do { unsigned _sp = 0; while (cond) { __builtin_amdgcn_s_sleep(1); \
    if ((++_sp & 255u) == 0u) { if (xb_ld(&(bar)[XB_TMO])) break; if (_sp > XB_SPIN_CAP) { atomicAdd(&(bar)[XB_TMO], 1u); break; } } } } while (0)

struct XcdBarrier {
    unsigned* bar; unsigned x;
    volatile LAS unsigned* st;
};

__device__ __forceinline__ XcdBarrier xcd_barrier_post(unsigned* bar, volatile LAS unsigned* st) {
    XcdBarrier b; b.bar = bar; b.x = xb_xcc_id(); b.st = st;
    if (threadIdx.x == 0) (void)xb_add(&bar[XB_XCNT(b.x)], 1u);
    return b;
}
__device__ __forceinline__ void xcd_barrier_complete(unsigned* bar, unsigned x, unsigned& nloc, unsigned& nx) {
    const unsigned G = gridDim.x * gridDim.y * gridDim.z;
    unsigned sum, cnt, mine, sp = 0u;
    for (;;) {
        sum = 0u; cnt = 0u; mine = 0u;
#pragma unroll
        for (unsigned j = 0; j < 16; ++j) { const unsigned c = xb_ld(&bar[XB_XCNT(j)]); sum += c; cnt += (c > 0u) ? 1u : 0u; mine = (j == x) ? c : mine; }
        if (sum == G) break;
        __builtin_amdgcn_s_sleep(1);
        if ((++sp & 255u) == 0u) { if (xb_ld(&bar[XB_TMO])) break; if (sp > XB_SPIN_CAP) { atomicAdd(&bar[XB_TMO], 1u); break; } }
    }
    nloc = mine > 0u ? mine : 1u; nx = cnt > 0u ? cnt : 1u;
}

__device__ __forceinline__ void xcd_barrier(const XcdBarrier& b) {
    asm volatile("s_waitcnt vmcnt(0)" ::: "memory");
    __syncthreads();
    if (threadIdx.x == 0) {
        unsigned* bar = b.bar;
        __builtin_amdgcn_s_waitcnt(0);
        unsigned nloc = b.st[0], nx = b.st[1];
        if (nloc == 0u) { xcd_barrier_complete(bar, b.x, nloc, nx); b.st[0] = nloc; b.st[1] = nx; }
        const unsigned old = xb_add(&bar[XB_XSUB(b.x)], 1u);
        const unsigned gen = old / nloc;
        if (old + 1u == (gen + 1u) * nloc) {
            __builtin_amdgcn_fence(__ATOMIC_RELEASE, "agent");
            asm volatile("s_waitcnt vmcnt(0)" ::: "memory");
            const unsigned og = xb_add(&bar[XB_TOP], 1u);
            const unsigned tg = og / nx;
            if (og + 1u == (tg + 1u) * nx) xb_add(&bar[XB_TOPGEN], 1u);
            else XB_SPIN(xb_ld(&bar[XB_TOPGEN]) == tg, bar);
            __builtin_amdgcn_fence(__ATOMIC_ACQUIRE, "agent");
            xb_add(&bar[XB_XGEN(b.x)], 1u);
            asm volatile("s_waitcnt vmcnt(0)" ::: "memory");
        } else {
            XB_SPIN(xb_ld(&bar[XB_XGEN(b.x)]) == gen, bar);
            __builtin_amdgcn_fence(__ATOMIC_ACQUIRE, "agent");
            asm volatile("s_waitcnt vmcnt(0)" ::: "memory");
        }
    }
    __syncthreads();
}

struct Frame {
    LAS unsigned char* lds;
    volatile LAS unsigned* MISC;
    gu32* ctl;
    int tid, lane, wave;
    int vcu, G;
};
__device__ __forceinline__ float wave_sum(float v) {
#pragma unroll
    for (int o = 1; o < 64; o <<= 1) v += __shfl_xor(v, o);
    return v;
}
enum { KIND_ID = 0, KIND_DSA_IN = 1, KIND_MLA_DOWN = 2, KIND_MLA_UQ = 3, KIND_FFN1 = 4 };
__host__ __device__ __forceinline__ int srcblk(int kind, int nb, int& nvalid) {
    nvalid = 32;
    const int pn = nb >> 3, pb = nb & 7, bj = pb >> 2, wc = pb & 3;
    if (kind == KIND_ID) return nb * 32;
    if (kind == KIND_DSA_IN) {
        if (pn < 8)  return (2 * pn + (wc >> 1)) * 128 + 64 * bj + 32 * (wc & 1);
        if (pn < 10) return 2048 + (2 * (pn - 8) + (wc >> 1)) * 128 + 64 * bj + 32 * (wc & 1);
        if (pn < 12) return 2560 + (pn - 10) * 256 + 32 * pb;
        if (pn < 20) return 3072 + (2 * (pn - 12) + (wc >> 1)) * 128 + (wc & 1) * 64 + bj * 32;
        if (wc == 0) return 5120 + bj * 32;
        if (wc == 1) return 5120 + 64 + bj * 32;
        if (wc == 2 && bj == 0) { nvalid = 16; return 5248; }
        return -1;
    }
    if (kind == KIND_MLA_DOWN) { if (pn < 4) return nb * 32; if (wc == 0) return 1024 + 32 * bj; return -1; }
    if (kind == KIND_MLA_UQ) { if (pn < 8) return (2 * pn + bj) * 192 + 32 * wc; return (4 * (pn - 8) + wc) * 192 + 128 + 32 * bj; }
      return (bj ? 5632 : 0) + 128 * pn + 32 * wc;
}
__device__ __forceinline__ void conv_item(const float* __restrict__ W, int K, int Nsrc, int Nphys, int kind, const float* __restrict__ gk, bf16* __restrict__ WT, LAS float* scr, int item, int lane) {
    const int nblk = Nphys / 32, kb = item / nblk, nb = item % nblk, k0 = 64 * kb, n0 = 32 * nb;
    int nvalid; const int sb = srcblk(kind, nb, nvalid);
    const int c = lane & 7;
    if (sb < 0) {
#pragma unroll
        for (int j = 0; j < 4; ++j) { const int n = (lane >> 3) + 8 * j; *(GAS v4u*)(WT + (size_t)(n0 + n) * K + k0 + 8 * c) = (v4u){0u, 0u, 0u, 0u}; }
        return;
    }
#pragma unroll 8
    for (int i = 0; i < 32; ++i) { const int kk = 2 * i + (lane >> 5), cc = lane & 31;
        float v = (cc < nvalid) ? W[(size_t)(k0 + kk) * Nsrc + sb + cc] : 0.f;
        if (gk) v *= gk[k0 + kk];
        scr[kk * 33 + cc] = v; }
    LDS_WAIT(); asm volatile("" ::: "memory");
#pragma unroll
    for (int j = 0; j < 4; ++j) { const int n = (lane >> 3) + 8 * j; const LAS float* s = scr + (8 * c) * 33 + n;
        v4u o; o.x = pk2(s[0 * 33], s[1 * 33]); o.y = pk2(s[2 * 33], s[3 * 33]); o.z = pk2(s[4 * 33], s[5 * 33]); o.w = pk2(s[6 * 33], s[7 * 33]);
        *(GAS v4u*)(WT + (size_t)(n0 + n) * K + k0 + 8 * c) = o; }
    LDS_WAIT(); asm volatile("" ::: "memory");
}
__device__ __forceinline__ void cs_entry(int pos, int i, const double* rp  , float& co, float& si) {
    double inv = 1.0;
#pragma unroll
    for (int k = 0; k < 6; ++k) if ((i >> k) & 1) inv *= rp[k];
    const double a = (double)pos * inv;
    const double n = __builtin_rint(a * 0.63661977236758134308);
    double y = a - n * 1.5707963267948966; y -= n * 6.123233995736766e-17;
    const double y2 = y * y;
    double s = -7.6471637318198164759e-13;
    s = s * y2 + 1.6059043836821614599e-10; s = s * y2 - 2.5052108385441718775e-08; s = s * y2 + 2.7557319223985890653e-06; s = s * y2 - 1.9841269841269841270e-04;
    s = s * y2 + 8.3333333333333333333e-03; s = s * y2 - 1.6666666666666666667e-01; s = y + y * y2 * s;
    double c = 4.7794773323873852974e-14;
    c = c * y2 - 1.1470745597729724714e-11; c = c * y2 + 2.0876756987868098979e-09; c = c * y2 - 2.7557319223985890653e-07; c = c * y2 + 2.4801587301587301587e-05;
    c = c * y2 - 1.3888888888888888889e-03; c = c * y2 + 4.1666666666666666667e-02; c = c * y2 - 0.5; c = 1.0 + y2 * c;
    const int q = ((int)n) & 3;
    const double cc = (q == 0) ? c : (q == 1) ? -s : (q == 2) ? -c : s;
    const double ss = (q == 0) ? s : (q == 1) ? c : (q == 2) ? -s : -c;
    co = (float)cc; si = (float)ss;
}
__device__ __forceinline__ void modnorm_phase(const Frame& F, const float* __restrict__ x, const float* __restrict__ g, const float* __restrict__ mods_l, int sh_off, int sc_off, bf16* __restrict__ H) {
    const int gw = F.vcu * NWAVES + F.wave, NGW = F.G * NWAVES;
    for (int m = gw; m < M; m += NGW) {
        const GAS f32x4* xr = (const GAS f32x4*)(x + (size_t)m * DM) + F.lane;
        f32x4 v[8]; float s = 0.f;
#pragma unroll
        for (int j = 0; j < 8; ++j) { v[j] = xr[64 * j]; s += (v[j].x * v[j].x + v[j].y * v[j].y) + (v[j].z * v[j].z + v[j].w * v[j].w); }
        const float rstd = 1.0f / sqrtf(wave_sum(s) * (1.0f / DM) + 1e-6f);
        const float* mb = mods_l + (size_t)(m >> 12) * 12288;
        GAS unsigned long long* o8 = (GAS unsigned long long*)(H + (size_t)m * DM) + F.lane;
#pragma unroll
        for (int j = 0; j < 8; ++j) { const int col = 256 * j + 4 * F.lane;
            const f32x4 g4 = *(const f32x4*)(g + col), sc4 = *(const f32x4*)(mb + sc_off + col), sh4 = *(const f32x4*)(mb + sh_off + col);
            const f32x4 r = v[j] * rstd * g4 * (sc4 + 1.0f) + sh4;
            o8[64 * j] = (unsigned long long)pk2(r.x, r.y) | ((unsigned long long)pk2(r.z, r.w) << 32); }
    }
}
__device__ __forceinline__ void finalnorm_phase(const Frame& F, float* __restrict__ x, const float* __restrict__ g) {
    const int gw = F.vcu * NWAVES + F.wave, NGW = F.G * NWAVES;
    for (int m = gw; m < M; m += NGW) {
        GAS f32x4* xr = (GAS f32x4*)(x + (size_t)m * DM) + F.lane;
        f32x4 v[8]; float s = 0.f;
#pragma unroll
        for (int j = 0; j < 8; ++j) { v[j] = xr[64 * j]; s += (v[j].x * v[j].x + v[j].y * v[j].y) + (v[j].z * v[j].z + v[j].w * v[j].w); }
        const float rstd = 1.0f / sqrtf(wave_sum(s) * (1.0f / DM) + 1e-6f);
#pragma unroll
        for (int j = 0; j < 8; ++j) { const f32x4 g4 = *(const f32x4*)(g + 256 * j + 4 * F.lane); xr[64 * j] = v[j] * rstd * g4; }
    }
}

#ifndef SITE_MASK
#define SITE_MASK 0xFFFFu
#endif
#define SITE(s_) ((((unsigned)(SITE_MASK)) >> (s_)) & 1u)
#define IN(k) (LO <= (k) && (k) < HI)
#define SEAM(k) do { if constexpr (IN(k) && IN((k) + 1)) xcd_barrier(bar); } while (0)
struct Args { const float* in[39]; float* out; unsigned char* ws; int ph_lo, ph_hi, li, pad; };
template <int L, int LO, int HI> __device__ __forceinline__ void run_layer(const Frame& F, const Args& args, const XcdBarrier& bar, unsigned char* lds) {
        unsigned char* const ws = args.ws;
        float* const MODS = (float*)(ws + WS_MODS);
        float* const CS128 = (float*)(ws + WS_CS128);
        float* const CS64 = (float*)(ws + WS_CS64);
        float* const SSQ = (float*)(ws + WS_SSQ);
        bf16* const HB = (bf16*)(ws + WS_H);
        bf16* const OB = (bf16*)(ws + WS_O);
        unsigned char* const MIX = ws + WS_MIX;
        const int gw = F.vcu * NWAVES + F.wave, NGW = F.G * NWAVES;
        constexpr int l = L; constexpr int kind = (l == 3) ? 0 : l;
        constexpr int pb = (l == 0) ? 2 : (l == 1) ? 11 : (l == 2) ? 19 : 26;
        constexpr int cb = pb + ((kind == 0) ? 4 : (kind == 1) ? 3 : 2);
        unsigned char* const WL = ws + WS_W + (size_t)l * WL_STRIDE;
        const float* const mods_l = MODS + (size_t)l * 4 * 12288;
        if constexpr (kind == 0) {
            bf16* const DQ = (bf16*)(MIX + MX_DQ); bf16* const DK = (bf16*)(MIX + MX_DK); bf16* const DV = (bf16*)(MIX + MX_DV); bf16* const DIQ = (bf16*)(MIX + MX_DIQ); bf16* const DIK = (bf16*)(MIX + MX_DIK);
            float* const DIW = (float*)(MIX + MX_DIW); unsigned long long* const DMASK = (unsigned long long*)(MIX + MX_DMASK); float* const DSC = (float*)(MIX + MX_DSC);
            if constexpr (SITE(2) && IN(pb)) {
                pg8::Gemm g{HB, (const bf16*)(ws + WS_WDSA + (size_t)(l == 3) * WDSA_STRIDE), M, DSA_NP, DM}; pg8::StaticOrder S; S.init(M, DSA_NP, F.G, (int)blockIdx.x);
                pg8::EpiDsaIn E{DQ, DK, DV, DIQ, DIK, DIW, CS128, CS64};
                pg8::gemm_phase<pg8::EpiDsaIn, pg8::StaticOrder, true, true>(F.lds, g, S, E);
                SEAM(pb);
            }
            if constexpr (SITE(3) && IN(pb + 1)) {
                for (int idx = F.vcu; idx < 512; idx += F.G) { const int s = idx & 255, r = idx >> 8, b = s >> 6, loc = s & 63, qq = r ? 127 - loc : loc;
                    att::idx_unit(b, qq, DIQ, DIK, DIW, DSC, (char*)lds); }
                SEAM(pb + 1);
            }
            if constexpr (SITE(4) && IN(pb + 2)) {
                for (int row = gw; row < M; row += NGW) att::topk_row(DSC + (size_t)row * 4096, (row & 4095) >> 6, DMASK + (size_t)row * 64, F.lane);
                SEAM(pb + 2);
            }
            if constexpr (SITE(5) && IN(pb + 3)) {
                for (int idx = F.vcu; idx < 1024; idx += F.G) { const int s = idx & 255, r = idx >> 8, bg = s >> 4, loc = s & 15;
                    const int c = (r == 0) ? loc : (r == 1) ? 63 - loc : (r == 2) ? loc + 16 : 47 - loc;
                    att::dsa_attn_unit(bg >> 2, bg & 3, c, DQ, DK, DV, DMASK, OB, (char*)lds); }
                SEAM(pb + 3);
            }
        } else if constexpr (kind == 1) {
            bf16* const CQ = (bf16*)(MIX + MX_MCQ); bf16* const CKV = (bf16*)(MIX + MX_MCKV); bf16* const KR = (bf16*)(MIX + MX_MKR); bf16* const QN = (bf16*)(MIX + MX_MQN); bf16* const QR = (bf16*)(MIX + MX_MQR);
            bf16* const KN = (bf16*)(MIX + MX_MKN); bf16* const MV = (bf16*)(MIX + MX_MV);
            if constexpr (SITE(6) && IN(pb)) {
                pg8::Gemm g{HB, (const bf16*)(ws + WS_WMLA + WMLA_DOWN), M, MLA_DOWN_NP, DM}; pg8::StaticOrder S; S.init(M, MLA_DOWN_NP, F.G, (int)blockIdx.x);
                pg8::EpiMlaDown E{CQ, CKV, KR, SSQ, CS64};
                pg8::gemm_phase<pg8::EpiMlaDown, pg8::StaticOrder, true, true>(F.lds, g, S, E);
                SEAM(pb);
            }
            if constexpr (SITE(7) && IN(pb + 1)) {
                { pg8::Gemm g{CQ, (const bf16*)(ws + WS_WMLA + WMLA_UQ), M, 3072, 512}; pg8::StaticOrder S; S.init(M, 3072, F.G, (int)blockIdx.x);
                  pg8::EpiMlaUq E{QN, QR, SSQ, CS64};
                  pg8::gemm_phase<pg8::EpiMlaUq, pg8::StaticOrder, true, true>(F.lds, g, S, E); }
                { pg8::Gemm g{CKV, (const bf16*)(ws + WS_WMLA + WMLA_UKV), M, 4096, 512}; pg8::StaticOrder S; S.init(M, 4096, F.G, (int)blockIdx.x);
                  pg8::EpiMlaUkv E{KN, MV, SSQ};
                  pg8::gemm_phase<pg8::EpiMlaUkv, pg8::StaticOrder, true, true>(F.lds, g, S, E); }
                SEAM(pb + 1);
            }
            if constexpr (SITE(8) && IN(pb + 2)) {
                for (int idx = F.vcu; idx < 1024; idx += F.G) { const int s = idx & 255, r = idx >> 8, bh = s >> 2, loc = s & 3;
                    const int qb = (r == 0) ? loc : (r == 1) ? 15 - loc : (r == 2) ? loc + 4 : 11 - loc;
                    att::mla_attn_unit(bh >> 4, bh & 15, qb, QN, QR, KN, KR, MV, OB, (char*)lds); }
                SEAM(pb + 2);
            }
        } else {
            bf16* const SQ = (bf16*)(MIX + MX_SQ); bf16* const SK = (bf16*)(MIX + MX_SK); bf16* const SV = (bf16*)(MIX + MX_SV);
            if constexpr (SITE(9) && IN(pb)) {
                pg8::Gemm g{HB, (const bf16*)(ws + WS_WSB), M, 3 * DM, DM}; pg8::StaticOrder S; S.init(M, 3 * DM, F.G, (int)blockIdx.x);
                pg8::EpiSplit3 E{SQ, (size_t)(MX_SK - MX_SQ) / 2}; static_assert(MX_SV - MX_SK == MX_SK - MX_SQ, "q | k | v equally spaced");
                pg8::gemm_phase<pg8::EpiSplit3, pg8::StaticOrder, true, true>(F.lds, g, S, E);
                SEAM(pb);
            }
            if constexpr (SITE(10) && IN(pb + 1)) {
                for (int idx = F.vcu; idx < 1024; idx += F.G) { const int s = idx & 255, r = idx >> 8, bh = s >> 2, loc = s & 3;
                    const int qb = (r == 0) ? loc : (r == 1) ? 15 - loc : (r == 2) ? loc + 4 : 11 - loc;
                    att::sb_attn_unit(bh >> 4, bh & 15, qb, SQ, SK, SV, OB, (char*)lds); }
                SEAM(pb + 1);
            }
        }
        if constexpr (SITE(11) && IN(cb)) {
            pg8::Gemm g{OB, (const bf16*)(WL + WL_OUT), M, DM, DM}; pg8::StaticOrder S; S.init(M, DM, F.G, (int)blockIdx.x);
            pg8::EpiResid E{(l == 0) ? args.in[0] : (const float*)args.out, args.out, mods_l + 4096};
            pg8::gemm_phase<pg8::EpiResid, pg8::StaticOrder, true, true>(F.lds, g, S, E);
            SEAM(cb);
        }
        if constexpr (SITE(12) && IN(cb + 1)) {
            const float* gf = (l == 0) ? args.in[5] : (l == 1) ? args.in[13] : (l == 2) ? args.in[25] : args.in[33];
            modnorm_phase(F, args.out, gf, mods_l, 6144, 8192, HB); SEAM(cb + 1);
        }
        if constexpr (SITE(13) && IN(cb + 2)) {
            pg8::Gemm g{HB, (const bf16*)(WL + WL_FFN1), M, 2 * DFF, DM}; pg8::StaticOrder S; S.init(M, 2 * DFF, F.G, (int)blockIdx.x);
            pg8::EpiSwiglu E{(bf16*)(MIX + MX_ACT)};
            pg8::gemm_phase<pg8::EpiSwiglu, pg8::StaticOrder, true, true>(F.lds, g, S, E);
            SEAM(cb + 2);
        }
        if constexpr (SITE(14) && IN(cb + 3)) {
            pg8::Gemm g{(const bf16*)(MIX + MX_ACT), (const bf16*)(WL + WL_FFN2), M, DM, DFF}; pg8::StaticOrder S; S.init(M, DM, F.G, (int)blockIdx.x);
            pg8::EpiResid E{(const float*)args.out, args.out, mods_l + 10240};
            pg8::gemm_phase<pg8::EpiResid, pg8::StaticOrder, true, true>(F.lds, g, S, E);
            SEAM(cb + 3);
        }
        if constexpr (SITE(15) && IN(cb + 4)) {
            if (l < 3) { const float* gm = (l == 0) ? args.in[12] : (l == 1) ? args.in[24] : args.in[32];
                modnorm_phase(F, args.out, gm, mods_l + 4 * 12288, 0, 2048, HB); SEAM(cb + 4); }
            else finalnorm_phase(F, args.out, args.in[38]);
        }
}
template <int LO, int HI> __global__ void __launch_bounds__(NWAVES * 64, 2) trunk_fwd(Args args) {
    extern __shared__ __attribute__((aligned(16))) unsigned char lds[];
    Frame F;
    F.lds = (LAS unsigned char*)lds;
    F.MISC = (volatile LAS unsigned*)(F.lds + MISC_OFF);
    F.tid = threadIdx.x; F.lane = F.tid & 63; F.wave = __builtin_amdgcn_readfirstlane(F.tid >> 6);
    F.G = gridDim.x; { const int bx = blockIdx.x; F.vcu = (F.G % 8 == 0) ? (bx % 8) * (F.G / 8) + bx / 8 : bx; }
    unsigned char* const ws = args.ws;
    F.ctl = (gu32*)(ws + WS_CTL);
    for (int u = F.tid; u < (LDS_BYTES - LDSCTL_OFF) / 4; u += NWAVES * 64) ((LAS unsigned*)(F.lds + LDSCTL_OFF))[u] = 0u;
    __syncthreads();
    XcdBarrier bar = xcd_barrier_post((unsigned*)(F.ctl + CW_BAR) + args.li * XCD_BAR_WORDS, F.MISC + 8);
    float* const MODS = (float*)(ws + WS_MODS);
    float* const CS128 = (float*)(ws + WS_CS128);
    float* const CS64 = (float*)(ws + WS_CS64);
    float* const SSQ = (float*)(ws + WS_SSQ);
    bf16* const HB = (bf16*)(ws + WS_H);
    bf16* const OB = (bf16*)(ws + WS_O);
    unsigned char* const MIX = ws + WS_MIX;
    const int gw = F.vcu * NWAVES + F.wave, NGW = F.G * NWAVES;

    if constexpr (SITE(0) && IN(0)) {
        {
            LAS float* silc = (LAS float*)F.lds;
            LAS float* red = (LAS float*)(F.lds + 32768);
            const float* cvec = args.in[1];
            for (int i = F.tid; i < 4 * DM; i += NWAVES * 64) { const float c = cvec[i]; silc[i] = c / (1.0f + __expf(-c)); }
            __syncthreads();
            for (int it = F.vcu; it < 4 * 192; it += F.G) {
                const int l = it / 192, ng = it % 192;
                const float* W = (l == 0) ? args.in[2] : (l == 1) ? args.in[10] : (l == 2) ? args.in[22] : args.in[30];
                const float* Bv = (l == 0) ? args.in[3] : (l == 1) ? args.in[11] : (l == 2) ? args.in[23] : args.in[31];
                const int c4 = F.lane & 15, kr = F.lane >> 4, k0 = 256 * F.wave;
                f32x4 acc[4];
#pragma unroll
                for (int b = 0; b < 4; ++b) acc[b] = (f32x4){0.f, 0.f, 0.f, 0.f};
#pragma unroll 8
                for (int kk = 0; kk < 64; ++kk) { const int k = k0 + 4 * kk + kr;
                    const f32x4 w4 = *(const GAS f32x4*)(W + (size_t)k * 12288 + 64 * ng + 4 * c4);
#pragma unroll
                    for (int b = 0; b < 4; ++b) acc[b] += w4 * silc[b * DM + k]; }
#pragma unroll
                for (int b = 0; b < 4; ++b)
#pragma unroll
                    for (int e = 0; e < 4; ++e) { float v = acc[b][e]; v += __shfl_xor(v, 16); v += __shfl_xor(v, 32); acc[b][e] = v; }
                if (kr == 0) {
#pragma unroll
                    for (int b = 0; b < 4; ++b) *(LAS f32x4*)(red + (F.wave * 4 + b) * 64 + 4 * c4) = acc[b]; }
                __syncthreads();
                if (F.tid < 256) { const int b = F.tid >> 6, col = F.tid & 63; float s = Bv[64 * ng + col];
#pragma unroll
                    for (int w = 0; w < 8; ++w) s += red[(w * 4 + b) * 64 + col];
                    MODS[((size_t)l * 4 + b) * 12288 + 64 * ng + col] = s; }
                __syncthreads();
            }
        }
        {
            LAS float* scr = (LAS float*)(F.lds + F.wave * 16384);
            int it = gw;
#define CONV_SEG(Wp, K_, Nsrc_, Nphys_, kind_, gk_, dst_) do { const int n_items_ = ((K_) / 64) * ((Nphys_) / 32); \
                for (; it < n_items_; it += NGW) conv_item((Wp), (K_), (Nsrc_), (Nphys_), (kind_), (gk_), (bf16*)(dst_), scr, it, F.lane); it -= n_items_; } while (0)
            CONV_SEG(args.in[8],  DM, 2 * DFF, 2 * DFF, KIND_FFN1, (const float*)nullptr, ws + WS_W + 0 * WL_STRIDE + WL_FFN1);
            CONV_SEG(args.in[20], DM, 2 * DFF, 2 * DFF, KIND_FFN1, (const float*)nullptr, ws + WS_W + 1 * WL_STRIDE + WL_FFN1);
            CONV_SEG(args.in[28], DM, 2 * DFF, 2 * DFF, KIND_FFN1, (const float*)nullptr, ws + WS_W + 2 * WL_STRIDE + WL_FFN1);
            CONV_SEG(args.in[36], DM, 2 * DFF, 2 * DFF, KIND_FFN1, (const float*)nullptr, ws + WS_W + 3 * WL_STRIDE + WL_FFN1);
            CONV_SEG(args.in[9],  DFF, DM, DM, KIND_ID, (const float*)nullptr, ws + WS_W + 0 * WL_STRIDE + WL_FFN2);
            CONV_SEG(args.in[21], DFF, DM, DM, KIND_ID, (const float*)nullptr, ws + WS_W + 1 * WL_STRIDE + WL_FFN2);
            CONV_SEG(args.in[29], DFF, DM, DM, KIND_ID, (const float*)nullptr, ws + WS_W + 2 * WL_STRIDE + WL_FFN2);
            CONV_SEG(args.in[37], DFF, DM, DM, KIND_ID, (const float*)nullptr, ws + WS_W + 3 * WL_STRIDE + WL_FFN2);
            CONV_SEG(args.in[7],  DM, DM, DM, KIND_ID, (const float*)nullptr, ws + WS_W + 0 * WL_STRIDE + WL_OUT);
            CONV_SEG(args.in[19], DM, DM, DM, KIND_ID, (const float*)nullptr, ws + WS_W + 1 * WL_STRIDE + WL_OUT);
            CONV_SEG(args.in[27], DM, DM, DM, KIND_ID, (const float*)nullptr, ws + WS_W + 2 * WL_STRIDE + WL_OUT);
            CONV_SEG(args.in[35], DM, DM, DM, KIND_ID, (const float*)nullptr, ws + WS_W + 3 * WL_STRIDE + WL_OUT);
            CONV_SEG(args.in[6],  DM, 5264, DSA_NP, KIND_DSA_IN, (const float*)nullptr, ws + WS_WDSA + 0 * WDSA_STRIDE);
            CONV_SEG(args.in[34], DM, 5264, DSA_NP, KIND_DSA_IN, (const float*)nullptr, ws + WS_WDSA + 1 * WDSA_STRIDE);
            CONV_SEG(args.in[14], DM, 1088, MLA_DOWN_NP, KIND_MLA_DOWN, (const float*)nullptr, ws + WS_WMLA + WMLA_DOWN);
            CONV_SEG(args.in[17], 512, 3072, 3072, KIND_MLA_UQ, args.in[15], ws + WS_WMLA + WMLA_UQ);
            CONV_SEG(args.in[18], 512, 4096, 4096, KIND_ID, args.in[16], ws + WS_WMLA + WMLA_UKV);
            CONV_SEG(args.in[26], DM, 3 * DM, 3 * DM, KIND_ID, (const float*)nullptr, ws + WS_WSB);
#undef CONV_SEG
        }
        {
            const double rp128[6] = {0.8659643233600653523531, 0.7498942093324558273021, 0.5623413251903490803949, 0.3162277660168379331998, 0.1, 0.01};
            const double rp64[6]  = {0.7498942093324558273021, 0.5623413251903490803949, 0.3162277660168379331998, 0.1, 0.01, 0.0001};
            const int gt = F.vcu * (NWAVES * 64) + F.tid, NGT = F.G * NWAVES * 64;
            for (int e = gt; e < 4096 * 64; e += NGT) { float co, si; cs_entry(e >> 6, e & 63, rp128, co, si); CS128[2 * e] = co; CS128[2 * e + 1] = si; }
            for (int e = gt; e < 4096 * 32; e += NGT) { float co, si; cs_entry(e >> 5, e & 31, rp64, co, si); CS64[2 * e] = co; CS64[2 * e + 1] = si; }
        }
        SEAM(0);
    }
    if constexpr (SITE(1) && IN(1)) { modnorm_phase(F, args.in[0], args.in[4], MODS, 0, 2048, HB); SEAM(1); }

    run_layer<0, LO, HI>(F, args, bar, lds); run_layer<1, LO, HI>(F, args, bar, lds); run_layer<2, LO, HI>(F, args, bar, lds); run_layer<3, LO, HI>(F, args, bar, lds);
}
#undef IN
#undef SEAM
template <int LO, int HI> static void launch_range(int grid, const Args& a, hipStream_t stream) {
    static bool attr_done = false;
    if (!attr_done) { if (hipFuncSetAttribute((const void*)trunk_fwd<LO, HI>, hipFuncAttributeMaxDynamicSharedMemorySize, LDS_BYTES) != hipSuccess) fprintf(stderr, "kernel_launch: hipFuncSetAttribute failed\n"); attr_done = true; }
    hipLaunchKernelGGL((trunk_fwd<LO, HI>), dim3(grid), dim3(NWAVES * 64), LDS_BYTES, stream, a);
}
template <int P> struct PerPhase { static void go(int grid, const Args& a, hipStream_t stream) { launch_range<P, P + 1>(grid, a, stream); PerPhase<P + 1>::go(grid, a, stream); } };
template <> struct PerPhase<NPH> { static void go(int, const Args&, hipStream_t) {} };
extern "C" void kernel_launch(void* const* d_in, const int* in_sizes, int n_in, void* d_out, int out_size, void* d_ws, size_t ws_size, hipStream_t stream) {
    static int grid = 0;
    if (grid == 0) {
        if (n_in != 39 || in_sizes[0] != M * DM || out_size != M * DM || ws_size < WS_END) { fprintf(stderr, "kernel_launch: shape mismatch (n_in %d, in0 %d, out %d, ws %zu < %zu)\n", n_in, n_in > 0 ? in_sizes[0] : -1, out_size, ws_size, (size_t)WS_END); grid = -1; return; }
        int dev = 0, cus = 0;
        if (hipGetDevice(&dev) != hipSuccess || hipDeviceGetAttribute(&cus, hipDeviceAttributeMultiprocessorCount, dev) != hipSuccess) { grid = -1; return; }
        grid = cus;
    }
    if (grid < 0) return;
    if (hipMemsetAsync((char*)d_ws + WS_CTL, 0, CTL_ZERO_BYTES, stream) != hipSuccess) return;
    Args a{};
    for (int i = 0; i < 39; ++i) a.in[i] = (const float*)d_in[i];
    a.out = (float*)d_out; a.ws = (unsigned char*)d_ws; a.ph_lo = 0; a.ph_hi = NPH; a.li = 0;
#if MK_ONE_LAUNCH
    launch_range<0, NPH>(grid, a, stream);
#else
    PerPhase<0>::go(grid, a, stream);
#endif
    const hipError_t le = hipPeekAtLastError();
    if (le != hipSuccess) fprintf(stderr, "kernel_launch: launch failed: %s\n", hipGetErrorName(le));
}
```

```cpp
#include <hip/hip_runtime.h>
#include <cstdio>
#include <cstdint>
namespace pg8 {
#define PG8_LAS __attribute__((address_space(3)))
typedef unsigned short bf16_t;
typedef short bf16x8 __attribute__((ext_vector_type(8)));
typedef float f32x4 __attribute__((ext_vector_type(4)));
typedef unsigned u32x4 __attribute__((ext_vector_type(4)));
constexpr int BM = 256, BK = 64, HALF = 128, HTB = HALF * BK * 2  , STAGE_BYTES = 8 * HTB, NXCD = 8, WGM = 8;

__host__ __device__ __forceinline__ int lds_byte(int r, int c) { const int st = (r >> 4) * 2 + (c >> 5), rr = r & 15, cc = c & 31, ob = rr * 64 + cc * 2; return st * 1024 + (ob ^ (((ob >> 9) & 1) << 5)); }
__host__ __device__ __forceinline__ void stage_rc(int b, int& R, int& C) { const int st = b / 1024, sb = b % 1024, swz = sb ^ (((sb >> 9) & 1) << 5); R = (st >> 1) * 16 + swz / 64; C = (st & 1) * 32 + (swz % 64) / 2; }
__host__ __device__ __forceinline__ int perm32(int rho) { const int n = rho >> 4, i = rho & 15; return 8 * (i >> 2) + 4 * n + (i & 3); }

struct Unit { int pm, pn; };
struct Gemm { const bf16_t* A; const bf16_t* Bt; int M, N, K; };

struct StaticOrder {
    int nM, nN, nwg, G, c;
    __host__ __device__ void init(int M, int N, int G_, int c_) { nM = M / BM; nN = N / BM; nwg = nM * nN; G = G_; c = c_; }
    __host__ __device__ bool next(int i, Unit& u) const {
        const long L = (long)i * G + c; if (L >= nwg) return false;
        int wgid = (int)L; { const int q = nwg / NXCD, r = nwg % NXCD, xcd = wgid % NXCD, off = wgid / NXCD; wgid = (xcd < r ? xcd * (q + 1) : r * (q + 1) + (xcd - r) * q) + off; }
        const int nig = WGM * nN, gid = wgid / nig, fm = gid * WGM, gsz = (nM - fm) < WGM ? (nM - fm) : WGM;
        u.pm = fm + ((wgid % nig) % gsz); u.pn = (wgid % nig) / gsz; return true;
    }
    __device__ __forceinline__ void a_ready(const Unit&) const {}
    __device__ __forceinline__ void done(const Unit&) const {}
};

__device__ __forceinline__ unsigned cvt_pk_bf16(float lo, float hi) { unsigned r; asm volatile("v_cvt_pk_bf16_f32 %0, %1, %2" : "=v"(r) : "v"(lo), "v"(hi)); return r; }
typedef float f32x2 __attribute__((ext_vector_type(2)));
__device__ __forceinline__ u32x4 pack8(const f32x4 v0, const f32x4 v1) { u32x4 w; w.x = cvt_pk_bf16(v0[0], v0[1]); w.y = cvt_pk_bf16(v0[2], v0[3]); w.z = cvt_pk_bf16(v1[0], v1[1]); w.w = cvt_pk_bf16(v1[2], v1[3]); return w; }
__device__ __forceinline__ void rope8(const float* cs, const f32x4 a0, const f32x4 a1, const f32x4 b0, const f32x4 b1, u32x4& o1, u32x4& o2) {
    const f32x4 t0 = *(const f32x4*)(cs), t1 = *(const f32x4*)(cs + 4), t2 = *(const f32x4*)(cs + 8), t3 = *(const f32x4*)(cs + 12);
    f32x4 c0 = {t0[0], t0[2], t1[0], t1[2]}, s0 = {t0[1], t0[3], t1[1], t1[3]}, c1 = {t2[0], t2[2], t3[0], t3[2]}, s1 = {t2[1], t2[3], t3[1], t3[3]};
    const f32x4 p0 = a0 * c0 - b0 * s0, p1 = a1 * c1 - b1 * s1, q0 = b0 * c0 + a0 * s0, q1 = b1 * c1 + a1 * s1;
    o1 = pack8(p0, p1); o2 = pack8(q0, q1);
}
struct EpiResid {
    static constexpr bool PERM = false, AFTER_DRAIN = false;
    const float* xin; float* xout; const float* gate;
    __device__ __forceinline__ void operator()(const f32x4 (&acc)[2][2][4][2], const Unit& u, int wr, int wc, int fr, int fq) const {
        const int row0 = u.pm * BM + wr * 64 + fr, col0 = u.pn * BM + wc * 32 + 4 * fq;
        const float* gb = gate + (size_t)(u.pm >> 4) * 12288 + col0;
        f32x4 gv[2][2];
#pragma unroll
        for (int bj = 0; bj < 2; ++bj)
#pragma unroll
            for (int n = 0; n < 2; ++n) gv[bj][n] = *(const f32x4*)(gb + bj * HALF + n * 16);
#pragma unroll
        for (int ai = 0; ai < 2; ++ai)
#pragma unroll
            for (int m = 0; m < 4; ++m) { const size_t off = (size_t)(row0 + ai * HALF + m * 16) * 2048 + col0;
#pragma unroll
                for (int bj = 0; bj < 2; ++bj)
#pragma unroll
                    for (int n = 0; n < 2; ++n) { const f32x4 xi = *(const f32x4*)(xin + off + bj * HALF + n * 16); *(f32x4*)(xout + off + bj * HALF + n * 16) = xi + gv[bj][n] * acc[ai][bj][m][n]; } }
    }
};
struct EpiSwiglu {
    static constexpr bool PERM = true, AFTER_DRAIN = false;
    bf16_t* act;
    __device__ __forceinline__ void operator()(const f32x4 (&acc)[2][2][4][2], const Unit& u, int wr, int wc, int fr, int fq) const {
        const int row0 = u.pm * BM + wr * 64 + fr, col0 = u.pn * 128 + wc * 32 + 8 * fq;
#pragma unroll
        for (int ai = 0; ai < 2; ++ai)
#pragma unroll
            for (int m = 0; m < 4; ++m) { f32x4 r[2];
#pragma unroll
                for (int n = 0; n < 2; ++n)
#pragma unroll
                    for (int i = 0; i < 4; ++i) { const float g = acc[ai][0][m][n][i], up = acc[ai][1][m][n][i];
                        r[n][i] = g * __builtin_amdgcn_rcpf(1.0f + __builtin_amdgcn_exp2f(-1.4426950408889634f * g)) * up; }
                *(u32x4*)(act + (size_t)(row0 + ai * HALF + m * 16) * 5632 + col0) = pack8(r[0], r[1]); }
    }
};
struct EpiSplit3 {
    static constexpr bool PERM = true, AFTER_DRAIN = false;
    bf16_t* O0; size_t stride;
    __device__ __forceinline__ void operator()(const f32x4 (&acc)[2][2][4][2], const Unit& u, int wr, int wc, int fr, int fq) const {
        const int t = u.pn >> 3; bf16_t* base = O0 + (size_t)t * stride;
        const int row0 = u.pm * BM + wr * 64 + fr, col0 = (u.pn & 7) * 256 + wc * 32 + 8 * fq;
#pragma unroll
        for (int ai = 0; ai < 2; ++ai)
#pragma unroll
            for (int m = 0; m < 4; ++m) { bf16_t* rowp = base + (size_t)(row0 + ai * HALF + m * 16) * 2048 + col0;
#pragma unroll
                for (int bj = 0; bj < 2; ++bj) *(u32x4*)(rowp + bj * HALF) = pack8(acc[ai][bj][m][0], acc[ai][bj][m][1]); }
    }
};
struct EpiDsaIn {
    static constexpr bool PERM = true, AFTER_DRAIN = false;
    bf16_t *Q, *K, *V, *IQ, *IK; float* IW; const float* cs128; const float* cs64;
    __device__ __forceinline__ void operator()(const f32x4 (&acc)[2][2][4][2], const Unit& u, int wr, int wc, int fr, int fq) const {
        const int pn = u.pn, row0 = u.pm * BM + wr * 64 + fr;
        if (pn < 10) {
            bf16_t* base; int ld, hcol;
            if (pn < 8) { base = Q; ld = 2048; hcol = (2 * pn + (wc >> 1)) * 128; } else { base = K; ld = 512; hcol = (2 * (pn - 8) + (wc >> 1)) * 128; }
            const int dd0 = 32 * (wc & 1) + 8 * fq;
#pragma unroll
            for (int ai = 0; ai < 2; ++ai)
#pragma unroll
                for (int m = 0; m < 4; ++m) { const int row = row0 + ai * HALF + m * 16, pos = row & 4095; u32x4 o1, o2;
                    rope8(cs128 + ((size_t)pos * 64 + dd0) * 2, acc[ai][0][m][0], acc[ai][0][m][1], acc[ai][1][m][0], acc[ai][1][m][1], o1, o2);
                    bf16_t* p = base + (size_t)row * ld + hcol + dd0; *(u32x4*)p = o1; *(u32x4*)(p + 64) = o2; }
        } else if (pn < 12) {
            const int col0 = (pn - 10) * 256 + wc * 32 + 8 * fq;
#pragma unroll
            for (int ai = 0; ai < 2; ++ai)
#pragma unroll
                for (int m = 0; m < 4; ++m) { bf16_t* rowp = V + (size_t)(row0 + ai * HALF + m * 16) * 512 + col0;
#pragma unroll
                    for (int bj = 0; bj < 2; ++bj) *(u32x4*)(rowp + bj * HALF) = pack8(acc[ai][bj][m][0], acc[ai][bj][m][1]); }
        } else {
            bf16_t* base; int ld, hcol;
            if (pn < 20) { base = IQ; ld = 2048; hcol = (2 * (pn - 12) + (wc >> 1)) * 128; } else { base = IK; ld = 128; hcol = 0; }
            const int sub = (pn < 20) ? (wc & 1) : wc;
            if (sub == 0) {
                const int dd0 = 8 * fq;
#pragma unroll
                for (int ai = 0; ai < 2; ++ai)
#pragma unroll
                    for (int m = 0; m < 4; ++m) { const int row = row0 + ai * HALF + m * 16, pos = row & 4095; u32x4 o1, o2;
                        rope8(cs64 + ((size_t)pos * 32 + dd0) * 2, acc[ai][0][m][0], acc[ai][0][m][1], acc[ai][1][m][0], acc[ai][1][m][1], o1, o2);
                        bf16_t* p = base + (size_t)row * ld + hcol + dd0; *(u32x4*)p = o1; *(u32x4*)(p + 32) = o2; }
            } else if (sub == 1) {
#pragma unroll
                for (int ai = 0; ai < 2; ++ai)
#pragma unroll
                    for (int m = 0; m < 4; ++m) { bf16_t* p = base + (size_t)(row0 + ai * HALF + m * 16) * ld + hcol + 64 + 8 * fq;
                        *(u32x4*)p = pack8(acc[ai][0][m][0], acc[ai][0][m][1]); *(u32x4*)(p + 32) = pack8(acc[ai][1][m][0], acc[ai][1][m][1]); }
            } else if (sub == 2 && pn == 20) {
                if (fq < 2) {
#pragma unroll
                    for (int ai = 0; ai < 2; ++ai)
#pragma unroll
                        for (int m = 0; m < 4; ++m) { float* p = IW + (size_t)(row0 + ai * HALF + m * 16) * 16 + 8 * fq; *(f32x4*)p = acc[ai][0][m][0]; *(f32x4*)(p + 4) = acc[ai][0][m][1]; }
                }
            }
        }
    }
};
struct EpiMlaDown {
    static constexpr bool PERM = true, AFTER_DRAIN = false;
    bf16_t *CQ, *CKV, *KR; float* ssq; const float* cs64;
    __device__ __forceinline__ void operator()(const f32x4 (&acc)[2][2][4][2], const Unit& u, int wr, int wc, int fr, int fq) const {
        const int pn = u.pn, row0 = u.pm * BM + wr * 64 + fr;
        if (pn < 4) {
            bf16_t* base = pn < 2 ? CQ : CKV; const int col0 = (pn & 1) * 256 + wc * 32 + 8 * fq;
#pragma unroll
            for (int ai = 0; ai < 2; ++ai)
#pragma unroll
                for (int m = 0; m < 4; ++m) { const int row = row0 + ai * HALF + m * 16; float s = 0.f;
#pragma unroll
                    for (int bj = 0; bj < 2; ++bj) { const f32x4 v0 = acc[ai][bj][m][0], v1 = acc[ai][bj][m][1];
                        s += (v0[0] * v0[0] + v0[1] * v0[1]) + (v0[2] * v0[2] + v0[3] * v0[3]) + (v1[0] * v1[0] + v1[1] * v1[1]) + (v1[2] * v1[2] + v1[3] * v1[3]);
                        *(u32x4*)(base + (size_t)row * 512 + col0 + bj * HALF) = pack8(v0, v1); }
                    s += __shfl_xor(s, 16); s += __shfl_xor(s, 32);
                    if (fq == 0) ssq[(size_t)row * 16 + pn * 4 + wc] = s; }
        } else if (wc == 0) {
            const int dd0 = 8 * fq;
#pragma unroll
            for (int ai = 0; ai < 2; ++ai)
#pragma unroll
                for (int m = 0; m < 4; ++m) { const int row = row0 + ai * HALF + m * 16, pos = row & 4095; u32x4 o1, o2;
                    rope8(cs64 + ((size_t)pos * 32 + dd0) * 2, acc[ai][0][m][0], acc[ai][0][m][1], acc[ai][1][m][0], acc[ai][1][m][1], o1, o2);
                    bf16_t* p = KR + (size_t)row * 64 + dd0; *(u32x4*)p = o1; *(u32x4*)(p + 32) = o2; }
        }
    }
};
struct EpiMlaUq {
    static constexpr bool PERM = true, AFTER_DRAIN = false;
    bf16_t *QN, *QR; const float* ssq; const float* cs64;
    __device__ __forceinline__ void operator()(const f32x4 (&acc)[2][2][4][2], const Unit& u, int wr, int wc, int fr, int fq) const {
        const int pn = u.pn, row0 = u.pm * BM + wr * 64 + fr;
#pragma unroll
        for (int ai = 0; ai < 2; ++ai)
#pragma unroll
            for (int m = 0; m < 4; ++m) { const int row = row0 + ai * HALF + m * 16, pos = row & 4095;
                const f32x4 sa = *(const f32x4*)(ssq + (size_t)row * 16), sb = *(const f32x4*)(ssq + (size_t)row * 16 + 4);
                const float rstd = 1.0f / sqrtf((((sa[0] + sa[1]) + (sa[2] + sa[3])) + ((sb[0] + sb[1]) + (sb[2] + sb[3]))) * (1.0f / 512.0f) + 1e-6f);
                if (pn < 8) { bf16_t* rowp = QN + (size_t)row * 2048 + pn * 256 + wc * 32 + 8 * fq;
#pragma unroll
                    for (int bj = 0; bj < 2; ++bj) *(u32x4*)(rowp + bj * HALF) = pack8(acc[ai][bj][m][0] * rstd, acc[ai][bj][m][1] * rstd);
                } else { u32x4 o1, o2; const int dd0 = 8 * fq;
                    rope8(cs64 + ((size_t)pos * 32 + dd0) * 2, acc[ai][0][m][0] * rstd, acc[ai][0][m][1] * rstd, acc[ai][1][m][0] * rstd, acc[ai][1][m][1] * rstd, o1, o2);
                    bf16_t* p = QR + (size_t)row * 1024 + (4 * (pn - 8) + wc) * 64 + dd0; *(u32x4*)p = o1; *(u32x4*)(p + 32) = o2; } }
    }
};
struct EpiMlaUkv {
    static constexpr bool PERM = true, AFTER_DRAIN = false;
    bf16_t *KN, *V; const float* ssq;
    __device__ __forceinline__ void operator()(const f32x4 (&acc)[2][2][4][2], const Unit& u, int wr, int wc, int fr, int fq) const {
        const int row0 = u.pm * BM + wr * 64 + fr, col0 = u.pn * 128 + wc * 32 + 8 * fq;
#pragma unroll
        for (int ai = 0; ai < 2; ++ai)
#pragma unroll
            for (int m = 0; m < 4; ++m) { const int row = row0 + ai * HALF + m * 16;
                const f32x4 sa = *(const f32x4*)(ssq + (size_t)row * 16 + 8), sb = *(const f32x4*)(ssq + (size_t)row * 16 + 12);
                const float rstd = 1.0f / sqrtf((((sa[0] + sa[1]) + (sa[2] + sa[3])) + ((sb[0] + sb[1]) + (sb[2] + sb[3]))) * (1.0f / 512.0f) + 1e-6f);
                *(u32x4*)(KN + (size_t)row * 2048 + col0) = pack8(acc[ai][0][m][0] * rstd, acc[ai][0][m][1] * rstd);
                *(u32x4*)(V + (size_t)row * 2048 + col0) = pack8(acc[ai][1][m][0] * rstd, acc[ai][1][m][1] * rstd); }
    }
};

template <class Epi, class Sched, bool ALIGN_EPI = false, bool SP2 = false>
__device__ __forceinline__ void gemm_phase(PG8_LAS unsigned char* lds, const Gemm g, const Sched& S, const Epi& E) {
    int tid = threadIdx.x; asm volatile("" : "+v"(tid));
    const int wid = __builtin_amdgcn_readfirstlane(tid >> 6), lane = tid & 63, wr = wid >> 2, wc = wid & 3, fr = lane & 15, fq = lane >> 4;
    const int K = g.K, nt = K / BK;
    unsigned voffA[2], voffB[2];
#pragma unroll
    for (int i = 0; i < 2; ++i) { int R, C; stage_rc(tid * 16 + i * 8192, R, C); const int Rb = Epi::PERM ? ((R & ~31) + perm32(R & 31)) : R;
        voffA[i] = (unsigned)(R * K + C) * 2u; voffB[i] = (unsigned)(Rb * K + C) * 2u; }
    const size_t kstep = (size_t)(BK * 2);
    const size_t hstep = (size_t)HALF * K * 2;
    const size_t tstep = 2 * hstep;
    const unsigned ldsw = (unsigned)wid * 1024u;
    const int aoff = lds_byte(wr * 64 + fr, fq * 8), boff = lds_byte(wc * 32 + fr, fq * 8);
#define PG8_SA(b, h) (((b) * 2 + (h)) * HTB)
#define PG8_SB(b, h) ((4 + (b) * 2 + (h)) * HTB)
#define PG8_STAGE(bufoff, gbase, voff) do { _Pragma("unroll") for (int _i = 0; _i < 2; ++_i) \
        __builtin_amdgcn_global_load_lds((const unsigned*)((const char*)(gbase) + (voff)[_i]), (PG8_LAS unsigned*)(lds + (bufoff) + ldsw + _i * 8192), 16, 0, 0); } while (0)
#define PG8_LDA(dst, b, h) do { _Pragma("unroll") for (int m = 0; m < 4; ++m) _Pragma("unroll") for (int k = 0; k < 2; ++k) dst[m][k] = *(const PG8_LAS bf16x8*)(lds + PG8_SA(b, h) + aoff + m * 2048 + k * 1024); } while (0)
#define PG8_LDB(dst, b, h) do { _Pragma("unroll") for (int n = 0; n < 2; ++n) _Pragma("unroll") for (int k = 0; k < 2; ++k) dst[n][k] = *(const PG8_LAS bf16x8*)(lds + PG8_SB(b, h) + boff + n * 2048 + k * 1024); } while (0)
#define PG8_MMA(ai, bj, At, Bt) do { __builtin_amdgcn_s_setprio(1); _Pragma("unroll") for (int m = 0; m < 4; ++m) _Pragma("unroll") for (int n = 0; n < 2; ++n) _Pragma("unroll") for (int k = 0; k < 2; ++k) \
        acc[ai][bj][m][n] = __builtin_amdgcn_mfma_f32_16x16x32_bf16(Bt[n][k], At[m][k], acc[ai][bj][m][n], 0, 0, 0); __builtin_amdgcn_s_setprio(0); } while (0)
#define PG8_WAIT_V(n) asm volatile("s_waitcnt vmcnt(" #n ")" ::: "memory")
#define PG8_WAIT_L(n) asm volatile("s_waitcnt lgkmcnt(" #n ")" ::: "memory")
#define PG8_BAR __builtin_amdgcn_s_barrier()
#define PG8_SCHED __builtin_amdgcn_sched_barrier(0)
    Unit cur, nxt; int ui = 0;
    if (!S.next(0, cur)) return;
    f32x4 acc[2][2][4][2];
#pragma unroll
    for (int a = 0; a < 2; ++a)
#pragma unroll
        for (int b = 0; b < 2; ++b)
#pragma unroll
            for (int m = 0; m < 4; ++m)
#pragma unroll
                for (int n = 0; n < 2; ++n) acc[a][b][m][n] = (f32x4){0.f, 0.f, 0.f, 0.f};
    bf16x8 At[4][2], B0[2][2], B1[2][2];
    const char* cA = (const char*)g.A + (size_t)cur.pm * tstep; const char* cB = (const char*)g.Bt + (size_t)cur.pn * tstep;
    S.a_ready(cur);
    if constexpr (SP2) {
        PG8_STAGE(PG8_SB(0, 0), cB, voffB); PG8_STAGE(PG8_SB(0, 1), cB + hstep, voffB); PG8_STAGE(PG8_SA(0, 0), cA, voffA); PG8_STAGE(PG8_SA(0, 1), cA + hstep, voffA);
        if (wr == 1) PG8_BAR;
        PG8_WAIT_V(2); PG8_BAR;
        PG8_STAGE(PG8_SB(1, 0), cB + kstep, voffB); PG8_STAGE(PG8_SA(1, 0), cA + kstep, voffA); PG8_STAGE(PG8_SB(1, 1), cB + hstep + kstep, voffB);
        PG8_WAIT_V(6); PG8_BAR;
    } else {
        PG8_STAGE(PG8_SB(0, 0), cB, voffB); PG8_STAGE(PG8_SA(0, 0), cA, voffA); PG8_STAGE(PG8_SB(0, 1), cB + hstep, voffB); PG8_STAGE(PG8_SA(0, 1), cA + hstep, voffA);
        if (wr == 1) PG8_BAR;
        PG8_WAIT_V(4); PG8_BAR;
        PG8_STAGE(PG8_SB(1, 0), cB + kstep, voffB); PG8_STAGE(PG8_SA(1, 0), cA + kstep, voffA); PG8_STAGE(PG8_SB(1, 1), cB + hstep + kstep, voffB);
        PG8_WAIT_V(6); PG8_BAR;
    }
    for (;;) {
        const bool has_next = S.next(ui + 1, nxt);
        const char* nA = has_next ? (const char*)g.A + (size_t)nxt.pm * tstep : cA; const char* nB = has_next ? (const char*)g.Bt + (size_t)nxt.pn * tstep : cB;
        for (int t = 0; t < nt; t += 2) {
            const bool last = (t == nt - 2);
            const char* a1 = cA + (size_t)(t + 1) * kstep;
            const char* a2 = last ? nA : cA + (size_t)(t + 2) * kstep; const char* b2 = last ? nB : cB + (size_t)(t + 2) * kstep;
            const char* a3 = a2 + kstep; const char* b3 = b2 + kstep;
            if (last && has_next) S.a_ready(nxt);
            if constexpr (SP2) {
            PG8_LDB(B0, 0, 0); PG8_LDB(B1, 0, 1); PG8_SCHED; PG8_LDA(At, 0, 0); PG8_STAGE(PG8_SA(1, 1), a1 + hstep, voffA);
            PG8_WAIT_V(8); PG8_WAIT_L(0); PG8_BAR; PG8_MMA(0, 0, At, B0); PG8_MMA(0, 1, At, B1); PG8_BAR; PG8_SCHED;
            PG8_LDA(At, 0, 1); PG8_STAGE(PG8_SB(0, 0), b2, voffB); PG8_STAGE(PG8_SB(0, 1), b2 + hstep, voffB); PG8_STAGE(PG8_SA(0, 0), a2, voffA);
            PG8_WAIT_V(8); PG8_WAIT_L(0); PG8_BAR; PG8_MMA(1, 0, At, B0); PG8_MMA(1, 1, At, B1); PG8_BAR; PG8_SCHED;
            PG8_LDB(B0, 1, 0); PG8_LDB(B1, 1, 1); PG8_SCHED; PG8_LDA(At, 1, 0); PG8_STAGE(PG8_SA(0, 1), a2 + hstep, voffA);
            PG8_WAIT_V(8); PG8_WAIT_L(0); PG8_BAR; PG8_MMA(0, 0, At, B0); PG8_MMA(0, 1, At, B1); PG8_BAR; PG8_SCHED;
            PG8_LDA(At, 1, 1); PG8_STAGE(PG8_SB(1, 0), b3, voffB); PG8_STAGE(PG8_SB(1, 1), b3 + hstep, voffB); PG8_STAGE(PG8_SA(1, 0), a3, voffA);
            PG8_WAIT_V(8); PG8_WAIT_L(0); PG8_BAR; PG8_MMA(1, 0, At, B0); PG8_MMA(1, 1, At, B1); PG8_BAR; PG8_SCHED;
            } else {
            PG8_LDB(B0, 0, 0); PG8_SCHED; PG8_LDA(At, 0, 0); PG8_STAGE(PG8_SA(1, 1), a1 + hstep, voffA);
            PG8_WAIT_L(8); PG8_BAR; PG8_WAIT_L(0); PG8_MMA(0, 0, At, B0); PG8_BAR; PG8_SCHED;
            PG8_LDB(B1, 0, 1); PG8_STAGE(PG8_SB(0, 0), b2, voffB);
            PG8_BAR; PG8_WAIT_L(0); PG8_MMA(0, 1, At, B1); PG8_BAR;
            PG8_LDA(At, 0, 1); PG8_STAGE(PG8_SA(0, 0), a2, voffA);
            PG8_BAR; PG8_WAIT_L(0); PG8_MMA(1, 0, At, B0); PG8_BAR; PG8_SCHED;
            PG8_STAGE(PG8_SB(0, 1), b2 + hstep, voffB);
            PG8_WAIT_V(6); PG8_BAR; PG8_MMA(1, 1, At, B1); PG8_BAR;
            PG8_LDB(B0, 1, 0); PG8_SCHED; PG8_LDA(At, 1, 0); PG8_STAGE(PG8_SA(0, 1), a2 + hstep, voffA);
            PG8_WAIT_L(8); PG8_BAR; PG8_WAIT_L(0); PG8_MMA(0, 0, At, B0); PG8_BAR; PG8_SCHED;
            PG8_LDB(B1, 1, 1); PG8_STAGE(PG8_SB(1, 0), b3, voffB);
            PG8_BAR; PG8_WAIT_L(0); PG8_MMA(0, 1, At, B1); PG8_BAR;
            PG8_LDA(At, 1, 1); PG8_STAGE(PG8_SA(1, 0), a3, voffA);
            PG8_BAR; PG8_WAIT_L(0); PG8_MMA(1, 0, At, B0); PG8_BAR; PG8_SCHED;
            PG8_STAGE(PG8_SB(1, 1), b3 + hstep, voffB);
            PG8_WAIT_V(6); PG8_BAR; PG8_MMA(1, 1, At, B1); PG8_BAR;
            }
        }
        if constexpr (ALIGN_EPI) { if (wr == 0) PG8_BAR; }
        if constexpr (!Epi::AFTER_DRAIN) { E(acc, cur, wr, wc, fr, fq); S.done(cur); }
        if (!has_next) break;
#pragma unroll
        for (int a = 0; a < 2; ++a)
#pragma unroll
            for (int b = 0; b < 2; ++b)
#pragma unroll
                for (int m = 0; m < 4; ++m)
#pragma unroll
                    for (int n = 0; n < 2; ++n) acc[a][b][m][n] = (f32x4){0.f, 0.f, 0.f, 0.f};
        cur = nxt; cA = nA; cB = nB; ++ui;
        if constexpr (ALIGN_EPI) { if (wr == 1) PG8_BAR; }
    }
    PG8_WAIT_V(0);
    if constexpr (!ALIGN_EPI) { if (wr == 0) PG8_BAR; }
    PG8_BAR;
    if constexpr (Epi::AFTER_DRAIN) { E.fused(acc, cur, wr, wc, fr, fq, lds, wid, lane); S.done(cur); }
#undef PG8_SA
#undef PG8_SB
#undef PG8_STAGE
#undef PG8_LDA
#undef PG8_LDB
#undef PG8_MMA
#undef PG8_WAIT_V
#undef PG8_WAIT_L
#undef PG8_BAR
#undef PG8_SCHED
}
}
namespace att {
typedef unsigned short bf16_t;
using bf16x8 = __attribute__((ext_vector_type(8))) short;
using s16x4  = __attribute__((ext_vector_type(4))) short;
using f32x16 = __attribute__((ext_vector_type(16))) float;
using f32x4  = __attribute__((ext_vector_type(4))) float;
using u32x4  = __attribute__((ext_vector_type(4))) unsigned;
#define KSWZ(row, colB) ((row) * 256 + ((colB) ^ (((row) & 7) << 4)))
#define ATT_SBAR() __builtin_amdgcn_sched_barrier(0)
constexpr int SHM_KV = 16384;
__device__ __forceinline__ int crow(int r, int hi) { return (r & 3) + 8 * (r >> 2) + 4 * hi; }
__device__ __forceinline__ unsigned cvtpk(float lo, float hi) { unsigned r; asm volatile("v_cvt_pk_bf16_f32 %0, %1, %2" : "=v"(r) : "v"(lo), "v"(hi)); return r; }
template <int SC1E9> __device__ __forceinline__ void partialSM(f32x16& p0, f32x16& p1, float& m_reg, float& mn, float& alpha) {
  constexpr float SCALE = (float)(SC1E9 * 1e-9), THR = 8.f, C = SCALE * 1.4426950408889634f;
  float pmax = p0[0];
#pragma unroll
  for (int r = 1; r < 16; ++r) pmax = fmaxf(pmax, p0[r]);
#pragma unroll
  for (int r = 0; r < 16; ++r) pmax = fmaxf(pmax, p1[r]);
  { auto rr = __builtin_amdgcn_permlane32_swap(__float_as_uint(pmax), __float_as_uint(pmax), false, false);
    pmax = fmaxf(__uint_as_float(rr[0]), __uint_as_float(rr[1])); }
  if (__builtin_expect(__all(pmax - m_reg <= THR / SCALE), 1)) { mn = m_reg; alpha = 1.f; }
  else { mn = fmaxf(m_reg, pmax); alpha = __builtin_amdgcn_exp2f((m_reg - mn) * C); m_reg = mn; }
  const float mnC = -mn * C;
#pragma unroll
  for (int r = 0; r < 16; ++r) p0[r] = fmaf(p0[r], C, mnC);
#pragma unroll
  for (int r = 0; r < 16; ++r) p1[r] = fmaf(p1[r], C, mnC);
#pragma unroll
  for (int r = 0; r < 16; ++r) p0[r] = __builtin_amdgcn_exp2f(p0[r]);
}
__device__ __forceinline__ void packP(const f32x16& p0, const f32x16& p1, bf16x8& pa0, bf16x8& pa1, bf16x8& pa2, bf16x8& pa3) {
#define PK4(P, BASE, OUT) do { unsigned a0 = cvtpk(P[BASE + 0], P[BASE + 1]), a1 = cvtpk(P[BASE + 2], P[BASE + 3]);   \
    unsigned b0 = cvtpk(P[BASE + 4], P[BASE + 5]), b1 = cvtpk(P[BASE + 6], P[BASE + 7]);                              \
    auto r0 = __builtin_amdgcn_permlane32_swap(a0, b0, false, false); auto r1 = __builtin_amdgcn_permlane32_swap(a1, b1, false, false); \
    u32x4 w = {r0[0], r1[0], r0[1], r1[1]}; OUT = *reinterpret_cast<bf16x8*>(&w); } while (0)
  PK4(p0, 0, pa0); PK4(p0, 8, pa1); PK4(p1, 0, pa2); PK4(p1, 8, pa3);
#undef PK4
}
__device__ __forceinline__ void finishSM(f32x16& p0, f32x16& p1, float alpha, float& l_reg, bf16x8& pa0, bf16x8& pa1, bf16x8& pa2, bf16x8& pa3) {
#pragma unroll
  for (int r = 0; r < 16; ++r) p1[r] = __builtin_amdgcn_exp2f(p1[r]);
  float ps = 0;
#pragma unroll
  for (int r = 0; r < 16; ++r) ps += p0[r];
#pragma unroll
  for (int r = 0; r < 16; ++r) ps += p1[r];
  { auto rr = __builtin_amdgcn_permlane32_swap(__float_as_uint(ps), __float_as_uint(ps), false, false);
    ps = __uint_as_float(rr[0]) + __uint_as_float(rr[1]); }
  l_reg = l_reg * alpha + ps;
  packP(p0, p1, pa0, pa1, pa2, pa3);
}
__device__ __forceinline__ void qkt(f32x16& p0, f32x16& p1, const char* Ks, const bf16x8* qr, int r32, int hi) {
  p0 = f32x16{}; p1 = f32x16{};
#pragma unroll
  for (int d0 = 0; d0 < 8; ++d0) { const int cb = (d0 * 16 + hi * 8) * 2;
    const bf16x8 b0 = *reinterpret_cast<const bf16x8*>(Ks + KSWZ(r32, cb));
    const bf16x8 b1 = *reinterpret_cast<const bf16x8*>(Ks + KSWZ(32 + r32, cb));
    p0 = __builtin_amdgcn_mfma_f32_32x32x16_bf16(b0, qr[d0], p0, 0, 0, 0);
    p1 = __builtin_amdgcn_mfma_f32_32x32x16_bf16(b1, qr[d0], p1, 0, 0, 0); }
}
__device__ __forceinline__ void qkt_rope(f32x16& p0, f32x16& p1, const char* Kr, const bf16x8* qr, int r32, int hi) {
#pragma unroll
  for (int d0 = 0; d0 < 4; ++d0) { const int cb = ((d0 * 16 + hi * 8) * 2) ^ ((r32 & 7) << 4);
    const bf16x8 b0 = *reinterpret_cast<const bf16x8*>(Kr + r32 * 128 + cb);
    const bf16x8 b1 = *reinterpret_cast<const bf16x8*>(Kr + (32 + r32) * 128 + cb);
    p0 = __builtin_amdgcn_mfma_f32_32x32x16_bf16(b0, qr[d0], p0, 0, 0, 0);
    p1 = __builtin_amdgcn_mfma_f32_32x32x16_bf16(b1, qr[d0], p1, 0, 0, 0); }
}
__device__ __forceinline__ int v_st(int k, int c) { const int kk = (k & ~0xC) | ((k & 4) << 1) | ((k & 8) >> 1); return ((kk >> 3) * 4 + (c >> 5)) * 512 + ((kk & 7) * 32 + (c & 31)) * 2; }
__device__ __forceinline__ int v_rd_base(int lane) { return ((lane & 3) << 3) | (((lane >> 2) & 3) << 6) | (((lane >> 4) & 1) << 5) | (((lane >> 5) & 1) << 8); }
constexpr int v_rd_off(int d0, int ks, int half) { return d0 * 512 + ks * 4096 + half * 2048; }
template <int OFF> __device__ __forceinline__ s16x4 tr_read(int vb) {
  s16x4 r; asm volatile("ds_read_b64_tr_b16 %0, %1 offset:%2" : "=&v"(r) : "v"(vb), "i"(OFF) : "memory"); return r;
}
template <int D0> __device__ __forceinline__ void pv_one(f32x16& od, int vb, bf16x8 pa0, bf16x8 pa1, bf16x8 pa2, bf16x8 pa3) {
  const s16x4 l0 = tr_read<v_rd_off(D0, 0, 0)>(vb), h0 = tr_read<v_rd_off(D0, 0, 1)>(vb), l1 = tr_read<v_rd_off(D0, 1, 0)>(vb), h1 = tr_read<v_rd_off(D0, 1, 1)>(vb);
  const s16x4 l2 = tr_read<v_rd_off(D0, 2, 0)>(vb), h2 = tr_read<v_rd_off(D0, 2, 1)>(vb), l3 = tr_read<v_rd_off(D0, 3, 0)>(vb), h3 = tr_read<v_rd_off(D0, 3, 1)>(vb);
  asm volatile("s_waitcnt lgkmcnt(0)" ::: "memory"); ATT_SBAR();
#define PK(L, H) (bf16x8){L[0], L[1], L[2], L[3], H[0], H[1], H[2], H[3]}
  od = __builtin_amdgcn_mfma_f32_32x32x16_bf16(pa0, PK(l0, h0), od, 0, 0, 0);
  od = __builtin_amdgcn_mfma_f32_32x32x16_bf16(pa1, PK(l1, h1), od, 0, 0, 0);
  od = __builtin_amdgcn_mfma_f32_32x32x16_bf16(pa2, PK(l2, h2), od, 0, 0, 0);
  od = __builtin_amdgcn_mfma_f32_32x32x16_bf16(pa3, PK(l3, h3), od, 0, 0, 0);
#undef PK
}
__device__ __forceinline__ void pv_d0(f32x16* o, int vb, bf16x8 pa0, bf16x8 pa1, bf16x8 pa2, bf16x8 pa3) {
  pv_one<0>(o[0], vb, pa0, pa1, pa2, pa3); pv_one<1>(o[1], vb, pa0, pa1, pa2, pa3); pv_one<2>(o[2], vb, pa0, pa1, pa2, pa3); pv_one<3>(o[3], vb, pa0, pa1, pa2, pa3);
}
#define ATT_RESC(a) do { if (__any((a) < 1.f)) { if (hi == 0) al_l[r32] = (a); asm volatile("s_waitcnt lgkmcnt(0)" ::: "memory"); \
    _Pragma("unroll") for (int d = 0; d < 4; ++d) _Pragma("unroll") for (int r = 0; r < 16; ++r) o[d][r] *= al_l[crow(r, hi)]; } } while (0)
__device__ __forceinline__ void store_o(const f32x16* o, const float* rli, bf16_t* stg, bf16_t* Og  , int ldo, int lane, int r32, int hi) {
#pragma unroll
  for (int r = 0; r < 16; ++r) { const int orow = crow(r, hi);
#pragma unroll
    for (int d0 = 0; d0 < 4; ++d0) stg[orow * 128 + d0 * 32 + r32] = (bf16_t)(cvtpk(o[d0][r] * rli[r], 0.f) & 0xffffu); }
  asm volatile("s_waitcnt lgkmcnt(0)" ::: "memory");
#pragma unroll
  for (int i = 0; i < 8; ++i) { const int row = i * 4 + (lane >> 4), ch = lane & 15; const u32x4 v = *(const u32x4*)(stg + row * 128 + ch * 8); *(u32x4*)(Og + (size_t)row * ldo + ch * 8) = v; }
}

__device__ __forceinline__ void dsa_attn_unit(int b, int g, int c, const bf16_t* __restrict__ Q, const bf16_t* __restrict__ K, const bf16_t* __restrict__ V,
                                              const unsigned long long* __restrict__ MASK, bf16_t* __restrict__ O, char* lds) {
  int tid = threadIdx.x; asm volatile("" : "+v"(tid));
  const int wid = __builtin_amdgcn_readfirstlane(tid >> 6), lane = tid & 63, r32 = lane & 31, hi = lane >> 5;
  char* V_lds = lds; char* K_lds = lds + 2 * SHM_KV;
  float* ws = (float*)(lds + 4 * SHM_KV) + wid * 64; float* li_l = ws; float* al_l = ws + 32;
  const int head = 4 * g + (wid >> 1);
  const long qrow0 = (long)b * 4096 + 64 * c + 32 * (wid & 1), qrow = qrow0 + r32;
  bf16x8 qr[8];
  { const bf16_t* Qw = Q + qrow * 2048 + head * 128 + hi * 8;
#pragma unroll
    for (int d0 = 0; d0 < 8; ++d0) qr[d0] = *reinterpret_cast<const bf16x8*>(Qw + d0 * 16); }
  const int sr = tid >> 4, sc = (tid & 15) * 8, vst0 = v_st(sr, sc), vst1 = v_st(32 + sr, sc);
  const int vb0 = (int)(uintptr_t)V_lds + v_rd_base(lane);
  const bf16_t* Kh = K + (long)b * 4096 * 512 + g * 128; const bf16_t* Vh = V + (long)b * 4096 * 512 + g * 128;
  bf16x8 vs0, vs1, ks0, ks1;
#define SLOAD(k0) do { vs0 = *reinterpret_cast<const bf16x8*>(Vh + (long)((k0) + sr) * 512 + sc); vs1 = *reinterpret_cast<const bf16x8*>(Vh + (long)((k0) + 32 + sr) * 512 + sc); \
    ks0 = *reinterpret_cast<const bf16x8*>(Kh + (long)((k0) + sr) * 512 + sc); ks1 = *reinterpret_cast<const bf16x8*>(Kh + (long)((k0) + 32 + sr) * 512 + sc); } while (0)
#define SWRITE(bf) do { *(bf16x8*)(V_lds + (bf) * SHM_KV + vst0) = vs0; *(bf16x8*)(V_lds + (bf) * SHM_KV + vst1) = vs1; \
    *(bf16x8*)(K_lds + (bf) * SHM_KV + KSWZ(sr, sc * 2)) = ks0; *(bf16x8*)(K_lds + (bf) * SHM_KV + KSWZ(32 + sr, sc * 2)) = ks1; } while (0)
  const int NT = c + 1;
  float m_reg = -1e30f, l_reg = 0.f; f32x16 o[4];
#pragma unroll
  for (int d = 0; d < 4; ++d) o[d] = f32x16{};
  const unsigned long long* mrow = MASK + qrow * 64;
  SLOAD(0); SWRITE(0); if (NT > 1) SLOAD(64);
  unsigned long long mw = mrow[0];
  for (int j = 0; j < NT; ++j) {
    __syncthreads();
    if (j + 1 < NT) SWRITE((j + 1) & 1);
    if (j + 2 < NT) SLOAD((j + 2) * 64);
    const unsigned long long mw_next = (j + 1 < NT) ? mrow[j + 1] : 0ull;
    f32x16 p0, p1; qkt(p0, p1, K_lds + (j & 1) * SHM_KV, qr, r32, hi);
    { const unsigned mlo = (unsigned)mw >> (4 * hi), mhi = (unsigned)(mw >> 32) >> (4 * hi);
#pragma unroll
      for (int r = 0; r < 16; ++r) { const int cb = (r & 3) + 8 * (r >> 2);
        p0[r] = ((mlo >> cb) & 1u) ? p0[r] : -INFINITY; p1[r] = ((mhi >> cb) & 1u) ? p1[r] : -INFINITY; } }
    float mn, alpha; partialSM<88388348>(p0, p1, m_reg, mn, alpha);
    bf16x8 pa0, pa1, pa2, pa3; finishSM(p0, p1, alpha, l_reg, pa0, pa1, pa2, pa3);
    ATT_RESC(alpha);
    pv_d0(o, vb0 + (j & 1) * SHM_KV, pa0, pa1, pa2, pa3);
    mw = mw_next;
  }
  if (hi == 0) li_l[r32] = l_reg; asm volatile("s_waitcnt lgkmcnt(0)" ::: "memory");
  float rli[16];
#pragma unroll
  for (int r = 0; r < 16; ++r) rli[r] = __builtin_amdgcn_rcpf(li_l[crow(r, hi)]);
  __syncthreads();
  store_o(o, rli, (bf16_t*)(lds + wid * 8192), O + qrow0 * 2048 + head * 128, 2048, lane, r32, hi);
  __syncthreads();
#undef SLOAD
#undef SWRITE
}

__device__ __forceinline__ void mla_attn_unit(int b, int h, int qb, const bf16_t* __restrict__ QN, const bf16_t* __restrict__ QR, const bf16_t* __restrict__ KN, const bf16_t* __restrict__ KR,
                                              const bf16_t* __restrict__ V, bf16_t* __restrict__ O, char* lds) {
  int tid = threadIdx.x; asm volatile("" : "+v"(tid));
  const int wid = __builtin_amdgcn_readfirstlane(tid >> 6), lane = tid & 63, r32 = lane & 31, hi = lane >> 5;
  char* V_lds = lds; char* K_lds = lds + 2 * SHM_KV; char* R_lds = lds + 4 * SHM_KV;
  float* ws = (float*)(lds + 4 * SHM_KV + 16384) + wid * 64; float* li_l = ws; float* al_l = ws + 32;
  const long qrow0 = (long)b * 4096 + 256 * qb + 32 * wid, qrow = qrow0 + r32;
  bf16x8 qr[12];
  { const bf16_t* Qw = QN + qrow * 2048 + h * 128 + hi * 8;
#pragma unroll
    for (int d0 = 0; d0 < 8; ++d0) qr[d0] = *reinterpret_cast<const bf16x8*>(Qw + d0 * 16);
    const bf16_t* Qx = QR + qrow * 1024 + h * 64 + hi * 8;
#pragma unroll
    for (int d0 = 0; d0 < 4; ++d0) qr[8 + d0] = *reinterpret_cast<const bf16x8*>(Qx + d0 * 16); }
  const int sr = tid >> 4, sc = (tid & 15) * 8, vst0 = v_st(sr, sc), vst1 = v_st(32 + sr, sc);
  const int rr_ = tid >> 3, rc = (tid & 7) * 8, rst = rr_ * 128 + ((rc * 2) ^ ((rr_ & 7) << 4));
  const int vb0 = (int)(uintptr_t)V_lds + v_rd_base(lane);
  const bf16_t* Kh = KN + (long)b * 4096 * 2048 + h * 128; const bf16_t* Vh = V + (long)b * 4096 * 2048 + h * 128; const bf16_t* Rh = KR + (long)b * 4096 * 64;
  bf16x8 vs0, vs1, ks0, ks1, rs0;
#define SLOAD(k0) do { vs0 = *reinterpret_cast<const bf16x8*>(Vh + (long)((k0) + sr) * 2048 + sc); vs1 = *reinterpret_cast<const bf16x8*>(Vh + (long)((k0) + 32 + sr) * 2048 + sc); \
    ks0 = *reinterpret_cast<const bf16x8*>(Kh + (long)((k0) + sr) * 2048 + sc); ks1 = *reinterpret_cast<const bf16x8*>(Kh + (long)((k0) + 32 + sr) * 2048 + sc); \
    rs0 = *reinterpret_cast<const bf16x8*>(Rh + (long)((k0) + rr_) * 64 + rc); } while (0)
#define SWRITE(bf) do { *(bf16x8*)(V_lds + (bf) * SHM_KV + vst0) = vs0; *(bf16x8*)(V_lds + (bf) * SHM_KV + vst1) = vs1; \
    *(bf16x8*)(K_lds + (bf) * SHM_KV + KSWZ(sr, sc * 2)) = ks0; *(bf16x8*)(K_lds + (bf) * SHM_KV + KSWZ(32 + sr, sc * 2)) = ks1; \
    *(bf16x8*)(R_lds + (bf) * 8192 + rst) = rs0; } while (0)
  const int NT = 4 * qb + 4, NTw = 4 * qb + (wid >> 1) + 1;
  float m_reg = -1e30f, l_reg = 0.f; f32x16 o[4];
#pragma unroll
  for (int d = 0; d < 4; ++d) o[d] = f32x16{};
  SLOAD(0); SWRITE(0); SLOAD(64);
  for (int j = 0; j < NT; ++j) {
    __syncthreads();
    if (j + 1 < NT) SWRITE((j + 1) & 1);
    if (j + 2 < NT) SLOAD((j + 2) * 64);
    if (j < NTw) {
      f32x16 p0, p1; qkt(p0, p1, K_lds + (j & 1) * SHM_KV, qr, r32, hi); qkt_rope(p0, p1, R_lds + (j & 1) * 8192, qr + 8, r32, hi);
      float mn, alpha; partialSM<72168784>(p0, p1, m_reg, mn, alpha);
      bf16x8 pa0, pa1, pa2, pa3; finishSM(p0, p1, alpha, l_reg, pa0, pa1, pa2, pa3);
      ATT_RESC(alpha);
      pv_d0(o, vb0 + (j & 1) * SHM_KV, pa0, pa1, pa2, pa3);
    }
  }
  if (hi == 0) li_l[r32] = l_reg; asm volatile("s_waitcnt lgkmcnt(0)" ::: "memory");
  float rli[16];
#pragma unroll
  for (int r = 0; r < 16; ++r) rli[r] = __builtin_amdgcn_rcpf(li_l[crow(r, hi)]);
  __syncthreads();
  store_o(o, rli, (bf16_t*)(lds + wid * 8192), O + qrow0 * 2048 + h * 128, 2048, lane, r32, hi);
  __syncthreads();
#undef SLOAD
#undef SWRITE
}

__device__ __forceinline__ void sb_attn_unit(int b, int h, int qb, const bf16_t* __restrict__ Q, const bf16_t* __restrict__ K, const bf16_t* __restrict__ V, bf16_t* __restrict__ O, char* lds) {
  int tid = threadIdx.x; asm volatile("" : "+v"(tid));
  const int wid = __builtin_amdgcn_readfirstlane(tid >> 6), lane = tid & 63, r32 = lane & 31, hi = lane >> 5;
  char* V_lds = lds; char* K_lds = lds + 2 * SHM_KV;
  volatile __attribute__((address_space(3))) int* fl = (volatile __attribute__((address_space(3))) int*)(lds + 4 * SHM_KV + 2048);
  const int tw0 = 256 * qb + 32 * wid, t = tw0 + r32;
  const long qrow0 = (long)b * 4096 + tw0, qrow = qrow0 + r32;
  bf16x8 qr[8];
  { const bf16_t* Qw = Q + qrow * 2048 + h * 128 + hi * 8;
#pragma unroll
    for (int d0 = 0; d0 < 8; ++d0) qr[d0] = *reinterpret_cast<const bf16x8*>(Qw + d0 * 16); }
  const int sr = tid >> 4, sc = (tid & 15) * 8, vst0 = v_st(sr, sc), vst1 = v_st(32 + sr, sc);
  const int vb0 = (int)(uintptr_t)V_lds + v_rd_base(lane);
  const bf16_t* Kh = K + (long)b * 4096 * 2048 + h * 128; const bf16_t* Vh = V + (long)b * 4096 * 2048 + h * 128;
  bf16x8 vs0, vs1, ks0, ks1;
#define SLOAD(k0) do { vs0 = *reinterpret_cast<const bf16x8*>(Vh + (long)((k0) + sr) * 2048 + sc); vs1 = *reinterpret_cast<const bf16x8*>(Vh + (long)((k0) + 32 + sr) * 2048 + sc); \
    ks0 = *reinterpret_cast<const bf16x8*>(Kh + (long)((k0) + sr) * 2048 + sc); ks1 = *reinterpret_cast<const bf16x8*>(Kh + (long)((k0) + 32 + sr) * 2048 + sc); } while (0)
#define SWRITE(bf) do { *(bf16x8*)(V_lds + (bf) * SHM_KV + vst0) = vs0; *(bf16x8*)(V_lds + (bf) * SHM_KV + vst1) = vs1; \
    *(bf16x8*)(K_lds + (bf) * SHM_KV + KSWZ(sr, sc * 2)) = ks0; *(bf16x8*)(K_lds + (bf) * SHM_KV + KSWZ(32 + sr, sc * 2)) = ks1; } while (0)
  const int NT = 4 * qb + 4;
  constexpr float C = 0.08838834764831845f * 1.4426950408889634f;
  float Rp = 1.f; bool wdone = false; f32x16 o[4];
#pragma unroll
  for (int d = 0; d < 4; ++d) o[d] = f32x16{};
  SLOAD((NT - 1) * 64); SWRITE(0); SLOAD((NT - 2) * 64);
  for (int j = 0; j < NT; ++j) {
    __syncthreads();
    if (j > 0) { int all = 1;
#pragma unroll
      for (int w = 0; w < 8; ++w) all &= fl[((j - 1) & 1) * 8 + w];
      if (all) break; }
    if (j + 1 < NT) SWRITE((j + 1) & 1);
    if (j + 2 < NT) SLOAD((NT - 3 - j) * 64);
    const int T = NT - 1 - j;
    if (64 * T <= tw0 + 30 && !wdone) {
      f32x16 p0, p1; qkt(p0, p1, K_lds + (j & 1) * SHM_KV, qr, r32, hi);
      f32x16 k0, k1;
      const bool needmask = (64 * T + 63 >= tw0);
#pragma unroll
      for (int r = 0; r < 16; ++r) {
        { const float z = p0[r] * C, e = __builtin_amdgcn_exp2f(-fabsf(z)), big = __builtin_amdgcn_rcpf(1.f + e), sml = e * big; float be = z >= 0.f ? big : sml, ke = z >= 0.f ? sml : big;
          if (needmask && (64 * T + crow(r, hi) >= t)) { be = 0.f; ke = 1.f; } p0[r] = be; k0[r] = ke; }
        { const float z = p1[r] * C, e = __builtin_amdgcn_exp2f(-fabsf(z)), big = __builtin_amdgcn_rcpf(1.f + e), sml = e * big; float be = z >= 0.f ? big : sml, ke = z >= 0.f ? sml : big;
          if (needmask && (64 * T + 32 + crow(r, hi) >= t)) { be = 0.f; ke = 1.f; } p1[r] = be; k1[r] = ke; }
      }
      float GP[16];
#pragma unroll
      for (int q = 0; q < 4; ++q) {
        const float g0 = (k0[4 * q] * k0[4 * q + 1]) * (k0[4 * q + 2] * k0[4 * q + 3]), g1 = (k1[4 * q] * k1[4 * q + 1]) * (k1[4 * q + 2] * k1[4 * q + 3]);
        auto x0 = __builtin_amdgcn_permlane32_swap(__float_as_uint(g0), __float_as_uint(g0), false, false);
        auto x1 = __builtin_amdgcn_permlane32_swap(__float_as_uint(g1), __float_as_uint(g1), false, false);
        GP[2 * q] = __uint_as_float(x0[0]); GP[2 * q + 1] = __uint_as_float(x0[1]); GP[8 + 2 * q] = __uint_as_float(x1[0]); GP[8 + 2 * q + 1] = __uint_as_float(x1[1]);
      }
      float SG[16]; SG[15] = 1.f;
#pragma unroll
      for (int g = 14; g >= 0; --g) SG[g] = SG[g + 1] * GP[g + 1];
      const float tileprod = SG[0] * GP[0];
#pragma unroll
      for (int q = 0; q < 4; ++q) {
        { const float base = Rp * (hi ? SG[2 * q + 1] : SG[2 * q]); const float w2 = k0[4 * q + 3], w1 = w2 * k0[4 * q + 2], w0 = w1 * k0[4 * q + 1];
          p0[4 * q + 3] *= base; p0[4 * q + 2] *= base * w2; p0[4 * q + 1] *= base * w1; p0[4 * q] *= base * w0; }
        { const float base = Rp * (hi ? SG[8 + 2 * q + 1] : SG[8 + 2 * q]); const float w2 = k1[4 * q + 3], w1 = w2 * k1[4 * q + 2], w0 = w1 * k1[4 * q + 1];
          p1[4 * q + 3] *= base; p1[4 * q + 2] *= base * w2; p1[4 * q + 1] *= base * w1; p1[4 * q] *= base * w0; }
      }
      Rp *= tileprod;
      bf16x8 pa0, pa1, pa2, pa3; packP(p0, p1, pa0, pa1, pa2, pa3);
      pv_d0(o, vb0 + (j & 1) * SHM_KV, pa0, pa1, pa2, pa3);
      wdone = __all(Rp == 0.f);
    }
    if (lane == 0) fl[(j & 1) * 8 + wid] = wdone ? 1 : 0;
  }
  float rli[16];
#pragma unroll
  for (int r = 0; r < 16; ++r) rli[r] = 1.f;
  __syncthreads();
  store_o(o, rli, (bf16_t*)(lds + wid * 8192), O + qrow0 * 2048 + h * 128, 2048, lane, r32, hi);
  __syncthreads();
#undef SLOAD
#undef SWRITE
}

__device__ __forceinline__ void idx_unit(int b, int qq, const bf16_t* __restrict__ IQ, const bf16_t* __restrict__ IK, const float* __restrict__ IW, float* __restrict__ SC, char* lds) {
  int tid = threadIdx.x; asm volatile("" : "+v"(tid));
  const int wid = __builtin_amdgcn_readfirstlane(tid >> 6), lane = tid & 63, r32 = lane & 31, hi = lane >> 5;
  char* K_lds = lds;
  const int c = qq >> 1, NT = c + 1;
  const long t0 = (long)b * 4096 + 32 * qq + 4 * wid;
  bf16x8 a[2][8]; float wgt[2][16];
#pragma unroll
  for (int rt = 0; rt < 2; ++rt) {
    const long qa = t0 + 2 * rt + ((r32 >> 2) & 1); const int ha = (r32 & 3) + 4 * (r32 >> 3);
    const bf16_t* p = IQ + qa * 2048 + ha * 128 + hi * 8;
#pragma unroll
    for (int ks = 0; ks < 8; ++ks) a[rt][ks] = *reinterpret_cast<const bf16x8*>(p + ks * 16);
    const float* wp = IW + (t0 + 2 * rt + hi) * 16;
#pragma unroll
    for (int i4 = 0; i4 < 4; ++i4) { const f32x4 w4 = *(const f32x4*)(wp + 4 * i4); wgt[rt][4 * i4] = w4[0]; wgt[rt][4 * i4 + 1] = w4[1]; wgt[rt][4 * i4 + 2] = w4[2]; wgt[rt][4 * i4 + 3] = w4[3]; }
  }
  const int sr = tid >> 4, sc = (tid & 15) * 8;
  const bf16_t* Kb = IK + (long)b * 4096 * 128;
  bf16x8 ks0, ks1;
#define SLOAD(k0) do { ks0 = *reinterpret_cast<const bf16x8*>(Kb + (long)((k0) + sr) * 128 + sc); ks1 = *reinterpret_cast<const bf16x8*>(Kb + (long)((k0) + 32 + sr) * 128 + sc); } while (0)
#define SWRITE(bf) do { *(bf16x8*)(K_lds + (bf) * SHM_KV + KSWZ(sr, sc * 2)) = ks0; *(bf16x8*)(K_lds + (bf) * SHM_KV + KSWZ(32 + sr, sc * 2)) = ks1; } while (0)
  SLOAD(0); SWRITE(0); if (NT > 1) SLOAD(64);
  for (int j = 0; j < NT; ++j) {
    __syncthreads();
    if (j + 1 < NT) SWRITE((j + 1) & 1);
    if (j + 2 < NT) SLOAD((j + 2) * 64);
    const char* Kt = K_lds + (j & 1) * SHM_KV;
#pragma unroll
    for (int kh = 0; kh < 2; ++kh) {
      bf16x8 bfr[8];
#pragma unroll
      for (int ks = 0; ks < 8; ++ks) bfr[ks] = *reinterpret_cast<const bf16x8*>(Kt + KSWZ(32 * kh + r32, (ks * 16 + hi * 8) * 2));
#pragma unroll
      for (int rt = 0; rt < 2; ++rt) {
        f32x16 acc = f32x16{};
#pragma unroll
        for (int ks = 0; ks < 8; ++ks) acc = __builtin_amdgcn_mfma_f32_32x32x16_bf16(a[rt][ks], bfr[ks], acc, 0, 0, 0);
        float s = 0.f;
#pragma unroll
        for (int i = 0; i < 16; ++i) s += wgt[rt][i] * fmaxf(acc[i], 0.f);
        SC[(t0 + 2 * rt + hi) * 4096 + 64 * j + 32 * kh + r32] = s;
      }
    }
  }
  __syncthreads();
#undef SLOAD
#undef SWRITE
}

__device__ __forceinline__ int wave_sum_i(int v) {
#pragma unroll
  for (int o = 1; o < 64; o <<= 1) v += __shfl_xor(v, o);
  return v;
}
__device__ __forceinline__ void topk_row(const float* __restrict__ sc_row, int c, unsigned long long* __restrict__ mask_row, int lane) {
  unsigned key[64];
  int cv = c; asm volatile("" : "+v"(cv));
#pragma unroll
  for (int g4 = 0; g4 < 4; ++g4) {
    if (16 * g4 <= c) {
#pragma unroll
      for (int j = 16 * g4; j < 16 * g4 + 16; ++j) key[j] = __float_as_uint(sc_row[j * 64 + lane]);
    } else {
#pragma unroll
      for (int j = 16 * g4; j < 16 * g4 + 16; ++j) key[j] = 0u;
    }
  }
#pragma unroll
  for (int j = 0; j < 64; ++j) { const unsigned u = key[j]; const unsigned k = (u & 0x80000000u) ? ~u : (u | 0x80000000u); key[j] = (j <= cv) ? k : 0u; }
  unsigned long long mine = 0ull; unsigned mlo = 0u, mhi = 0u;
  if (c < 4) {
    mine = (lane <= c) ? ~0ull : 0ull;
  } else {
    unsigned T = 0u; bool exact = false;
    for (int bit = 31; bit >= 0; --bit) {
      const unsigned cand = T | (1u << bit); int cnt = 0;
#pragma unroll
      for (int j = 0; j < 64; ++j) cnt += (key[j] >= cand) ? 1 : 0;
      cnt = __builtin_amdgcn_readfirstlane(wave_sum_i(cnt));
      if (cnt >= 256) { T = cand; if (cnt == 256) { exact = true; break; } }
    }
    asm volatile("" : "+v"(T));
    if (exact) {
#pragma unroll
      for (int j = 0; j < 64; ++j) { const unsigned long long m = __ballot(key[j] >= T);
        asm volatile("s_nop 3\n\tv_writelane_b32 %0, %2, %4\n\tv_writelane_b32 %1, %3, %4" : "+v"(mlo), "+v"(mhi) : "s"((unsigned)m), "s"((unsigned)(m >> 32)), "i"(j));     }
    } else {
      int gt = 0;
#pragma unroll
      for (int j = 0; j < 64; ++j) gt += (key[j] > T) ? 1 : 0;
      int need = 256 - __builtin_amdgcn_readfirstlane(wave_sum_i(gt));
#pragma unroll
      for (int j = 0; j < 64; ++j) {
        const unsigned long long g = __ballot(key[j] > T); unsigned long long e = __ballot(key[j] == T), take = 0ull;
        const int pe = __popcll(e);
        if (pe <= need) { take = e; need -= pe; } else { while (need > 0) { const unsigned long long lowb = e & (~e + 1ull); take |= lowb; e ^= lowb; --need; } }
        const unsigned long long m = g | take;
        asm volatile("s_nop 3\n\tv_writelane_b32 %0, %2, %4\n\tv_writelane_b32 %1, %3, %4" : "+v"(mlo), "+v"(mhi) : "s"((unsigned)m), "s"((unsigned)(m >> 32)), "i"(j));
      }
    }
  }
  if (c >= 4) mine = (unsigned long long)mlo | ((unsigned long long)mhi << 32);
  mask_row[lane] = mine;
}
#undef KSWZ
}

constexpr int NWAVES = 8;
constexpr int BATCH = 4, SEQ = 4096, DM = 2048, DFF = 5632, M = BATCH * SEQ;
constexpr int DSA_NP = 5376, MLA_DOWN_NP = 1280;
constexpr int NPH = 35;
#ifndef MK_ONE_LAUNCH
#define MK_ONE_LAUNCH 1
#endif
constexpr size_t MiB = 1u << 20;
constexpr size_t WS_CTL = 0, CTL_ZERO_BYTES = 1 * MiB;
constexpr size_t WS_MODS = 1 * MiB;
constexpr size_t WS_CS128 = 2 * MiB;
constexpr size_t WS_CS64 = 4 * MiB;
constexpr size_t WS_SSQ = 5 * MiB;
constexpr size_t WS_W = 6 * MiB;
constexpr size_t WL_STRIDE = 74 * MiB, WL_FFN1 = 0, WL_FFN2 = 44 * MiB, WL_OUT = 66 * MiB;
constexpr size_t WS_WDSA = WS_W + 4 * WL_STRIDE, WDSA_STRIDE = 21 * MiB;
constexpr size_t WS_WMLA = WS_WDSA + 2 * WDSA_STRIDE, WMLA_DOWN = 0, WMLA_UQ = 5 * MiB, WMLA_UKV = 8 * MiB;
constexpr size_t WS_WSB = WS_WMLA + 12 * MiB;
constexpr size_t WS_H = WS_WSB + 24 * MiB;
constexpr size_t WS_O = WS_H + 64 * MiB;
constexpr size_t WS_MIX = WS_O + 64 * MiB;
constexpr size_t MX_ACT = 0;
constexpr size_t MX_DQ = 0, MX_DK = 64 * MiB, MX_DV = 80 * MiB, MX_DIQ = 96 * MiB, MX_DIK = 160 * MiB, MX_DIW = 164 * MiB, MX_DMASK = 165 * MiB, MX_DSC = 176 * MiB;
constexpr size_t MX_MCQ = 0, MX_MCKV = 16 * MiB, MX_MKR = 32 * MiB, MX_MQN = 34 * MiB, MX_MQR = 98 * MiB, MX_MKN = 130 * MiB, MX_MV = 194 * MiB;
constexpr size_t MX_SQ = 0, MX_SK = 64 * MiB, MX_SV = 128 * MiB;
constexpr size_t WS_END = WS_MIX + 432 * MiB;
static_assert(WS_W + 380 * MiB - 6 * MiB == WS_H, "weight map");
constexpr int CW_TMO = 0, CW_BAR = 4096;
constexpr int RING_BYTES = 131072, LDSCTL_OFF = RING_BYTES, MISC_OFF = LDSCTL_OFF + 320, LDS_BYTES = 147456;

#define GAS __attribute__((address_space(1)))
#define LAS __attribute__((address_space(3)))
typedef unsigned short bf16;
typedef unsigned v4u __attribute__((ext_vector_type(4)));
typedef float f32x4 __attribute__((ext_vector_type(4)));
typedef GAS unsigned gu32;
#define RLX_AGENT __ATOMIC_RELAXED, __HIP_MEMORY_SCOPE_AGENT
#define LDS_WAIT() asm volatile("s_waitcnt lgkmcnt(0)" ::: "memory")
__device__ __forceinline__ unsigned f2bf(float f) { unsigned u = __builtin_bit_cast(unsigned, f); return (u + 0x7fffu + ((u >> 16) & 1u)) >> 16; }
__device__ __forceinline__ unsigned pk2(float lo, float hi) { return f2bf(lo) | (f2bf(hi) << 16); }

#define XB_TMO      128
#define XB_XCNT(j)  (256  + 64 * (j))
#define XB_XSUB(j)  (1280 + 64 * (j))
#define XB_XGEN(j)  (2304 + 64 * (j))
#define XB_TOP      3328
#define XB_TOPGEN   3392
#define XCD_BAR_WORDS 3456
#define XB_SPIN_CAP (1u << 18)

__device__ __forceinline__ unsigned xb_ld(unsigned* p)              { return __hip_atomic_load(p, __ATOMIC_RELAXED, __HIP_MEMORY_SCOPE_AGENT); }
__device__ __forceinline__ unsigned xb_add(unsigned* p, unsigned v) { return __hip_atomic_fetch_add(p, v, __ATOMIC_RELAXED, __HIP_MEMORY_SCOPE_AGENT); }
__device__ __forceinline__ unsigned xb_xcc_id() { return (unsigned)__builtin_amdgcn_s_getreg((3 << 11) | 20) & 0xFu; }
#define XB_SPIN(cond, bar) do { unsigned _sp = 0; while (cond) { __builtin_amdgcn_s_sleep(1); \
    if ((++_sp & 255u) == 0u) { if (xb_ld(&(bar)[XB_TMO])) break; if (_sp > XB_SPIN_CAP) { atomicAdd(&(bar)[XB_TMO], 1u); break; } } } } while (0)

struct XcdBarrier {
    unsigned* bar; unsigned x;
    volatile LAS unsigned* st;
};

__device__ __forceinline__ XcdBarrier xcd_barrier_post(unsigned* bar, volatile LAS unsigned* st) {
    XcdBarrier b; b.bar = bar; b.x = xb_xcc_id(); b.st = st;
    if (threadIdx.x == 0) (void)xb_add(&bar[XB_XCNT(b.x)], 1u);
    return b;
}
__device__ __forceinline__ void xcd_barrier_complete(unsigned* bar, unsigned x, unsigned& nloc, unsigned& nx) {
    const unsigned G = gridDim.x * gridDim.y * gridDim.z;
    unsigned sum, cnt, mine, sp = 0u;
    for (;;) {
        sum = 0u; cnt = 0u; mine = 0u;
#pragma unroll
        for (unsigned j = 0; j < 16; ++j) { const unsigned c = xb_ld(&bar[XB_XCNT(j)]); sum += c; cnt += (c > 0u) ? 1u : 0u; mine = (j == x) ? c : mine; }
        if (sum == G) break;
        __builtin_amdgcn_s_sleep(1);
        if ((++sp & 255u) == 0u) { if (xb_ld(&bar[XB_TMO])) break; if (sp > XB_SPIN_CAP) { atomicAdd(&bar[XB_TMO], 1u); break; } }
    }
    nloc = mine > 0u ? mine : 1u; nx = cnt > 0u ? cnt : 1u;
}

__device__ __forceinline__ void xcd_barrier(const XcdBarrier& b) {
    asm volatile("s_waitcnt vmcnt(0)" ::: "memory");
    __syncthreads();
    if (threadIdx.x == 0) {
        unsigned* bar = b.bar;
        __builtin_amdgcn_s_waitcnt(0);
        unsigned nloc = b.st[0], nx = b.st[1];
        if (nloc == 0u) { xcd_barrier_complete(bar, b.x, nloc, nx); b.st[0] = nloc; b.st[1] = nx; }
        const unsigned old = xb_add(&bar[XB_XSUB(b.x)], 1u);
        const unsigned gen = old / nloc;
        if (old + 1u == (gen + 1u) * nloc) {
            __builtin_amdgcn_fence(__ATOMIC_RELEASE, "agent");
            asm volatile("s_waitcnt vmcnt(0)" ::: "memory");
            const unsigned og = xb_add(&bar[XB_TOP], 1u);
            const unsigned tg = og / nx;
            if (og + 1u == (tg + 1u) * nx) xb_add(&bar[XB_TOPGEN], 1u);
            else XB_SPIN(xb_ld(&bar[XB_TOPGEN]) == tg, bar);
            __builtin_amdgcn_fence(__ATOMIC_ACQUIRE, "agent");
            xb_add(&bar[XB_XGEN(b.x)], 1u);
            asm volatile("s_waitcnt vmcnt(0)" ::: "memory");
        } else {
            XB_SPIN(xb_ld(&bar[XB_XGEN(b.x)]) == gen, bar);
            __builtin_amdgcn_fence(__ATOMIC_ACQUIRE, "agent");
            asm volatile("s_waitcnt vmcnt(0)" ::: "memory");
        }
    }
    __syncthreads();
}

struct Frame {
    LAS unsigned char* lds;
    volatile LAS unsigned* MISC;
    gu32* ctl;
    int tid, lane, wave;
    int vcu, G;
};
__device__ __forceinline__ float wave_sum(float v) {
#pragma unroll
    for (int o = 1; o < 64; o <<= 1) v += __shfl_xor(v, o);
    return v;
}
enum { KIND_ID = 0, KIND_DSA_IN = 1, KIND_MLA_DOWN = 2, KIND_MLA_UQ = 3, KIND_FFN1 = 4 };
__host__ __device__ __forceinline__ int srcblk(int kind, int nb, int& nvalid) {
    nvalid = 32;
    const int pn = nb >> 3, pb = nb & 7, bj = pb >> 2, wc = pb & 3;
    if (kind == KIND_ID) return nb * 32;
    if (kind == KIND_DSA_IN) {
        if (pn < 8)  return (2 * pn + (wc >> 1)) * 128 + 64 * bj + 32 * (wc & 1);
        if (pn < 10) return 2048 + (2 * (pn - 8) + (wc >> 1)) * 128 + 64 * bj + 32 * (wc & 1);
        if (pn < 12) return 2560 + (pn - 10) * 256 + 32 * pb;
        if (pn < 20) return 3072 + (2 * (pn - 12) + (wc >> 1)) * 128 + (wc & 1) * 64 + bj * 32;
        if (wc == 0) return 5120 + bj * 32;
        if (wc == 1) return 5120 + 64 + bj * 32;
        if (wc == 2 && bj == 0) { nvalid = 16; return 5248; }
        return -1;
    }
    if (kind == KIND_MLA_DOWN) { if (pn < 4) return nb * 32; if (wc == 0) return 1024 + 32 * bj; return -1; }
    if (kind == KIND_MLA_UQ) { if (pn < 8) return (2 * pn + bj) * 192 + 32 * wc; return (4 * (pn - 8) + wc) * 192 + 128 + 32 * bj; }
      return (bj ? 5632 : 0) + 128 * pn + 32 * wc;
}
__device__ __forceinline__ void conv_item(const float* __restrict__ W, int K, int Nsrc, int Nphys, int kind, const float* __restrict__ gk, bf16* __restrict__ WT, LAS float* scr, int item, int lane) {
    const int nblk = Nphys / 32, kb = item / nblk, nb = item % nblk, k0 = 64 * kb, n0 = 32 * nb;
    int nvalid; const int sb = srcblk(kind, nb, nvalid);
    const int c = lane & 7;
    if (sb < 0) {
#pragma unroll
        for (int j = 0; j < 4; ++j) { const int n = (lane >> 3) + 8 * j; *(GAS v4u*)(WT + (size_t)(n0 + n) * K + k0 + 8 * c) = (v4u){0u, 0u, 0u, 0u}; }
        return;
    }
#pragma unroll 8
    for (int i = 0; i < 32; ++i) { const int kk = 2 * i + (lane >> 5), cc = lane & 31;
        float v = (cc < nvalid) ? W[(size_t)(k0 + kk) * Nsrc + sb + cc] : 0.f;
        if (gk) v *= gk[k0 + kk];
        scr[kk * 33 + cc] = v; }
    LDS_WAIT(); asm volatile("" ::: "memory");
#pragma unroll
    for (int j = 0; j < 4; ++j) { const int n = (lane >> 3) + 8 * j; const LAS float* s = scr + (8 * c) * 33 + n;
        v4u o; o.x = pk2(s[0 * 33], s[1 * 33]); o.y = pk2(s[2 * 33], s[3 * 33]); o.z = pk2(s[4 * 33], s[5 * 33]); o.w = pk2(s[6 * 33], s[7 * 33]);
        *(GAS v4u*)(WT + (size_t)(n0 + n) * K + k0 + 8 * c) = o; }
    LDS_WAIT(); asm volatile("" ::: "memory");
}
__device__ __forceinline__ void cs_entry(int pos, int i, const double* rp  , float& co, float& si) {
    double inv = 1.0;
#pragma unroll
    for (int k = 0; k < 6; ++k) if ((i >> k) & 1) inv *= rp[k];
    const double a = (double)pos * inv;
    const double n = __builtin_rint(a * 0.63661977236758134308);
    double y = a - n * 1.5707963267948966; y -= n * 6.123233995736766e-17;
    const double y2 = y * y;
    double s = -7.6471637318198164759e-13;
    s = s * y2 + 1.6059043836821614599e-10; s = s * y2 - 2.5052108385441718775e-08; s = s * y2 + 2.7557319223985890653e-06; s = s * y2 - 1.9841269841269841270e-04;
    s = s * y2 + 8.3333333333333333333e-03; s = s * y2 - 1.6666666666666666667e-01; s = y + y * y2 * s;
    double c = 4.7794773323873852974e-14;
    c = c * y2 - 1.1470745597729724714e-11; c = c * y2 + 2.0876756987868098979e-09; c = c * y2 - 2.7557319223985890653e-07; c = c * y2 + 2.4801587301587301587e-05;
    c = c * y2 - 1.3888888888888888889e-03; c = c * y2 + 4.1666666666666666667e-02; c = c * y2 - 0.5; c = 1.0 + y2 * c;
    const int q = ((int)n) & 3;
    const double cc = (q == 0) ? c : (q == 1) ? -s : (q == 2) ? -c : s;
    const double ss = (q == 0) ? s : (q == 1) ? c : (q == 2) ? -s : -c;
    co = (float)cc; si = (float)ss;
}
__device__ __forceinline__ void modnorm_phase(const Frame& F0, const float* __restrict__ x, const float* __restrict__ g, const float* __restrict__ mods_l, int sh_off, int sc_off, bf16* __restrict__ H) {
    int tid_ = threadIdx.x; asm volatile("" : "+v"(tid_)); struct { int lane, wave, vcu, G; } F{tid_ & 63, __builtin_amdgcn_readfirstlane(tid_ >> 6), F0.vcu, F0.G};
    const int gw = F.vcu * NWAVES + F.wave, NGW = F.G * NWAVES;
    for (int m = gw; m < M; m += NGW) {
        const GAS f32x4* xr = (const GAS f32x4*)(x + (size_t)m * DM) + F.lane;
        f32x4 v[8]; float s = 0.f;
#pragma unroll
        for (int j = 0; j < 8; ++j) { v[j] = xr[64 * j]; s += (v[j].x * v[j].x + v[j].y * v[j].y) + (v[j].z * v[j].z + v[j].w * v[j].w); }
        const float rstd = 1.0f / sqrtf(wave_sum(s) * (1.0f / DM) + 1e-6f);
        const float* mb = mods_l + (size_t)(m >> 12) * 12288;
        GAS unsigned long long* o8 = (GAS unsigned long long*)(H + (size_t)m * DM) + F.lane;
#pragma unroll
        for (int j = 0; j < 8; ++j) { const int col = 256 * j + 4 * F.lane;
            const f32x4 g4 = *(const f32x4*)(g + col), sc4 = *(const f32x4*)(mb + sc_off + col), sh4 = *(const f32x4*)(mb + sh_off + col);
            const f32x4 r = v[j] * rstd * g4 * (sc4 + 1.0f) + sh4;
            o8[64 * j] = (unsigned long long)pk2(r.x, r.y) | ((unsigned long long)pk2(r.z, r.w) << 32); }
    }
}
__device__ __forceinline__ void finalnorm_phase(const Frame& F0, float* __restrict__ x, const float* __restrict__ g) {
    int tid_ = threadIdx.x; asm volatile("" : "+v"(tid_)); struct { int lane, wave, vcu, G; } F{tid_ & 63, __builtin_amdgcn_readfirstlane(tid_ >> 6), F0.vcu, F0.G};
    const int gw = F.vcu * NWAVES + F.wave, NGW = F.G * NWAVES;
    for (int m = gw; m < M; m += NGW) {
        GAS f32x4* xr = (GAS f32x4*)(x + (size_t)m * DM) + F.lane;
        f32x4 v[8]; float s = 0.f;
#pragma unroll
        for (int j = 0; j < 8; ++j) { v[j] = xr[64 * j]; s += (v[j].x * v[j].x + v[j].y * v[j].y) + (v[j].z * v[j].z + v[j].w * v[j].w); }
        const float rstd = 1.0f / sqrtf(wave_sum(s) * (1.0f / DM) + 1e-6f);
#pragma unroll
        for (int j = 0; j < 8; ++j) { const f32x4 g4 = *(const f32x4*)(g + 256 * j + 4 * F.lane); xr[64 * j] = v[j] * rstd * g4; }
    }
}

#ifndef SITE_MASK
#define SITE_MASK 0xFFFFu
#endif
#define SITE(s_) ((((unsigned)(SITE_MASK)) >> (s_)) & 1u)
#define IN(k) (LO <= (k) && (k) < HI)
#define SEAM(k) do { if constexpr (IN(k) && IN((k) + 1)) xcd_barrier(bar); } while (0)
struct Args { const float* in[39]; float* out; unsigned char* ws; int ph_lo, ph_hi, li, pad; };
template <int L, int LO, int HI> __device__ __forceinline__ void run_layer(const Frame& F, const Args& args, const XcdBarrier& bar, unsigned char* lds) {
        unsigned char* const ws = args.ws;
        float* const MODS = (float*)(ws + WS_MODS);
        float* const CS128 = (float*)(ws + WS_CS128);
        float* const CS64 = (float*)(ws + WS_CS64);
        float* const SSQ = (float*)(ws + WS_SSQ);
        bf16* const HB = (bf16*)(ws + WS_H);
        bf16* const OB = (bf16*)(ws + WS_O);
        unsigned char* const MIX = ws + WS_MIX;
        const int gw = F.vcu * NWAVES + F.wave, NGW = F.G * NWAVES;
        constexpr int l = L; constexpr int kind = (l == 3) ? 0 : l;
        constexpr int pb = (l == 0) ? 2 : (l == 1) ? 11 : (l == 2) ? 19 : 26;
        constexpr int cb = pb + ((kind == 0) ? 4 : (kind == 1) ? 3 : 2);
        unsigned char* const WL = ws + WS_W + (size_t)l * WL_STRIDE;
        const float* const mods_l = MODS + (size_t)l * 4 * 12288;
        if constexpr (kind == 0) {
            bf16* const DQ = (bf16*)(MIX + MX_DQ); bf16* const DK = (bf16*)(MIX + MX_DK); bf16* const DV = (bf16*)(MIX + MX_DV); bf16* const DIQ = (bf16*)(MIX + MX_DIQ); bf16* const DIK = (bf16*)(MIX + MX_DIK);
            float* const DIW = (float*)(MIX + MX_DIW); unsigned long long* const DMASK = (unsigned long long*)(MIX + MX_DMASK); float* const DSC = (float*)(MIX + MX_DSC);
            if constexpr (SITE(2) && IN(pb)) {
                pg8::Gemm g{HB, (const bf16*)(ws + WS_WDSA + (size_t)(l == 3) * WDSA_STRIDE), M, DSA_NP, DM}; pg8::StaticOrder S; S.init(M, DSA_NP, F.G, (int)blockIdx.x);
                pg8::EpiDsaIn E{DQ, DK, DV, DIQ, DIK, DIW, CS128, CS64};
                pg8::gemm_phase<pg8::EpiDsaIn, pg8::StaticOrder, true, true>(F.lds, g, S, E);
                SEAM(pb);
            }
            if constexpr (SITE(3) && IN(pb + 1)) {
                for (int idx = F.vcu; idx < 512; idx += F.G) { const int s = idx & 255, r = idx >> 8, b = s >> 6, loc = s & 63, qq = r ? 127 - loc : loc;
                    att::idx_unit(b, qq, DIQ, DIK, DIW, DSC, (char*)lds); }
                SEAM(pb + 1);
            }
            if constexpr (SITE(4) && IN(pb + 2)) {
                int tid_ = threadIdx.x; asm volatile("" : "+v"(tid_)); const int lane_ = tid_ & 63, gw_ = F.vcu * NWAVES + __builtin_amdgcn_readfirstlane(tid_ >> 6);
                for (int row = gw_; row < M; row += NGW) att::topk_row(DSC + (size_t)row * 4096, (row & 4095) >> 6, DMASK + (size_t)row * 64, lane_);
                SEAM(pb + 2);
            }
            if constexpr (SITE(5) && IN(pb + 3)) {
                for (int idx = F.vcu; idx < 1024; idx += F.G) { const int s = idx & 255, r = idx >> 8, bg = s >> 4, loc = s & 15;
                    const int c = (r == 0) ? loc : (r == 1) ? 63 - loc : (r == 2) ? loc + 16 : 47 - loc;
                    att::dsa_attn_unit(bg >> 2, bg & 3, c, DQ, DK, DV, DMASK, OB, (char*)lds); }
                SEAM(pb + 3);
            }
        } else if constexpr (kind == 1) {
            bf16* const CQ = (bf16*)(MIX + MX_MCQ); bf16* const CKV = (bf16*)(MIX + MX_MCKV); bf16* const KR = (bf16*)(MIX + MX_MKR); bf16* const QN = (bf16*)(MIX + MX_MQN); bf16* const QR = (bf16*)(MIX + MX_MQR);
            bf16* const KN = (bf16*)(MIX + MX_MKN); bf16* const MV = (bf16*)(MIX + MX_MV);
            if constexpr (SITE(6) && IN(pb)) {
                pg8::Gemm g{HB, (const bf16*)(ws + WS_WMLA + WMLA_DOWN), M, MLA_DOWN_NP, DM}; pg8::StaticOrder S; S.init(M, MLA_DOWN_NP, F.G, (int)blockIdx.x);
                pg8::EpiMlaDown E{CQ, CKV, KR, SSQ, CS64};
                pg8::gemm_phase<pg8::EpiMlaDown, pg8::StaticOrder, true, true>(F.lds, g, S, E);
                SEAM(pb);
            }
            if constexpr (SITE(7) && IN(pb + 1)) {
                { pg8::Gemm g{CQ, (const bf16*)(ws + WS_WMLA + WMLA_UQ), M, 3072, 512}; pg8::StaticOrder S; S.init(M, 3072, F.G, (int)blockIdx.x);
                  pg8::EpiMlaUq E{QN, QR, SSQ, CS64};
                  pg8::gemm_phase<pg8::EpiMlaUq, pg8::StaticOrder, true, true>(F.lds, g, S, E); }
                { pg8::Gemm g{CKV, (const bf16*)(ws + WS_WMLA + WMLA_UKV), M, 4096, 512}; pg8::StaticOrder S; S.init(M, 4096, F.G, (int)blockIdx.x);
                  pg8::EpiMlaUkv E{KN, MV, SSQ};
                  pg8::gemm_phase<pg8::EpiMlaUkv, pg8::StaticOrder, true, true>(F.lds, g, S, E); }
                SEAM(pb + 1);
            }
            if constexpr (SITE(8) && IN(pb + 2)) {
                for (int idx = F.vcu; idx < 1024; idx += F.G) { const int s = idx & 255, r = idx >> 8, bh = s >> 2, loc = s & 3;
                    const int qb = (r == 0) ? loc : (r == 1) ? 15 - loc : (r == 2) ? loc + 4 : 11 - loc;
                    att::mla_attn_unit(bh >> 4, bh & 15, qb, QN, QR, KN, KR, MV, OB, (char*)lds); }
                SEAM(pb + 2);
            }
        } else {
            bf16* const SQ = (bf16*)(MIX + MX_SQ); bf16* const SK = (bf16*)(MIX + MX_SK); bf16* const SV = (bf16*)(MIX + MX_SV);
            if constexpr (SITE(9) && IN(pb)) {
                pg8::Gemm g{HB, (const bf16*)(ws + WS_WSB), M, 3 * DM, DM}; pg8::StaticOrder S; S.init(M, 3 * DM, F.G, (int)blockIdx.x);
                pg8::EpiSplit3 E{SQ, (size_t)(MX_SK - MX_SQ) / 2}; static_assert(MX_SV - MX_SK == MX_SK - MX_SQ, "q | k | v equally spaced");
                pg8::gemm_phase<pg8::EpiSplit3, pg8::StaticOrder, true, true>(F.lds, g, S, E);
                SEAM(pb);
            }
            if constexpr (SITE(10) && IN(pb + 1)) {
                for (int idx = F.vcu; idx < 1024; idx += F.G) { const int s = idx & 255, r = idx >> 8, bh = s >> 2, loc = s & 3;
                    const int qb = (r == 0) ? loc : (r == 1) ? 15 - loc : (r == 2) ? loc + 4 : 11 - loc;
                    att::sb_attn_unit(bh >> 4, bh & 15, qb, SQ, SK, SV, OB, (char*)lds); }
                SEAM(pb + 1);
            }
        }
        if constexpr (SITE(11) && IN(cb)) {
            pg8::Gemm g{OB, (const bf16*)(WL + WL_OUT), M, DM, DM}; pg8::StaticOrder S; S.init(M, DM, F.G, (int)blockIdx.x);
            pg8::EpiResid E{(l == 0) ? args.in[0] : (const float*)args.out, args.out, mods_l + 4096};
            pg8::gemm_phase<pg8::EpiResid, pg8::StaticOrder, true, true>(F.lds, g, S, E);
            SEAM(cb);
        }
        if constexpr (SITE(12) && IN(cb + 1)) {
            const float* gf = (l == 0) ? args.in[5] : (l == 1) ? args.in[13] : (l == 2) ? args.in[25] : args.in[33];
            modnorm_phase(F, args.out, gf, mods_l, 6144, 8192, HB); SEAM(cb + 1);
        }
        if constexpr (SITE(13) && IN(cb + 2)) {
            pg8::Gemm g{HB, (const bf16*)(WL + WL_FFN1), M, 2 * DFF, DM}; pg8::StaticOrder S; S.init(M, 2 * DFF, F.G, (int)blockIdx.x);
            pg8::EpiSwiglu E{(bf16*)(MIX + MX_ACT)};
            pg8::gemm_phase<pg8::EpiSwiglu, pg8::StaticOrder, true, true>(F.lds, g, S, E);
            SEAM(cb + 2);
        }
        if constexpr (SITE(14) && IN(cb + 3)) {
            pg8::Gemm g{(const bf16*)(MIX + MX_ACT), (const bf16*)(WL + WL_FFN2), M, DM, DFF}; pg8::StaticOrder S; S.init(M, DM, F.G, (int)blockIdx.x);
            pg8::EpiResid E{(const float*)args.out, args.out, mods_l + 10240};
            pg8::gemm_phase<pg8::EpiResid, pg8::StaticOrder, true, true>(F.lds, g, S, E);
            SEAM(cb + 3);
        }
        if constexpr (SITE(15) && IN(cb + 4)) {
            if (l < 3) { const float* gm = (l == 0) ? args.in[12] : (l == 1) ? args.in[24] : args.in[32];
                modnorm_phase(F, args.out, gm, mods_l + 4 * 12288, 0, 2048, HB); SEAM(cb + 4); }
            else finalnorm_phase(F, args.out, args.in[38]);
        }
}
template <int LO, int HI> __global__ void __launch_bounds__(NWAVES * 64, 2) trunk_fwd(Args args) {
    extern __shared__ __attribute__((aligned(16))) unsigned char lds[];
    Frame F;
    F.lds = (LAS unsigned char*)lds;
    F.MISC = (volatile LAS unsigned*)(F.lds + MISC_OFF);
    F.tid = threadIdx.x; F.lane = F.tid & 63; F.wave = __builtin_amdgcn_readfirstlane(F.tid >> 6);
    F.G = gridDim.x; { const int bx = blockIdx.x; F.vcu = (F.G % 8 == 0) ? (bx % 8) * (F.G / 8) + bx / 8 : bx; }
    unsigned char* const ws = args.ws;
    F.ctl = (gu32*)(ws + WS_CTL);
    for (int u = F.tid; u < (LDS_BYTES - LDSCTL_OFF) / 4; u += NWAVES * 64) ((LAS unsigned*)(F.lds + LDSCTL_OFF))[u] = 0u;
    __syncthreads();
    XcdBarrier bar = xcd_barrier_post((unsigned*)(F.ctl + CW_BAR) + args.li * XCD_BAR_WORDS, F.MISC + 8);
    float* const MODS = (float*)(ws + WS_MODS);
    float* const CS128 = (float*)(ws + WS_CS128);
    float* const CS64 = (float*)(ws + WS_CS64);
    float* const SSQ = (float*)(ws + WS_SSQ);
    bf16* const HB = (bf16*)(ws + WS_H);
    bf16* const OB = (bf16*)(ws + WS_O);
    unsigned char* const MIX = ws + WS_MIX;
    const int gw = F.vcu * NWAVES + F.wave, NGW = F.G * NWAVES;

    if constexpr (SITE(0) && IN(0)) {
        {
            LAS float* silc = (LAS float*)F.lds;
            LAS float* red = (LAS float*)(F.lds + 32768);
            const float* cvec = args.in[1];
            for (int i = F.tid; i < 4 * DM; i += NWAVES * 64) { const float c = cvec[i]; silc[i] = c / (1.0f + __expf(-c)); }
            __syncthreads();
            for (int it = F.vcu; it < 4 * 192; it += F.G) {
                const int l = it / 192, ng = it % 192;
                const float* W = (l == 0) ? args.in[2] : (l == 1) ? args.in[10] : (l == 2) ? args.in[22] : args.in[30];
                const float* Bv = (l == 0) ? args.in[3] : (l == 1) ? args.in[11] : (l == 2) ? args.in[23] : args.in[31];
                const int c4 = F.lane & 15, kr = F.lane >> 4, k0 = 256 * F.wave;
                f32x4 acc[4];
#pragma unroll
                for (int b = 0; b < 4; ++b) acc[b] = (f32x4){0.f, 0.f, 0.f, 0.f};
#pragma unroll 8
                for (int kk = 0; kk < 64; ++kk) { const int k = k0 + 4 * kk + kr;
                    const f32x4 w4 = *(const GAS f32x4*)(W + (size_t)k * 12288 + 64 * ng + 4 * c4);
#pragma unroll
                    for (int b = 0; b < 4; ++b) acc[b] += w4 * silc[b * DM + k]; }
#pragma unroll
                for (int b = 0; b < 4; ++b)
#pragma unroll
                    for (int e = 0; e < 4; ++e) { float v = acc[b][e]; v += __shfl_xor(v, 16); v += __shfl_xor(v, 32); acc[b][e] = v; }
                if (kr == 0) {
#pragma unroll
                    for (int b = 0; b < 4; ++b) *(LAS f32x4*)(red + (F.wave * 4 + b) * 64 + 4 * c4) = acc[b]; }
                __syncthreads();
                if (F.tid < 256) { const int b = F.tid >> 6, col = F.tid & 63; float s = Bv[64 * ng + col];
#pragma unroll
                    for (int w = 0; w < 8; ++w) s += red[(w * 4 + b) * 64 + col];
                    MODS[((size_t)l * 4 + b) * 12288 + 64 * ng + col] = s; }
                __syncthreads();
            }
        }
        {
            LAS float* scr = (LAS float*)(F.lds + F.wave * 16384);
            int it = gw;
#define CONV_SEG(Wp, K_, Nsrc_, Nphys_, kind_, gk_, dst_) do { const int n_items_ = ((K_) / 64) * ((Nphys_) / 32); \
                for (; it < n_items_; it += NGW) conv_item((Wp), (K_), (Nsrc_), (Nphys_), (kind_), (gk_), (bf16*)(dst_), scr, it, F.lane); it -= n_items_; } while (0)
            CONV_SEG(args.in[8],  DM, 2 * DFF, 2 * DFF, KIND_FFN1, (const float*)nullptr, ws + WS_W + 0 * WL_STRIDE + WL_FFN1);
            CONV_SEG(args.in[20], DM, 2 * DFF, 2 * DFF, KIND_FFN1, (const float*)nullptr, ws + WS_W + 1 * WL_STRIDE + WL_FFN1);
            CONV_SEG(args.in[28], DM, 2 * DFF, 2 * DFF, KIND_FFN1, (const float*)nullptr, ws + WS_W + 2 * WL_STRIDE + WL_FFN1);
            CONV_SEG(args.in[36], DM, 2 * DFF, 2 * DFF, KIND_FFN1, (const float*)nullptr, ws + WS_W + 3 * WL_STRIDE + WL_FFN1);
            CONV_SEG(args.in[9],  DFF, DM, DM, KIND_ID, (const float*)nullptr, ws + WS_W + 0 * WL_STRIDE + WL_FFN2);
            CONV_SEG(args.in[21], DFF, DM, DM, KIND_ID, (const float*)nullptr, ws + WS_W + 1 * WL_STRIDE + WL_FFN2);
            CONV_SEG(args.in[29], DFF, DM, DM, KIND_ID, (const float*)nullptr, ws + WS_W + 2 * WL_STRIDE + WL_FFN2);
            CONV_SEG(args.in[37], DFF, DM, DM, KIND_ID, (const float*)nullptr, ws + WS_W + 3 * WL_STRIDE + WL_FFN2);
            CONV_SEG(args.in[7],  DM, DM, DM, KIND_ID, (const float*)nullptr, ws + WS_W + 0 * WL_STRIDE + WL_OUT);
            CONV_SEG(args.in[19], DM, DM, DM, KIND_ID, (const float*)nullptr, ws + WS_W + 1 * WL_STRIDE + WL_OUT);
            CONV_SEG(args.in[27], DM, DM, DM, KIND_ID, (const float*)nullptr, ws + WS_W + 2 * WL_STRIDE + WL_OUT);
            CONV_SEG(args.in[35], DM, DM, DM, KIND_ID, (const float*)nullptr, ws + WS_W + 3 * WL_STRIDE + WL_OUT);
            CONV_SEG(args.in[6],  DM, 5264, DSA_NP, KIND_DSA_IN, (const float*)nullptr, ws + WS_WDSA + 0 * WDSA_STRIDE);
            CONV_SEG(args.in[34], DM, 5264, DSA_NP, KIND_DSA_IN, (const float*)nullptr, ws + WS_WDSA + 1 * WDSA_STRIDE);
            CONV_SEG(args.in[14], DM, 1088, MLA_DOWN_NP, KIND_MLA_DOWN, (const float*)nullptr, ws + WS_WMLA + WMLA_DOWN);
            CONV_SEG(args.in[17], 512, 3072, 3072, KIND_MLA_UQ, args.in[15], ws + WS_WMLA + WMLA_UQ);
            CONV_SEG(args.in[18], 512, 4096, 4096, KIND_ID, args.in[16], ws + WS_WMLA + WMLA_UKV);
            CONV_SEG(args.in[26], DM, 3 * DM, 3 * DM, KIND_ID, (const float*)nullptr, ws + WS_WSB);
#undef CONV_SEG
        }
        {
            const double rp128[6] = {0.8659643233600653523531, 0.7498942093324558273021, 0.5623413251903490803949, 0.3162277660168379331998, 0.1, 0.01};
            const double rp64[6]  = {0.7498942093324558273021, 0.5623413251903490803949, 0.3162277660168379331998, 0.1, 0.01, 0.0001};
            const int gt = F.vcu * (NWAVES * 64) + F.tid, NGT = F.G * NWAVES * 64;
            for (int e = gt; e < 4096 * 64; e += NGT) { float co, si; cs_entry(e >> 6, e & 63, rp128, co, si); CS128[2 * e] = co; CS128[2 * e + 1] = si; }
            for (int e = gt; e < 4096 * 32; e += NGT) { float co, si; cs_entry(e >> 5, e & 31, rp64, co, si); CS64[2 * e] = co; CS64[2 * e + 1] = si; }
        }
        SEAM(0);
    }
    if constexpr (SITE(1) && IN(1)) { modnorm_phase(F, args.in[0], args.in[4], MODS, 0, 2048, HB); SEAM(1); }

    run_layer<0, LO, HI>(F, args, bar, lds); run_layer<1, LO, HI>(F, args, bar, lds); run_layer<2, LO, HI>(F, args, bar, lds); run_layer<3, LO, HI>(F, args, bar, lds);
}
#undef IN
#undef SEAM
template <int LO, int HI> static void launch_range(int grid, const Args& a, hipStream_t stream) {
    static bool attr_done = false;
    if (!attr_done) { if (hipFuncSetAttribute((const void*)trunk_fwd<LO, HI>, hipFuncAttributeMaxDynamicSharedMemorySize, LDS_BYTES) != hipSuccess) fprintf(stderr, "kernel_launch: hipFuncSetAttribute failed\n"); attr_done = true; }
    hipLaunchKernelGGL((trunk_fwd<LO, HI>), dim3(grid), dim3(NWAVES * 64), LDS_BYTES, stream, a);
}
template <int P> struct PerPhase { static void go(int grid, const Args& a, hipStream_t stream) { launch_range<P, P + 1>(grid, a, stream); PerPhase<P + 1>::go(grid, a, stream); } };
template <> struct PerPhase<NPH> { static void go(int, const Args&, hipStream_t) {} };
extern "C" void kernel_launch(void* const* d_in, const int* in_sizes, int n_in, void* d_out, int out_size, void* d_ws, size_t ws_size, hipStream_t stream) {
    static int grid = 0;
    if (grid == 0) {
        if (n_in != 39 || in_sizes[0] != M * DM || out_size != M * DM || ws_size < WS_END) { fprintf(stderr, "kernel_launch: shape mismatch (n_in %d, in0 %d, out %d, ws %zu < %zu)\n", n_in, n_in > 0 ? in_sizes[0] : -1, out_size, ws_size, (size_t)WS_END); grid = -1; return; }
        int dev = 0, cus = 0;
        if (hipGetDevice(&dev) != hipSuccess || hipDeviceGetAttribute(&cus, hipDeviceAttributeMultiprocessorCount, dev) != hipSuccess) { grid = -1; return; }
        grid = cus;
    }
    if (grid < 0) return;
    if (hipMemsetAsync((char*)d_ws + WS_CTL, 0, CTL_ZERO_BYTES, stream) != hipSuccess) return;
    Args a{};
    for (int i = 0; i < 39; ++i) a.in[i] = (const float*)d_in[i];
    a.out = (float*)d_out; a.ws = (unsigned char*)d_ws; a.ph_lo = 0; a.ph_hi = NPH; a.li = 0;
#if MK_ONE_LAUNCH
    launch_range<0, NPH>(grid, a, stream);
#else
    PerPhase<0>::go(grid, a, stream);
#endif
    const hipError_t le = hipPeekAtLastError();
    if (le != hipSuccess) fprintf(stderr, "kernel_launch: launch failed: %s\n", hipGetErrorName(le));
}
```

```cpp
#include <hip/hip_runtime.h>
#include <cstdio>
#include <cstdint>
namespace pg8 {
#define PG8_LAS __attribute__((address_space(3)))
typedef unsigned short bf16_t;
typedef short bf16x8 __attribute__((ext_vector_type(8)));
typedef float f32x4 __attribute__((ext_vector_type(4)));
typedef unsigned u32x4 __attribute__((ext_vector_type(4)));
constexpr int BM = 256, BK = 64, HALF = 128, HTB = HALF * BK * 2  , STAGE_BYTES = 8 * HTB, NXCD = 8, WGM = 8;

__host__ __device__ __forceinline__ int lds_byte(int r, int c) { const int st = (r >> 4) * 2 + (c >> 5), rr = r & 15, cc = c & 31, ob = rr * 64 + cc * 2; return st * 1024 + (ob ^ (((ob >> 9) & 1) << 5)); }
__host__ __device__ __forceinline__ void stage_rc(int b, int& R, int& C) { const int st = b / 1024, sb = b % 1024, swz = sb ^ (((sb >> 9) & 1) << 5); R = (st >> 1) * 16 + swz / 64; C = (st & 1) * 32 + (swz % 64) / 2; }
__host__ __device__ __forceinline__ int perm32(int rho) { const int n = rho >> 4, i = rho & 15; return 8 * (i >> 2) + 4 * n + (i & 3); }

struct Unit { int pm, pn; };
struct Gemm { const bf16_t* A; const bf16_t* Bt; int M, N, K; };

struct StaticOrder {
    int nM, nN, nwg, G, c;
    __host__ __device__ void init(int M, int N, int G_, int c_) { nM = M / BM; nN = N / BM; nwg = nM * nN; G = G_; c = c_; }
    __host__ __device__ bool next(int i, Unit& u) const {
        const long L = (long)i * G + c; if (L >= nwg) return false;
        int wgid = (int)L; { const int q = nwg / NXCD, r = nwg % NXCD, xcd = wgid % NXCD, off = wgid / NXCD; wgid = (xcd < r ? xcd * (q + 1) : r * (q + 1) + (xcd - r) * q) + off; }
        const int nig = WGM * nN, gid = wgid / nig, fm = gid * WGM, gsz = (nM - fm) < WGM ? (nM - fm) : WGM;
        u.pm = fm + ((wgid % nig) % gsz); u.pn = (wgid % nig) / gsz; return true;
    }
    __device__ __forceinline__ void a_ready(const Unit&) const {}
    __device__ __forceinline__ void done(const Unit&) const {}
};

__device__ __forceinline__ unsigned cvt_pk_bf16(float lo, float hi) { unsigned r; asm volatile("v_cvt_pk_bf16_f32 %0, %1, %2" : "=v"(r) : "v"(lo), "v"(hi)); return r; }
typedef float f32x2 __attribute__((ext_vector_type(2)));
__device__ __forceinline__ u32x4 pack8(const f32x4 v0, const f32x4 v1) { u32x4 w; w.x = cvt_pk_bf16(v0[0], v0[1]); w.y = cvt_pk_bf16(v0[2], v0[3]); w.z = cvt_pk_bf16(v1[0], v1[1]); w.w = cvt_pk_bf16(v1[2], v1[3]); return w; }
__device__ __forceinline__ void rope8(const float* cs, const f32x4 a0, const f32x4 a1, const f32x4 b0, const f32x4 b1, u32x4& o1, u32x4& o2) {
    const f32x4 t0 = *(const f32x4*)(cs), t1 = *(const f32x4*)(cs + 4), t2 = *(const f32x4*)(cs + 8), t3 = *(const f32x4*)(cs + 12);
    f32x4 c0 = {t0[0], t0[2], t1[0], t1[2]}, s0 = {t0[1], t0[3], t1[1], t1[3]}, c1 = {t2[0], t2[2], t3[0], t3[2]}, s1 = {t2[1], t2[3], t3[1], t3[3]};
    const f32x4 p0 = a0 * c0 - b0 * s0, p1 = a1 * c1 - b1 * s1, q0 = b0 * c0 + a0 * s0, q1 = b1 * c1 + a1 * s1;
    o1 = pack8(p0, p1); o2 = pack8(q0, q1);
}
struct EpiResid {
    static constexpr bool PERM = false, AFTER_DRAIN = false;
    const float* xin; float* xout; const float* gate;
    __device__ __forceinline__ void operator()(const f32x4 (&acc)[2][2][4][2], const Unit& u, int wr, int wc, int fr, int fq) const {
        const int row0 = u.pm * BM + wr * 64 + fr, col0 = u.pn * BM + wc * 32 + 4 * fq;
        const float* gb = gate + (size_t)(u.pm >> 4) * 12288 + col0;
        f32x4 gv[2][2];
#pragma unroll
        for (int bj = 0; bj < 2; ++bj)
#pragma unroll
            for (int n = 0; n < 2; ++n) gv[bj][n] = *(const f32x4*)(gb + bj * HALF + n * 16);
#pragma unroll
        for (int ai = 0; ai < 2; ++ai)
#pragma unroll
            for (int m = 0; m < 4; ++m) { const size_t off = (size_t)(row0 + ai * HALF + m * 16) * 2048 + col0;
#pragma unroll
                for (int bj = 0; bj < 2; ++bj)
#pragma unroll
                    for (int n = 0; n < 2; ++n) { const f32x4 xi = *(const f32x4*)(xin + off + bj * HALF + n * 16); *(f32x4*)(xout + off + bj * HALF + n * 16) = xi + gv[bj][n] * acc[ai][bj][m][n]; } }
    }
};
struct EpiSwiglu {
    static constexpr bool PERM = true, AFTER_DRAIN = false;
    bf16_t* act;
    __device__ __forceinline__ void operator()(const f32x4 (&acc)[2][2][4][2], const Unit& u, int wr, int wc, int fr, int fq) const {
        const int row0 = u.pm * BM + wr * 64 + fr, col0 = u.pn * 128 + wc * 32 + 8 * fq;
#pragma unroll
        for (int ai = 0; ai < 2; ++ai)
#pragma unroll
            for (int m = 0; m < 4; ++m) { f32x4 r[2];
#pragma unroll
                for (int n = 0; n < 2; ++n)
#pragma unroll
                    for (int i = 0; i < 4; ++i) { const float g = acc[ai][0][m][n][i], up = acc[ai][1][m][n][i];
                        r[n][i] = g * __builtin_amdgcn_rcpf(1.0f + __builtin_amdgcn_exp2f(-1.4426950408889634f * g)) * up; }
                *(u32x4*)(act + (size_t)(row0 + ai * HALF + m * 16) * 5632 + col0) = pack8(r[0], r[1]); }
    }
};
struct EpiSplit3 {
    static constexpr bool PERM = true, AFTER_DRAIN = false;
    bf16_t* O0; size_t stride;
    __device__ __forceinline__ void operator()(const f32x4 (&acc)[2][2][4][2], const Unit& u, int wr, int wc, int fr, int fq) const {
        const int t = u.pn >> 3; bf16_t* base = O0 + (size_t)t * stride;
        const int row0 = u.pm * BM + wr * 64 + fr, col0 = (u.pn & 7) * 256 + wc * 32 + 8 * fq;
#pragma unroll
        for (int ai = 0; ai < 2; ++ai)
#pragma unroll
            for (int m = 0; m < 4; ++m) { bf16_t* rowp = base + (size_t)(row0 + ai * HALF + m * 16) * 2048 + col0;
#pragma unroll
                for (int bj = 0; bj < 2; ++bj) *(u32x4*)(rowp + bj * HALF) = pack8(acc[ai][bj][m][0], acc[ai][bj][m][1]); }
    }
};
struct EpiDsaIn {
    static constexpr bool PERM = true, AFTER_DRAIN = false;
    bf16_t *Q, *K, *V, *IQ, *IK; float* IW; const float* cs128; const float* cs64;
    __device__ __forceinline__ void operator()(const f32x4 (&acc)[2][2][4][2], const Unit& u, int wr, int wc, int fr, int fq) const {
        const int pn = u.pn, row0 = u.pm * BM + wr * 64 + fr;
        if (pn < 10) {
            bf16_t* base; int ld, hcol;
            if (pn < 8) { base = Q; ld = 2048; hcol = (2 * pn + (wc >> 1)) * 128; } else { base = K; ld = 512; hcol = (2 * (pn - 8) + (wc >> 1)) * 128; }
            const int dd0 = 32 * (wc & 1) + 8 * fq;
#pragma unroll
            for (int ai = 0; ai < 2; ++ai)
#pragma unroll
                for (int m = 0; m < 4; ++m) { const int row = row0 + ai * HALF + m * 16, pos = row & 4095; u32x4 o1, o2;
                    rope8(cs128 + ((size_t)pos * 64 + dd0) * 2, acc[ai][0][m][0], acc[ai][0][m][1], acc[ai][1][m][0], acc[ai][1][m][1], o1, o2);
                    bf16_t* p = base + (size_t)row * ld + hcol + dd0; *(u32x4*)p = o1; *(u32x4*)(p + 64) = o2; }
        } else if (pn < 12) {
            const int col0 = (pn - 10) * 256 + wc * 32 + 8 * fq;
#pragma unroll
            for (int ai = 0; ai < 2; ++ai)
#pragma unroll
                for (int m = 0; m < 4; ++m) { bf16_t* rowp = V + (size_t)(row0 + ai * HALF + m * 16) * 512 + col0;
#pragma unroll
                    for (int bj = 0; bj < 2; ++bj) *(u32x4*)(rowp + bj * HALF) = pack8(acc[ai][bj][m][0], acc[ai][bj][m][1]); }
        } else {
            bf16_t* base; int ld, hcol;
            if (pn < 20) { base = IQ; ld = 2048; hcol = (2 * (pn - 12) + (wc >> 1)) * 128; } else { base = IK; ld = 128; hcol = 0; }
            const int sub = (pn < 20) ? (wc & 1) : wc;
            if (sub == 0) {
                const int dd0 = 8 * fq;
#pragma unroll
                for (int ai = 0; ai < 2; ++ai)
#pragma unroll
                    for (int m = 0; m < 4; ++m) { const int row = row0 + ai * HALF + m * 16, pos = row & 4095; u32x4 o1, o2;
                        rope8(cs64 + ((size_t)pos * 32 + dd0) * 2, acc[ai][0][m][0], acc[ai][0][m][1], acc[ai][1][m][0], acc[ai][1][m][1], o1, o2);
                        bf16_t* p = base + (size_t)row * ld + hcol + dd0; *(u32x4*)p = o1; *(u32x4*)(p + 32) = o2; }
            } else if (sub == 1) {
#pragma unroll
                for (int ai = 0; ai < 2; ++ai)
#pragma unroll
                    for (int m = 0; m < 4; ++m) { bf16_t* p = base + (size_t)(row0 + ai * HALF + m * 16) * ld + hcol + 64 + 8 * fq;
                        *(u32x4*)p = pack8(acc[ai][0][m][0], acc[ai][0][m][1]); *(u32x4*)(p + 32) = pack8(acc[ai][1][m][0], acc[ai][1][m][1]); }
            } else if (sub == 2 && pn == 20) {
                if (fq < 2) {
#pragma unroll
                    for (int ai = 0; ai < 2; ++ai)
#pragma unroll
                        for (int m = 0; m < 4; ++m) { float* p = IW + (size_t)(row0 + ai * HALF + m * 16) * 16 + 8 * fq; *(f32x4*)p = acc[ai][0][m][0]; *(f32x4*)(p + 4) = acc[ai][0][m][1]; }
                }
            }
        }
    }
};
struct EpiMlaDown {
    static constexpr bool PERM = true, AFTER_DRAIN = false;
    bf16_t *CQ, *CKV, *KR; float* ssq; const float* cs64;
    __device__ __forceinline__ void operator()(const f32x4 (&acc)[2][2][4][2], const Unit& u, int wr, int wc, int fr, int fq) const {
        const int pn = u.pn, row0 = u.pm * BM + wr * 64 + fr;
        if (pn < 4) {
            bf16_t* base = pn < 2 ? CQ : CKV; const int col0 = (pn & 1) * 256 + wc * 32 + 8 * fq;
#pragma unroll
            for (int ai = 0; ai < 2; ++ai)
#pragma unroll
                for (int m = 0; m < 4; ++m) { const int row = row0 + ai * HALF + m * 16; float s = 0.f;
#pragma unroll
                    for (int bj = 0; bj < 2; ++bj) { const f32x4 v0 = acc[ai][bj][m][0], v1 = acc[ai][bj][m][1];
                        s += (v0[0] * v0[0] + v0[1] * v0[1]) + (v0[2] * v0[2] + v0[3] * v0[3]) + (v1[0] * v1[0] + v1[1] * v1[1]) + (v1[2] * v1[2] + v1[3] * v1[3]);
                        *(u32x4*)(base + (size_t)row * 512 + col0 + bj * HALF) = pack8(v0, v1); }
                    s += __shfl_xor(s, 16); s += __shfl_xor(s, 32);
                    if (fq == 0) ssq[(size_t)row * 16 + pn * 4 + wc] = s; }
        } else if (wc == 0) {
            const int dd0 = 8 * fq;
#pragma unroll
            for (int ai = 0; ai < 2; ++ai)
#pragma unroll
                for (int m = 0; m < 4; ++m) { const int row = row0 + ai * HALF + m * 16, pos = row & 4095; u32x4 o1, o2;
                    rope8(cs64 + ((size_t)pos * 32 + dd0) * 2, acc[ai][0][m][0], acc[ai][0][m][1], acc[ai][1][m][0], acc[ai][1][m][1], o1, o2);
                    bf16_t* p = KR + (size_t)row * 64 + dd0; *(u32x4*)p = o1; *(u32x4*)(p + 32) = o2; }
        }
    }
};
struct EpiMlaUq {
    static constexpr bool PERM = true, AFTER_DRAIN = false;
    bf16_t *QN, *QR; const float* ssq; const float* cs64;
    __device__ __forceinline__ void operator()(const f32x4 (&acc)[2][2][4][2], const Unit& u, int wr, int wc, int fr, int fq) const {
        const int pn = u.pn, row0 = u.pm * BM + wr * 64 + fr;
#pragma unroll
        for (int ai = 0; ai < 2; ++ai)
#pragma unroll
            for (int m = 0; m < 4; ++m) { const int row = row0 + ai * HALF + m * 16, pos = row & 4095;
                const f32x4 sa = *(const f32x4*)(ssq + (size_t)row * 16), sb = *(const f32x4*)(ssq + (size_t)row * 16 + 4);
                const float rstd = 1.0f / sqrtf((((sa[0] + sa[1]) + (sa[2] + sa[3])) + ((sb[0] + sb[1]) + (sb[2] + sb[3]))) * (1.0f / 512.0f) + 1e-6f);
                if (pn < 8) { bf16_t* rowp = QN + (size_t)row * 2048 + pn * 256 + wc * 32 + 8 * fq;
#pragma unroll
                    for (int bj = 0; bj < 2; ++bj) *(u32x4*)(rowp + bj * HALF) = pack8(acc[ai][bj][m][0] * rstd, acc[ai][bj][m][1] * rstd);
                } else { u32x4 o1, o2; const int dd0 = 8 * fq;
                    rope8(cs64 + ((size_t)pos * 32 + dd0) * 2, acc[ai][0][m][0] * rstd, acc[ai][0][m][1] * rstd, acc[ai][1][m][0] * rstd, acc[ai][1][m][1] * rstd, o1, o2);
                    bf16_t* p = QR + (size_t)row * 1024 + (4 * (pn - 8) + wc) * 64 + dd0; *(u32x4*)p = o1; *(u32x4*)(p + 32) = o2; } }
    }
};
struct EpiMlaUkv {
    static constexpr bool PERM = true, AFTER_DRAIN = false;
    bf16_t *KN, *V; const float* ssq;
    __device__ __forceinline__ void operator()(const f32x4 (&acc)[2][2][4][2], const Unit& u, int wr, int wc, int fr, int fq) const {
        const int row0 = u.pm * BM + wr * 64 + fr, col0 = u.pn * 128 + wc * 32 + 8 * fq;
#pragma unroll
        for (int ai = 0; ai < 2; ++ai)
#pragma unroll
            for (int m = 0; m < 4; ++m) { const int row = row0 + ai * HALF + m * 16;
                const f32x4 sa = *(const f32x4*)(ssq + (size_t)row * 16 + 8), sb = *(const f32x4*)(ssq + (size_t)row * 16 + 12);
                const float rstd = 1.0f / sqrtf((((sa[0] + sa[1]) + (sa[2] + sa[3])) + ((sb[0] + sb[1]) + (sb[2] + sb[3]))) * (1.0f / 512.0f) + 1e-6f);
                *(u32x4*)(KN + (size_t)row * 2048 + col0) = pack8(acc[ai][0][m][0] * rstd, acc[ai][0][m][1] * rstd);
                *(u32x4*)(V + (size_t)row * 2048 + col0) = pack8(acc[ai][1][m][0] * rstd, acc[ai][1][m][1] * rstd); }
    }
};

template <class Epi, class Sched, bool ALIGN_EPI = false, bool SP2 = false>
__device__ __forceinline__ void gemm_phase(PG8_LAS unsigned char* lds, const Gemm g, const Sched& S, const Epi& E) {
    int tid = threadIdx.x; asm volatile("" : "+v"(tid));
    const int wid = __builtin_amdgcn_readfirstlane(tid >> 6), lane = tid & 63, wr = wid >> 2, wc = wid & 3, fr = lane & 15, fq = lane >> 4;
    const int K = g.K, nt = K / BK;
    unsigned voffA[2], voffB[2];
#pragma unroll
    for (int i = 0; i < 2; ++i) { int R, C; stage_rc(tid * 16 + i * 8192, R, C); const int Rb = Epi::PERM ? ((R & ~31) + perm32(R & 31)) : R;
        voffA[i] = (unsigned)(R * K + C) * 2u; voffB[i] = (unsigned)(Rb * K + C) * 2u; }
    const size_t kstep = (size_t)(BK * 2);
    const size_t hstep = (size_t)HALF * K * 2;
    const size_t tstep = 2 * hstep;
    const unsigned ldsw = (unsigned)wid * 1024u;
    const int aoff = lds_byte(wr * 64 + fr, fq * 8), boff = lds_byte(wc * 32 + fr, fq * 8);
#define PG8_SA(b, h) (((b) * 2 + (h)) * HTB)
#define PG8_SB(b, h) ((4 + (b) * 2 + (h)) * HTB)
#define PG8_STAGE(bufoff, gbase, voff) do { _Pragma("unroll") for (int _i = 0; _i < 2; ++_i) \
        __builtin_amdgcn_global_load_lds((const unsigned*)((const char*)(gbase) + (voff)[_i]), (PG8_LAS unsigned*)(lds + (bufoff) + ldsw + _i * 8192), 16, 0, 0); } while (0)
#define PG8_LDA(dst, b, h) do { _Pragma("unroll") for (int m = 0; m < 4; ++m) _Pragma("unroll") for (int k = 0; k < 2; ++k) dst[m][k] = *(const PG8_LAS bf16x8*)(lds + PG8_SA(b, h) + aoff + m * 2048 + k * 1024); } while (0)
#define PG8_LDB(dst, b, h) do { _Pragma("unroll") for (int n = 0; n < 2; ++n) _Pragma("unroll") for (int k = 0; k < 2; ++k) dst[n][k] = *(const PG8_LAS bf16x8*)(lds + PG8_SB(b, h) + boff + n * 2048 + k * 1024); } while (0)
#define PG8_MMA(ai, bj, At, Bt) do { __builtin_amdgcn_s_setprio(1); _Pragma("unroll") for (int m = 0; m < 4; ++m) _Pragma("unroll") for (int n = 0; n < 2; ++n) _Pragma("unroll") for (int k = 0; k < 2; ++k) \
        acc[ai][bj][m][n] = __builtin_amdgcn_mfma_f32_16x16x32_bf16(Bt[n][k], At[m][k], acc[ai][bj][m][n], 0, 0, 0); __builtin_amdgcn_s_setprio(0); } while (0)
#define PG8_WAIT_V(n) asm volatile("s_waitcnt vmcnt(" #n ")" ::: "memory")
#define PG8_WAIT_L(n) asm volatile("s_waitcnt lgkmcnt(" #n ")" ::: "memory")
#define PG8_BAR __builtin_amdgcn_s_barrier()
#define PG8_SCHED __builtin_amdgcn_sched_barrier(0)
    Unit cur, nxt; int ui = 0;
    if (!S.next(0, cur)) return;
    f32x4 acc[2][2][4][2];
#pragma unroll
    for (int a = 0; a < 2; ++a)
#pragma unroll
        for (int b = 0; b < 2; ++b)
#pragma unroll
            for (int m = 0; m < 4; ++m)
#pragma unroll
                for (int n = 0; n < 2; ++n) acc[a][b][m][n] = (f32x4){0.f, 0.f, 0.f, 0.f};
    bf16x8 At[4][2], B0[2][2], B1[2][2];
    const char* cA = (const char*)g.A + (size_t)cur.pm * tstep; const char* cB = (const char*)g.Bt + (size_t)cur.pn * tstep;
    S.a_ready(cur);
    if constexpr (SP2) {
        PG8_STAGE(PG8_SB(0, 0), cB, voffB); PG8_STAGE(PG8_SB(0, 1), cB + hstep, voffB); PG8_STAGE(PG8_SA(0, 0), cA, voffA); PG8_STAGE(PG8_SA(0, 1), cA + hstep, voffA);
        if (wr == 1) PG8_BAR;
        PG8_WAIT_V(2); PG8_BAR;
        PG8_STAGE(PG8_SB(1, 0), cB + kstep, voffB); PG8_STAGE(PG8_SA(1, 0), cA + kstep, voffA); PG8_STAGE(PG8_SB(1, 1), cB + hstep + kstep, voffB);
        PG8_WAIT_V(6); PG8_BAR;
    } else {
        PG8_STAGE(PG8_SB(0, 0), cB, voffB); PG8_STAGE(PG8_SA(0, 0), cA, voffA); PG8_STAGE(PG8_SB(0, 1), cB + hstep, voffB); PG8_STAGE(PG8_SA(0, 1), cA + hstep, voffA);
        if (wr == 1) PG8_BAR;
        PG8_WAIT_V(4); PG8_BAR;
        PG8_STAGE(PG8_SB(1, 0), cB + kstep, voffB); PG8_STAGE(PG8_SA(1, 0), cA + kstep, voffA); PG8_STAGE(PG8_SB(1, 1), cB + hstep + kstep, voffB);
        PG8_WAIT_V(6); PG8_BAR;
    }
    for (;;) {
        const bool has_next = S.next(ui + 1, nxt);
        const char* nA = has_next ? (const char*)g.A + (size_t)nxt.pm * tstep : cA; const char* nB = has_next ? (const char*)g.Bt + (size_t)nxt.pn * tstep : cB;
        for (int t = 0; t < nt; t += 2) {
            const bool last = (t == nt - 2);
            const char* a1 = cA + (size_t)(t + 1) * kstep;
            const char* a2 = last ? nA : cA + (size_t)(t + 2) * kstep; const char* b2 = last ? nB : cB + (size_t)(t + 2) * kstep;
            const char* a3 = a2 + kstep; const char* b3 = b2 + kstep;
            if (last && has_next) S.a_ready(nxt);
            if constexpr (SP2) {
            PG8_LDB(B0, 0, 0); PG8_LDB(B1, 0, 1); PG8_SCHED; PG8_LDA(At, 0, 0); PG8_STAGE(PG8_SA(1, 1), a1 + hstep, voffA);
            PG8_WAIT_V(8); PG8_WAIT_L(0); PG8_BAR; PG8_MMA(0, 0, At, B0); PG8_MMA(0, 1, At, B1); PG8_BAR; PG8_SCHED;
            PG8_LDA(At, 0, 1); PG8_STAGE(PG8_SB(0, 0), b2, voffB); PG8_STAGE(PG8_SB(0, 1), b2 + hstep, voffB); PG8_STAGE(PG8_SA(0, 0), a2, voffA);
            PG8_WAIT_V(8); PG8_WAIT_L(0); PG8_BAR; PG8_MMA(1, 0, At, B0); PG8_MMA(1, 1, At, B1); PG8_BAR; PG8_SCHED;
            PG8_LDB(B0, 1, 0); PG8_LDB(B1, 1, 1); PG8_SCHED; PG8_LDA(At, 1, 0); PG8_STAGE(PG8_SA(0, 1), a2 + hstep, voffA);
            PG8_WAIT_V(8); PG8_WAIT_L(0); PG8_BAR; PG8_MMA(0, 0, At, B0); PG8_MMA(0, 1, At, B1); PG8_BAR; PG8_SCHED;
            PG8_LDA(At, 1, 1); PG8_STAGE(PG8_SB(1, 0), b3, voffB); PG8_STAGE(PG8_SB(1, 1), b3 + hstep, voffB); PG8_STAGE(PG8_SA(1, 0), a3, voffA);
            PG8_WAIT_V(8); PG8_WAIT_L(0); PG8_BAR; PG8_MMA(1, 0, At, B0); PG8_MMA(1, 1, At, B1); PG8_BAR; PG8_SCHED;
            } else {
            PG8_LDB(B0, 0, 0); PG8_SCHED; PG8_LDA(At, 0, 0); PG8_STAGE(PG8_SA(1, 1), a1 + hstep, voffA);
            PG8_WAIT_L(8); PG8_BAR; PG8_WAIT_L(0); PG8_MMA(0, 0, At, B0); PG8_BAR; PG8_SCHED;
            PG8_LDB(B1, 0, 1); PG8_STAGE(PG8_SB(0, 0), b2, voffB);
            PG8_BAR; PG8_WAIT_L(0); PG8_MMA(0, 1, At, B1); PG8_BAR;
            PG8_LDA(At, 0, 1); PG8_STAGE(PG8_SA(0, 0), a2, voffA);
            PG8_BAR; PG8_WAIT_L(0); PG8_MMA(1, 0, At, B0); PG8_BAR; PG8_SCHED;
            PG8_STAGE(PG8_SB(0, 1), b2 + hstep, voffB);
            PG8_WAIT_V(6); PG8_BAR; PG8_MMA(1, 1, At, B1); PG8_BAR;
            PG8_LDB(B0, 1, 0); PG8_SCHED; PG8_LDA(At, 1, 0); PG8_STAGE(PG8_SA(0, 1), a2 + hstep, voffA);
            PG8_WAIT_L(8); PG8_BAR; PG8_WAIT_L(0); PG8_MMA(0, 0, At, B0); PG8_BAR; PG8_SCHED;
            PG8_LDB(B1, 1, 1); PG8_STAGE(PG8_SB(1, 0), b3, voffB);
            PG8_BAR; PG8_WAIT_L(0); PG8_MMA(0, 1, At, B1); PG8_BAR;
            PG8_LDA(At, 1, 1); PG8_STAGE(PG8_SA(1, 0), a3, voffA);
            PG8_BAR; PG8_WAIT_L(0); PG8_MMA(1, 0, At, B0); PG8_BAR; PG8_SCHED;
            PG8_STAGE(PG8_SB(1, 1), b3 + hstep, voffB);
            PG8_WAIT_V(6); PG8_BAR; PG8_MMA(1, 1, At, B1); PG8_BAR;
            }
        }
        if constexpr (ALIGN_EPI) { if (wr == 0) PG8_BAR; }
        if constexpr (!Epi::AFTER_DRAIN) { E(acc, cur, wr, wc, fr, fq); S.done(cur); }
        if (!has_next) break;
#pragma unroll
        for (int a = 0; a < 2; ++a)
#pragma unroll
            for (int b = 0; b < 2; ++b)
#pragma unroll
                for (int m = 0; m < 4; ++m)
#pragma unroll
                    for (int n = 0; n < 2; ++n) acc[a][b][m][n] = (f32x4){0.f, 0.f, 0.f, 0.f};
        cur = nxt; cA = nA; cB = nB; ++ui;
        if constexpr (ALIGN_EPI) { if (wr == 1) PG8_BAR; }
    }
    PG8_WAIT_V(0);
    if constexpr (!ALIGN_EPI) { if (wr == 0) PG8_BAR; }
    PG8_BAR;
    if constexpr (Epi::AFTER_DRAIN) { E.fused(acc, cur, wr, wc, fr, fq, lds, wid, lane); S.done(cur); }
#undef PG8_SA
#undef PG8_SB
#undef PG8_STAGE
#undef PG8_LDA
#undef PG8_LDB
#undef PG8_MMA
#undef PG8_WAIT_V
#undef PG8_WAIT_L
#undef PG8_BAR
#undef PG8_SCHED
}
}
namespace att {
typedef unsigned short bf16_t;
using bf16x8 = __attribute__((ext_vector_type(8))) short;
using s16x4  = __attribute__((ext_vector_type(4))) short;
using f32x16 = __attribute__((ext_vector_type(16))) float;
using f32x4  = __attribute__((ext_vector_type(4))) float;
using u32x4  = __attribute__((ext_vector_type(4))) unsigned;
#define KSWZ(row, colB) ((row) * 256 + ((colB) ^ (((row) & 7) << 4)))
#define ATT_SBAR() __builtin_amdgcn_sched_barrier(0)
constexpr int SHM_KV = 16384;
__device__ __forceinline__ int crow(int r, int hi) { return (r & 3) + 8 * (r >> 2) + 4 * hi; }
__device__ __forceinline__ unsigned cvtpk(float lo, float hi) { unsigned r; asm volatile("v_cvt_pk_bf16_f32 %0, %1, %2" : "=v"(r) : "v"(lo), "v"(hi)); return r; }
template <int SC1E9> __device__ __forceinline__ void partialSM(f32x16& p0, f32x16& p1, float& m_reg, float& mn, float& alpha) {
  constexpr float SCALE = (float)(SC1E9 * 1e-9), THR = 8.f, C = SCALE * 1.4426950408889634f;
  float pmax = p0[0];
#pragma unroll
  for (int r = 1; r < 16; ++r) pmax = fmaxf(pmax, p0[r]);
#pragma unroll
  for (int r = 0; r < 16; ++r) pmax = fmaxf(pmax, p1[r]);
  { auto rr = __builtin_amdgcn_permlane32_swap(__float_as_uint(pmax), __float_as_uint(pmax), false, false);
    pmax = fmaxf(__uint_as_float(rr[0]), __uint_as_float(rr[1])); }
  if (__builtin_expect(__all(pmax - m_reg <= THR / SCALE), 1)) { mn = m_reg; alpha = 1.f; }
  else { mn = fmaxf(m_reg, pmax); alpha = __builtin_amdgcn_exp2f((m_reg - mn) * C); m_reg = mn; }
  const float mnC = -mn * C;
#pragma unroll
  for (int r = 0; r < 16; ++r) p0[r] = fmaf(p0[r], C, mnC);
#pragma unroll
  for (int r = 0; r < 16; ++r) p1[r] = fmaf(p1[r], C, mnC);
#pragma unroll
  for (int r = 0; r < 16; ++r) p0[r] = __builtin_amdgcn_exp2f(p0[r]);
}
__device__ __forceinline__ void packP(const f32x16& p0, const f32x16& p1, bf16x8& pa0, bf16x8& pa1, bf16x8& pa2, bf16x8& pa3) {
#define PK4(P, BASE, OUT) do { unsigned a0 = cvtpk(P[BASE + 0], P[BASE + 1]), a1 = cvtpk(P[BASE + 2], P[BASE + 3]);   \
    unsigned b0 = cvtpk(P[BASE + 4], P[BASE + 5]), b1 = cvtpk(P[BASE + 6], P[BASE + 7]);                              \
    auto r0 = __builtin_amdgcn_permlane32_swap(a0, b0, false, false); auto r1 = __builtin_amdgcn_permlane32_swap(a1, b1, false, false); \
    u32x4 w = {r0[0], r1[0], r0[1], r1[1]}; OUT = *reinterpret_cast<bf16x8*>(&w); } while (0)
  PK4(p0, 0, pa0); PK4(p0, 8, pa1); PK4(p1, 0, pa2); PK4(p1, 8, pa3);
#undef PK4
}
__device__ __forceinline__ void finishSM(f32x16& p0, f32x16& p1, float alpha, float& l_reg, bf16x8& pa0, bf16x8& pa1, bf16x8& pa2, bf16x8& pa3) {
#pragma unroll
  for (int r = 0; r < 16; ++r) p1[r] = __builtin_amdgcn_exp2f(p1[r]);
  float ps = 0;
#pragma unroll
  for (int r = 0; r < 16; ++r) ps += p0[r];
#pragma unroll
  for (int r = 0; r < 16; ++r) ps += p1[r];
  { auto rr = __builtin_amdgcn_permlane32_swap(__float_as_uint(ps), __float_as_uint(ps), false, false);
    ps = __uint_as_float(rr[0]) + __uint_as_float(rr[1]); }
  l_reg = l_reg * alpha + ps;
  packP(p0, p1, pa0, pa1, pa2, pa3);
}
__device__ __forceinline__ void qkt(f32x16& p0, f32x16& p1, const char* Ks, const bf16x8* qr, int r32, int hi) {
  p0 = f32x16{}; p1 = f32x16{};
#pragma unroll
  for (int d0 = 0; d0 < 8; ++d0) { const int cb = (d0 * 16 + hi * 8) * 2;
    const bf16x8 b0 = *reinterpret_cast<const bf16x8*>(Ks + KSWZ(r32, cb));
    const bf16x8 b1 = *reinterpret_cast<const bf16x8*>(Ks + KSWZ(32 + r32, cb));
    p0 = __builtin_amdgcn_mfma_f32_32x32x16_bf16(b0, qr[d0], p0, 0, 0, 0);
    p1 = __builtin_amdgcn_mfma_f32_32x32x16_bf16(b1, qr[d0], p1, 0, 0, 0); }
}
__device__ __forceinline__ void qkt_rope(f32x16& p0, f32x16& p1, const char* Kr, const bf16x8* qr, int r32, int hi) {
#pragma unroll
  for (int d0 = 0; d0 < 4; ++d0) { const int cb = ((d0 * 16 + hi * 8) * 2) ^ ((r32 & 7) << 4);
    const bf16x8 b0 = *reinterpret_cast<const bf16x8*>(Kr + r32 * 128 + cb);
    const bf16x8 b1 = *reinterpret_cast<const bf16x8*>(Kr + (32 + r32) * 128 + cb);
    p0 = __builtin_amdgcn_mfma_f32_32x32x16_bf16(b0, qr[d0], p0, 0, 0, 0);
    p1 = __builtin_amdgcn_mfma_f32_32x32x16_bf16(b1, qr[d0], p1, 0, 0, 0); }
}
__device__ __forceinline__ int v_st(int k, int c) { const int kk = (k & ~0xC) | ((k & 4) << 1) | ((k & 8) >> 1); return ((kk >> 3) * 4 + (c >> 5)) * 512 + ((kk & 7) * 32 + (c & 31)) * 2; }
__device__ __forceinline__ int v_rd_base(int lane) { return ((lane & 3) << 3) | (((lane >> 2) & 3) << 6) | (((lane >> 4) & 1) << 5) | (((lane >> 5) & 1) << 8); }
constexpr int v_rd_off(int d0, int ks, int half) { return d0 * 512 + ks * 4096 + half * 2048; }
template <int OFF> __device__ __forceinline__ s16x4 tr_read(int vb) {
  s16x4 r; asm volatile("ds_read_b64_tr_b16 %0, %1 offset:%2" : "=&v"(r) : "v"(vb), "i"(OFF) : "memory"); return r;
}
template <int D0> __device__ __forceinline__ void pv_one(f32x16& od, int vb, bf16x8 pa0, bf16x8 pa1, bf16x8 pa2, bf16x8 pa3) {
  const s16x4 l0 = tr_read<v_rd_off(D0, 0, 0)>(vb), h0 = tr_read<v_rd_off(D0, 0, 1)>(vb), l1 = tr_read<v_rd_off(D0, 1, 0)>(vb), h1 = tr_read<v_rd_off(D0, 1, 1)>(vb);
  const s16x4 l2 = tr_read<v_rd_off(D0, 2, 0)>(vb), h2 = tr_read<v_rd_off(D0, 2, 1)>(vb), l3 = tr_read<v_rd_off(D0, 3, 0)>(vb), h3 = tr_read<v_rd_off(D0, 3, 1)>(vb);
  asm volatile("s_waitcnt lgkmcnt(0)" ::: "memory"); ATT_SBAR();
#define PK(L, H) (bf16x8){L[0], L[1], L[2], L[3], H[0], H[1], H[2], H[3]}
  od = __builtin_amdgcn_mfma_f32_32x32x16_bf16(pa0, PK(l0, h0), od, 0, 0, 0);
  od = __builtin_amdgcn_mfma_f32_32x32x16_bf16(pa1, PK(l1, h1), od, 0, 0, 0);
  od = __builtin_amdgcn_mfma_f32_32x32x16_bf16(pa2, PK(l2, h2), od, 0, 0, 0);
  od = __builtin_amdgcn_mfma_f32_32x32x16_bf16(pa3, PK(l3, h3), od, 0, 0, 0);
#undef PK
}
__device__ __forceinline__ void pv_d0(f32x16* o, int vb, bf16x8 pa0, bf16x8 pa1, bf16x8 pa2, bf16x8 pa3) {
  pv_one<0>(o[0], vb, pa0, pa1, pa2, pa3); pv_one<1>(o[1], vb, pa0, pa1, pa2, pa3); pv_one<2>(o[2], vb, pa0, pa1, pa2, pa3); pv_one<3>(o[3], vb, pa0, pa1, pa2, pa3);
}
#define ATT_RESC(a) do { if (__any((a) < 1.f)) { if (hi == 0) al_l[r32] = (a); asm volatile("s_waitcnt lgkmcnt(0)" ::: "memory"); \
    _Pragma("unroll") for (int d = 0; d < 4; ++d) _Pragma("unroll") for (int r = 0; r < 16; ++r) o[d][r] *= al_l[crow(r, hi)]; } } while (0)
__device__ __forceinline__ void store_o(const f32x16* o, const float* rli, bf16_t* stg, bf16_t* Og  , int ldo, int lane, int r32, int hi) {
#pragma unroll
  for (int r = 0; r < 16; ++r) { const int orow = crow(r, hi);
#pragma unroll
    for (int d0 = 0; d0 < 4; ++d0) stg[orow * 128 + d0 * 32 + r32] = (bf16_t)(cvtpk(o[d0][r] * rli[r], 0.f) & 0xffffu); }
  asm volatile("s_waitcnt lgkmcnt(0)" ::: "memory");
#pragma unroll
  for (int i = 0; i < 8; ++i) { const int row = i * 4 + (lane >> 4), ch = lane & 15; const u32x4 v = *(const u32x4*)(stg + row * 128 + ch * 8); *(u32x4*)(Og + (size_t)row * ldo + ch * 8) = v; }
}

template <int MODE>
__device__ __forceinline__ void attn_sm_unit(int b, int hx, int ux, const bf16_t* __restrict__ Q, const bf16_t* __restrict__ QR, const bf16_t* __restrict__ K, const bf16_t* __restrict__ KR,
                                             const bf16_t* __restrict__ V, const unsigned long long* __restrict__ MASK, bf16_t* __restrict__ O, char* lds) {
  int tid = threadIdx.x; asm volatile("" : "+v"(tid));
  const int wid = __builtin_amdgcn_readfirstlane(tid >> 6), lane = tid & 63, r32 = lane & 31, hi = lane >> 5;
  constexpr int NQ = MODE ? 12 : 8, LDK = MODE ? 2048 : 512;
  char* V_lds = lds; char* K_lds = lds + 2 * SHM_KV; char* R_lds = lds + 4 * SHM_KV;
  float* ws = (float*)(lds + 4 * SHM_KV + 16384) + wid * 64; float* li_l = ws; float* al_l = ws + 32;
  const int head = MODE ? hx : 4 * hx + (wid >> 1);
  const long qrow0 = MODE ? (long)b * 4096 + 256 * ux + 32 * wid : (long)b * 4096 + 64 * ux + 32 * (wid & 1);
  const long qrow = qrow0 + r32;
  const int NT = MODE ? 4 * ux + 4 : ux + 1, NTw = MODE ? 4 * ux + (wid >> 1) + 1 : NT;
  bf16x8 qr[NQ];
  { const bf16_t* Qw = Q + qrow * 2048 + head * 128 + hi * 8;
#pragma unroll
    for (int d0 = 0; d0 < 8; ++d0) qr[d0] = *reinterpret_cast<const bf16x8*>(Qw + d0 * 16);
    if constexpr (MODE == 1) { const bf16_t* Qx = QR + qrow * 1024 + head * 64 + hi * 8;
#pragma unroll
      for (int d0 = 0; d0 < 4; ++d0) qr[8 + d0] = *reinterpret_cast<const bf16x8*>(Qx + d0 * 16); } }
  const int sr = tid >> 4, sc = (tid & 15) * 8, vst0 = v_st(sr, sc), vst1 = v_st(32 + sr, sc);
  const int rr_ = tid >> 3, rc = (tid & 7) * 8, rst = rr_ * 128 + ((rc * 2) ^ ((rr_ & 7) << 4));
  const int vb0 = (int)(uintptr_t)V_lds + v_rd_base(lane);
  const bf16_t* Kh = K + (long)b * 4096 * LDK + hx * 128; const bf16_t* Vh = V + (long)b * 4096 * LDK + hx * 128; const bf16_t* Rh = MODE ? KR + (long)b * 4096 * 64 : nullptr;
  const unsigned long long* mrow = MODE ? nullptr : MASK + qrow * 64;
  bf16x8 vs0, vs1, ks0, ks1, rs0;
#define SLOAD(k0) do { vs0 = *reinterpret_cast<const bf16x8*>(Vh + (long)((k0) + sr) * LDK + sc); vs1 = *reinterpret_cast<const bf16x8*>(Vh + (long)((k0) + 32 + sr) * LDK + sc); \
    ks0 = *reinterpret_cast<const bf16x8*>(Kh + (long)((k0) + sr) * LDK + sc); ks1 = *reinterpret_cast<const bf16x8*>(Kh + (long)((k0) + 32 + sr) * LDK + sc); \
    if constexpr (MODE == 1) rs0 = *reinterpret_cast<const bf16x8*>(Rh + (long)((k0) + rr_) * 64 + rc); } while (0)
#define SWRITE(bf) do { *(bf16x8*)(V_lds + (bf) * SHM_KV + vst0) = vs0; *(bf16x8*)(V_lds + (bf) * SHM_KV + vst1) = vs1; \
    *(bf16x8*)(K_lds + (bf) * SHM_KV + KSWZ(sr, sc * 2)) = ks0; *(bf16x8*)(K_lds + (bf) * SHM_KV + KSWZ(32 + sr, sc * 2)) = ks1; \
    if constexpr (MODE == 1) *(bf16x8*)(R_lds + (bf) * 8192 + rst) = rs0; } while (0)
#define QK(P0, P1, t) do { qkt(P0, P1, K_lds + ((t) & 1) * SHM_KV, qr, r32, hi); \
    if constexpr (MODE == 1) qkt_rope(P0, P1, R_lds + ((t) & 1) * 8192, qr + 8, r32, hi); \
    if constexpr (MODE == 0) { const int mlo = (int)((unsigned)mwc >> (4 * hi)), mhi = (int)((unsigned)(mwc >> 32) >> (4 * hi)); \
      _Pragma("unroll") for (int r = 0; r < 16; ++r) { const int cb = (r & 3) + 8 * (r >> 2); \
        const unsigned t0_ = (unsigned)__builtin_amdgcn_sbfe(mlo, cb, 1), t1_ = (unsigned)__builtin_amdgcn_sbfe(mhi, cb, 1);     \
        P0[r] = __uint_as_float((__float_as_uint(P0[r]) & t0_) | (~t0_ & 0xFF800000u)); P1[r] = __uint_as_float((__float_as_uint(P1[r]) & t1_) | (~t1_ & 0xFF800000u)); } } } while (0)
  constexpr int SC9 = MODE ? 72168784 : 88388348;
  float m_reg = -1e30f, l_reg = 0.f; f32x16 o[4];
#pragma unroll
  for (int d = 0; d < 4; ++d) o[d] = f32x16{};
  f32x16 pA0, pA1, pB0, pB1; float mnA, mnB, alA = 1.f, alB = 1.f; bf16x8 pa0, pa1, pa2, pa3;
  unsigned long long mwc = 0ull, mwn = 0ull;
#define STEP(N0, N1, mnN, alN, E0, E1, alE, t) do { const bool an_ = (t) < NTw, ap_ = (t) - 1 < NTw; \
    if constexpr (MODE == 0) mwn = ((t) + 1 < NT) ? mrow[(t) + 1] : 0ull; \
    ATT_SBAR(); if (an_) { QK(N0, N1, t); } \
    if (ap_) { finishSM(E0, E1, alE, l_reg, pa0, pa1, pa2, pa3); } ATT_SBAR(); \
    if (ap_) { pv_d0(o, vb0 + (((t) - 1) & 1) * SHM_KV, pa0, pa1, pa2, pa3); } \
    if (an_) { partialSM<SC9>(N0, N1, m_reg, mnN, alN); } \
    __syncthreads(); \
    if ((t) + 1 < NT) SWRITE(((t) + 1) & 1); \
    if ((t) + 2 < NT) SLOAD(((t) + 2) * 64); \
    if (an_) { ATT_RESC(alN); } mwc = mwn; \
    __syncthreads(); } while (0)
  SLOAD(0); SWRITE(0); if (NT > 1) SLOAD(64);
  if constexpr (MODE == 0) { mwc = mrow[0]; }
  __syncthreads();
  QK(pA0, pA1, 0); partialSM<SC9>(pA0, pA1, m_reg, mnA, alA);
  if constexpr (MODE == 0) { mwc = (NT > 1) ? mrow[1] : 0ull; }
  if (NT > 1) { SWRITE(1); if (NT > 2) SLOAD(128); }
  __syncthreads();
  int t = 1;
  for (; t + 1 < NT; t += 2) {
    STEP(pB0, pB1, mnB, alB, pA0, pA1, alA, t);
    STEP(pA0, pA1, mnA, alA, pB0, pB1, alB, t + 1);
  }
  if (t < NT) {
    STEP(pB0, pB1, mnB, alB, pA0, pA1, alA, t);
    if (t < NTw) { finishSM(pB0, pB1, alB, l_reg, pa0, pa1, pa2, pa3); ATT_SBAR(); pv_d0(o, vb0 + (t & 1) * SHM_KV, pa0, pa1, pa2, pa3); }
  } else {
    if (NT - 1 < NTw) { finishSM(pA0, pA1, alA, l_reg, pa0, pa1, pa2, pa3); ATT_SBAR(); pv_d0(o, vb0 + ((NT - 1) & 1) * SHM_KV, pa0, pa1, pa2, pa3); }
  }
  if (hi == 0) li_l[r32] = l_reg; asm volatile("s_waitcnt lgkmcnt(0)" ::: "memory");
  float rli[16];
#pragma unroll
  for (int r = 0; r < 16; ++r) rli[r] = __builtin_amdgcn_rcpf(li_l[crow(r, hi)]);
  __syncthreads();
  store_o(o, rli, (bf16_t*)(lds + wid * 8192), O + qrow0 * 2048 + head * 128, 2048, lane, r32, hi);
  __syncthreads();
#undef SLOAD
#undef SWRITE
#undef QK
#undef STEP
}

__device__ __forceinline__ void mla_attn_unit(int b, int h, int qb, const bf16_t* __restrict__ QN, const bf16_t* __restrict__ QR, const bf16_t* __restrict__ KN, const bf16_t* __restrict__ KR,
                                              const bf16_t* __restrict__ V, bf16_t* __restrict__ O, char* lds) {
  int tid = threadIdx.x; asm volatile("" : "+v"(tid));
  const int wid = __builtin_amdgcn_readfirstlane(tid >> 6), lane = tid & 63, r32 = lane & 31, hi = lane >> 5;
  char* V_lds = lds; char* K_lds = lds + 2 * SHM_KV; char* R_lds = lds + 4 * SHM_KV;
  float* ws = (float*)(lds + 4 * SHM_KV + 16384) + wid * 64; float* li_l = ws; float* al_l = ws + 32;
  const long qrow0 = (long)b * 4096 + 256 * qb + 32 * wid, qrow = qrow0 + r32;
  bf16x8 qr[12];
  { const bf16_t* Qw = QN + qrow * 2048 + h * 128 + hi * 8;
#pragma unroll
    for (int d0 = 0; d0 < 8; ++d0) qr[d0] = *reinterpret_cast<const bf16x8*>(Qw + d0 * 16);
    const bf16_t* Qx = QR + qrow * 1024 + h * 64 + hi * 8;
#pragma unroll
    for (int d0 = 0; d0 < 4; ++d0) qr[8 + d0] = *reinterpret_cast<const bf16x8*>(Qx + d0 * 16); }
  const int sr = tid >> 4, sc = (tid & 15) * 8, vst0 = v_st(sr, sc), vst1 = v_st(32 + sr, sc);
  const int rr_ = tid >> 3, rc = (tid & 7) * 8, rst = rr_ * 128 + ((rc * 2) ^ ((rr_ & 7) << 4));
  const int vb0 = (int)(uintptr_t)V_lds + v_rd_base(lane);
  const bf16_t* Kh = KN + (long)b * 4096 * 2048 + h * 128; const bf16_t* Vh = V + (long)b * 4096 * 2048 + h * 128; const bf16_t* Rh = KR + (long)b * 4096 * 64;
  bf16x8 vs0, vs1, ks0, ks1, rs0;
#define SLOAD(k0) do { vs0 = *reinterpret_cast<const bf16x8*>(Vh + (long)((k0) + sr) * 2048 + sc); vs1 = *reinterpret_cast<const bf16x8*>(Vh + (long)((k0) + 32 + sr) * 2048 + sc); \
    ks0 = *reinterpret_cast<const bf16x8*>(Kh + (long)((k0) + sr) * 2048 + sc); ks1 = *reinterpret_cast<const bf16x8*>(Kh + (long)((k0) + 32 + sr) * 2048 + sc); \
    rs0 = *reinterpret_cast<const bf16x8*>(Rh + (long)((k0) + rr_) * 64 + rc); } while (0)
#define SWRITE(bf) do { *(bf16x8*)(V_lds + (bf) * SHM_KV + vst0) = vs0; *(bf16x8*)(V_lds + (bf) * SHM_KV + vst1) = vs1; \
    *(bf16x8*)(K_lds + (bf) * SHM_KV + KSWZ(sr, sc * 2)) = ks0; *(bf16x8*)(K_lds + (bf) * SHM_KV + KSWZ(32 + sr, sc * 2)) = ks1; \
    *(bf16x8*)(R_lds + (bf) * 8192 + rst) = rs0; } while (0)
  const int NT = 4 * qb + 4, NTw = 4 * qb + (wid >> 1) + 1;
  float m_reg = -1e30f, l_reg = 0.f; f32x16 o[4];
#pragma unroll
  for (int d = 0; d < 4; ++d) o[d] = f32x16{};
  SLOAD(0); SWRITE(0); SLOAD(64);
  for (int j = 0; j < NT; ++j) {
    __syncthreads();
    if (j + 1 < NT) SWRITE((j + 1) & 1);
    if (j + 2 < NT) SLOAD((j + 2) * 64);
    if (j < NTw) {
      f32x16 p0, p1; qkt(p0, p1, K_lds + (j & 1) * SHM_KV, qr, r32, hi); qkt_rope(p0, p1, R_lds + (j & 1) * 8192, qr + 8, r32, hi);
      float mn, alpha; partialSM<72168784>(p0, p1, m_reg, mn, alpha);
      bf16x8 pa0, pa1, pa2, pa3; finishSM(p0, p1, alpha, l_reg, pa0, pa1, pa2, pa3);
      ATT_RESC(alpha);
      pv_d0(o, vb0 + (j & 1) * SHM_KV, pa0, pa1, pa2, pa3);
    }
  }
  if (hi == 0) li_l[r32] = l_reg; asm volatile("s_waitcnt lgkmcnt(0)" ::: "memory");
  float rli[16];
#pragma unroll
  for (int r = 0; r < 16; ++r) rli[r] = __builtin_amdgcn_rcpf(li_l[crow(r, hi)]);
  __syncthreads();
  store_o(o, rli, (bf16_t*)(lds + wid * 8192), O + qrow0 * 2048 + h * 128, 2048, lane, r32, hi);
  __syncthreads();
#undef SLOAD
#undef SWRITE
}

__device__ __forceinline__ void sb_attn_unit(int b, int h, int qb, const bf16_t* __restrict__ Q, const bf16_t* __restrict__ K, const bf16_t* __restrict__ V, bf16_t* __restrict__ O, char* lds, unsigned* diag = nullptr) {
  int tid = threadIdx.x; asm volatile("" : "+v"(tid));
  const int wid = __builtin_amdgcn_readfirstlane(tid >> 6), lane = tid & 63, r32 = lane & 31, hi = lane >> 5;
  char* V_lds = lds; char* K_lds = lds + 2 * SHM_KV;
  volatile __attribute__((address_space(3))) int* fl = (volatile __attribute__((address_space(3))) int*)(lds + 4 * SHM_KV + 2048);
  const int tw0 = 256 * qb + 32 * wid, t = tw0 + r32;
  const long qrow0 = (long)b * 4096 + tw0, qrow = qrow0 + r32;
  bf16x8 qr[8];
  { const bf16_t* Qw = Q + qrow * 2048 + h * 128 + hi * 8;
#pragma unroll
    for (int d0 = 0; d0 < 8; ++d0) qr[d0] = *reinterpret_cast<const bf16x8*>(Qw + d0 * 16); }
  const int sr = tid >> 4, sc = (tid & 15) * 8, vst0 = v_st(sr, sc), vst1 = v_st(32 + sr, sc);
  const int vb0 = (int)(uintptr_t)V_lds + v_rd_base(lane);
  const bf16_t* Kh = K + (long)b * 4096 * 2048 + h * 128; const bf16_t* Vh = V + (long)b * 4096 * 2048 + h * 128;
  bf16x8 vs0, vs1, ks0, ks1;
#define SLOAD(k0) do { vs0 = *reinterpret_cast<const bf16x8*>(Vh + (long)((k0) + sr) * 2048 + sc); vs1 = *reinterpret_cast<const bf16x8*>(Vh + (long)((k0) + 32 + sr) * 2048 + sc); \
    ks0 = *reinterpret_cast<const bf16x8*>(Kh + (long)((k0) + sr) * 2048 + sc); ks1 = *reinterpret_cast<const bf16x8*>(Kh + (long)((k0) + 32 + sr) * 2048 + sc); } while (0)
#define SWRITE(bf) do { *(bf16x8*)(V_lds + (bf) * SHM_KV + vst0) = vs0; *(bf16x8*)(V_lds + (bf) * SHM_KV + vst1) = vs1; \
    *(bf16x8*)(K_lds + (bf) * SHM_KV + KSWZ(sr, sc * 2)) = ks0; *(bf16x8*)(K_lds + (bf) * SHM_KV + KSWZ(32 + sr, sc * 2)) = ks1; } while (0)
  const int NT = 4 * qb + 4;
  constexpr float C = 0.08838834764831845f * 1.4426950408889634f;
  float Rp = 1.f; bool wdone = false; f32x16 o[4];
#pragma unroll
  for (int d = 0; d < 4; ++d) o[d] = f32x16{};
  SLOAD((NT - 1) * 64); SWRITE(0); SLOAD((NT - 2) * 64);
  int j = 0;
  for (; j < NT; ++j) {
    __syncthreads();
    if (j > 0) { int all = 1;
#pragma unroll
      for (int w = 0; w < 8; ++w) all &= fl[((j - 1) & 1) * 8 + w];
      if (all) break; }
    if (j + 1 < NT) SWRITE((j + 1) & 1);
    if (j + 2 < NT) SLOAD((NT - 3 - j) * 64);
    const int T = NT - 1 - j;
    if (64 * T <= tw0 + 30 && !wdone) {
      f32x16 p0, p1; qkt(p0, p1, K_lds + (j & 1) * SHM_KV, qr, r32, hi);
      f32x16 k0, k1;
      const bool needmask = (64 * T + 63 >= tw0);
#pragma unroll
      for (int r = 0; r < 16; ++r) {
        { const float z = p0[r] * C, e = __builtin_amdgcn_exp2f(-fabsf(z)), big = __builtin_amdgcn_rcpf(1.f + e), sml = e * big; float be = z >= 0.f ? big : sml, ke = z >= 0.f ? sml : big;
          if (needmask && (64 * T + crow(r, hi) >= t)) { be = 0.f; ke = 1.f; } p0[r] = be; k0[r] = ke; }
        { const float z = p1[r] * C, e = __builtin_amdgcn_exp2f(-fabsf(z)), big = __builtin_amdgcn_rcpf(1.f + e), sml = e * big; float be = z >= 0.f ? big : sml, ke = z >= 0.f ? sml : big;
          if (needmask && (64 * T + 32 + crow(r, hi) >= t)) { be = 0.f; ke = 1.f; } p1[r] = be; k1[r] = ke; }
      }
      float GP[16];
#pragma unroll
      for (int q = 0; q < 4; ++q) {
        const float g0 = (k0[4 * q] * k0[4 * q + 1]) * (k0[4 * q + 2] * k0[4 * q + 3]), g1 = (k1[4 * q] * k1[4 * q + 1]) * (k1[4 * q + 2] * k1[4 * q + 3]);
        auto x0 = __builtin_amdgcn_permlane32_swap(__float_as_uint(g0), __float_as_uint(g0), false, false);
        auto x1 = __builtin_amdgcn_permlane32_swap(__float_as_uint(g1), __float_as_uint(g1), false, false);
        GP[2 * q] = __uint_as_float(x0[0]); GP[2 * q + 1] = __uint_as_float(x0[1]); GP[8 + 2 * q] = __uint_as_float(x1[0]); GP[8 + 2 * q + 1] = __uint_as_float(x1[1]);
      }
      float SG[16]; SG[15] = 1.f;
#pragma unroll
      for (int g = 14; g >= 0; --g) SG[g] = SG[g + 1] * GP[g + 1];
      const float tileprod = SG[0] * GP[0];
#pragma unroll
      for (int q = 0; q < 4; ++q) {
        { const float base = Rp * (hi ? SG[2 * q + 1] : SG[2 * q]); const float w2 = k0[4 * q + 3], w1 = w2 * k0[4 * q + 2], w0 = w1 * k0[4 * q + 1];
          p0[4 * q + 3] *= base; p0[4 * q + 2] *= base * w2; p0[4 * q + 1] *= base * w1; p0[4 * q] *= base * w0; }
        { const float base = Rp * (hi ? SG[8 + 2 * q + 1] : SG[8 + 2 * q]); const float w2 = k1[4 * q + 3], w1 = w2 * k1[4 * q + 2], w0 = w1 * k1[4 * q + 1];
          p1[4 * q + 3] *= base; p1[4 * q + 2] *= base * w2; p1[4 * q + 1] *= base * w1; p1[4 * q] *= base * w0; }
      }
      Rp *= tileprod;
      bf16x8 pa0, pa1, pa2, pa3; packP(p0, p1, pa0, pa1, pa2, pa3);
      pv_d0(o, vb0 + (j & 1) * SHM_KV, pa0, pa1, pa2, pa3);
      wdone = __all(Rp == 0.f);
    }
    if (lane == 0) fl[(j & 1) * 8 + wid] = wdone ? 1 : 0;
  }
  if (diag && tid == 0) atomicAdd(diag, (unsigned)j);
  float rli[16];
#pragma unroll
  for (int r = 0; r < 16; ++r) rli[r] = 1.f;
  __syncthreads();
  store_o(o, rli, (bf16_t*)(lds + wid * 8192), O + qrow0 * 2048 + h * 128, 2048, lane, r32, hi);
  __syncthreads();
#undef SLOAD
#undef SWRITE
}

__device__ __forceinline__ void idx_unit(int b, int qq, const bf16_t* __restrict__ IQ, const bf16_t* __restrict__ IK, const float* __restrict__ IW, float* __restrict__ SC, char* lds) {
  int tid = threadIdx.x; asm volatile("" : "+v"(tid));
  const int wid = __builtin_amdgcn_readfirstlane(tid >> 6), lane = tid & 63, r32 = lane & 31, hi = lane >> 5;
  char* K_lds = lds;
  const int c = qq >> 1, NT = c + 1;
  const long t0 = (long)b * 4096 + 32 * qq + 4 * wid;
  bf16x8 a[2][8]; float wgt[2][16];
#pragma unroll
  for (int rt = 0; rt < 2; ++rt) {
    const long qa = t0 + 2 * rt + ((r32 >> 2) & 1); const int ha = (r32 & 3) + 4 * (r32 >> 3);
    const bf16_t* p = IQ + qa * 2048 + ha * 128 + hi * 8;
#pragma unroll
    for (int ks = 0; ks < 8; ++ks) a[rt][ks] = *reinterpret_cast<const bf16x8*>(p + ks * 16);
    const float* wp = IW + (t0 + 2 * rt + hi) * 16;
#pragma unroll
    for (int i4 = 0; i4 < 4; ++i4) { const f32x4 w4 = *(const f32x4*)(wp + 4 * i4); wgt[rt][4 * i4] = w4[0]; wgt[rt][4 * i4 + 1] = w4[1]; wgt[rt][4 * i4 + 2] = w4[2]; wgt[rt][4 * i4 + 3] = w4[3]; }
  }
  const int sr = tid >> 4, sc = (tid & 15) * 8;
  const bf16_t* Kb = IK + (long)b * 4096 * 128;
  bf16x8 ks0, ks1;
#define SLOAD(k0) do { ks0 = *reinterpret_cast<const bf16x8*>(Kb + (long)((k0) + sr) * 128 + sc); ks1 = *reinterpret_cast<const bf16x8*>(Kb + (long)((k0) + 32 + sr) * 128 + sc); } while (0)
#define SWRITE(bf) do { *(bf16x8*)(K_lds + (bf) * SHM_KV + KSWZ(sr, sc * 2)) = ks0; *(bf16x8*)(K_lds + (bf) * SHM_KV + KSWZ(32 + sr, sc * 2)) = ks1; } while (0)
  SLOAD(0); SWRITE(0); if (NT > 1) SLOAD(64);
  for (int j = 0; j < NT; ++j) {
    __syncthreads();
    if (j + 1 < NT) SWRITE((j + 1) & 1);
    if (j + 2 < NT) SLOAD((j + 2) * 64);
    const char* Kt = K_lds + (j & 1) * SHM_KV;
#pragma unroll
    for (int kh = 0; kh < 2; ++kh) {
      bf16x8 bfr[8];
#pragma unroll
      for (int ks = 0; ks < 8; ++ks) bfr[ks] = *reinterpret_cast<const bf16x8*>(Kt + KSWZ(32 * kh + r32, (ks * 16 + hi * 8) * 2));
#pragma unroll
      for (int rt = 0; rt < 2; ++rt) {
        f32x16 acc = f32x16{};
#pragma unroll
        for (int ks = 0; ks < 8; ++ks) acc = __builtin_amdgcn_mfma_f32_32x32x16_bf16(a[rt][ks], bfr[ks], acc, 0, 0, 0);
        float s = 0.f;
#pragma unroll
        for (int i = 0; i < 16; ++i) s += wgt[rt][i] * fmaxf(acc[i], 0.f);
        SC[(t0 + 2 * rt + hi) * 4096 + 64 * j + 32 * kh + r32] = s;
      }
    }
  }
  __syncthreads();
#undef SLOAD
#undef SWRITE
}

__device__ __forceinline__ int wave_sum_i(int v) {
#pragma unroll
  for (int o = 1; o < 64; o <<= 1) v += __shfl_xor(v, o);
  return v;
}
__device__ __forceinline__ void topk_row(const float* __restrict__ sc_row, int c, unsigned long long* __restrict__ mask_row, int lane) {
  unsigned key[64];
  int cv = c; asm volatile("" : "+v"(cv));
#pragma unroll
  for (int g4 = 0; g4 < 4; ++g4) {
    if (16 * g4 <= c) {
#pragma unroll
      for (int j = 16 * g4; j < 16 * g4 + 16; ++j) key[j] = __float_as_uint(sc_row[j * 64 + lane]);
    } else {
#pragma unroll
      for (int j = 16 * g4; j < 16 * g4 + 16; ++j) key[j] = 0u;
    }
  }
#pragma unroll
  for (int j = 0; j < 64; ++j) { const unsigned u = key[j]; const unsigned k = (u & 0x80000000u) ? ~u : (u | 0x80000000u); key[j] = (j <= cv) ? k : 0u; }
  unsigned long long mine = 0ull; unsigned mlo = 0u, mhi = 0u;
  if (c < 4) {
    mine = (lane <= c) ? ~0ull : 0ull;
  } else {
    unsigned T = 0u; bool exact = false;
    for (int bit = 31; bit >= 0; --bit) {
      const unsigned cand = T | (1u << bit); int cnt = 0;
#pragma unroll
      for (int g8 = 0; g8 < 8; ++g8) {
        if (8 * g8 <= c) {
#pragma unroll
          for (int j = 8 * g8; j < 8 * g8 + 8; ++j) cnt += __builtin_popcountll(__ballot(key[j] >= cand));
        }
        ATT_SBAR();
      }
      if (cnt >= 256) { T = cand; if (cnt == 256) { exact = true; break; } }
    }
    asm volatile("" : "+v"(T));
    if (exact) {
#pragma unroll
      for (int j = 0; j < 64; ++j) { const unsigned long long m = __ballot(key[j] >= T);
        asm volatile("s_nop 3\n\tv_writelane_b32 %0, %2, %4\n\tv_writelane_b32 %1, %3, %4" : "+v"(mlo), "+v"(mhi) : "s"((unsigned)m), "s"((unsigned)(m >> 32)), "i"(j));     }
    } else {
      int gt = 0;
#pragma unroll
      for (int g8 = 0; g8 < 8; ++g8) {
#pragma unroll
        for (int j = 8 * g8; j < 8 * g8 + 8; ++j) gt += __builtin_popcountll(__ballot(key[j] > T));
        ATT_SBAR();
      }
      int need = 256 - gt;
#pragma unroll
      for (int j = 0; j < 64; ++j) {
        const unsigned long long g = __ballot(key[j] > T); unsigned long long e = __ballot(key[j] == T), take = 0ull;
        const int pe = __popcll(e);
        if (pe <= need) { take = e; need -= pe; } else { while (need > 0) { const unsigned long long lowb = e & (~e + 1ull); take |= lowb; e ^= lowb; --need; } }
        const unsigned long long m = g | take;
        asm volatile("s_nop 3\n\tv_writelane_b32 %0, %2, %4\n\tv_writelane_b32 %1, %3, %4" : "+v"(mlo), "+v"(mhi) : "s"((unsigned)m), "s"((unsigned)(m >> 32)), "i"(j));
      }
    }
  }
  if (c >= 4) mine = (unsigned long long)mlo | ((unsigned long long)mhi << 32);
  mask_row[lane] = mine;
}
#undef KSWZ
}

constexpr int NWAVES = 8;
constexpr int BATCH = 4, SEQ = 4096, DM = 2048, DFF = 5632, M = BATCH * SEQ;
constexpr int DSA_NP = 5376, MLA_DOWN_NP = 1280;
constexpr int NPH = 35;
#ifndef MK_ONE_LAUNCH
#define MK_ONE_LAUNCH 1
#endif
constexpr size_t MiB = 1u << 20;
constexpr size_t WS_CTL = 0, CTL_ZERO_BYTES = 1 * MiB;
constexpr size_t WS_MODS = 1 * MiB;
constexpr size_t WS_CS128 = 2 * MiB;
constexpr size_t WS_CS64 = 4 * MiB;
constexpr size_t WS_SSQ = 5 * MiB;
constexpr size_t WS_W = 6 * MiB;
constexpr size_t WL_STRIDE = 74 * MiB, WL_FFN1 = 0, WL_FFN2 = 44 * MiB, WL_OUT = 66 * MiB;
constexpr size_t WS_WDSA = WS_W + 4 * WL_STRIDE, WDSA_STRIDE = 21 * MiB;
constexpr size_t WS_WMLA = WS_WDSA + 2 * WDSA_STRIDE, WMLA_DOWN = 0, WMLA_UQ = 5 * MiB, WMLA_UKV = 8 * MiB;
constexpr size_t WS_WSB = WS_WMLA + 12 * MiB;
constexpr size_t WS_H = WS_WSB + 24 * MiB;
constexpr size_t WS_O = WS_H + 64 * MiB;
constexpr size_t WS_MIX = WS_O + 64 * MiB;
constexpr size_t MX_ACT = 0;
constexpr size_t MX_DQ = 0, MX_DK = 64 * MiB, MX_DV = 80 * MiB, MX_DIQ = 96 * MiB, MX_DIK = 160 * MiB, MX_DIW = 164 * MiB, MX_DMASK = 165 * MiB, MX_DSC = 176 * MiB;
constexpr size_t MX_MCQ = 0, MX_MCKV = 16 * MiB, MX_MKR = 32 * MiB, MX_MQN = 34 * MiB, MX_MQR = 98 * MiB, MX_MKN = 130 * MiB, MX_MV = 194 * MiB;
constexpr size_t MX_SQ = 0, MX_SK = 64 * MiB, MX_SV = 128 * MiB;
constexpr size_t WS_END = WS_MIX + 432 * MiB;
static_assert(WS_W + 380 * MiB - 6 * MiB == WS_H, "weight map");
constexpr int CW_TMO = 0, CW_BAR = 4096;
constexpr int RING_BYTES = 131072, LDSCTL_OFF = RING_BYTES, MISC_OFF = LDSCTL_OFF + 320, LDS_BYTES = 147456;

#define GAS __attribute__((address_space(1)))
#define LAS __attribute__((address_space(3)))
typedef unsigned short bf16;
typedef unsigned v4u __attribute__((ext_vector_type(4)));
typedef float f32x4 __attribute__((ext_vector_type(4)));
typedef GAS unsigned gu32;
#define RLX_AGENT __ATOMIC_RELAXED, __HIP_MEMORY_SCOPE_AGENT
#define LDS_WAIT() asm volatile("s_waitcnt lgkmcnt(0)" ::: "memory")
__device__ __forceinline__ unsigned f2bf(float f) { unsigned u = __builtin_bit_cast(unsigned, f); return (u + 0x7fffu + ((u >> 16) & 1u)) >> 16; }
__device__ __forceinline__ unsigned pk2(float lo, float hi) { return f2bf(lo) | (f2bf(hi) << 16); }

#define XB_TMO      128
#define XB_XCNT(j)  (256  + 64 * (j))
#define XB_XSUB(j)  (1280 + 64 * (j))
#define XB_XGEN(j)  (2304 + 64 * (j))
#define XB_TOP      3328
#define XB_TOPGEN   3392
#define XCD_BAR_WORDS 3456
#define XB_SPIN_CAP (1u << 18)

__device__ __forceinline__ unsigned xb_ld(unsigned* p)              { return __hip_atomic_load(p, __ATOMIC_RELAXED, __HIP_MEMORY_SCOPE_AGENT); }
__device__ __forceinline__ unsigned xb_add(unsigned* p, unsigned v) { return __hip_atomic_fetch_add(p, v, __ATOMIC_RELAXED, __HIP_MEMORY_SCOPE_AGENT); }
__device__ __forceinline__ unsigned xb_xcc_id() { return (unsigned)__builtin_amdgcn_s_getreg((3 << 11) | 20) & 0xFu; }
#define XB_SPIN(cond, bar) do { unsigned _sp = 0; while (cond) { __builtin_amdgcn_s_sleep(1); \
    if ((++_sp & 255u) == 0u) { if (xb_ld(&(bar)[XB_TMO])) break; if (_sp > XB_SPIN_CAP) { atomicAdd(&(bar)[XB_TMO], 1u); break; } } } } while (0)

struct XcdBarrier {
    unsigned* bar; unsigned x;
    volatile LAS unsigned* st;
};

__device__ __forceinline__ XcdBarrier xcd_barrier_post(unsigned* bar, volatile LAS unsigned* st) {
    XcdBarrier b; b.bar = bar; b.x = xb_xcc_id(); b.st = st;
    if (threadIdx.x == 0) (void)xb_add(&bar[XB_XCNT(b.x)], 1u);
    return b;
}
__device__ __forceinline__ void xcd_barrier_complete(unsigned* bar, unsigned x, unsigned& nloc, unsigned& nx) {
    const unsigned G = gridDim.x * gridDim.y * gridDim.z;
    unsigned sum, cnt, mine, sp = 0u;
    for (;;) {
        sum = 0u; cnt = 0u; mine = 0u;
#pragma unroll
        for (unsigned j = 0; j < 16; ++j) { const unsigned c = xb_ld(&bar[XB_XCNT(j)]); sum += c; cnt += (c > 0u) ? 1u : 0u; mine = (j == x) ? c : mine; }
        if (sum == G) break;
        __builtin_amdgcn_s_sleep(1);
        if ((++sp & 255u) == 0u) { if (xb_ld(&bar[XB_TMO])) break; if (sp > XB_SPIN_CAP) { atomicAdd(&bar[XB_TMO], 1u); break; } }
    }
    nloc = mine > 0u ? mine : 1u; nx = cnt > 0u ? cnt : 1u;
}

__device__ __forceinline__ void xcd_barrier(const XcdBarrier& b) {
    asm volatile("s_waitcnt vmcnt(0)" ::: "memory");
    __syncthreads();
    if (threadIdx.x == 0) {
        unsigned* bar = b.bar;
        __builtin_amdgcn_s_waitcnt(0);
        unsigned nloc = b.st[0], nx = b.st[1];
        if (nloc == 0u) { xcd_barrier_complete(bar, b.x, nloc, nx); b.st[0] = nloc; b.st[1] = nx; }
        const unsigned old = xb_add(&bar[XB_XSUB(b.x)], 1u);
        const unsigned gen = old / nloc;
        if (old + 1u == (gen + 1u) * nloc) {
            __builtin_amdgcn_fence(__ATOMIC_RELEASE, "agent");
            asm volatile("s_waitcnt vmcnt(0)" ::: "memory");
            const unsigned og = xb_add(&bar[XB_TOP], 1u);
            const unsigned tg = og / nx;
            if (og + 1u == (tg + 1u) * nx) xb_add(&bar[XB_TOPGEN], 1u);
            else XB_SPIN(xb_ld(&bar[XB_TOPGEN]) == tg, bar);
            __builtin_amdgcn_fence(__ATOMIC_ACQUIRE, "agent");
            xb_add(&bar[XB_XGEN(b.x)], 1u);
            asm volatile("s_waitcnt vmcnt(0)" ::: "memory");
        } else {
            XB_SPIN(xb_ld(&bar[XB_XGEN(b.x)]) == gen, bar);
            __builtin_amdgcn_fence(__ATOMIC_ACQUIRE, "agent");
            asm volatile("s_waitcnt vmcnt(0)" ::: "memory");
        }
    }
    __syncthreads();
}

struct Frame {
    LAS unsigned char* lds;
    volatile LAS unsigned* MISC;
    gu32* ctl;
    int tid, lane, wave;
    int vcu, G;
};
__device__ __forceinline__ float wave_sum(float v) {
#pragma unroll
    for (int o = 1; o < 64; o <<= 1) v += __shfl_xor(v, o);
    return v;
}
enum { KIND_ID = 0, KIND_DSA_IN = 1, KIND_MLA_DOWN = 2, KIND_MLA_UQ = 3, KIND_FFN1 = 4 };
__host__ __device__ __forceinline__ int srcblk(int kind, int nb, int& nvalid) {
    nvalid = 32;
    const int pn = nb >> 3, pb = nb & 7, bj = pb >> 2, wc = pb & 3;
    if (kind == KIND_ID) return nb * 32;
    if (kind == KIND_DSA_IN) {
        if (pn < 8)  return (2 * pn + (wc >> 1)) * 128 + 64 * bj + 32 * (wc & 1);
        if (pn < 10) return 2048 + (2 * (pn - 8) + (wc >> 1)) * 128 + 64 * bj + 32 * (wc & 1);
        if (pn < 12) return 2560 + (pn - 10) * 256 + 32 * pb;
        if (pn < 20) return 3072 + (2 * (pn - 12) + (wc >> 1)) * 128 + (wc & 1) * 64 + bj * 32;
        if (wc == 0) return 5120 + bj * 32;
        if (wc == 1) return 5120 + 64 + bj * 32;
        if (wc == 2 && bj == 0) { nvalid = 16; return 5248; }
        return -1;
    }
    if (kind == KIND_MLA_DOWN) { if (pn < 4) return nb * 32; if (wc == 0) return 1024 + 32 * bj; return -1; }
    if (kind == KIND_MLA_UQ) { if (pn < 8) return (2 * pn + bj) * 192 + 32 * wc; return (4 * (pn - 8) + wc) * 192 + 128 + 32 * bj; }
      return (bj ? 5632 : 0) + 128 * pn + 32 * wc;
}
__device__ __forceinline__ void conv_item(const float* __restrict__ W, int K, int Nsrc, int Nphys, int kind, const float* __restrict__ gk, bf16* __restrict__ WT, LAS unsigned* scr, int item, int lane) {
    const int nblk = Nphys / 64, kb = item / nblk, ib = item % nblk, k0 = 64 * kb, n0 = 64 * ib;
    const int c4 = lane & 15, kr = lane >> 4;
    int nvalid; const int sb = srcblk(kind, 2 * ib + (c4 >> 3), nvalid);
    const int col = 4 * (c4 & 7);
    const bool valid = (sb >= 0) && (col < nvalid);
    const float* src = W + (size_t)(k0 + 2 * kr) * Nsrc + (valid ? sb + col : 0);
    f32x4 va[8], vb[8];
#pragma unroll
    for (int kk = 0; kk < 8; ++kk) { va[kk] = *(const GAS f32x4*)(src + (size_t)(8 * kk) * Nsrc); vb[kk] = *(const GAS f32x4*)(src + (size_t)(8 * kk + 1) * Nsrc); }
    if (gk) {
#pragma unroll
        for (int kk = 0; kk < 8; ++kk) { va[kk] *= gk[k0 + 8 * kk + 2 * kr]; vb[kk] *= gk[k0 + 8 * kk + 2 * kr + 1]; } }
    if (!valid) {
#pragma unroll
        for (int kk = 0; kk < 8; ++kk) { va[kk] = (f32x4){0.f, 0.f, 0.f, 0.f}; vb[kk] = (f32x4){0.f, 0.f, 0.f, 0.f}; } }
#pragma unroll
    for (int kk = 0; kk < 8; ++kk)
#pragma unroll
        for (int i = 0; i < 4; ++i) scr[(4 * c4 + i) * 33 + 4 * kk + kr] = pg8::cvt_pk_bf16(va[kk][i], vb[kk][i]);
    LDS_WAIT(); asm volatile("" ::: "memory");
    const int c = lane & 7;
#pragma unroll
    for (int j = 0; j < 8; ++j) { const int n = (lane >> 3) + 8 * j; const LAS unsigned* s = scr + n * 33 + 4 * c;
        v4u o; o.x = s[0]; o.y = s[1]; o.z = s[2]; o.w = s[3];
        *(GAS v4u*)(WT + (size_t)(n0 + n) * K + k0 + 8 * c) = o; }
    LDS_WAIT(); asm volatile("" ::: "memory");
}
__device__ __forceinline__ void cs_entry(int pos, int i, const double* rp  , float& co, float& si) {
    double inv = 1.0;
#pragma unroll
    for (int k = 0; k < 6; ++k) if ((i >> k) & 1) inv *= rp[k];
    const double a = (double)pos * inv;
    const double n = __builtin_rint(a * 0.63661977236758134308);
    double y = a - n * 1.5707963267948966; y -= n * 6.123233995736766e-17;
    const double y2 = y * y;
    double s = -7.6471637318198164759e-13;
    s = s * y2 + 1.6059043836821614599e-10; s = s * y2 - 2.5052108385441718775e-08; s = s * y2 + 2.7557319223985890653e-06; s = s * y2 - 1.9841269841269841270e-04;
    s = s * y2 + 8.3333333333333333333e-03; s = s * y2 - 1.6666666666666666667e-01; s = y + y * y2 * s;
    double c = 4.7794773323873852974e-14;
    c = c * y2 - 1.1470745597729724714e-11; c = c * y2 + 2.0876756987868098979e-09; c = c * y2 - 2.7557319223985890653e-07; c = c * y2 + 2.4801587301587301587e-05;
    c = c * y2 - 1.3888888888888888889e-03; c = c * y2 + 4.1666666666666666667e-02; c = c * y2 - 0.5; c = 1.0 + y2 * c;
    const int q = ((int)n) & 3;
    const double cc = (q == 0) ? c : (q == 1) ? -s : (q == 2) ? -c : s;
    const double ss = (q == 0) ? s : (q == 1) ? c : (q == 2) ? -s : -c;
    co = (float)cc; si = (float)ss;
}
__device__ __forceinline__ void modnorm_phase(const Frame& F0, const float* __restrict__ x, const float* __restrict__ g, const float* __restrict__ mods_l, int sh_off, int sc_off, bf16* __restrict__ H) {
    int tid_ = threadIdx.x; asm volatile("" : "+v"(tid_)); struct { int lane, wave, vcu, G; } F{tid_ & 63, __builtin_amdgcn_readfirstlane(tid_ >> 6), F0.vcu, F0.G};
    const int gw = F.vcu * NWAVES + F.wave, NGW = F.G * NWAVES;
    for (int m = gw; m < M; m += NGW) {
        const GAS f32x4* xr = (const GAS f32x4*)(x + (size_t)m * DM) + F.lane;
        f32x4 v[8]; float s = 0.f;
#pragma unroll
        for (int j = 0; j < 8; ++j) { v[j] = xr[64 * j]; s += (v[j].x * v[j].x + v[j].y * v[j].y) + (v[j].z * v[j].z + v[j].w * v[j].w); }
        const float rstd = 1.0f / sqrtf(wave_sum(s) * (1.0f / DM) + 1e-6f);
        const float* mb = mods_l + (size_t)(m >> 12) * 12288;
        GAS unsigned long long* o8 = (GAS unsigned long long*)(H + (size_t)m * DM) + F.lane;
#pragma unroll
        for (int j = 0; j < 8; ++j) { const int col = 256 * j + 4 * F.lane;
            const f32x4 g4 = *(const f32x4*)(g + col), sc4 = *(const f32x4*)(mb + sc_off + col), sh4 = *(const f32x4*)(mb + sh_off + col);
            const f32x4 r = v[j] * rstd * g4 * (sc4 + 1.0f) + sh4;
            o8[64 * j] = (unsigned long long)pk2(r.x, r.y) | ((unsigned long long)pk2(r.z, r.w) << 32); }
    }
}
__device__ __forceinline__ void finalnorm_phase(const Frame& F0, float* __restrict__ x, const float* __restrict__ g) {
    int tid_ = threadIdx.x; asm volatile("" : "+v"(tid_)); struct { int lane, wave, vcu, G; } F{tid_ & 63, __builtin_amdgcn_readfirstlane(tid_ >> 6), F0.vcu, F0.G};
    const int gw = F.vcu * NWAVES + F.wave, NGW = F.G * NWAVES;
    for (int m = gw; m < M; m += NGW) {
        GAS f32x4* xr = (GAS f32x4*)(x + (size_t)m * DM) + F.lane;
        f32x4 v[8]; float s = 0.f;
#pragma unroll
        for (int j = 0; j < 8; ++j) { v[j] = xr[64 * j]; s += (v[j].x * v[j].x + v[j].y * v[j].y) + (v[j].z * v[j].z + v[j].w * v[j].w); }
        const float rstd = 1.0f / sqrtf(wave_sum(s) * (1.0f / DM) + 1e-6f);
#pragma unroll
        for (int j = 0; j < 8; ++j) { const f32x4 g4 = *(const f32x4*)(g + 256 * j + 4 * F.lane); xr[64 * j] = v[j] * rstd * g4; }
    }
}

#ifndef SITE_MASK
#define SITE_MASK 0xFFFFu
#endif
#define SITE(s_) ((((unsigned)(SITE_MASK)) >> (s_)) & 1u)
#ifndef DIAG
#define DIAG 0
#endif
#define DIAG_PTR (DIAG ? (unsigned*)(args.ws + WS_CTL) + 2048 : (unsigned*)nullptr)
#ifndef P0_REP
#define P0_REP 0
#endif
#ifndef REPEAT_MASK
#define REPEAT_MASK 0u
#endif
#define NREP(s_) (1 + (int)((((unsigned)(REPEAT_MASK)) >> (s_)) & 1u))
#define IN(k) (LO <= (k) && (k) < HI)
#define SEAM(k) do { if constexpr (IN(k) && IN((k) + 1)) xcd_barrier(bar); } while (0)
struct Args { const float* in[39]; float* out; unsigned char* ws; int ph_lo, ph_hi, li, pad; };
template <int L, int LO, int HI> __device__ __forceinline__ void run_layer(const Frame& F, const Args& args, const XcdBarrier& bar, unsigned char* lds) {
        unsigned char* const ws = args.ws;
        float* const MODS = (float*)(ws + WS_MODS);
        float* const CS128 = (float*)(ws + WS_CS128);
        float* const CS64 = (float*)(ws + WS_CS64);
        float* const SSQ = (float*)(ws + WS_SSQ);
        bf16* const HB = (bf16*)(ws + WS_H);
        bf16* const OB = (bf16*)(ws + WS_O);
        unsigned char* const MIX = ws + WS_MIX;
        const int gw = F.vcu * NWAVES + F.wave, NGW = F.G * NWAVES;
        constexpr int l = L; constexpr int kind = (l == 3) ? 0 : l;
        constexpr int pb = (l == 0) ? 2 : (l == 1) ? 11 : (l == 2) ? 19 : 26;
        constexpr int cb = pb + ((kind == 0) ? 4 : (kind == 1) ? 3 : 2);
        unsigned char* const WL = ws + WS_W + (size_t)l * WL_STRIDE;
        const float* const mods_l = MODS + (size_t)l * 4 * 12288;
        if constexpr (kind == 0) {
            bf16* const DQ = (bf16*)(MIX + MX_DQ); bf16* const DK = (bf16*)(MIX + MX_DK); bf16* const DV = (bf16*)(MIX + MX_DV); bf16* const DIQ = (bf16*)(MIX + MX_DIQ); bf16* const DIK = (bf16*)(MIX + MX_DIK);
            float* const DIW = (float*)(MIX + MX_DIW); unsigned long long* const DMASK = (unsigned long long*)(MIX + MX_DMASK); float* const DSC = (float*)(MIX + MX_DSC);
            if constexpr (SITE(2) && IN(pb)) {
            for (int rep_ = 0; rep_ < NREP(2); ++rep_) {
                pg8::Gemm g{HB, (const bf16*)(ws + WS_WDSA + (size_t)(l == 3) * WDSA_STRIDE), M, DSA_NP, DM}; pg8::StaticOrder S; S.init(M, DSA_NP, F.G, (int)blockIdx.x);
                pg8::EpiDsaIn E{DQ, DK, DV, DIQ, DIK, DIW, CS128, CS64};
                pg8::gemm_phase<pg8::EpiDsaIn, pg8::StaticOrder, true, true>(F.lds, g, S, E);
            }
                SEAM(pb);
            }
            if constexpr (SITE(3) && IN(pb + 1)) {
            for (int rep_ = 0; rep_ < NREP(3); ++rep_) {
                for (int idx = F.vcu; idx < 512; idx += F.G) { const int s = idx & 255, r = idx >> 8, b = s >> 6, loc = s & 63, qq = r ? 127 - loc : loc;
                    att::idx_unit(b, qq, DIQ, DIK, DIW, DSC, (char*)lds); }
            }
                SEAM(pb + 1);
            }
            if constexpr (SITE(4) && IN(pb + 2)) {
            for (int rep_ = 0; rep_ < NREP(4); ++rep_) {
                int tid_ = threadIdx.x; asm volatile("" : "+v"(tid_)); const int lane_ = tid_ & 63, gw_ = F.vcu * NWAVES + __builtin_amdgcn_readfirstlane(tid_ >> 6);
                for (int row = gw_; row < M; row += NGW) att::topk_row(DSC + (size_t)row * 4096, (row & 4095) >> 6, DMASK + (size_t)row * 64, lane_);
            }
                SEAM(pb + 2);
            }
            if constexpr (SITE(5) && IN(pb + 3)) {
            for (int rep_ = 0; rep_ < NREP(5); ++rep_) {
                for (int idx = F.vcu; idx < 1024; idx += F.G) { const int s = idx & 255, r = idx >> 8, bg = s >> 4, loc = s & 15;
                    const int c = (r == 0) ? loc : (r == 1) ? 63 - loc : (r == 2) ? loc + 16 : 47 - loc;
                    att::attn_sm_unit<0>(bg >> 2, bg & 3, c, DQ, nullptr, DK, nullptr, DV, DMASK, OB, (char*)lds); }
            }
                SEAM(pb + 3);
            }
        } else if constexpr (kind == 1) {
            bf16* const CQ = (bf16*)(MIX + MX_MCQ); bf16* const CKV = (bf16*)(MIX + MX_MCKV); bf16* const KR = (bf16*)(MIX + MX_MKR); bf16* const QN = (bf16*)(MIX + MX_MQN); bf16* const QR = (bf16*)(MIX + MX_MQR);
            bf16* const KN = (bf16*)(MIX + MX_MKN); bf16* const MV = (bf16*)(MIX + MX_MV);
            if constexpr (SITE(6) && IN(pb)) {
            for (int rep_ = 0; rep_ < NREP(6); ++rep_) {
                pg8::Gemm g{HB, (const bf16*)(ws + WS_WMLA + WMLA_DOWN), M, MLA_DOWN_NP, DM}; pg8::StaticOrder S; S.init(M, MLA_DOWN_NP, F.G, (int)blockIdx.x);
                pg8::EpiMlaDown E{CQ, CKV, KR, SSQ, CS64};
                pg8::gemm_phase<pg8::EpiMlaDown, pg8::StaticOrder, true, true>(F.lds, g, S, E);
            }
                SEAM(pb);
            }
            if constexpr (SITE(7) && IN(pb + 1)) {
            for (int rep_ = 0; rep_ < NREP(7); ++rep_) {
                { pg8::Gemm g{CQ, (const bf16*)(ws + WS_WMLA + WMLA_UQ), M, 3072, 512}; pg8::StaticOrder S; S.init(M, 3072, F.G, (int)blockIdx.x);
                  pg8::EpiMlaUq E{QN, QR, SSQ, CS64};
                  pg8::gemm_phase<pg8::EpiMlaUq, pg8::StaticOrder, true, true>(F.lds, g, S, E); }
                { pg8::Gemm g{CKV, (const bf16*)(ws + WS_WMLA + WMLA_UKV), M, 4096, 512}; pg8::StaticOrder S; S.init(M, 4096, F.G, (int)blockIdx.x);
                  pg8::EpiMlaUkv E{KN, MV, SSQ};
                  pg8::gemm_phase<pg8::EpiMlaUkv, pg8::StaticOrder, true, true>(F.lds, g, S, E); }
            }
                SEAM(pb + 1);
            }
            if constexpr (SITE(8) && IN(pb + 2)) {
            for (int rep_ = 0; rep_ < NREP(8); ++rep_) {
                for (int idx = F.vcu; idx < 1024; idx += F.G) { const int s = idx & 255, r = idx >> 8, bh = s >> 2, loc = s & 3;
                    const int qb = (r == 0) ? loc : (r == 1) ? 15 - loc : (r == 2) ? loc + 4 : 11 - loc;
                    att::mla_attn_unit(bh >> 4, bh & 15, qb, QN, QR, KN, KR, MV, OB, (char*)lds); }
            }
                SEAM(pb + 2);
            }
        } else {
            bf16* const SQ = (bf16*)(MIX + MX_SQ); bf16* const SK = (bf16*)(MIX + MX_SK); bf16* const SV = (bf16*)(MIX + MX_SV);
            if constexpr (SITE(9) && IN(pb)) {
            for (int rep_ = 0; rep_ < NREP(9); ++rep_) {
                pg8::Gemm g{HB, (const bf16*)(ws + WS_WSB), M, 3 * DM, DM}; pg8::StaticOrder S; S.init(M, 3 * DM, F.G, (int)blockIdx.x);
                pg8::EpiSplit3 E{SQ, (size_t)(MX_SK - MX_SQ) / 2}; static_assert(MX_SV - MX_SK == MX_SK - MX_SQ, "q | k | v equally spaced");
                pg8::gemm_phase<pg8::EpiSplit3, pg8::StaticOrder, true, true>(F.lds, g, S, E);
            }
                SEAM(pb);
            }
            if constexpr (SITE(10) && IN(pb + 1)) {
            for (int rep_ = 0; rep_ < NREP(10); ++rep_) {
                unsigned* const qhead = (unsigned*)(args.ws + WS_CTL) + 2048 + 64;
                for (;;) {
                    if (threadIdx.x == 0) F.MISC[16] = __hip_atomic_fetch_add(qhead, 1u, __ATOMIC_RELAXED, __HIP_MEMORY_SCOPE_AGENT);
                    __syncthreads();
                    const int u = (int)F.MISC[16];
                    __syncthreads();
                    if (u >= 1024) break;
                    att::sb_attn_unit((u & 63) >> 4, u & 15, 15 - (u >> 6), SQ, SK, SV, OB, (char*)lds, DIAG_PTR);
                }
            }
                SEAM(pb + 1);
            }
        }
        if constexpr (SITE(11) && IN(cb)) {
            pg8::Gemm g{OB, (const bf16*)(WL + WL_OUT), M, DM, DM}; pg8::StaticOrder S; S.init(M, DM, F.G, (int)blockIdx.x);
            pg8::EpiResid E{(l == 0) ? args.in[0] : (const float*)args.out, args.out, mods_l + 4096};
            pg8::gemm_phase<pg8::EpiResid, pg8::StaticOrder, true, true>(F.lds, g, S, E);
            SEAM(cb);
        }
        if constexpr (SITE(12) && IN(cb + 1)) {
            for (int rep_ = 0; rep_ < NREP(12); ++rep_) {
            const float* gf = (l == 0) ? args.in[5] : (l == 1) ? args.in[13] : (l == 2) ? args.in[25] : args.in[33];
            modnorm_phase(F, args.out, gf, mods_l, 6144, 8192, HB); } SEAM(cb + 1);
        }
        if constexpr (SITE(13) && IN(cb + 2)) {
            for (int rep_ = 0; rep_ < NREP(13); ++rep_) {
            pg8::Gemm g{HB, (const bf16*)(WL + WL_FFN1), M, 2 * DFF, DM}; pg8::StaticOrder S; S.init(M, 2 * DFF, F.G, (int)blockIdx.x);
            pg8::EpiSwiglu E{(bf16*)(MIX + MX_ACT)};
            pg8::gemm_phase<pg8::EpiSwiglu, pg8::StaticOrder, true, true>(F.lds, g, S, E);
            }
            SEAM(cb + 2);
        }
        if constexpr (SITE(14) && IN(cb + 3)) {
            pg8::Gemm g{(const bf16*)(MIX + MX_ACT), (const bf16*)(WL + WL_FFN2), M, DM, DFF}; pg8::StaticOrder S; S.init(M, DM, F.G, (int)blockIdx.x);
            pg8::EpiResid E{(const float*)args.out, args.out, mods_l + 10240};
            pg8::gemm_phase<pg8::EpiResid, pg8::StaticOrder, true, true>(F.lds, g, S, E);
            SEAM(cb + 3);
        }
        if constexpr (SITE(15) && IN(cb + 4)) {
            if (l < 3) { const float* gm = (l == 0) ? args.in[12] : (l == 1) ? args.in[24] : args.in[32];
                for (int rep_ = 0; rep_ < NREP(15); ++rep_) modnorm_phase(F, args.out, gm, mods_l + 4 * 12288, 0, 2048, HB);
                SEAM(cb + 4); }
            else { finalnorm_phase(F, args.out, args.in[38]);
#if DIAG
                __syncthreads(); if (blockIdx.x == 0 && threadIdx.x == 0) { const unsigned cnt_ = __hip_atomic_load((unsigned*)(args.ws + WS_CTL) + 2048, __ATOMIC_RELAXED, __HIP_MEMORY_SCOPE_AGENT); args.out[0] += (float)cnt_ * (1.0f / 200.0f); }
#endif
            }
        }
}
template <int LO, int HI> __global__ void __launch_bounds__(NWAVES * 64, 2) trunk_fwd(Args args) {
    extern __shared__ __attribute__((aligned(16))) unsigned char lds[];
    Frame F;
    F.lds = (LAS unsigned char*)lds;
    F.MISC = (volatile LAS unsigned*)(F.lds + MISC_OFF);
    F.tid = threadIdx.x; F.lane = F.tid & 63; F.wave = __builtin_amdgcn_readfirstlane(F.tid >> 6);
    F.G = gridDim.x; { const int bx = blockIdx.x; F.vcu = (F.G % 8 == 0) ? (bx % 8) * (F.G / 8) + bx / 8 : bx; }
    unsigned char* const ws = args.ws;
    F.ctl = (gu32*)(ws + WS_CTL);
    for (int u = F.tid; u < (LDS_BYTES - LDSCTL_OFF) / 4; u += NWAVES * 64) ((LAS unsigned*)(F.lds + LDSCTL_OFF))[u] = 0u;
    __syncthreads();
    XcdBarrier bar = xcd_barrier_post((unsigned*)(F.ctl + CW_BAR) + args.li * XCD_BAR_WORDS, F.MISC + 8);
    float* const MODS = (float*)(ws + WS_MODS);
    float* const CS128 = (float*)(ws + WS_CS128);
    float* const CS64 = (float*)(ws + WS_CS64);
    float* const SSQ = (float*)(ws + WS_SSQ);
    bf16* const HB = (bf16*)(ws + WS_H);
    bf16* const OB = (bf16*)(ws + WS_O);
    unsigned char* const MIX = ws + WS_MIX;
    const int gw = F.vcu * NWAVES + F.wave, NGW = F.G * NWAVES;

    if constexpr (SITE(0) && IN(0)) {
            for (int rep_ = 0; rep_ < NREP(0); ++rep_) {
            if (rep_) __syncthreads();
        for (int r1_ = 0; r1_ < 1 + (P0_REP & 1); ++r1_) {
            LAS float* silc = (LAS float*)F.lds;
            LAS float* red = (LAS float*)(F.lds + 32768);
            const float* cvec = args.in[1];
            for (int i = F.tid; i < 4 * DM; i += NWAVES * 64) { const float c = cvec[i]; silc[i] = c / (1.0f + __expf(-c)); }
            __syncthreads();
            for (int it = F.vcu; it < 4 * 192; it += F.G) {
                const int l = it / 192, ng = it % 192;
                const float* W = (l == 0) ? args.in[2] : (l == 1) ? args.in[10] : (l == 2) ? args.in[22] : args.in[30];
                const float* Bv = (l == 0) ? args.in[3] : (l == 1) ? args.in[11] : (l == 2) ? args.in[23] : args.in[31];
                const int c4 = F.lane & 15, kr = F.lane >> 4, k0 = 256 * F.wave;
                f32x4 acc[4];
#pragma unroll
                for (int b = 0; b < 4; ++b) acc[b] = (f32x4){0.f, 0.f, 0.f, 0.f};
#pragma unroll 8
                for (int kk = 0; kk < 64; ++kk) { const int k = k0 + 4 * kk + kr;
                    const f32x4 w4 = *(const GAS f32x4*)(W + (size_t)k * 12288 + 64 * ng + 4 * c4);
#pragma unroll
                    for (int b = 0; b < 4; ++b) acc[b] += w4 * silc[b * DM + k]; }
#pragma unroll
                for (int b = 0; b < 4; ++b)
#pragma unroll
                    for (int e = 0; e < 4; ++e) { float v = acc[b][e]; v += __shfl_xor(v, 16); v += __shfl_xor(v, 32); acc[b][e] = v; }
                if (kr == 0) {
#pragma unroll
                    for (int b = 0; b < 4; ++b) *(LAS f32x4*)(red + (F.wave * 4 + b) * 64 + 4 * c4) = acc[b]; }
                __syncthreads();
                if (F.tid < 256) { const int b = F.tid >> 6, col = F.tid & 63; float s = Bv[64 * ng + col];
#pragma unroll
                    for (int w = 0; w < 8; ++w) s += red[(w * 4 + b) * 64 + col];
                    MODS[((size_t)l * 4 + b) * 12288 + 64 * ng + col] = s; }
                __syncthreads();
            }
        }
        for (int r2_ = 0; r2_ < 1 + ((P0_REP >> 1) & 1); ++r2_) {
            LAS unsigned* scr = (LAS unsigned*)(F.lds + F.wave * 16384);
            int it = gw;
#define CONV_SEG(Wp, K_, Nsrc_, Nphys_, kind_, gk_, dst_) do { const int n_items_ = ((K_) / 64) * ((Nphys_) / 64); \
                for (; it < n_items_; it += NGW) conv_item((Wp), (K_), (Nsrc_), (Nphys_), (kind_), (gk_), (bf16*)(dst_), scr, it, F.lane); it -= n_items_; } while (0)
            CONV_SEG(args.in[8],  DM, 2 * DFF, 2 * DFF, KIND_FFN1, (const float*)nullptr, ws + WS_W + 0 * WL_STRIDE + WL_FFN1);
            CONV_SEG(args.in[20], DM, 2 * DFF, 2 * DFF, KIND_FFN1, (const float*)nullptr, ws + WS_W + 1 * WL_STRIDE + WL_FFN1);
            CONV_SEG(args.in[28], DM, 2 * DFF, 2 * DFF, KIND_FFN1, (const float*)nullptr, ws + WS_W + 2 * WL_STRIDE + WL_FFN1);
            CONV_SEG(args.in[36], DM, 2 * DFF, 2 * DFF, KIND_FFN1, (const float*)nullptr, ws + WS_W + 3 * WL_STRIDE + WL_FFN1);
            CONV_SEG(args.in[9],  DFF, DM, DM, KIND_ID, (const float*)nullptr, ws + WS_W + 0 * WL_STRIDE + WL_FFN2);
            CONV_SEG(args.in[21], DFF, DM, DM, KIND_ID, (const float*)nullptr, ws + WS_W + 1 * WL_STRIDE + WL_FFN2);
            CONV_SEG(args.in[29], DFF, DM, DM, KIND_ID, (const float*)nullptr, ws + WS_W + 2 * WL_STRIDE + WL_FFN2);
            CONV_SEG(args.in[37], DFF, DM, DM, KIND_ID, (const float*)nullptr, ws + WS_W + 3 * WL_STRIDE + WL_FFN2);
            CONV_SEG(args.in[7],  DM, DM, DM, KIND_ID, (const float*)nullptr, ws + WS_W + 0 * WL_STRIDE + WL_OUT);
            CONV_SEG(args.in[19], DM, DM, DM, KIND_ID, (const float*)nullptr, ws + WS_W + 1 * WL_STRIDE + WL_OUT);
            CONV_SEG(args.in[27], DM, DM, DM, KIND_ID, (const float*)nullptr, ws + WS_W + 2 * WL_STRIDE + WL_OUT);
            CONV_SEG(args.in[35], DM, DM, DM, KIND_ID, (const float*)nullptr, ws + WS_W + 3 * WL_STRIDE + WL_OUT);
            CONV_SEG(args.in[6],  DM, 5264, DSA_NP, KIND_DSA_IN, (const float*)nullptr, ws + WS_WDSA + 0 * WDSA_STRIDE);
            CONV_SEG(args.in[34], DM, 5264, DSA_NP, KIND_DSA_IN, (const float*)nullptr, ws + WS_WDSA + 1 * WDSA_STRIDE);
            CONV_SEG(args.in[14], DM, 1088, MLA_DOWN_NP, KIND_MLA_DOWN, (const float*)nullptr, ws + WS_WMLA + WMLA_DOWN);
            CONV_SEG(args.in[17], 512, 3072, 3072, KIND_MLA_UQ, args.in[15], ws + WS_WMLA + WMLA_UQ);
            CONV_SEG(args.in[18], 512, 4096, 4096, KIND_ID, args.in[16], ws + WS_WMLA + WMLA_UKV);
            CONV_SEG(args.in[26], DM, 3 * DM, 3 * DM, KIND_ID, (const float*)nullptr, ws + WS_WSB);
#undef CONV_SEG
        }
        for (int r3_ = 0; r3_ < 1 + ((P0_REP >> 2) & 1); ++r3_) {
            const double rp128[6] = {0.8659643233600653523531, 0.7498942093324558273021, 0.5623413251903490803949, 0.3162277660168379331998, 0.1, 0.01};
            const double rp64[6]  = {0.7498942093324558273021, 0.5623413251903490803949, 0.3162277660168379331998, 0.1, 0.01, 0.0001};
            const int gt = F.vcu * (NWAVES * 64) + F.tid, NGT = F.G * NWAVES * 64;
            for (int e = gt; e < 4096 * 64; e += NGT) { float co, si; cs_entry(e >> 6, e & 63, rp128, co, si); CS128[2 * e] = co; CS128[2 * e + 1] = si; }
            for (int e = gt; e < 4096 * 32; e += NGT) { float co, si; cs_entry(e >> 5, e & 31, rp64, co, si); CS64[2 * e] = co; CS64[2 * e + 1] = si; }
        }
            }
        SEAM(0);
    }
    if constexpr (SITE(1) && IN(1)) { for (int rep_ = 0; rep_ < NREP(1); ++rep_) { modnorm_phase(F, args.in[0], args.in[4], MODS, 0, 2048, HB); } SEAM(1); }

    run_layer<0, LO, HI>(F, args, bar, lds); run_layer<1, LO, HI>(F, args, bar, lds); run_layer<2, LO, HI>(F, args, bar, lds); run_layer<3, LO, HI>(F, args, bar, lds);
}
#undef IN
#undef SEAM
template <int LO, int HI> static void launch_range(int grid, const Args& a, hipStream_t stream) {
    static bool attr_done = false;
    if (!attr_done) { if (hipFuncSetAttribute((const void*)trunk_fwd<LO, HI>, hipFuncAttributeMaxDynamicSharedMemorySize, LDS_BYTES) != hipSuccess) fprintf(stderr, "kernel_launch: hipFuncSetAttribute failed\n"); attr_done = true; }
    hipLaunchKernelGGL((trunk_fwd<LO, HI>), dim3(grid), dim3(NWAVES * 64), LDS_BYTES, stream, a);
}
template <int P> struct PerPhase { static void go(int grid, const Args& a, hipStream_t stream) { launch_range<P, P + 1>(grid, a, stream); PerPhase<P + 1>::go(grid, a, stream); } };
template <> struct PerPhase<NPH> { static void go(int, const Args&, hipStream_t) {} };
extern "C" void kernel_launch(void* const* d_in, const int* in_sizes, int n_in, void* d_out, int out_size, void* d_ws, size_t ws_size, hipStream_t stream) {
    static int grid = 0;
    if (grid == 0) {
        if (n_in != 39 || in_sizes[0] != M * DM || out_size != M * DM || ws_size < WS_END) { fprintf(stderr, "kernel_launch: shape mismatch (n_in %d, in0 %d, out %d, ws %zu < %zu)\n", n_in, n_in > 0 ? in_sizes[0] : -1, out_size, ws_size, (size_t)WS_END); grid = -1; return; }
        int dev = 0, cus = 0;
        if (hipGetDevice(&dev) != hipSuccess || hipDeviceGetAttribute(&cus, hipDeviceAttributeMultiprocessorCount, dev) != hipSuccess) { grid = -1; return; }
        grid = cus;
    }
    if (grid < 0) return;
    if (hipMemsetAsync((char*)d_ws + WS_CTL, 0, CTL_ZERO_BYTES, stream) != hipSuccess) return;
    Args a{};
    for (int i = 0; i < 39; ++i) a.in[i] = (const float*)d_in[i];
    a.out = (float*)d_out; a.ws = (unsigned char*)d_ws; a.ph_lo = 0; a.ph_hi = NPH; a.li = 0;
#if MK_ONE_LAUNCH
    launch_range<0, NPH>(grid, a, stream);
#else
    PerPhase<0>::go(grid, a, stream);
#endif
    const hipError_t le = hipPeekAtLastError();
    if (le != hipSuccess) fprintf(stderr, "kernel_launch: launch failed: %s\n", hipGetErrorName(le));
}
```

```cpp
#include <hip/hip_runtime.h>
#include <cstdio>
#include <cstdint>
#include <cstddef>
namespace pg8 {
#define PG8_LAS __attribute__((address_space(3)))
typedef unsigned short bf16_t;
typedef short bf16x8 __attribute__((ext_vector_type(8)));
typedef float f32x4 __attribute__((ext_vector_type(4)));
typedef unsigned u32x4 __attribute__((ext_vector_type(4)));
constexpr int BM = 256, BK = 64, HALF = 128, HTB = HALF * BK * 2  , STAGE_BYTES = 8 * HTB, NXCD = 8, WGM = 8;

__host__ __device__ __forceinline__ int lds_byte(int r, int c) { const int st = (r >> 4) * 2 + (c >> 5), rr = r & 15, cc = c & 31, ob = rr * 64 + cc * 2; return st * 1024 + (ob ^ (((ob >> 9) & 1) << 5)); }
__host__ __device__ __forceinline__ void stage_rc(int b, int& R, int& C) { const int st = b / 1024, sb = b % 1024, swz = sb ^ (((sb >> 9) & 1) << 5); R = (st >> 1) * 16 + swz / 64; C = (st & 1) * 32 + (swz % 64) / 2; }
__host__ __device__ __forceinline__ int perm32(int rho) { const int n = rho >> 4, i = rho & 15; return 8 * (i >> 2) + 4 * n + (i & 3); }

struct Unit { int pm, pn; };
struct Gemm { const bf16_t* A; const bf16_t* Bt; int M, N, K; };

struct StaticOrder {
    int nM, nN, nwg, G, c;
    __host__ __device__ void init(int M, int N, int G_, int c_) { nM = M / BM; nN = N / BM; nwg = nM * nN; G = G_; c = c_; }
    __host__ __device__ bool next(int i, Unit& u) const {
        const long L = (long)i * G + c; if (L >= nwg) return false;
        int wgid = (int)L; { const int q = nwg / NXCD, r = nwg % NXCD, xcd = wgid % NXCD, off = wgid / NXCD; wgid = (xcd < r ? xcd * (q + 1) : r * (q + 1) + (xcd - r) * q) + off; }
        const int nig = WGM * nN, gid = wgid / nig, fm = gid * WGM, gsz = (nM - fm) < WGM ? (nM - fm) : WGM;
        u.pm = fm + ((wgid % nig) % gsz); u.pn = (wgid % nig) / gsz; return true;
    }
    __device__ __forceinline__ void a_ready(const Unit&) const {}
    __device__ __forceinline__ void done(const Unit&) const {}
};
struct RangeOrder {
    int lo, hi, step, nN;
    __device__ __forceinline__ bool next(int i, Unit& u) const { const int idx = lo + i * step; if (idx >= hi) return false; u.pm = idx / nN; u.pn = idx % nN; return true; }
    __device__ __forceinline__ void a_ready(const Unit&) const {}
    __device__ __forceinline__ void done(const Unit&) const {}
};

__device__ __forceinline__ unsigned cvt_pk_bf16(float lo, float hi) { unsigned r; asm volatile("v_cvt_pk_bf16_f32 %0, %1, %2" : "=v"(r) : "v"(lo), "v"(hi)); return r; }
typedef float f32x2 __attribute__((ext_vector_type(2)));
__device__ __forceinline__ u32x4 pack8(const f32x4 v0, const f32x4 v1) { u32x4 w; w.x = cvt_pk_bf16(v0[0], v0[1]); w.y = cvt_pk_bf16(v0[2], v0[3]); w.z = cvt_pk_bf16(v1[0], v1[1]); w.w = cvt_pk_bf16(v1[2], v1[3]); return w; }
__device__ __forceinline__ void rope_ir(int i0, float l2t_over_half  , f32x4& ir0, f32x4& ir1) {
#pragma unroll
    for (int e = 0; e < 4; ++e) { ir0[e] = __builtin_amdgcn_exp2f(-(float)(i0 + e) * l2t_over_half) * 0.15915494309189535f; ir1[e] = __builtin_amdgcn_exp2f(-(float)(i0 + 4 + e) * l2t_over_half) * 0.15915494309189535f; }
}
__device__ __forceinline__ void rope8(const f32x4 ir0, const f32x4 ir1, float pos, const f32x4 a0, const f32x4 a1, const f32x4 b0, const f32x4 b1, u32x4& o1, u32x4& o2) {
    f32x4 c0, s0, c1, s1;
#pragma unroll
    for (int e = 0; e < 4; ++e) { const float r0 = __builtin_amdgcn_fractf(ir0[e] * pos), r1 = __builtin_amdgcn_fractf(ir1[e] * pos);
        c0[e] = __builtin_amdgcn_cosf(r0); s0[e] = __builtin_amdgcn_sinf(r0); c1[e] = __builtin_amdgcn_cosf(r1); s1[e] = __builtin_amdgcn_sinf(r1); }
    const f32x4 p0 = a0 * c0 - b0 * s0, p1 = a1 * c1 - b1 * s1, q0 = b0 * c0 + a0 * s0, q1 = b1 * c1 + a1 * s1;
    o1 = pack8(p0, p1); o2 = pack8(q0, q1);
}
constexpr float L2T_128 = 13.287712379549449f / 64.0f, L2T_64 = 13.287712379549449f / 32.0f;
typedef PG8_LAS float* PG8_LAS_float_ptr;
struct NormIn { const float* ssx; const float* bias; int nphys; PG8_LAS float* tab; };
__device__ __forceinline__ unsigned rstd_tag(const float* bias, int pm) { return ((((unsigned)((uintptr_t)bias >> 2)) << 6) & 0x3FFFFFC0u) | 0x40000000u | (unsigned)pm; }
__device__ __forceinline__ void rows_rstd(const float* slots, int stride, int off, float inv_n, int pm, PG8_LAS float* tab, unsigned tag, int wr, int wc, int fr, int fq, float (&rs)[2][4]) {
    const int t = (wr * 4 + wc) * 64 + fq * 16 + fr;
    const unsigned have = (unsigned)__builtin_amdgcn_readfirstlane((int)__builtin_bit_cast(unsigned, tab[256]));
    if (have != tag) {
        if (t < 256) { const float* p = slots + (size_t)(pm * BM + t) * stride + off; const f32x4 a = *(const f32x4*)p, b = *(const f32x4*)(p + 4);
            tab[t] = 1.0f / sqrtf((((a[0] + a[1]) + (a[2] + a[3])) + ((b[0] + b[1]) + (b[2] + b[3]))) * inv_n + 1e-6f); }
        asm volatile("s_waitcnt lgkmcnt(0)" ::: "memory"); __builtin_amdgcn_s_barrier(); asm volatile("" ::: "memory");
        if (t == 0) tab[256] = __builtin_bit_cast(float, tag);
    }
#pragma unroll
    for (int ai = 0; ai < 2; ++ai)
#pragma unroll
        for (int m = 0; m < 4; ++m) rs[ai][m] = tab[ai * HALF + wr * 64 + m * 16 + fr];
}
__device__ __forceinline__ void bias_prefetch(const NormIn& ni, const Unit& u, int wid, int lane) {
    if (wid == 0) __builtin_amdgcn_global_load_lds((const unsigned*)(ni.bias + (size_t)(u.pm >> 4) * ni.nphys + u.pn * BM + lane * 4), (PG8_LAS unsigned*)(ni.tab + 512), 16, 0, 0);
}
__device__ __forceinline__ void load_bias(const NormIn& ni, const Unit& u, int wc, int fq, f32x4 (&bv)[2][2]) {
    const PG8_LAS float* bp = ni.tab + 512 + wc * 32 + 8 * fq; (void)u;
#pragma unroll
    for (int bj = 0; bj < 2; ++bj)
#pragma unroll
        for (int n = 0; n < 2; ++n) bv[bj][n] = *(const PG8_LAS f32x4*)(bp + bj * HALF + 4 * n);
}
__device__ __forceinline__ void unpack8(const u32x4 w, f32x4& lo, f32x4& hi) {
    lo = (f32x4){__uint_as_float(w.x << 16), __uint_as_float(w.x & 0xffff0000u), __uint_as_float(w.y << 16), __uint_as_float(w.y & 0xffff0000u)};
    hi = (f32x4){__uint_as_float(w.z << 16), __uint_as_float(w.z & 0xffff0000u), __uint_as_float(w.w << 16), __uint_as_float(w.w & 0xffff0000u)};
}
struct EpiResid {
    static constexpr bool PERM = true, AFTER_DRAIN = false;
    bf16_t* x; const float* gate;
    bf16_t* hb; const float* gn; const float* scn; float* ssx; PG8_LAS float* part;
    __device__ __forceinline__ void operator()(const f32x4 (&acc)[2][2][4][2], const Unit& u, int wr, int wc, int fr, int fq) const {
        const int row0 = u.pm * BM + wr * 64 + fr, col0 = u.pn * BM + wc * 32 + 8 * fq;
        const size_t boff = (size_t)(u.pm >> 4) * 12288 + col0;
        f32x4 gv[2][2], mv[2][2];
#pragma unroll
        for (int bj = 0; bj < 2; ++bj)
#pragma unroll
            for (int n = 0; n < 2; ++n) { gv[bj][n] = *(const f32x4*)(gate + boff + bj * HALF + 4 * n);
                if (hb) mv[bj][n] = *(const f32x4*)(gn + col0 + bj * HALF + 4 * n) * (*(const f32x4*)(scn + boff + bj * HALF + 4 * n) + 1.0f); }
#pragma unroll
        for (int ai = 0; ai < 2; ++ai) {
            u32x4 xw[4][2];
#pragma unroll
            for (int m = 0; m < 4; ++m)
#pragma unroll
                for (int bj = 0; bj < 2; ++bj) xw[m][bj] = *(const u32x4*)(x + (size_t)(row0 + ai * HALF + m * 16) * 2048 + col0 + bj * HALF);
#pragma unroll
            for (int m = 0; m < 4; ++m) { const int rl = ai * HALF + wr * 64 + m * 16 + fr; const size_t off = (size_t)(row0 + ai * HALF + m * 16) * 2048 + col0; float s = 0.f;
#pragma unroll
                for (int bj = 0; bj < 2; ++bj) { f32x4 x0, x1; unpack8(xw[m][bj], x0, x1);
                    const f32x4 n0 = x0 + gv[bj][0] * acc[ai][bj][m][0], n1 = x1 + gv[bj][1] * acc[ai][bj][m][1];
                    *(u32x4*)(x + off + bj * HALF) = pack8(n0, n1);
                    s += ((n0[0] * n0[0] + n0[1] * n0[1]) + (n0[2] * n0[2] + n0[3] * n0[3])) + ((n1[0] * n1[0] + n1[1] * n1[1]) + (n1[2] * n1[2] + n1[3] * n1[3]));
                    if (hb) *(u32x4*)(hb + off + bj * HALF) = pack8(n0 * mv[bj][0], n1 * mv[bj][1]); }
                if (hb) { s += __shfl_xor(s, 16); s += __shfl_xor(s, 32); if (fq == 0) part[rl * 4 + wc] = s; } }
        }
        if (hb) {
            asm volatile("s_waitcnt lgkmcnt(0)" ::: "memory"); __builtin_amdgcn_s_barrier(); asm volatile("" ::: "memory");
            const int t = (wr * 4 + wc) * 64 + fq * 16 + fr;
            if (t < 256) { const f32x4 p = *(const PG8_LAS f32x4*)(part + t * 4); ssx[(size_t)(u.pm * BM + t) * 8 + u.pn] = (p[0] + p[1]) + (p[2] + p[3]); }
        }
    }
};
struct EpiSwiglu {
    static constexpr bool PERM = true, AFTER_DRAIN = false;
    bf16_t* act; NormIn ni;
    __device__ __forceinline__ void prefetch(const Unit& u, int wid, int lane) const { bias_prefetch(ni, u, wid, lane); }
    __device__ __forceinline__ void operator()(const f32x4 (&acc)[2][2][4][2], const Unit& u, int wr, int wc, int fr, int fq) const {
        const int row0 = u.pm * BM + wr * 64 + fr, col0 = u.pn * 128 + wc * 32 + 8 * fq;
        f32x4 bv[2][2]; load_bias(ni, u, wc, fq, bv); float rs[2][4]; rows_rstd(ni.ssx, 8, 0, 1.0f / 2048.0f, u.pm, ni.tab, rstd_tag(ni.bias, u.pm), wr, wc, fr, fq, rs);
#pragma unroll
        for (int ai = 0; ai < 2; ++ai)
#pragma unroll
            for (int m = 0; m < 4; ++m) { const int row = row0 + ai * HALF + m * 16; const float rstd = rs[ai][m]; f32x4 r[2];
#pragma unroll
                for (int n = 0; n < 2; ++n)
#pragma unroll
                    for (int i = 0; i < 4; ++i) { const float g = acc[ai][0][m][n][i] * rstd + bv[0][n][i], up = acc[ai][1][m][n][i] * rstd + bv[1][n][i];
                        r[n][i] = g * __builtin_amdgcn_rcpf(1.0f + __builtin_amdgcn_exp2f(-1.4426950408889634f * g)) * up; }
                *(u32x4*)(act + (size_t)row * 5632 + col0) = pack8(r[0], r[1]); }
    }
};
struct EpiSplit3 {
    static constexpr bool PERM = true, AFTER_DRAIN = false;
    bf16_t* O0; size_t stride; NormIn ni;
    __device__ __forceinline__ void prefetch(const Unit& u, int wid, int lane) const { bias_prefetch(ni, u, wid, lane); }
    __device__ __forceinline__ void operator()(const f32x4 (&acc)[2][2][4][2], const Unit& u, int wr, int wc, int fr, int fq) const {
        const int t = u.pn >> 3; bf16_t* base = O0 + (size_t)t * stride;
        const int row0 = u.pm * BM + wr * 64 + fr, col0 = (u.pn & 7) * 256 + wc * 32 + 8 * fq;
        f32x4 bv[2][2]; load_bias(ni, u, wc, fq, bv); float rs[2][4]; rows_rstd(ni.ssx, 8, 0, 1.0f / 2048.0f, u.pm, ni.tab, rstd_tag(ni.bias, u.pm), wr, wc, fr, fq, rs);
#pragma unroll
        for (int ai = 0; ai < 2; ++ai)
#pragma unroll
            for (int m = 0; m < 4; ++m) { const int row = row0 + ai * HALF + m * 16; const float rstd = rs[ai][m]; bf16_t* rowp = base + (size_t)row * 2048 + col0;
#pragma unroll
                for (int bj = 0; bj < 2; ++bj) *(u32x4*)(rowp + bj * HALF) = pack8(acc[ai][bj][m][0] * rstd + bv[bj][0], acc[ai][bj][m][1] * rstd + bv[bj][1]); }
    }
};
#define NI_VALS(ai, m) const int row = row0 + (ai) * HALF + (m) * 16; const float rstd = rs[ai][m]; \
    const f32x4 v00 = acc[ai][0][m][0] * rstd + bv[0][0], v01 = acc[ai][0][m][1] * rstd + bv[0][1], v10 = acc[ai][1][m][0] * rstd + bv[1][0], v11 = acc[ai][1][m][1] * rstd + bv[1][1];
struct EpiDsaIn {
    static constexpr bool PERM = true, AFTER_DRAIN = false;
    bf16_t *Q, *K, *V, *IQ, *IK; float* IW; NormIn ni;
    __device__ __forceinline__ void prefetch(const Unit& u, int wid, int lane) const { bias_prefetch(ni, u, wid, lane); }
    __device__ __forceinline__ void operator()(const f32x4 (&acc)[2][2][4][2], const Unit& u, int wr, int wc, int fr, int fq) const {
        const int pn = u.pn, row0 = u.pm * BM + wr * 64 + fr;
        f32x4 bv[2][2]; load_bias(ni, u, wc, fq, bv); float rs[2][4]; rows_rstd(ni.ssx, 8, 0, 1.0f / 2048.0f, u.pm, ni.tab, rstd_tag(ni.bias, u.pm), wr, wc, fr, fq, rs);
        if (pn < 10) {
            bf16_t* base; int ld, hcol;
            if (pn < 8) { base = Q; ld = 2048; hcol = (2 * pn + (wc >> 1)) * 128; } else { base = K; ld = 512; hcol = (2 * (pn - 8) + (wc >> 1)) * 128; }
            const int dd0 = 32 * (wc & 1) + 8 * fq; f32x4 ir0, ir1; rope_ir(dd0, L2T_128, ir0, ir1);
#pragma unroll
            for (int ai = 0; ai < 2; ++ai)
#pragma unroll
                for (int m = 0; m < 4; ++m) { NI_VALS(ai, m) const float pos = (float)(row & 4095); u32x4 o1, o2;
                    rope8(ir0, ir1, pos, v00, v01, v10, v11, o1, o2);
                    bf16_t* p = base + (size_t)row * ld + hcol + dd0; *(u32x4*)p = o1; *(u32x4*)(p + 64) = o2; }
        } else if (pn < 12) {
            const int col0 = (pn - 10) * 256 + wc * 32 + 8 * fq;
#pragma unroll
            for (int ai = 0; ai < 2; ++ai)
#pragma unroll
                for (int m = 0; m < 4; ++m) { NI_VALS(ai, m) bf16_t* rowp = V + (size_t)row * 512 + col0;
                    *(u32x4*)rowp = pack8(v00, v01); *(u32x4*)(rowp + HALF) = pack8(v10, v11); }
        } else {
            bf16_t* base; int ld, hcol;
            if (pn < 20) { base = IQ; ld = 2048; hcol = (2 * (pn - 12) + (wc >> 1)) * 128; } else { base = IK; ld = 128; hcol = 0; }
            const int sub = (pn < 20) ? (wc & 1) : wc;
            if (sub == 0) {
                const int dd0 = 8 * fq; f32x4 ir0, ir1; rope_ir(dd0, L2T_64, ir0, ir1);
#pragma unroll
                for (int ai = 0; ai < 2; ++ai)
#pragma unroll
                    for (int m = 0; m < 4; ++m) { NI_VALS(ai, m) const float pos = (float)(row & 4095); u32x4 o1, o2;
                        rope8(ir0, ir1, pos, v00, v01, v10, v11, o1, o2);
                        bf16_t* p = base + (size_t)row * ld + hcol + dd0; *(u32x4*)p = o1; *(u32x4*)(p + 32) = o2; }
            } else if (sub == 1) {
#pragma unroll
                for (int ai = 0; ai < 2; ++ai)
#pragma unroll
                    for (int m = 0; m < 4; ++m) { NI_VALS(ai, m) bf16_t* p = base + (size_t)row * ld + hcol + 64 + 8 * fq;
                        *(u32x4*)p = pack8(v00, v01); *(u32x4*)(p + 32) = pack8(v10, v11); }
            } else if (sub == 2 && pn == 20) {
                if (fq < 2) {
#pragma unroll
                    for (int ai = 0; ai < 2; ++ai)
#pragma unroll
                        for (int m = 0; m < 4; ++m) { NI_VALS(ai, m) float* p = IW + (size_t)row * 16 + 8 * fq; *(f32x4*)p = v00; *(f32x4*)(p + 4) = v01; (void)v10; (void)v11; }
                }
            }
        }
    }
};
struct EpiMlaDown {
    static constexpr bool PERM = true, AFTER_DRAIN = false;
    bf16_t *CQ, *CKV, *KR; float* ssq; NormIn ni; int pn_off;
    __device__ __forceinline__ void prefetch(const Unit& u, int wid, int lane) const { Unit ub = u; ub.pn = u.pn + pn_off; bias_prefetch(ni, ub, wid, lane); }
    __device__ __forceinline__ void operator()(const f32x4 (&acc)[2][2][4][2], const Unit& u, int wr, int wc, int fr, int fq) const {
        const int pn = u.pn + pn_off, row0 = u.pm * BM + wr * 64 + fr;
        Unit ub = u; ub.pn = pn;
        f32x4 bv[2][2]; load_bias(ni, ub, wc, fq, bv); float rs[2][4]; rows_rstd(ni.ssx, 8, 0, 1.0f / 2048.0f, u.pm, ni.tab, rstd_tag(ni.bias, u.pm), wr, wc, fr, fq, rs);
        if (pn < 4) {
            bf16_t* base = pn < 2 ? CQ : CKV; const int col0 = (pn & 1) * 256 + wc * 32 + 8 * fq;
#pragma unroll
            for (int ai = 0; ai < 2; ++ai)
#pragma unroll
                for (int m = 0; m < 4; ++m) { NI_VALS(ai, m)
                    float s = ((v00[0] * v00[0] + v00[1] * v00[1]) + (v00[2] * v00[2] + v00[3] * v00[3])) + ((v01[0] * v01[0] + v01[1] * v01[1]) + (v01[2] * v01[2] + v01[3] * v01[3]));
                    s += ((v10[0] * v10[0] + v10[1] * v10[1]) + (v10[2] * v10[2] + v10[3] * v10[3])) + ((v11[0] * v11[0] + v11[1] * v11[1]) + (v11[2] * v11[2] + v11[3] * v11[3]));
                    *(u32x4*)(base + (size_t)row * 512 + col0) = pack8(v00, v01); *(u32x4*)(base + (size_t)row * 512 + col0 + HALF) = pack8(v10, v11);
                    s += __shfl_xor(s, 16); s += __shfl_xor(s, 32);
                    if (fq == 0) ssq[(size_t)row * 16 + pn * 4 + wc] = s; }
        } else if (wc == 0) {
            const int dd0 = 8 * fq; f32x4 ir0, ir1; rope_ir(dd0, L2T_64, ir0, ir1);
#pragma unroll
            for (int ai = 0; ai < 2; ++ai)
#pragma unroll
                for (int m = 0; m < 4; ++m) { NI_VALS(ai, m) const float pos = (float)(row & 4095); u32x4 o1, o2;
                    rope8(ir0, ir1, pos, v00, v01, v10, v11, o1, o2);
                    bf16_t* p = KR + (size_t)row * 64 + dd0; *(u32x4*)p = o1; *(u32x4*)(p + 32) = o2; }
        }
    }
};
#undef NI_VALS
struct EpiMlaUq {
    static constexpr bool PERM = true, AFTER_DRAIN = false;
    bf16_t *QN, *QR; const float* ssq; PG8_LAS float* tab;
    __device__ __forceinline__ void operator()(const f32x4 (&acc)[2][2][4][2], const Unit& u, int wr, int wc, int fr, int fq) const {
        const int pn = u.pn, row0 = u.pm * BM + wr * 64 + fr;
        float rs[2][4]; rows_rstd(ssq, 16, 0, 1.0f / 512.0f, u.pm, tab, 0x80000000u | (unsigned)u.pm, wr, wc, fr, fq, rs);
        f32x4 ir0, ir1; rope_ir(8 * fq, L2T_64, ir0, ir1);
#pragma unroll
        for (int ai = 0; ai < 2; ++ai)
#pragma unroll
            for (int m = 0; m < 4; ++m) { const int row = row0 + ai * HALF + m * 16; const float rstd = rs[ai][m];
                if (pn < 8) { bf16_t* rowp = QN + (size_t)row * 2048 + pn * 256 + wc * 32 + 8 * fq;
#pragma unroll
                    for (int bj = 0; bj < 2; ++bj) *(u32x4*)(rowp + bj * HALF) = pack8(acc[ai][bj][m][0] * rstd, acc[ai][bj][m][1] * rstd);
                } else { u32x4 o1, o2; const int dd0 = 8 * fq;
                    rope8(ir0, ir1, (float)(row & 4095), acc[ai][0][m][0] * rstd, acc[ai][0][m][1] * rstd, acc[ai][1][m][0] * rstd, acc[ai][1][m][1] * rstd, o1, o2);
                    bf16_t* p = QR + (size_t)row * 1024 + (4 * (pn - 8) + wc) * 64 + dd0; *(u32x4*)p = o1; *(u32x4*)(p + 32) = o2; } }
    }
};
struct EpiMlaUkv {
    static constexpr bool PERM = true, AFTER_DRAIN = false;
    bf16_t *KN, *V; const float* ssq; PG8_LAS float* tab;
    __device__ __forceinline__ void operator()(const f32x4 (&acc)[2][2][4][2], const Unit& u, int wr, int wc, int fr, int fq) const {
        const int row0 = u.pm * BM + wr * 64 + fr, col0 = u.pn * 128 + wc * 32 + 8 * fq;
        float rs[2][4]; rows_rstd(ssq, 16, 8, 1.0f / 512.0f, u.pm, tab, 0x80000100u | (unsigned)u.pm, wr, wc, fr, fq, rs);
#pragma unroll
        for (int ai = 0; ai < 2; ++ai)
#pragma unroll
            for (int m = 0; m < 4; ++m) { const int row = row0 + ai * HALF + m * 16; const float rstd = rs[ai][m];
                *(u32x4*)(KN + (size_t)row * 2048 + col0) = pack8(acc[ai][0][m][0] * rstd, acc[ai][0][m][1] * rstd);
                *(u32x4*)(V + (size_t)row * 2048 + col0) = pack8(acc[ai][1][m][0] * rstd, acc[ai][1][m][1] * rstd); }
    }
};

template <class E> __device__ __forceinline__ auto epi_pre(const E& e, const Unit& u, int wid, int lane, int) -> decltype(e.prefetch(u, wid, lane), void()) { e.prefetch(u, wid, lane); }
template <class E> __device__ __forceinline__ void epi_pre(const E&, const Unit&, int, int, long) {}
template <class Epi, class Sched, bool ALIGN_EPI = false, bool SP2 = false>
__device__ __forceinline__ void gemm_phase(PG8_LAS unsigned char* lds, const Gemm g, const Sched& S, const Epi& E) {
    int tid = threadIdx.x; asm volatile("" : "+v"(tid));
    const int wid = __builtin_amdgcn_readfirstlane(tid >> 6), lane = tid & 63, wr = wid >> 2, wc = wid & 3, fr = lane & 15, fq = lane >> 4;
    const int K = g.K, nt = K / BK;
    unsigned voffA[2], voffB[2];
#pragma unroll
    for (int i = 0; i < 2; ++i) { int R, C; stage_rc(tid * 16 + i * 8192, R, C); const int Rb = Epi::PERM ? ((R & ~31) + perm32(R & 31)) : R;
        voffA[i] = (unsigned)(R * K + C) * 2u; voffB[i] = (unsigned)(Rb * K + C) * 2u; }
    const size_t kstep = (size_t)(BK * 2);
    const size_t hstep = (size_t)HALF * K * 2;
    const size_t tstep = 2 * hstep;
    const unsigned ldsw = (unsigned)wid * 1024u;
    const int aoff = lds_byte(wr * 64 + fr, fq * 8), boff = lds_byte(wc * 32 + fr, fq * 8);
#define PG8_SA(b, h) (((b) * 2 + (h)) * HTB)
#define PG8_SB(b, h) ((4 + (b) * 2 + (h)) * HTB)
#define PG8_STAGE(bufoff, gbase, voff) do { _Pragma("unroll") for (int _i = 0; _i < 2; ++_i) \
        __builtin_amdgcn_global_load_lds((const unsigned*)((const char*)(gbase) + (voff)[_i]), (PG8_LAS unsigned*)(lds + (bufoff) + ldsw + _i * 8192), 16, 0, 0); } while (0)
#define PG8_LDA(dst, b, h) do { _Pragma("unroll") for (int m = 0; m < 4; ++m) _Pragma("unroll") for (int k = 0; k < 2; ++k) dst[m][k] = *(const PG8_LAS bf16x8*)(lds + PG8_SA(b, h) + aoff + m * 2048 + k * 1024); } while (0)
#define PG8_LDB(dst, b, h) do { _Pragma("unroll") for (int n = 0; n < 2; ++n) _Pragma("unroll") for (int k = 0; k < 2; ++k) dst[n][k] = *(const PG8_LAS bf16x8*)(lds + PG8_SB(b, h) + boff + n * 2048 + k * 1024); } while (0)
#define PG8_MMA(ai, bj, At, Bt) do { __builtin_amdgcn_s_setprio(1); _Pragma("unroll") for (int m = 0; m < 4; ++m) _Pragma("unroll") for (int n = 0; n < 2; ++n) _Pragma("unroll") for (int k = 0; k < 2; ++k) \
        acc[ai][bj][m][n] = __builtin_amdgcn_mfma_f32_16x16x32_bf16(Bt[n][k], At[m][k], acc[ai][bj][m][n], 0, 0, 0); __builtin_amdgcn_s_setprio(0); } while (0)
#define PG8_WAIT_V(n) asm volatile("s_waitcnt vmcnt(" #n ")" ::: "memory")
#define PG8_WAIT_L(n) asm volatile("s_waitcnt lgkmcnt(" #n ")" ::: "memory")
#define PG8_BAR __builtin_amdgcn_s_barrier()
#define PG8_SCHED __builtin_amdgcn_sched_barrier(0)
    Unit cur, nxt; int ui = 0;
    if (!S.next(0, cur)) return;
    f32x4 acc[2][2][4][2];
#pragma unroll
    for (int a = 0; a < 2; ++a)
#pragma unroll
        for (int b = 0; b < 2; ++b)
#pragma unroll
            for (int m = 0; m < 4; ++m)
#pragma unroll
                for (int n = 0; n < 2; ++n) acc[a][b][m][n] = (f32x4){0.f, 0.f, 0.f, 0.f};
    bf16x8 At[4][2], B0[2][2], B1[2][2];
    const char* cA = (const char*)g.A + (size_t)cur.pm * tstep; const char* cB = (const char*)g.Bt + (size_t)cur.pn * tstep;
    S.a_ready(cur);
    if constexpr (SP2) {
        PG8_STAGE(PG8_SB(0, 0), cB, voffB); PG8_STAGE(PG8_SB(0, 1), cB + hstep, voffB); PG8_STAGE(PG8_SA(0, 0), cA, voffA); PG8_STAGE(PG8_SA(0, 1), cA + hstep, voffA);
        if (wr == 1) PG8_BAR;
        PG8_WAIT_V(2); PG8_BAR;
        PG8_STAGE(PG8_SB(1, 0), cB + kstep, voffB); PG8_STAGE(PG8_SA(1, 0), cA + kstep, voffA); PG8_STAGE(PG8_SB(1, 1), cB + hstep + kstep, voffB);
        PG8_WAIT_V(6); PG8_BAR;
    } else {
        PG8_STAGE(PG8_SB(0, 0), cB, voffB); PG8_STAGE(PG8_SA(0, 0), cA, voffA); PG8_STAGE(PG8_SB(0, 1), cB + hstep, voffB); PG8_STAGE(PG8_SA(0, 1), cA + hstep, voffA);
        if (wr == 1) PG8_BAR;
        PG8_WAIT_V(4); PG8_BAR;
        PG8_STAGE(PG8_SB(1, 0), cB + kstep, voffB); PG8_STAGE(PG8_SA(1, 0), cA + kstep, voffA); PG8_STAGE(PG8_SB(1, 1), cB + hstep + kstep, voffB);
        PG8_WAIT_V(6); PG8_BAR;
    }
    for (;;) {
        const bool has_next = S.next(ui + 1, nxt);
        const char* nA = has_next ? (const char*)g.A + (size_t)nxt.pm * tstep : cA; const char* nB = has_next ? (const char*)g.Bt + (size_t)nxt.pn * tstep : cB;
        for (int t = 0; t < nt; t += 2) {
            const bool last = (t == nt - 2);
            const char* a1 = cA + (size_t)(t + 1) * kstep;
            const char* a2 = last ? nA : cA + (size_t)(t + 2) * kstep; const char* b2 = last ? nB : cB + (size_t)(t + 2) * kstep;
            const char* a3 = a2 + kstep; const char* b3 = b2 + kstep;
            if (last && has_next) S.a_ready(nxt);
            if (last) epi_pre(E, cur, wid, lane, 0);
            if constexpr (SP2) {
            PG8_LDB(B0, 0, 0); PG8_LDB(B1, 0, 1); PG8_SCHED; PG8_LDA(At, 0, 0); PG8_STAGE(PG8_SA(1, 1), a1 + hstep, voffA);
            PG8_WAIT_V(8); PG8_WAIT_L(0); PG8_BAR; PG8_MMA(0, 0, At, B0); PG8_MMA(0, 1, At, B1); PG8_BAR; PG8_SCHED;
            PG8_LDA(At, 0, 1); PG8_STAGE(PG8_SB(0, 0), b2, voffB); PG8_STAGE(PG8_SB(0, 1), b2 + hstep, voffB); PG8_STAGE(PG8_SA(0, 0), a2, voffA);
            PG8_WAIT_V(8); PG8_WAIT_L(0); PG8_BAR; PG8_MMA(1, 0, At, B0); PG8_MMA(1, 1, At, B1); PG8_BAR; PG8_SCHED;
            PG8_LDB(B0, 1, 0); PG8_LDB(B1, 1, 1); PG8_SCHED; PG8_LDA(At, 1, 0); PG8_STAGE(PG8_SA(0, 1), a2 + hstep, voffA);
            PG8_WAIT_V(8); PG8_WAIT_L(0); PG8_BAR; PG8_MMA(0, 0, At, B0); PG8_MMA(0, 1, At, B1); PG8_BAR; PG8_SCHED;
            PG8_LDA(At, 1, 1); PG8_STAGE(PG8_SB(1, 0), b3, voffB); PG8_STAGE(PG8_SB(1, 1), b3 + hstep, voffB); PG8_STAGE(PG8_SA(1, 0), a3, voffA);
            PG8_WAIT_V(8); PG8_WAIT_L(0); PG8_BAR; PG8_MMA(1, 0, At, B0); PG8_MMA(1, 1, At, B1); PG8_BAR; PG8_SCHED;
            } else {
            PG8_LDB(B0, 0, 0); PG8_SCHED; PG8_LDA(At, 0, 0); PG8_STAGE(PG8_SA(1, 1), a1 + hstep, voffA);
            PG8_WAIT_L(8); PG8_BAR; PG8_WAIT_L(0); PG8_MMA(0, 0, At, B0); PG8_BAR; PG8_SCHED;
            PG8_LDB(B1, 0, 1); PG8_STAGE(PG8_SB(0, 0), b2, voffB);
            PG8_BAR; PG8_WAIT_L(0); PG8_MMA(0, 1, At, B1); PG8_BAR;
            PG8_LDA(At, 0, 1); PG8_STAGE(PG8_SA(0, 0), a2, voffA);
            PG8_BAR; PG8_WAIT_L(0); PG8_MMA(1, 0, At, B0); PG8_BAR; PG8_SCHED;
            PG8_STAGE(PG8_SB(0, 1), b2 + hstep, voffB);
            PG8_WAIT_V(6); PG8_BAR; PG8_MMA(1, 1, At, B1); PG8_BAR;
            PG8_LDB(B0, 1, 0); PG8_SCHED; PG8_LDA(At, 1, 0); PG8_STAGE(PG8_SA(0, 1), a2 + hstep, voffA);
            PG8_WAIT_L(8); PG8_BAR; PG8_WAIT_L(0); PG8_MMA(0, 0, At, B0); PG8_BAR; PG8_SCHED;
            PG8_LDB(B1, 1, 1); PG8_STAGE(PG8_SB(1, 0), b3, voffB);
            PG8_BAR; PG8_WAIT_L(0); PG8_MMA(0, 1, At, B1); PG8_BAR;
            PG8_LDA(At, 1, 1); PG8_STAGE(PG8_SA(1, 0), a3, voffA);
            PG8_BAR; PG8_WAIT_L(0); PG8_MMA(1, 0, At, B0); PG8_BAR; PG8_SCHED;
            PG8_STAGE(PG8_SB(1, 1), b3 + hstep, voffB);
            PG8_WAIT_V(6); PG8_BAR; PG8_MMA(1, 1, At, B1); PG8_BAR;
            }
        }
        if constexpr (ALIGN_EPI) { if (wr == 0) PG8_BAR; }
        if constexpr (!Epi::AFTER_DRAIN) { E(acc, cur, wr, wc, fr, fq); S.done(cur); }
        if (!has_next) break;
#pragma unroll
        for (int a = 0; a < 2; ++a)
#pragma unroll
            for (int b = 0; b < 2; ++b)
#pragma unroll
                for (int m = 0; m < 4; ++m)
#pragma unroll
                    for (int n = 0; n < 2; ++n) acc[a][b][m][n] = (f32x4){0.f, 0.f, 0.f, 0.f};
        cur = nxt; cA = nA; cB = nB; ++ui;
        if constexpr (ALIGN_EPI) { if (wr == 1) PG8_BAR; }
    }
    PG8_WAIT_V(0);
    if constexpr (!ALIGN_EPI) { if (wr == 0) PG8_BAR; }
    PG8_BAR;
    if constexpr (Epi::AFTER_DRAIN) { E.fused(acc, cur, wr, wc, fr, fq, lds, wid, lane); S.done(cur); }
#undef PG8_SA
#undef PG8_SB
#undef PG8_STAGE
#undef PG8_LDA
#undef PG8_LDB
#undef PG8_MMA
#undef PG8_WAIT_V
#undef PG8_WAIT_L
#undef PG8_BAR
#undef PG8_SCHED
}
}
#ifndef LATE_PRIO
#define LATE_PRIO 1
#endif
#ifndef SM_SUM_MFMA
#define SM_SUM_MFMA 0
#endif
#ifndef DSTAMP
#define DSTAMP 0
#define DSTAMP_W 0
#endif
#ifndef DSTAMP_MUL
#define DSTAMP_MUL 1
#endif
#define DST_STAMP(t) do { __builtin_amdgcn_sched_barrier(0); asm volatile("s_memrealtime %0\n\ts_waitcnt lgkmcnt(0)" : "=s"(t) :: "memory"); __builtin_amdgcn_sched_barrier(0); } while (0)
#define DST_A(n) do { if constexpr (DSTAMP == (n)) DST_STAMP(dta_); } while (0)
#define DST_B(n) do { if constexpr (DSTAMP == (n)) { unsigned long long dtb_; DST_STAMP(dtb_); dacc_ += dtb_ - dta_; } } while (0)
namespace att {
typedef unsigned short bf16_t;
using bf16x8 = __attribute__((ext_vector_type(8))) short;
using s16x4  = __attribute__((ext_vector_type(4))) short;
using f32x16 = __attribute__((ext_vector_type(16))) float;
using f32x4  = __attribute__((ext_vector_type(4))) float;
using u32x4  = __attribute__((ext_vector_type(4))) unsigned;
#define KSWZ(row, colB) ((row) * 256 + ((colB) ^ (((row) & 15) << 4)))
#define ATT_SBAR() __builtin_amdgcn_sched_barrier(0)
constexpr int SHM_KV = 16384;
__device__ __forceinline__ int crow(int r, int hi) { return (r & 3) + 8 * (r >> 2) + 4 * hi; }
__device__ __forceinline__ unsigned cvtpk(float lo, float hi) { unsigned r; asm volatile("v_cvt_pk_bf16_f32 %0, %1, %2" : "=v"(r) : "v"(lo), "v"(hi)); return r; }
template <int SC1E9> __device__ __forceinline__ void partialSM(f32x16& p0, f32x16& p1, float& m_reg, float& mn, float& alpha) {
  constexpr float SCALE = (float)(SC1E9 * 1e-9), THR = 8.f, C = SCALE * 1.4426950408889634f;
  float pmax = p0[0];
#pragma unroll
  for (int r = 1; r < 16; ++r) pmax = fmaxf(pmax, p0[r]);
#pragma unroll
  for (int r = 0; r < 16; ++r) pmax = fmaxf(pmax, p1[r]);
  { auto rr = __builtin_amdgcn_permlane32_swap(__float_as_uint(pmax), __float_as_uint(pmax), false, false);
    pmax = fmaxf(__uint_as_float(rr[0]), __uint_as_float(rr[1])); }
  if (__builtin_expect(__all(pmax - m_reg <= THR / SCALE), 1)) { mn = m_reg; alpha = 1.f; }
  else { mn = fmaxf(m_reg, pmax); alpha = __builtin_amdgcn_exp2f((m_reg - mn) * C); m_reg = mn; }
  const float mnC = -mn * C;
#pragma unroll
  for (int r = 0; r < 16; ++r) p0[r] = fmaf(p0[r], C, mnC);
#pragma unroll
  for (int r = 0; r < 16; ++r) p1[r] = fmaf(p1[r], C, mnC);
#pragma unroll
  for (int r = 0; r < 16; ++r) p0[r] = __builtin_amdgcn_exp2f(p0[r]);
}
__device__ __forceinline__ void packP(const f32x16& p0, const f32x16& p1, bf16x8& pa0, bf16x8& pa1, bf16x8& pa2, bf16x8& pa3) {
#define PK4(P, BASE, OUT) do { unsigned a0 = cvtpk(P[BASE + 0], P[BASE + 1]), a1 = cvtpk(P[BASE + 2], P[BASE + 3]);   \
    unsigned b0 = cvtpk(P[BASE + 4], P[BASE + 5]), b1 = cvtpk(P[BASE + 6], P[BASE + 7]);                              \
    auto r0 = __builtin_amdgcn_permlane32_swap(a0, b0, false, false); auto r1 = __builtin_amdgcn_permlane32_swap(a1, b1, false, false); \
    u32x4 w = {r0[0], r1[0], r0[1], r1[1]}; OUT = *reinterpret_cast<bf16x8*>(&w); } while (0)
  PK4(p0, 0, pa0); PK4(p0, 8, pa1); PK4(p1, 0, pa2); PK4(p1, 8, pa3);
#undef PK4
}
__device__ __forceinline__ void finishSM(f32x16& p0, f32x16& p1, float alpha, float& l_reg, bf16x8& pa0, bf16x8& pa1, bf16x8& pa2, bf16x8& pa3) {
#pragma unroll
  for (int r = 0; r < 16; ++r) p1[r] = __builtin_amdgcn_exp2f(p1[r]);
  packP(p0, p1, pa0, pa1, pa2, pa3);
#if SM_SUM_MFMA
  { const u32x4 onesw = {0x3F803F80u, 0x3F803F80u, 0x3F803F80u, 0x3F803F80u}; const bf16x8 ones = *reinterpret_cast<const bf16x8*>(&onesw);
    f32x16 ls = __builtin_amdgcn_mfma_f32_32x32x16_bf16(ones, pa0, f32x16{}, 0, 0, 0);
    ls = __builtin_amdgcn_mfma_f32_32x32x16_bf16(ones, pa1, ls, 0, 0, 0);
    ls = __builtin_amdgcn_mfma_f32_32x32x16_bf16(ones, pa2, ls, 0, 0, 0);
    ls = __builtin_amdgcn_mfma_f32_32x32x16_bf16(ones, pa3, ls, 0, 0, 0);
    l_reg = l_reg * alpha + ls[0]; }
#else
  float ps = 0;
#pragma unroll
  for (int r = 0; r < 16; ++r) ps += p0[r];
#pragma unroll
  for (int r = 0; r < 16; ++r) ps += p1[r];
  { auto rr = __builtin_amdgcn_permlane32_swap(__float_as_uint(ps), __float_as_uint(ps), false, false);
    ps = __uint_as_float(rr[0]) + __uint_as_float(rr[1]); }
  l_reg = l_reg * alpha + ps;
#endif
}
template <int NG = 4>
__device__ __forceinline__ void qkt(f32x16& p0, f32x16& p1, const char* Ks, const bf16x8* qr, int r32, int hi) {
  p0 = f32x16{}; p1 = f32x16{};
  constexpr int DG = 8 / NG;
  bf16x8 kb[2][DG][2];
#define QKT_LOADG(bf, g) do { _Pragma("unroll") for (int d = 0; d < DG; ++d) { const int cb = ((DG * (g) + d) * 16 + hi * 8) * 2; \
    kb[bf][d][0] = *reinterpret_cast<const bf16x8*>(Ks + KSWZ(r32, cb)); kb[bf][d][1] = *reinterpret_cast<const bf16x8*>(Ks + KSWZ(32 + r32, cb)); } } while (0)
  QKT_LOADG(0, 0);
#pragma unroll
  for (int g = 0; g < NG; ++g) {
    if (g + 1 < NG) QKT_LOADG((g + 1) & 1, g + 1);
    ATT_SBAR();
#pragma unroll
    for (int d = 0; d < DG; ++d) {
      p0 = __builtin_amdgcn_mfma_f32_32x32x16_bf16(kb[g & 1][d][0], qr[DG * g + d], p0, 0, 0, 0);
      p1 = __builtin_amdgcn_mfma_f32_32x32x16_bf16(kb[g & 1][d][1], qr[DG * g + d], p1, 0, 0, 0); }
    ATT_SBAR();
  }
#undef QKT_LOADG
}
__device__ __forceinline__ void qkt_rope(f32x16& p0, f32x16& p1, const char* Kr, const bf16x8* qr, int r32, int hi) {
#pragma unroll
  for (int d0 = 0; d0 < 4; ++d0) { const int cb = ((d0 * 16 + hi * 8) * 2) ^ (((r32 >> 1) & 7) << 4);
    const bf16x8 b0 = *reinterpret_cast<const bf16x8*>(Kr + r32 * 128 + cb);
    const bf16x8 b1 = *reinterpret_cast<const bf16x8*>(Kr + (32 + r32) * 128 + cb);
    p0 = __builtin_amdgcn_mfma_f32_32x32x16_bf16(b0, qr[d0], p0, 0, 0, 0);
    p1 = __builtin_amdgcn_mfma_f32_32x32x16_bf16(b1, qr[d0], p1, 0, 0, 0); }
}
__device__ __forceinline__ int v_st(int k, int c) { const int kk = (k & ~0xC) | ((k & 4) << 1) | ((k & 8) >> 1); return ((kk >> 3) * 4 + (c >> 5)) * 512 + ((kk & 7) * 32 + (c & 31)) * 2; }
__device__ __forceinline__ int v_rd_base(int lane) { return ((lane & 3) << 3) | (((lane >> 2) & 3) << 6) | (((lane >> 4) & 1) << 5) | (((lane >> 5) & 1) << 8); }
constexpr int v_rd_off(int d0, int ks, int half) { return d0 * 512 + ks * 4096 + half * 2048; }
template <int OFF> __device__ __forceinline__ s16x4 tr_read(int vb) {
  s16x4 r; asm volatile("ds_read_b64_tr_b16 %0, %1 offset:%2" : "=&v"(r) : "v"(vb), "i"(OFF) : "memory"); return r;
}
template <int D0> __device__ __forceinline__ void pv_read(int vb, s16x4 (&f)[8]) {
  f[0] = tr_read<v_rd_off(D0, 0, 0)>(vb); f[1] = tr_read<v_rd_off(D0, 0, 1)>(vb); f[2] = tr_read<v_rd_off(D0, 1, 0)>(vb); f[3] = tr_read<v_rd_off(D0, 1, 1)>(vb);
  f[4] = tr_read<v_rd_off(D0, 2, 0)>(vb); f[5] = tr_read<v_rd_off(D0, 2, 1)>(vb); f[6] = tr_read<v_rd_off(D0, 3, 0)>(vb); f[7] = tr_read<v_rd_off(D0, 3, 1)>(vb);
}
__device__ __forceinline__ void pv_mma(f32x16& od, const s16x4 (&f)[8], bf16x8 pa0, bf16x8 pa1, bf16x8 pa2, bf16x8 pa3) {
#define PK(L, H) (bf16x8){L[0], L[1], L[2], L[3], H[0], H[1], H[2], H[3]}
  od = __builtin_amdgcn_mfma_f32_32x32x16_bf16(pa0, PK(f[0], f[1]), od, 0, 0, 0);
  od = __builtin_amdgcn_mfma_f32_32x32x16_bf16(pa1, PK(f[2], f[3]), od, 0, 0, 0);
  od = __builtin_amdgcn_mfma_f32_32x32x16_bf16(pa2, PK(f[4], f[5]), od, 0, 0, 0);
  od = __builtin_amdgcn_mfma_f32_32x32x16_bf16(pa3, PK(f[6], f[7]), od, 0, 0, 0);
#undef PK
}
template <bool PIPE = true>
__device__ __forceinline__ void pv_d0(f32x16* o, int vb, bf16x8 pa0, bf16x8 pa1, bf16x8 pa2, bf16x8 pa3) {
  if constexpr (!PIPE) {
    s16x4 f[8];
    pv_read<0>(vb, f); asm volatile("s_waitcnt lgkmcnt(0)" ::: "memory"); ATT_SBAR(); pv_mma(o[0], f, pa0, pa1, pa2, pa3); ATT_SBAR();
    pv_read<1>(vb, f); asm volatile("s_waitcnt lgkmcnt(0)" ::: "memory"); ATT_SBAR(); pv_mma(o[1], f, pa0, pa1, pa2, pa3); ATT_SBAR();
    pv_read<2>(vb, f); asm volatile("s_waitcnt lgkmcnt(0)" ::: "memory"); ATT_SBAR(); pv_mma(o[2], f, pa0, pa1, pa2, pa3); ATT_SBAR();
    pv_read<3>(vb, f); asm volatile("s_waitcnt lgkmcnt(0)" ::: "memory"); ATT_SBAR(); pv_mma(o[3], f, pa0, pa1, pa2, pa3);
    return;
  }
  s16x4 fa[8], fb[8];
  pv_read<0>(vb, fa);
  pv_read<1>(vb, fb); asm volatile("s_waitcnt lgkmcnt(8)" ::: "memory"); ATT_SBAR(); pv_mma(o[0], fa, pa0, pa1, pa2, pa3); ATT_SBAR();
  pv_read<2>(vb, fa); asm volatile("s_waitcnt lgkmcnt(8)" ::: "memory"); ATT_SBAR(); pv_mma(o[1], fb, pa0, pa1, pa2, pa3); ATT_SBAR();
  pv_read<3>(vb, fb); asm volatile("s_waitcnt lgkmcnt(8)" ::: "memory"); ATT_SBAR(); pv_mma(o[2], fa, pa0, pa1, pa2, pa3); ATT_SBAR();
  asm volatile("s_waitcnt lgkmcnt(0)" ::: "memory"); ATT_SBAR(); pv_mma(o[3], fb, pa0, pa1, pa2, pa3);
}
#define ATT_RESC(a) do { if (__any((a) < 1.f)) { if (hi == 0) al_l[r32] = (a); asm volatile("s_waitcnt lgkmcnt(0)" ::: "memory"); \
    _Pragma("unroll") for (int d = 0; d < 4; ++d) _Pragma("unroll") for (int r = 0; r < 16; ++r) o[d][r] *= al_l[crow(r, hi)]; } } while (0)
__device__ __forceinline__ void store_o(const f32x16* o, const float* rli, bf16_t* stg, bf16_t* Og  , int ldo, int lane, int r32, int hi) {
#pragma unroll
  for (int r = 0; r < 16; ++r) { const int orow = crow(r, hi);
#pragma unroll
    for (int d0 = 0; d0 < 4; ++d0) stg[orow * 128 + d0 * 32 + r32] = (bf16_t)(cvtpk(o[d0][r] * rli[r], 0.f) & 0xffffu); }
  asm volatile("s_waitcnt lgkmcnt(0)" ::: "memory");
#pragma unroll
  for (int i = 0; i < 8; ++i) { const int row = i * 4 + (lane >> 4), ch = lane & 15; const u32x4 v = *(const u32x4*)(stg + row * 128 + ch * 8); *(u32x4*)(Og + (size_t)row * ldo + ch * 8) = v; }
}

template <int MODE>
__device__ __forceinline__ void attn_sm_unit(int b, int hx, int ux, const bf16_t* __restrict__ Q, const bf16_t* __restrict__ QR, const bf16_t* __restrict__ K, const bf16_t* __restrict__ KR,
                                             const bf16_t* __restrict__ V, const unsigned long long* __restrict__ MASK, bf16_t* __restrict__ O, char* lds) {
  int tid = threadIdx.x; asm volatile("" : "+v"(tid));
  const int wid = __builtin_amdgcn_readfirstlane(tid >> 6), lane = tid & 63, r32 = lane & 31, hi = lane >> 5;
  constexpr int NQ = MODE ? 12 : 8, LDK = MODE ? 2048 : 512;
  char* V_lds = lds; char* K_lds = lds + 2 * SHM_KV; char* R_lds = lds + 4 * SHM_KV;
  float* ws = (float*)(lds + 4 * SHM_KV + 16384) + wid * 64; float* li_l = ws; float* al_l = ws + 32;
  const int head = MODE ? hx : 4 * hx + (wid >> 1);
  const long qrow0 = MODE ? (long)b * 4096 + 256 * ux + 32 * wid : (long)b * 4096 + 64 * ux + 32 * (wid & 1);
  const long qrow = qrow0 + r32;
  const int NT = MODE ? 4 * ux + 4 : ux + 1, NTw = MODE ? 4 * ux + (wid >> 1) + 1 : NT;
  bf16x8 qr[NQ];
  { const bf16_t* Qw = Q + qrow * 2048 + head * 128 + hi * 8;
#pragma unroll
    for (int d0 = 0; d0 < 8; ++d0) qr[d0] = *reinterpret_cast<const bf16x8*>(Qw + d0 * 16);
    if constexpr (MODE == 1) { const bf16_t* Qx = QR + qrow * 1024 + head * 64 + hi * 8;
#pragma unroll
      for (int d0 = 0; d0 < 4; ++d0) qr[8 + d0] = *reinterpret_cast<const bf16x8*>(Qx + d0 * 16); } }
  const int sr = tid >> 4, sc = (tid & 15) * 8, vst0 = v_st(sr, sc), vst1 = v_st(32 + sr, sc);
  const int rr_ = tid >> 3, rc = (tid & 7) * 8, rst = rr_ * 128 + ((rc * 2) ^ (((rr_ >> 1) & 7) << 4));
  const int vb0 = (int)(uintptr_t)V_lds + v_rd_base(lane);
  const bf16_t* Kh = K + (long)b * 4096 * LDK + hx * 128; const bf16_t* Vh = V + (long)b * 4096 * LDK + hx * 128; const bf16_t* Rh = MODE ? KR + (long)b * 4096 * 64 : nullptr;
  const unsigned long long* mrow = MODE ? nullptr : MASK + qrow * 64;
  bf16x8 vs0, vs1, ks0, ks1, rs0;
#define SLOAD(k0) do { vs0 = *reinterpret_cast<const bf16x8*>(Vh + (long)((k0) + sr) * LDK + sc); vs1 = *reinterpret_cast<const bf16x8*>(Vh + (long)((k0) + 32 + sr) * LDK + sc); \
    ks0 = *reinterpret_cast<const bf16x8*>(Kh + (long)((k0) + sr) * LDK + sc); ks1 = *reinterpret_cast<const bf16x8*>(Kh + (long)((k0) + 32 + sr) * LDK + sc); \
    if constexpr (MODE == 1) rs0 = *reinterpret_cast<const bf16x8*>(Rh + (long)((k0) + rr_) * 64 + rc); } while (0)
#define SWRITE(bf) do { *(bf16x8*)(V_lds + (bf) * SHM_KV + vst0) = vs0; *(bf16x8*)(V_lds + (bf) * SHM_KV + vst1) = vs1; \
    *(bf16x8*)(K_lds + (bf) * SHM_KV + KSWZ(sr, sc * 2)) = ks0; *(bf16x8*)(K_lds + (bf) * SHM_KV + KSWZ(32 + sr, sc * 2)) = ks1; \
    if constexpr (MODE == 1) *(bf16x8*)(R_lds + (bf) * 8192 + rst) = rs0; } while (0)
#define QK(P0, P1, t) do { qkt(P0, P1, K_lds + ((t) & 1) * SHM_KV, qr, r32, hi); \
    if constexpr (MODE == 1) qkt_rope(P0, P1, R_lds + ((t) & 1) * 8192, qr + 8, r32, hi); \
    if constexpr (MODE == 0) { const int mlo = (int)((unsigned)mwc >> (4 * hi)), mhi = (int)((unsigned)(mwc >> 32) >> (4 * hi)); \
      _Pragma("unroll") for (int r = 0; r < 16; ++r) { const int cb = (r & 3) + 8 * (r >> 2); \
        const unsigned t0_ = (unsigned)__builtin_amdgcn_sbfe(mlo, cb, 1), t1_ = (unsigned)__builtin_amdgcn_sbfe(mhi, cb, 1);     \
        P0[r] = __uint_as_float((__float_as_uint(P0[r]) & t0_) | (~t0_ & 0xFF800000u)); P1[r] = __uint_as_float((__float_as_uint(P1[r]) & t1_) | (~t1_ & 0xFF800000u)); } } } while (0)
  constexpr int SC9 = MODE ? 72168784 : 88388348;
  float m_reg = -1e30f, l_reg = 0.f; f32x16 o[4];
#pragma unroll
  for (int d = 0; d < 4; ++d) o[d] = f32x16{};
  f32x16 pA0, pA1, pB0, pB1; float mnA, mnB, alA = 1.f, alB = 1.f; bf16x8 pa0, pa1, pa2, pa3;
  unsigned long long mwc = 0ull, mwn = 0ull;
#define STEP(N0, N1, mnN, alN, E0, E1, alE, t) do { const bool an_ = (t) < NTw, ap_ = (t) - 1 < NTw; \
    if constexpr (MODE == 0) mwn = ((t) + 1 < NT) ? mrow[(t) + 1] : 0ull; \
    ATT_SBAR(); if (an_) { QK(N0, N1, t); } \
    if (ap_) { finishSM(E0, E1, alE, l_reg, pa0, pa1, pa2, pa3); } ATT_SBAR(); \
    if (ap_) { pv_d0(o, vb0 + (((t) - 1) & 1) * SHM_KV, pa0, pa1, pa2, pa3); } \
    if (an_) { partialSM<SC9>(N0, N1, m_reg, mnN, alN); } \
    __syncthreads(); \
    if ((t) + 1 < NT) SWRITE(((t) + 1) & 1); \
    if ((t) + 2 < NT) SLOAD(((t) + 2) * 64); \
    if (an_) { ATT_RESC(alN); } mwc = mwn; \
    __syncthreads(); } while (0)
  SLOAD(0); SWRITE(0); if (NT > 1) SLOAD(64);
  if constexpr (MODE == 0) { mwc = mrow[0]; }
  __syncthreads();
  QK(pA0, pA1, 0); partialSM<SC9>(pA0, pA1, m_reg, mnA, alA);
  if constexpr (MODE == 0) { mwc = (NT > 1) ? mrow[1] : 0ull; }
  if (NT > 1) { SWRITE(1); if (NT > 2) SLOAD(128); }
  __syncthreads();
  int t = 1;
  for (; t + 1 < NT; t += 2) {
    STEP(pB0, pB1, mnB, alB, pA0, pA1, alA, t);
    STEP(pA0, pA1, mnA, alA, pB0, pB1, alB, t + 1);
  }
  if (t < NT) {
    STEP(pB0, pB1, mnB, alB, pA0, pA1, alA, t);
    if (t < NTw) { finishSM(pB0, pB1, alB, l_reg, pa0, pa1, pa2, pa3); ATT_SBAR(); pv_d0(o, vb0 + (t & 1) * SHM_KV, pa0, pa1, pa2, pa3); }
  } else {
    if (NT - 1 < NTw) { finishSM(pA0, pA1, alA, l_reg, pa0, pa1, pa2, pa3); ATT_SBAR(); pv_d0(o, vb0 + ((NT - 1) & 1) * SHM_KV, pa0, pa1, pa2, pa3); }
  }
  if (hi == 0) li_l[r32] = l_reg; asm volatile("s_waitcnt lgkmcnt(0)" ::: "memory");
  float rli[16];
#pragma unroll
  for (int r = 0; r < 16; ++r) rli[r] = __builtin_amdgcn_rcpf(li_l[crow(r, hi)]);
  __syncthreads();
  store_o(o, rli, (bf16_t*)(lds + wid * 8192), O + qrow0 * 2048 + head * 128, 2048, lane, r32, hi);
  __syncthreads();
#undef SLOAD
#undef SWRITE
#undef QK
#undef STEP
}

struct DsaPre { bf16x8 qr[8]; bf16x8 vs0, vs1, ks0, ks1; unsigned long long mw; };
__device__ __forceinline__ void dsa_preload(DsaPre& P, int b, int g, int c, const bf16_t* __restrict__ Q, const bf16_t* __restrict__ K, const bf16_t* __restrict__ V, const unsigned long long* __restrict__ MASK) {
  int tid = threadIdx.x; asm volatile("" : "+v"(tid));
  const int wid = __builtin_amdgcn_readfirstlane(tid >> 6), lane = tid & 63, r32 = lane & 31, hi = lane >> 5;
  const int head = 4 * g + (wid >> 1);
  const long qrow = (long)b * 4096 + 64 * c + 32 * (wid & 1) + r32;
  const bf16_t* Qw = Q + qrow * 2048 + head * 128 + hi * 8;
#pragma unroll
  for (int d0 = 0; d0 < 8; ++d0) P.qr[d0] = *reinterpret_cast<const bf16x8*>(Qw + d0 * 16);
  const int sr = tid >> 4, sc = (tid & 15) * 8;
  const bf16_t* Kh = K + (long)b * 4096 * 512 + g * 128; const bf16_t* Vh = V + (long)b * 4096 * 512 + g * 128;
  P.vs0 = *reinterpret_cast<const bf16x8*>(Vh + (long)sr * 512 + sc); P.vs1 = *reinterpret_cast<const bf16x8*>(Vh + (long)(32 + sr) * 512 + sc);
  P.ks0 = *reinterpret_cast<const bf16x8*>(Kh + (long)sr * 512 + sc); P.ks1 = *reinterpret_cast<const bf16x8*>(Kh + (long)(32 + sr) * 512 + sc);
  P.mw = MASK[qrow * 64];
}
template <int VAR = 0>
__device__ __forceinline__ void dsa_attn_unit(int b, int g, int c, const bf16_t* __restrict__ Q, const bf16_t* __restrict__ K, const bf16_t* __restrict__ V,
                                              const unsigned long long* __restrict__ MASK, bf16_t* __restrict__ O, char* lds, DsaPre& P, bool has_next, int nb, int ng, int nc, unsigned* dstamp = nullptr) {
  int tid = threadIdx.x; asm volatile("" : "+v"(tid));
  const int wid = __builtin_amdgcn_readfirstlane(tid >> 6), lane = tid & 63, r32 = lane & 31, hi = lane >> 5;
  unsigned long long dta_ = 0, dacc_ = 0; (void)dta_;
  char* V_lds = lds; char* K_lds = lds + 3 * SHM_KV;
  float* ws = (float*)(lds + 6 * SHM_KV) + wid * 64; float* li_l = ws; float* al_l = ws + 32;
  const bool late = wid >= 4;
  const int head = 4 * g + (wid >> 1);
  const long qrow0 = (long)b * 4096 + 64 * c + 32 * (wid & 1), qrow = qrow0 + r32;
  if constexpr (VAR != 0) dsa_preload(P, b, g, c, Q, K, V, MASK);
  bf16x8 qr[8];
#pragma unroll
  for (int d0 = 0; d0 < 8; ++d0) qr[d0] = P.qr[d0];
  const int sr = tid >> 4, sc = (tid & 15) * 8, vst0 = v_st(sr, sc), vst1 = v_st(32 + sr, sc);
  const int vb0 = (int)(uintptr_t)V_lds + v_rd_base(lane);
  const bf16_t* Kh = K + (long)b * 4096 * 512 + g * 128; const bf16_t* Vh = V + (long)b * 4096 * 512 + g * 128;
  bf16x8 vs0, vs1, ks0, ks1;
#define SLOAD(k0) do { vs0 = *reinterpret_cast<const bf16x8*>(Vh + (long)((k0) + sr) * 512 + sc); vs1 = *reinterpret_cast<const bf16x8*>(Vh + (long)((k0) + 32 + sr) * 512 + sc); \
    ks0 = *reinterpret_cast<const bf16x8*>(Kh + (long)((k0) + sr) * 512 + sc); ks1 = *reinterpret_cast<const bf16x8*>(Kh + (long)((k0) + 32 + sr) * 512 + sc); } while (0)
#define SWRITE(bo) do { *(bf16x8*)(V_lds + (bo) + vst0) = vs0; *(bf16x8*)(V_lds + (bo) + vst1) = vs1; \
    *(bf16x8*)(K_lds + (bo) + KSWZ(sr, sc * 2)) = ks0; *(bf16x8*)(K_lds + (bo) + KSWZ(32 + sr, sc * 2)) = ks1; } while (0)
#define QKM() do { if constexpr (VAR < 4) qkt(p0, p1, K_lds + cur, qr, r32, hi);     \
    { const int mlo = (int)((unsigned)mw >> (4 * hi)), mhi = (int)((unsigned)(mw >> 32) >> (4 * hi)); \
      _Pragma("unroll") for (int r = 0; r < 16; ++r) { const int cb = (r & 3) + 8 * (r >> 2); \
        const unsigned t0_ = (unsigned)__builtin_amdgcn_sbfe(mlo, cb, 1), t1_ = (unsigned)__builtin_amdgcn_sbfe(mhi, cb, 1); \
        p0[r] = __uint_as_float((__float_as_uint(p0[r]) & t0_) | (~t0_ & 0xFF800000u)); p1[r] = __uint_as_float((__float_as_uint(p1[r]) & t1_) | (~t1_ & 0xFF800000u)); } } } while (0)
#define SMPV(vbo) do { if constexpr (VAR < 3) { float mn, alpha; partialSM<88388348>(p0, p1, m_reg, mn, alpha); \
    bf16x8 pa0, pa1, pa2, pa3; finishSM(p0, p1, alpha, l_reg, pa0, pa1, pa2, pa3); ATT_RESC(alpha); \
    if constexpr (VAR < 2) pv_d0(o, vb0 + (vbo), pa0, pa1, pa2, pa3); else { asm volatile("" :: "v"(pa0), "v"(pa1), "v"(pa2), "v"(pa3)); } } else { asm volatile("" : "+v"(p0), "+v"(p1)); } } while (0)
  const int NT = c + 1;
  float m_reg = -1e30f, l_reg = 0.f; f32x16 o[4];
#pragma unroll
  for (int d = 0; d < 4; ++d) o[d] = f32x16{};
  const unsigned long long* mrow = MASK + qrow * 64;
  vs0 = P.vs0; vs1 = P.vs1; ks0 = P.ks0; ks1 = P.ks1; SWRITE(0); if (NT > 1) SLOAD(64);
  unsigned long long mw = P.mw;
  f32x16 p0 = f32x16{}, p1 = f32x16{};
  int prv = 2 * SHM_KV, cur = 0, nxt = SHM_KV;
#define TILE_HEAD() __syncthreads(); if (j + 1 < NT) SWRITE(nxt); if (j + 2 < NT) SLOAD((j + 2) * 64); const unsigned long long mw_next = (j + 1 < NT) ? mrow[j + 1] : 0ull
#define TILE_TAIL() mw = mw_next; prv = cur; cur = nxt; nxt = (nxt == 2 * SHM_KV) ? 0 : nxt + SHM_KV
  if (!late) {
#if DSTAMP
    DST_A(5);
    for (int j = 0; j <= NT; ++j) {
      DST_A(1); __syncthreads(); DST_B(1);
      DST_A(6); if (j + 1 < NT) SWRITE(nxt); if (j + 2 < NT) SLOAD((j + 2) * 64); const unsigned long long mw_next = (j + 1 < NT) ? mrow[j + 1] : 0ull; DST_B(6);
      if (j < NT) { DST_A(2); QKM(); DST_B(2);
        DST_A(3); float mn, alpha; partialSM<88388348>(p0, p1, m_reg, mn, alpha); bf16x8 pa0, pa1, pa2, pa3; finishSM(p0, p1, alpha, l_reg, pa0, pa1, pa2, pa3); ATT_RESC(alpha); DST_B(3);
        DST_A(4); pv_d0(o, vb0 + cur, pa0, pa1, pa2, pa3); DST_B(4); }
      TILE_TAIL(); }
    DST_B(5);
#else
    for (int j = 0; j <= NT; ++j) { TILE_HEAD(); if (j < NT) { QKM(); SMPV(cur); } TILE_TAIL(); }
#endif
  } else {
    __builtin_amdgcn_s_setprio(LATE_PRIO);
#if DSTAMP
    DST_A(5);
    for (int j = 0; j <= NT; ++j) {
      DST_A(1); __syncthreads(); DST_B(1);
      DST_A(6); if (j + 1 < NT) SWRITE(nxt); if (j + 2 < NT) SLOAD((j + 2) * 64); const unsigned long long mw_next = (j + 1 < NT) ? mrow[j + 1] : 0ull; DST_B(6);
      if (j > 0) {
        DST_A(3); float mn, alpha; partialSM<88388348>(p0, p1, m_reg, mn, alpha); bf16x8 pa0, pa1, pa2, pa3; finishSM(p0, p1, alpha, l_reg, pa0, pa1, pa2, pa3); ATT_RESC(alpha); DST_B(3);
        DST_A(4); pv_d0(o, vb0 + prv, pa0, pa1, pa2, pa3); DST_B(4); }
      if (j < NT) { DST_A(2); QKM(); DST_B(2); }
      TILE_TAIL(); }
    DST_B(5);
#else
    for (int j = 0; j <= NT; ++j) { TILE_HEAD(); if (j > 0) SMPV(prv); if (j < NT) QKM(); TILE_TAIL(); }
#endif
    __builtin_amdgcn_s_setprio(0);
  }
#undef TILE_HEAD
#undef TILE_TAIL
  if (hi == 0) li_l[r32] = l_reg; asm volatile("s_waitcnt lgkmcnt(0)" ::: "memory");
  float rli[16];
#pragma unroll
  for (int r = 0; r < 16; ++r) rli[r] = __builtin_amdgcn_rcpf(li_l[crow(r, hi)]);
  __syncthreads();
  if constexpr (DSTAMP != 0) { if (dstamp && blockIdx.x == 0 && wid == DSTAMP_W && lane == 0) atomicAdd(dstamp, (unsigned)dacc_); }
  if constexpr (VAR == 0) { if (has_next) dsa_preload(P, nb, ng, nc, Q, K, V, MASK); }
  if constexpr (VAR == 0) store_o(o, rli, (bf16_t*)(lds + wid * 8192), O + qrow0 * 2048 + head * 128, 2048, lane, r32, hi); else { asm volatile("" :: "v"(o[0]), "v"(o[1]), "v"(o[2]), "v"(o[3]), "v"(rli[0]), "v"(l_reg), "v"(m_reg)); }
  __syncthreads();
#undef SLOAD
#undef SWRITE
#undef QKM
#undef SMPV
}

__device__ __forceinline__ void mla_attn_unit(int b, int h, int qb, const bf16_t* __restrict__ QN, const bf16_t* __restrict__ QR, const bf16_t* __restrict__ KN, const bf16_t* __restrict__ KR,
                                              const bf16_t* __restrict__ V, bf16_t* __restrict__ O, char* lds) {
  int tid = threadIdx.x; asm volatile("" : "+v"(tid));
  const int wid = __builtin_amdgcn_readfirstlane(tid >> 6), lane = tid & 63, r32 = lane & 31, hi = lane >> 5;
  char* V_lds = lds; char* K_lds = lds + 3 * SHM_KV; char* R_lds = lds + 6 * SHM_KV;
  float* ws = (float*)(lds + 6 * SHM_KV + 3 * 8192) + wid * 64; float* li_l = ws; float* al_l = ws + 32;
  const bool late = wid >= 4;
  const long qrow0 = (long)b * 4096 + 256 * qb + 32 * wid, qrow = qrow0 + r32;
  bf16x8 qr[12];
  { const bf16_t* Qw = QN + qrow * 2048 + h * 128 + hi * 8;
#pragma unroll
    for (int d0 = 0; d0 < 8; ++d0) qr[d0] = *reinterpret_cast<const bf16x8*>(Qw + d0 * 16);
    const bf16_t* Qx = QR + qrow * 1024 + h * 64 + hi * 8;
#pragma unroll
    for (int d0 = 0; d0 < 4; ++d0) qr[8 + d0] = *reinterpret_cast<const bf16x8*>(Qx + d0 * 16); }
  const int sr = tid >> 4, sc = (tid & 15) * 8, vst0 = v_st(sr, sc), vst1 = v_st(32 + sr, sc);
  const int rr_ = tid >> 3, rc = (tid & 7) * 8, rst = rr_ * 128 + ((rc * 2) ^ (((rr_ >> 1) & 7) << 4));
  const int vb0 = (int)(uintptr_t)V_lds + v_rd_base(lane);
  const bf16_t* Kh = KN + (long)b * 4096 * 2048 + h * 128; const bf16_t* Vh = V + (long)b * 4096 * 2048 + h * 128; const bf16_t* Rh = KR + (long)b * 4096 * 64;
  bf16x8 vs0, vs1, ks0, ks1, rs0;
#define SLOAD(k0) do { vs0 = *reinterpret_cast<const bf16x8*>(Vh + (long)((k0) + sr) * 2048 + sc); vs1 = *reinterpret_cast<const bf16x8*>(Vh + (long)((k0) + 32 + sr) * 2048 + sc); \
    ks0 = *reinterpret_cast<const bf16x8*>(Kh + (long)((k0) + sr) * 2048 + sc); ks1 = *reinterpret_cast<const bf16x8*>(Kh + (long)((k0) + 32 + sr) * 2048 + sc); \
    rs0 = *reinterpret_cast<const bf16x8*>(Rh + (long)((k0) + rr_) * 64 + rc); } while (0)
#define SWRITE(bo) do { *(bf16x8*)(V_lds + (bo) + vst0) = vs0; *(bf16x8*)(V_lds + (bo) + vst1) = vs1; \
    *(bf16x8*)(K_lds + (bo) + KSWZ(sr, sc * 2)) = ks0; *(bf16x8*)(K_lds + (bo) + KSWZ(32 + sr, sc * 2)) = ks1; \
    *(bf16x8*)(R_lds + ((bo) >> 1) + rst) = rs0; } while (0)
#define QKM() do { qkt<8>(p0, p1, K_lds + cur, qr, r32, hi); qkt_rope(p0, p1, R_lds + (cur >> 1), qr + 8, r32, hi); } while (0)
#define SMPV(vbo) do { float mn, alpha; partialSM<72168784>(p0, p1, m_reg, mn, alpha); \
    bf16x8 pa0, pa1, pa2, pa3; finishSM(p0, p1, alpha, l_reg, pa0, pa1, pa2, pa3); ATT_RESC(alpha); \
    pv_d0<false>(o, vb0 + (vbo), pa0, pa1, pa2, pa3); } while (0)
  const int NT = 4 * qb + 4, NTw = 4 * qb + (wid >> 1) + 1;
  float m_reg = -1e30f, l_reg = 0.f; f32x16 o[4];
#pragma unroll
  for (int d = 0; d < 4; ++d) o[d] = f32x16{};
  SLOAD(0); SWRITE(0); SLOAD(64);
  f32x16 p0 = f32x16{}, p1 = f32x16{};
  int prv = 2 * SHM_KV, cur = 0, nxt = SHM_KV;
#define TILE_HEAD() __syncthreads(); if (j + 1 < NT) SWRITE(nxt); if (j + 2 < NT) SLOAD((j + 2) * 64)
#define TILE_TAIL() prv = cur; cur = nxt; nxt = (nxt == 2 * SHM_KV) ? 0 : nxt + SHM_KV
  if (!late) {
    for (int j = 0; j <= NT; ++j) { TILE_HEAD(); if (j < NTw) { QKM(); SMPV(cur); } TILE_TAIL(); }
  } else {
    __builtin_amdgcn_s_setprio(LATE_PRIO);
    for (int j = 0; j <= NT; ++j) { TILE_HEAD(); if (j > 0 && j - 1 < NTw) SMPV(prv); if (j < NTw) QKM(); TILE_TAIL(); }
    __builtin_amdgcn_s_setprio(0);
  }
#undef TILE_HEAD
#undef TILE_TAIL
  if (hi == 0) li_l[r32] = l_reg; asm volatile("s_waitcnt lgkmcnt(0)" ::: "memory");
  float rli[16];
#pragma unroll
  for (int r = 0; r < 16; ++r) rli[r] = __builtin_amdgcn_rcpf(li_l[crow(r, hi)]);
  __syncthreads();
  store_o(o, rli, (bf16_t*)(lds + wid * 8192), O + qrow0 * 2048 + h * 128, 2048, lane, r32, hi);
  __syncthreads();
#undef SLOAD
#undef SWRITE
#undef QKM
#undef SMPV
}

__device__ __forceinline__ void sb_attn_unit(int b, int h, int qb, const bf16_t* __restrict__ Q, const bf16_t* __restrict__ K, const bf16_t* __restrict__ V, bf16_t* __restrict__ O, char* lds, unsigned* diag = nullptr) {
  int tid = threadIdx.x; asm volatile("" : "+v"(tid));
  const int wid = __builtin_amdgcn_readfirstlane(tid >> 6), lane = tid & 63, r32 = lane & 31, hi = lane >> 5;
  char* V_lds = lds; char* K_lds = lds + 2 * SHM_KV;
  volatile __attribute__((address_space(3))) int* fl = (volatile __attribute__((address_space(3))) int*)(lds + 4 * SHM_KV + 2048);
  const int tw0 = 256 * qb + 32 * wid, t = tw0 + r32;
  const long qrow0 = (long)b * 4096 + tw0, qrow = qrow0 + r32;
  bf16x8 qr[8];
  { const bf16_t* Qw = Q + qrow * 2048 + h * 128 + hi * 8;
#pragma unroll
    for (int d0 = 0; d0 < 8; ++d0) qr[d0] = *reinterpret_cast<const bf16x8*>(Qw + d0 * 16); }
  constexpr float C = 0.08838834764831845f * 1.4426950408889634f;
#pragma unroll
  for (int d0 = 0; d0 < 8; ++d0) { u32x4 w = *reinterpret_cast<u32x4*>(&qr[d0]);
#pragma unroll
    for (int k = 0; k < 4; ++k) w[k] = cvtpk(__uint_as_float(w[k] << 16) * C, __uint_as_float(w[k] & 0xffff0000u) * C);
    qr[d0] = *reinterpret_cast<bf16x8*>(&w); }
  const int sr = tid >> 4, sc = (tid & 15) * 8, vst0 = v_st(sr, sc), vst1 = v_st(32 + sr, sc);
  const int vb0 = (int)(uintptr_t)V_lds + v_rd_base(lane);
  const bf16_t* Kh = K + (long)b * 4096 * 2048 + h * 128; const bf16_t* Vh = V + (long)b * 4096 * 2048 + h * 128;
  bf16x8 vs0, vs1, ks0, ks1;
#define SLOAD(k0) do { vs0 = *reinterpret_cast<const bf16x8*>(Vh + (long)((k0) + sr) * 2048 + sc); vs1 = *reinterpret_cast<const bf16x8*>(Vh + (long)((k0) + 32 + sr) * 2048 + sc); \
    ks0 = *reinterpret_cast<const bf16x8*>(Kh + (long)((k0) + sr) * 2048 + sc); ks1 = *reinterpret_cast<const bf16x8*>(Kh + (long)((k0) + 32 + sr) * 2048 + sc); } while (0)
#define SWRITE(bf) do { *(bf16x8*)(V_lds + (bf) * SHM_KV + vst0) = vs0; *(bf16x8*)(V_lds + (bf) * SHM_KV + vst1) = vs1; \
    *(bf16x8*)(K_lds + (bf) * SHM_KV + KSWZ(sr, sc * 2)) = ks0; *(bf16x8*)(K_lds + (bf) * SHM_KV + KSWZ(32 + sr, sc * 2)) = ks1; } while (0)
  const int NT = 4 * qb + 4;
  float Rp = 1.f; bool wdone = false; f32x16 o[4];
#pragma unroll
  for (int d = 0; d < 4; ++d) o[d] = f32x16{};
  SLOAD((NT - 1) * 64); SWRITE(0); SLOAD((NT - 2) * 64);
  int j = 0;
  for (; j < NT; ++j) {
    __syncthreads();
    if (j > 0) { int all = 1;
#pragma unroll
      for (int w = 0; w < 8; ++w) all &= fl[((j - 1) & 1) * 8 + w];
      if (all) break; }
    if (j + 1 < NT) SWRITE((j + 1) & 1);
    if (j + 2 < NT) SLOAD((NT - 3 - j) * 64);
    const int T = NT - 1 - j;
    if (64 * T <= tw0 + 30 && !wdone) {
      f32x16 p0, p1; qkt(p0, p1, K_lds + (j & 1) * SHM_KV, qr, r32, hi);
      f32x16 k0, k1;
#define SB_SIG(P, K) do { const float e_ = __builtin_amdgcn_exp2f(-P), r_ = __builtin_amdgcn_rcpf(1.f + e_); P = r_; K = 1.f - r_; } while (0)
      if (64 * T + 63 >= tw0) {
#pragma unroll
        for (int r = 0; r < 16; ++r) { SB_SIG(p0[r], k0[r]); SB_SIG(p1[r], k1[r]);
          if (64 * T + crow(r, hi) >= t) { p0[r] = 0.f; k0[r] = 1.f; }
          if (64 * T + 32 + crow(r, hi) >= t) { p1[r] = 0.f; k1[r] = 1.f; } }
      } else {
#pragma unroll
        for (int r = 0; r < 16; ++r) { SB_SIG(p0[r], k0[r]); SB_SIG(p1[r], k1[r]); }
      }
#undef SB_SIG
      float GP[16];
#pragma unroll
      for (int q = 0; q < 4; ++q) {
        const float g0 = (k0[4 * q] * k0[4 * q + 1]) * (k0[4 * q + 2] * k0[4 * q + 3]), g1 = (k1[4 * q] * k1[4 * q + 1]) * (k1[4 * q + 2] * k1[4 * q + 3]);
        auto x0 = __builtin_amdgcn_permlane32_swap(__float_as_uint(g0), __float_as_uint(g0), false, false);
        auto x1 = __builtin_amdgcn_permlane32_swap(__float_as_uint(g1), __float_as_uint(g1), false, false);
        GP[2 * q] = __uint_as_float(x0[0]); GP[2 * q + 1] = __uint_as_float(x0[1]); GP[8 + 2 * q] = __uint_as_float(x1[0]); GP[8 + 2 * q + 1] = __uint_as_float(x1[1]);
      }
      float SG[16]; SG[15] = 1.f;
#pragma unroll
      for (int g = 14; g >= 0; --g) SG[g] = SG[g + 1] * GP[g + 1];
      const float tileprod = SG[0] * GP[0];
#pragma unroll
      for (int q = 0; q < 4; ++q) {
        { const float base = Rp * (hi ? SG[2 * q + 1] : SG[2 * q]); const float w2 = k0[4 * q + 3], w1 = w2 * k0[4 * q + 2], w0 = w1 * k0[4 * q + 1];
          p0[4 * q + 3] *= base; p0[4 * q + 2] *= base * w2; p0[4 * q + 1] *= base * w1; p0[4 * q] *= base * w0; }
        { const float base = Rp * (hi ? SG[8 + 2 * q + 1] : SG[8 + 2 * q]); const float w2 = k1[4 * q + 3], w1 = w2 * k1[4 * q + 2], w0 = w1 * k1[4 * q + 1];
          p1[4 * q + 3] *= base; p1[4 * q + 2] *= base * w2; p1[4 * q + 1] *= base * w1; p1[4 * q] *= base * w0; }
      }
      Rp *= tileprod;
      bf16x8 pa0, pa1, pa2, pa3; packP(p0, p1, pa0, pa1, pa2, pa3);
      pv_d0(o, vb0 + (j & 1) * SHM_KV, pa0, pa1, pa2, pa3);
      wdone = __all(Rp == 0.f);
    }
    if (lane == 0) fl[(j & 1) * 8 + wid] = wdone ? 1 : 0;
  }
  if (diag && tid == 0) atomicAdd(diag, (unsigned)j);
  float rli[16];
#pragma unroll
  for (int r = 0; r < 16; ++r) rli[r] = 1.f;
  __syncthreads();
  store_o(o, rli, (bf16_t*)(lds + wid * 8192), O + qrow0 * 2048 + h * 128, 2048, lane, r32, hi);
  __syncthreads();
#undef SLOAD
#undef SWRITE
}

__device__ __forceinline__ void idx_unit(int b, int qq, const bf16_t* __restrict__ IQ, const bf16_t* __restrict__ IK, const float* __restrict__ IW, float* __restrict__ SC, char* lds) {
  int tid = threadIdx.x; asm volatile("" : "+v"(tid));
  const int wid = __builtin_amdgcn_readfirstlane(tid >> 6), lane = tid & 63, r32 = lane & 31, hi = lane >> 5;
  char* K_lds = lds;
  const int c = qq >> 1, NT = c + 1;
  const long t0 = (long)b * 4096 + 32 * qq + 4 * wid;
  bf16x8 a[2][8]; float wgt[2][16];
#pragma unroll
  for (int rt = 0; rt < 2; ++rt) {
    const long qa = t0 + 2 * rt + ((r32 >> 2) & 1); const int ha = (r32 & 3) + 4 * (r32 >> 3);
    const bf16_t* p = IQ + qa * 2048 + ha * 128 + hi * 8;
#pragma unroll
    for (int ks = 0; ks < 8; ++ks) a[rt][ks] = *reinterpret_cast<const bf16x8*>(p + ks * 16);
    const float* wp = IW + (t0 + 2 * rt + hi) * 16;
#pragma unroll
    for (int i4 = 0; i4 < 4; ++i4) { const f32x4 w4 = *(const f32x4*)(wp + 4 * i4); wgt[rt][4 * i4] = w4[0]; wgt[rt][4 * i4 + 1] = w4[1]; wgt[rt][4 * i4 + 2] = w4[2]; wgt[rt][4 * i4 + 3] = w4[3]; }
  }
  const int sr = tid >> 4, sc = (tid & 15) * 8;
  const bf16_t* Kb = IK + (long)b * 4096 * 128;
  bf16x8 ks0, ks1;
#define SLOAD(k0) do { ks0 = *reinterpret_cast<const bf16x8*>(Kb + (long)((k0) + sr) * 128 + sc); ks1 = *reinterpret_cast<const bf16x8*>(Kb + (long)((k0) + 32 + sr) * 128 + sc); } while (0)
#define SWRITE(bf) do { *(bf16x8*)(K_lds + (bf) * SHM_KV + KSWZ(sr, sc * 2)) = ks0; *(bf16x8*)(K_lds + (bf) * SHM_KV + KSWZ(32 + sr, sc * 2)) = ks1; } while (0)
  SLOAD(0); SWRITE(0); if (NT > 1) SLOAD(64);
  for (int j = 0; j < NT; ++j) {
    __syncthreads();
    if (j + 1 < NT) SWRITE((j + 1) & 1);
    if (j + 2 < NT) SLOAD((j + 2) * 64);
    const char* Kt = K_lds + (j & 1) * SHM_KV;
#pragma unroll
    for (int kh = 0; kh < 2; ++kh) {
      bf16x8 bfr[8];
#pragma unroll
      for (int ks = 0; ks < 8; ++ks) bfr[ks] = *reinterpret_cast<const bf16x8*>(Kt + KSWZ(32 * kh + r32, (ks * 16 + hi * 8) * 2));
#pragma unroll
      for (int rt = 0; rt < 2; ++rt) {
        f32x16 acc = f32x16{};
#pragma unroll
        for (int ks = 0; ks < 8; ++ks) acc = __builtin_amdgcn_mfma_f32_32x32x16_bf16(a[rt][ks], bfr[ks], acc, 0, 0, 0);
        float s = 0.f;
#pragma unroll
        for (int i = 0; i < 16; ++i) s += wgt[rt][i] * fmaxf(acc[i], 0.f);
        SC[(t0 + 2 * rt + hi) * 4096 + 64 * j + 32 * kh + r32] = s;
      }
    }
  }
  asm volatile("s_waitcnt vmcnt(0)" ::: "memory");
  __syncthreads();
#undef SLOAD
#undef SWRITE
}

__device__ __forceinline__ int wave_sum_i(int v) {
#pragma unroll
  for (int o = 1; o < 64; o <<= 1) v += __shfl_xor(v, o);
  return v;
}
__device__ __forceinline__ unsigned f2key(float v) { const unsigned u = __float_as_uint(v); return (u & 0x80000000u) ? ~u : (u | 0x80000000u); }
__device__ __forceinline__ float key2f(unsigned k) { return __uint_as_float((k & 0x80000000u) ? (k & 0x7fffffffu) : ~k); }
__device__ __forceinline__ float wave_sum_f(float v) {
#pragma unroll
  for (int o = 1; o < 64; o <<= 1) v += __shfl_xor(v, o);
  return v;
}
typedef __attribute__((address_space(3))) unsigned las_u32;
__device__ __forceinline__ void topk_prefetch(const float* __restrict__ sc_row, int c, las_u32* buf, int lane) {
#pragma unroll
  for (int g4 = 0; g4 < 4; ++g4) {
    if (16 * g4 <= c) {
#pragma unroll
      for (int p = 4 * g4; p < 4 * g4 + 4; ++p) __builtin_amdgcn_global_load_lds((const unsigned*)(sc_row + p * 256 + lane * 4), buf + p * 256, 16, 0, 0);
    }
  }
}
__device__ __forceinline__ void topk_fetch(const las_u32* buf, int c, unsigned (&raw)[64], int lane) {
  asm volatile("s_waitcnt vmcnt(0)" ::: "memory");
#pragma unroll
  for (int g4 = 0; g4 < 4; ++g4) {
    if (16 * g4 <= c) {
#pragma unroll
      for (int j = 16 * g4; j < 16 * g4 + 16; ++j) raw[j] = buf[j * 64 + lane];
    } else {
#pragma unroll
      for (int j = 16 * g4; j < 16 * g4 + 16; ++j) raw[j] = 0u;
    }
  }
  asm volatile("s_waitcnt lgkmcnt(0)" ::: "memory");
}
__device__ __forceinline__ void topk_row(const unsigned (&raw)[64], int c, unsigned long long* __restrict__ mask_row, int lane) {
  unsigned key[64];
  int cv = c; asm volatile("" : "+v"(cv));
#pragma unroll
  for (int j = 0; j < 64; ++j) key[j] = raw[j];
  float s1 = 0.f, s2 = 0.f;
#pragma unroll
  for (int j = 0; j < 64; ++j) { const unsigned u = key[j]; const float v = (j <= cv) ? __uint_as_float(u) : 0.f; s1 += v; s2 = fmaf(v, v, s2);
    const unsigned k = (u & 0x80000000u) ? ~u : (u | 0x80000000u); key[j] = (j <= cv) ? k : 0u; }
  unsigned long long mine = 0ull; unsigned mlo = 0u, mhi = 0u;
  if (c < 4) {
    mine = (lane <= c) ? ~0ull : 0ull;
  } else {
    const float fN = (float)(64 * (c + 1));
    const float mean = __int_as_float(__builtin_amdgcn_readfirstlane(__float_as_int(wave_sum_f(s1)))) / fN;
    const float ex2 = __int_as_float(__builtin_amdgcn_readfirstlane(__float_as_int(wave_sum_f(s2)))) / fN;
    const float sd = sqrtf(fmaxf(ex2 - mean * mean, 1e-30f));
    float T;
    { const float q = 0.5f - 256.f / fN, r = q * q;
      const float num = (((((-3.969683028665376e+01f * r + 2.209460984245205e+02f) * r - 2.759285104469687e+02f) * r + 1.383577518672690e+02f) * r - 3.066479806614716e+01f) * r + 2.506628277459239e+00f) * q;
      const float den = ((((-5.447609879822406e+01f * r + 1.615858368580409e+02f) * r - 1.556989798598866e+02f) * r + 6.680131188771972e+01f) * r - 1.328068155288572e+01f) * r + 1.f;
      T = mean + (num / den) * sd; }
    unsigned Klo = 1u, Khi = 0xFFFFFFFFu; int clo = 64 * (c + 1), chi = 0; bool exact = false; unsigned Tk = 0u;
    for (int it = 0; it < 128; ++it) {
      unsigned cand = f2key(T);
      if (!(cand > Klo && cand < Khi) || (it % 3) == 2) cand = Klo + ((Khi - Klo) >> 1);
      cand = (unsigned)__builtin_amdgcn_readfirstlane((int)cand);
      if (cand == Klo) break;
      int cnt = 0;
#pragma unroll
      for (int g8 = 0; g8 < 8; ++g8) {
        if (8 * g8 <= c) {
#pragma unroll
          for (int j = 8 * g8; j < 8 * g8 + 8; ++j) cnt += __builtin_popcountll(__ballot(key[j] >= cand));
        }
        ATT_SBAR();
      }
      if (cnt == 256) { exact = true; Tk = cand; break; }
      const float Tc = key2f(cand);
      if (cnt > 256) { Klo = cand; clo = cnt; } else { Khi = cand; chi = cnt; }
      if (Klo != 1u && Khi != 0xFFFFFFFFu) {
        const float flo = key2f(Klo), fhi = key2f(Khi);
        T = flo + (fhi - flo) * (((float)(clo - 256) - 0.5f) / (float)(clo - chi));
      } else {
        const float z = (Tc - mean) / sd, dens = fN * 0.3989423f * __expf(-0.5f * z * z) / sd;
        T = Tc + 1.3f * (float)(cnt - 256) / fmaxf(dens, 1e-3f * fN / sd);
      }
    }
    if (!exact) Tk = Klo;
    asm volatile("" : "+v"(Tk));
    if (exact) {
#pragma unroll
      for (int j = 0; j < 64; ++j) { const unsigned long long m = __ballot(key[j] >= Tk);
        asm volatile("s_nop 3\n\tv_writelane_b32 %0, %2, %4\n\tv_writelane_b32 %1, %3, %4" : "+v"(mlo), "+v"(mhi) : "s"((unsigned)m), "s"((unsigned)(m >> 32)), "i"(j));     ATT_SBAR(); }
    } else {
      int gt = 0;
#pragma unroll
      for (int g8 = 0; g8 < 8; ++g8) {
#pragma unroll
        for (int j = 8 * g8; j < 8 * g8 + 8; ++j) gt += __builtin_popcountll(__ballot(key[j] > Tk));
        ATT_SBAR();
      }
      int need = 256 - gt;
      asm volatile("" : "+v"(Tk));
#pragma unroll
      for (int j = 0; j < 64; ++j) {
        const unsigned long long g = __ballot(key[j] > Tk); unsigned long long e = __ballot(key[j] == Tk), take = 0ull;
        const int pe = __popcll(e);
        if (pe <= need) { take = e; need -= pe; } else { while (need > 0) { const unsigned long long lowb = e & (~e + 1ull); take |= lowb; e ^= lowb; --need; } }
        const unsigned long long m = g | take;
        asm volatile("s_nop 3\n\tv_writelane_b32 %0, %2, %4\n\tv_writelane_b32 %1, %3, %4" : "+v"(mlo), "+v"(mhi) : "s"((unsigned)m), "s"((unsigned)(m >> 32)), "i"(j));
        ATT_SBAR();
      }
    }
  }
  if (c >= 4) mine = (unsigned long long)mlo | ((unsigned long long)mhi << 32);
  mask_row[lane] = mine;
}
#undef KSWZ
}

constexpr int NWAVES = 8;
constexpr int BATCH = 4, SEQ = 4096, DM = 2048, DFF = 5632, M = BATCH * SEQ;
constexpr int DSA_NP = 5376, MLA_DOWN_NP = 1280;
constexpr int NPH = 26;
#ifndef MK_ONE_LAUNCH
#define MK_ONE_LAUNCH 1
#endif
constexpr size_t MiB = 1u << 20;
constexpr size_t WS_CTL = 0, CTL_ZERO_BYTES = 1 * MiB;
constexpr size_t WS_MODS = 1 * MiB;
constexpr size_t WS_CS128 = 2 * MiB;
constexpr size_t WS_CS64 = 4 * MiB;
constexpr size_t WS_SSQ = 5 * MiB;
constexpr size_t WS_W = 6 * MiB;
constexpr size_t WL_STRIDE = 74 * MiB, WL_FFN1 = 0, WL_FFN2 = 44 * MiB, WL_OUT = 66 * MiB;
constexpr size_t WS_WDSA = WS_W + 4 * WL_STRIDE, WDSA_STRIDE = 21 * MiB;
constexpr size_t WS_WMLA = WS_WDSA + 2 * WDSA_STRIDE, WMLA_DOWN = 0, WMLA_UQ = 5 * MiB, WMLA_UKV = 8 * MiB;
constexpr size_t WS_WSB = WS_WMLA + 12 * MiB;
constexpr size_t WS_H = WS_WSB + 24 * MiB;
constexpr size_t WS_O = WS_H + 64 * MiB;
constexpr size_t WS_MIX = WS_O + 64 * MiB;
constexpr size_t MX_ACT = 0;
constexpr size_t MX_DQ = 0, MX_DK = 64 * MiB, MX_DV = 80 * MiB, MX_DIQ = 96 * MiB, MX_DIK = 160 * MiB, MX_DIW = 164 * MiB, MX_DMASK = 165 * MiB, MX_DSC = 176 * MiB;
constexpr size_t MX_MCQ = 0, MX_MCKV = 16 * MiB, MX_MKR = 32 * MiB, MX_MQN = 34 * MiB, MX_MQR = 98 * MiB, MX_MKN = 130 * MiB, MX_MV = 194 * MiB;
constexpr size_t MX_SQ = 0, MX_SK = 64 * MiB, MX_SV = 128 * MiB;
constexpr size_t WS_SSX = WS_MIX + 432 * MiB;
constexpr size_t WS_BIAS = WS_SSX + 1 * MiB;
constexpr size_t BIAS_DSA0 = 0, BIAS_DSA1 = 4 * 5376, BIAS_MLA = 8 * 5376, BIAS_SB = BIAS_MLA + 4 * 1280, BIAS_FFN = BIAS_SB + 4 * 6144;
static_assert((BIAS_FFN + 4 * 4 * 11264) * 4 <= 1 * MiB, "bias rows fit 1 MiB");
constexpr size_t WS_XB = WS_BIAS + 1 * MiB;
constexpr size_t WS_END = WS_XB + 64 * MiB;
static_assert(WS_W + 380 * MiB - 6 * MiB == WS_H, "weight map");
constexpr int CW_TMO = 0, CW_BAR = 4096;
constexpr int RING_BYTES = 131072, LDSCTL_OFF = RING_BYTES, MISC_OFF = LDSCTL_OFF + 320, EPI_PART_OFF = RING_BYTES + 1024  , EPI_TAB_OFF = RING_BYTES + 6144  , LDS_BYTES = 147456;

#define GAS __attribute__((address_space(1)))
#define LAS __attribute__((address_space(3)))
typedef unsigned short bf16;
typedef unsigned v4u __attribute__((ext_vector_type(4)));
typedef float f32x4 __attribute__((ext_vector_type(4)));
typedef GAS unsigned gu32;
#define RLX_AGENT __ATOMIC_RELAXED, __HIP_MEMORY_SCOPE_AGENT
#define LDS_WAIT() asm volatile("s_waitcnt lgkmcnt(0)" ::: "memory")
__device__ __forceinline__ unsigned f2bf(float f) { unsigned u = __builtin_bit_cast(unsigned, f); return (u + 0x7fffu + ((u >> 16) & 1u)) >> 16; }
__device__ __forceinline__ unsigned pk2(float lo, float hi) { return f2bf(lo) | (f2bf(hi) << 16); }

#define XB_TMO      128
#define XB_XCNT(j)  (256  + 64 * (j))
#define XB_XSUB(j)  (1280 + 64 * (j))
#define XB_XGEN(j)  (2304 + 64 * (j))
#define XB_TOP      3328
#define XB_TOPGEN   3392
#define XCD_BAR_WORDS 3456
#define XB_SPIN_CAP (1u << 18)

__device__ __forceinline__ unsigned xb_ld(unsigned* p)              { return __hip_atomic_load(p, __ATOMIC_RELAXED, __HIP_MEMORY_SCOPE_AGENT); }
__device__ __forceinline__ unsigned xb_add(unsigned* p, unsigned v) { return __hip_atomic_fetch_add(p, v, __ATOMIC_RELAXED, __HIP_MEMORY_SCOPE_AGENT); }
__device__ __forceinline__ unsigned xb_xcc_id() { return (unsigned)__builtin_amdgcn_s_getreg((3 << 11) | 20) & 0xFu; }
#define XB_SPIN(cond, bar) do { unsigned _sp = 0; while (cond) { __builtin_amdgcn_s_sleep(1); \
    if ((++_sp & 255u) == 0u) { if (xb_ld(&(bar)[XB_TMO])) break; if (_sp > XB_SPIN_CAP) { atomicAdd(&(bar)[XB_TMO], 1u); break; } } } } while (0)

struct XcdBarrier {
    unsigned* bar; unsigned x;
    volatile LAS unsigned* st;
};

__device__ __forceinline__ XcdBarrier xcd_barrier_post(unsigned* bar, volatile LAS unsigned* st) {
    XcdBarrier b; b.bar = bar; b.x = xb_xcc_id(); b.st = st;
    if (threadIdx.x == 0) (void)xb_add(&bar[XB_XCNT(b.x)], 1u);
    return b;
}
__device__ __forceinline__ void xcd_barrier_complete(unsigned* bar, unsigned x, unsigned& nloc, unsigned& nx) {
    const unsigned G = gridDim.x * gridDim.y * gridDim.z;
    unsigned sum, cnt, mine, sp = 0u;
    for (;;) {
        sum = 0u; cnt = 0u; mine = 0u;
#pragma unroll
        for (unsigned j = 0; j < 16; ++j) { const unsigned c = xb_ld(&bar[XB_XCNT(j)]); sum += c; cnt += (c > 0u) ? 1u : 0u; mine = (j == x) ? c : mine; }
        if (sum == G) break;
        __builtin_amdgcn_s_sleep(1);
        if ((++sp & 255u) == 0u) { if (xb_ld(&bar[XB_TMO])) break; if (sp > XB_SPIN_CAP) { atomicAdd(&bar[XB_TMO], 1u); break; } }
    }
    nloc = mine > 0u ? mine : 1u; nx = cnt > 0u ? cnt : 1u;
}

__device__ __forceinline__ void xcd_barrier(const XcdBarrier& b) {
    asm volatile("s_waitcnt vmcnt(0)" ::: "memory");
    __syncthreads();
    if (threadIdx.x == 0) {
        unsigned* bar = b.bar;
        __builtin_amdgcn_s_waitcnt(0);
        unsigned nloc = b.st[0], nx = b.st[1];
        if (nloc == 0u) { xcd_barrier_complete(bar, b.x, nloc, nx); b.st[0] = nloc; b.st[1] = nx; }
        const unsigned old = xb_add(&bar[XB_XSUB(b.x)], 1u);
        const unsigned gen = old / nloc;
        if (old + 1u == (gen + 1u) * nloc) {
            __builtin_amdgcn_fence(__ATOMIC_RELEASE, "agent");
            asm volatile("s_waitcnt vmcnt(0)" ::: "memory");
            const unsigned og = xb_add(&bar[XB_TOP], 1u);
            const unsigned tg = og / nx;
            if (og + 1u == (tg + 1u) * nx) xb_add(&bar[XB_TOPGEN], 1u);
            else XB_SPIN(xb_ld(&bar[XB_TOPGEN]) == tg, bar);
            __builtin_amdgcn_fence(__ATOMIC_ACQUIRE, "agent");
            xb_add(&bar[XB_XGEN(b.x)], 1u);
            asm volatile("s_waitcnt vmcnt(0)" ::: "memory");
        } else {
            XB_SPIN(xb_ld(&bar[XB_XGEN(b.x)]) == gen, bar);
            __builtin_amdgcn_fence(__ATOMIC_ACQUIRE, "agent");
            asm volatile("s_waitcnt vmcnt(0)" ::: "memory");
        }
    }
    __syncthreads();
}


struct Frame {
    LAS unsigned char* lds;
    volatile LAS unsigned* MISC;
    gu32* ctl;
    int tid, lane, wave;
    int vcu, G;
};
__device__ __forceinline__ float wave_sum(float v) {
#pragma unroll
    for (int o = 1; o < 64; o <<= 1) v += __shfl_xor(v, o);
    return v;
}
enum { KIND_ID = 0, KIND_DSA_IN = 1, KIND_MLA_DOWN = 2, KIND_MLA_UQ = 3, KIND_FFN1 = 4 };
__host__ __device__ __forceinline__ int srcblk(int kind, int nb, int& nvalid) {
    nvalid = 32;
    const int pn = nb >> 3, pb = nb & 7, bj = pb >> 2, wc = pb & 3;
    if (kind == KIND_ID) return nb * 32;
    if (kind == KIND_DSA_IN) {
        if (pn < 8)  return (2 * pn + (wc >> 1)) * 128 + 64 * bj + 32 * (wc & 1);
        if (pn < 10) return 2048 + (2 * (pn - 8) + (wc >> 1)) * 128 + 64 * bj + 32 * (wc & 1);
        if (pn < 12) return 2560 + (pn - 10) * 256 + 32 * pb;
        if (pn < 20) return 3072 + (2 * (pn - 12) + (wc >> 1)) * 128 + (wc & 1) * 64 + bj * 32;
        if (wc == 0) return 5120 + bj * 32;
        if (wc == 1) return 5120 + 64 + bj * 32;
        if (wc == 2 && bj == 0) { nvalid = 16; return 5248; }
        return -1;
    }
    if (kind == KIND_MLA_DOWN) { if (pn < 4) return nb * 32; if (wc == 0) return 1024 + 32 * bj; return -1; }
    if (kind == KIND_MLA_UQ) { if (pn < 8) return (2 * pn + bj) * 192 + 32 * wc; return (4 * (pn - 8) + wc) * 192 + 128 + 32 * bj; }
      return (bj ? 5632 : 0) + 128 * pn + 32 * wc;
}
__device__ __forceinline__ void conv_item(const float* __restrict__ W, int K, int Nsrc, int Nphys, int kind, const float* __restrict__ gk, bf16* __restrict__ WT, LAS unsigned* scr, int item, int lane) {
    const int nblk = Nphys / 64, kb = item / nblk, ib = item % nblk, k0 = 64 * kb, n0 = 64 * ib;
    const int c4 = lane & 15, kr = lane >> 4;
    int nvalid; const int sb = srcblk(kind, 2 * ib + (c4 >> 3), nvalid);
    const int col = 4 * (c4 & 7);
    const bool valid = (sb >= 0) && (col < nvalid);
    const float* src = W + (size_t)(k0 + 2 * kr) * Nsrc + (valid ? sb + col : 0);
    f32x4 va[8], vb[8];
#pragma unroll
    for (int kk = 0; kk < 8; ++kk) { va[kk] = *(const GAS f32x4*)(src + (size_t)(8 * kk) * Nsrc); vb[kk] = *(const GAS f32x4*)(src + (size_t)(8 * kk + 1) * Nsrc); }
    if (gk) {
#pragma unroll
        for (int kk = 0; kk < 8; ++kk) { va[kk] *= gk[k0 + 8 * kk + 2 * kr]; vb[kk] *= gk[k0 + 8 * kk + 2 * kr + 1]; } }
    if (!valid) {
#pragma unroll
        for (int kk = 0; kk < 8; ++kk) { va[kk] = (f32x4){0.f, 0.f, 0.f, 0.f}; vb[kk] = (f32x4){0.f, 0.f, 0.f, 0.f}; } }
#pragma unroll
    for (int kk = 0; kk < 8; ++kk)
#pragma unroll
        for (int i = 0; i < 4; ++i) scr[(4 * c4 + i) * 33 + 4 * kk + kr] = pg8::cvt_pk_bf16(va[kk][i], vb[kk][i]);
    LDS_WAIT(); asm volatile("" ::: "memory");
    const int c = lane & 7;
#pragma unroll
    for (int j = 0; j < 8; ++j) { const int n = (lane >> 3) + 8 * j; const LAS unsigned* s = scr + n * 33 + 4 * c;
        v4u o; o.x = s[0]; o.y = s[1]; o.z = s[2]; o.w = s[3];
        *(GAS v4u*)(WT + (size_t)(n0 + n) * K + k0 + 8 * c) = o; }
    LDS_WAIT(); asm volatile("" ::: "memory");
}
__device__ __forceinline__ void cs_entry(int pos, int i, const double* rp  , float& co, float& si) {
    double inv = 1.0;
#pragma unroll
    for (int k = 0; k < 6; ++k) if ((i >> k) & 1) inv *= rp[k];
    const double a = (double)pos * inv;
    const double n = __builtin_rint(a * 0.63661977236758134308);
    double y = a - n * 1.5707963267948966; y -= n * 6.123233995736766e-17;
    const double y2 = y * y;
    double s = -7.6471637318198164759e-13;
    s = s * y2 + 1.6059043836821614599e-10; s = s * y2 - 2.5052108385441718775e-08; s = s * y2 + 2.7557319223985890653e-06; s = s * y2 - 1.9841269841269841270e-04;
    s = s * y2 + 8.3333333333333333333e-03; s = s * y2 - 1.6666666666666666667e-01; s = y + y * y2 * s;
    double c = 4.7794773323873852974e-14;
    c = c * y2 - 1.1470745597729724714e-11; c = c * y2 + 2.0876756987868098979e-09; c = c * y2 - 2.7557319223985890653e-07; c = c * y2 + 2.4801587301587301587e-05;
    c = c * y2 - 1.3888888888888888889e-03; c = c * y2 + 4.1666666666666666667e-02; c = c * y2 - 0.5; c = 1.0 + y2 * c;
    const int q = ((int)n) & 3;
    const double cc = (q == 0) ? c : (q == 1) ? -s : (q == 2) ? -c : s;
    const double ss = (q == 0) ? s : (q == 1) ? c : (q == 2) ? -s : -c;
    co = (float)cc; si = (float)ss;
}
__device__ __forceinline__ void modnorm_phase(const Frame& F0, const float* __restrict__ x, const float* __restrict__ g, const float* __restrict__ mods_l, int sh_off, int sc_off, bf16* __restrict__ H) {
    int tid_ = threadIdx.x; asm volatile("" : "+v"(tid_)); struct { int lane, wave, vcu, G; } F{tid_ & 63, __builtin_amdgcn_readfirstlane(tid_ >> 6), F0.vcu, F0.G};
    const int gw = F.vcu * NWAVES + F.wave, NGW = F.G * NWAVES;
    for (int m = gw; m < M; m += NGW) {
        const GAS f32x4* xr = (const GAS f32x4*)(x + (size_t)m * DM) + F.lane;
        f32x4 v[8]; float s = 0.f;
#pragma unroll
        for (int j = 0; j < 8; ++j) { v[j] = xr[64 * j]; s += (v[j].x * v[j].x + v[j].y * v[j].y) + (v[j].z * v[j].z + v[j].w * v[j].w); }
        const float rstd = 1.0f / sqrtf(wave_sum(s) * (1.0f / DM) + 1e-6f);
        const float* mb = mods_l + (size_t)(m >> 12) * 12288;
        GAS unsigned long long* o8 = (GAS unsigned long long*)(H + (size_t)m * DM) + F.lane;
#pragma unroll
        for (int j = 0; j < 8; ++j) { const int col = 256 * j + 4 * F.lane;
            const f32x4 g4 = *(const f32x4*)(g + col), sc4 = *(const f32x4*)(mb + sc_off + col), sh4 = *(const f32x4*)(mb + sh_off + col);
            const f32x4 r = v[j] * rstd * g4 * (sc4 + 1.0f) + sh4;
            o8[64 * j] = (unsigned long long)pk2(r.x, r.y) | ((unsigned long long)pk2(r.z, r.w) << 32); }
    }
}
__device__ __forceinline__ void finalnorm_phase(const Frame& F0, const bf16* __restrict__ xb, float* __restrict__ out, const float* __restrict__ g) {
    int tid_ = threadIdx.x; asm volatile("" : "+v"(tid_)); struct { int lane, wave, vcu, G; } F{tid_ & 63, __builtin_amdgcn_readfirstlane(tid_ >> 6), F0.vcu, F0.G};
    const int gw = F.vcu * NWAVES + F.wave, NGW = F.G * NWAVES;
    for (int m = gw; m < M; m += NGW) {
        const GAS v4u* xr = (const GAS v4u*)(xb + (size_t)m * DM) + F.lane;
        v4u w[4]; float s = 0.f; float v[4][8];
#pragma unroll
        for (int j = 0; j < 4; ++j) w[j] = xr[64 * j];
#pragma unroll
        for (int j = 0; j < 4; ++j)
#pragma unroll
            for (int e = 0; e < 4; ++e) { const unsigned d = w[j][e]; v[j][2 * e] = __uint_as_float(d << 16); v[j][2 * e + 1] = __uint_as_float(d & 0xffff0000u); s += v[j][2 * e] * v[j][2 * e] + v[j][2 * e + 1] * v[j][2 * e + 1]; }
        const float rstd = 1.0f / sqrtf(wave_sum(s) * (1.0f / DM) + 1e-6f);
        GAS f32x4* orow = (GAS f32x4*)(out + (size_t)m * DM);
#pragma unroll
        for (int j = 0; j < 4; ++j) { const int col = 8 * (F.lane + 64 * j); const f32x4 g0 = *(const f32x4*)(g + col), g1 = *(const f32x4*)(g + col + 4);
            orow[col / 4] = (f32x4){v[j][0], v[j][1], v[j][2], v[j][3]} * rstd * g0; orow[col / 4 + 1] = (f32x4){v[j][4], v[j][5], v[j][6], v[j][7]} * rstd * g1; }
    }
}

#ifndef SITE_MASK
#define SITE_MASK 0xFFFFu
#endif
#define SITE(s_) ((((unsigned)(SITE_MASK)) >> (s_)) & 1u)
#ifndef DIAG
#define DIAG 0
#endif
#ifndef DIAG_K0
#define DIAG_K0 0
#define DIAG_K1 1
#define DIAG_DIV 4.0f
#endif
#ifndef DIAG_SEL
#define DIAG_SEL 0
#endif
#define DIAG_PTR (DIAG ? (unsigned*)(ARG_WS + WS_CTL) + 2048 : (unsigned*)nullptr)
#ifndef REP_VAR
#define REP_VAR 0
#endif
#ifndef P0_REP
#define P0_REP 0
#endif
#ifndef REPEAT_MASK
#define REPEAT_MASK 0u
#endif
#define NREP(s_) (1 + (int)((((unsigned)(REPEAT_MASK)) >> (s_)) & 1u))
#define IN(k) (LO <= (k) && (k) < HI)
#if DIAG == 2
#define SEAM(k) do { if constexpr (IN(k) && IN((k) + 1)) { if (threadIdx.x == 0) { const unsigned long long t_ = __builtin_amdgcn_s_memrealtime(); \
        __hip_atomic_fetch_max((unsigned long long*)(ARG_WS + WS_CTL + 0x9000) + (k), t_, __ATOMIC_RELAXED, __HIP_MEMORY_SCOPE_AGENT); \
        __hip_atomic_fetch_max((unsigned long long*)(ARG_WS + WS_CTL + 0xA000) + (k), (1ull << 62) - t_, __ATOMIC_RELAXED, __HIP_MEMORY_SCOPE_AGENT); } \
      xcd_barrier(bar); } if (blockIdx.x == 0 && threadIdx.x == 0) ((unsigned long long*)(ARG_WS + WS_CTL + 0x8000))[(k) + 1] = __builtin_amdgcn_s_memrealtime(); } while (0)
#else
#define SEAM(k) do { if constexpr (IN(k) && IN((k) + 1)) xcd_barrier(bar); } while (0)
#endif
struct Args { const float* in[39]; float* out; unsigned char* ws; int ph_lo, ph_hi, li, pad; };
static_assert(offsetof(Args, out) == 39 * 8 && offsetof(Args, ws) == 40 * 8 && offsetof(Args, li) == 84 * 4, "kernarg layout");
typedef const float* __attribute__((address_space(4))) const* kargp_t;
#define ARG_IN(i_) (((kargp_t)__builtin_amdgcn_kernarg_segment_ptr())[(i_)])
#define ARG_OUT ((float*)((kargp_t)__builtin_amdgcn_kernarg_segment_ptr())[39])
#define ARG_WS ((unsigned char*)((kargp_t)__builtin_amdgcn_kernarg_segment_ptr())[40])
#define ARG_LI (((const int __attribute__((address_space(4)))*)__builtin_amdgcn_kernarg_segment_ptr())[84])

__device__ __forceinline__ void bias_item(const bf16* __restrict__ WT, int nrows, float* __restrict__ out, int r32item, const LAS float* shl, int wave, int lane) {
    const int n0 = 32 * r32item + 4 * wave;
    const GAS v4u* wp = (const GAS v4u*)(WT + (size_t)n0 * DM) + lane;
    v4u w[16];
#pragma unroll
    for (int j = 0; j < 16; ++j) w[j] = wp[64 * j];
    float acc[4][4];
#pragma unroll
    for (int q = 0; q < 4; ++q)
#pragma unroll
        for (int b = 0; b < 4; ++b) acc[q][b] = 0.f;
#pragma unroll
    for (int jj = 0; jj < 4; ++jj) {
        f32x4 sa[4], sb[4];
#pragma unroll
        for (int b = 0; b < 4; ++b) { sa[b] = *(const LAS f32x4*)(shl + b * DM + 8 * (lane + 64 * jj)); sb[b] = *(const LAS f32x4*)(shl + b * DM + 8 * (lane + 64 * jj) + 4); }
#pragma unroll
        for (int q = 0; q < 4; ++q) { const v4u d = w[4 * q + jj];
            const float e0 = __uint_as_float(d.x << 16), e1 = __uint_as_float(d.x & 0xffff0000u), e2 = __uint_as_float(d.y << 16), e3 = __uint_as_float(d.y & 0xffff0000u);
            const float e4 = __uint_as_float(d.z << 16), e5 = __uint_as_float(d.z & 0xffff0000u), e6 = __uint_as_float(d.w << 16), e7 = __uint_as_float(d.w & 0xffff0000u);
#pragma unroll
            for (int b = 0; b < 4; ++b) { float t = acc[q][b];
                t = fmaf(e0, sa[b][0], t); t = fmaf(e1, sa[b][1], t); t = fmaf(e2, sa[b][2], t); t = fmaf(e3, sa[b][3], t);
                t = fmaf(e4, sb[b][0], t); t = fmaf(e5, sb[b][1], t); t = fmaf(e6, sb[b][2], t); t = fmaf(e7, sb[b][3], t); acc[q][b] = t; } }
    }
#pragma unroll
    for (int q = 0; q < 4; ++q)
#pragma unroll
        for (int b = 0; b < 4; ++b) { const float t = wave_sum(acc[q][b]); if (lane == 0) out[(size_t)b * nrows + n0 + q] = t; }
}
constexpr int NBIAS_ITEM = 168 + 40 + 192 + 168 + 4 * 352;
__device__ __forceinline__ void bias_range(const Frame& F0, int lo, int hi, int vb, int nb) {
    int tid_ = threadIdx.x; asm volatile("" : "+v"(tid_)); const int lane = tid_ & 63, wave = __builtin_amdgcn_readfirstlane(tid_ >> 6);
    unsigned char* const ws = ARG_WS;
    const float* const MODS = (const float*)(ws + WS_MODS); float* const BIAS = (float*)(ws + WS_BIAS);
    LAS float* const shl = (LAS float*)F0.lds;
    const int i0 = lo + (int)(((long)vb * (hi - lo)) / nb), i1 = lo + (int)(((long)(vb + 1) * (hi - lo)) / nb);
    int cur = -1;
    for (int it = i0; it < i1; ++it) {
        int seg, r; const bf16* WT; int nrows; const float* sh; float* out;
        if (it < 168) { seg = 0; r = it; WT = (const bf16*)(ws + WS_WDSA); nrows = DSA_NP; sh = MODS + 0 * 4 * 12288; out = BIAS + BIAS_DSA0; }
        else if (it < 208) { seg = 1; r = it - 168; WT = (const bf16*)(ws + WS_WMLA + WMLA_DOWN); nrows = MLA_DOWN_NP; sh = MODS + 1 * 4 * 12288; out = BIAS + BIAS_MLA; }
        else if (it < 400) { seg = 2; r = it - 208; WT = (const bf16*)(ws + WS_WSB); nrows = 3 * DM; sh = MODS + 2 * 4 * 12288; out = BIAS + BIAS_SB; }
        else if (it < 568) { seg = 3; r = it - 400; WT = (const bf16*)(ws + WS_WDSA + WDSA_STRIDE); nrows = DSA_NP; sh = MODS + 3 * 4 * 12288; out = BIAS + BIAS_DSA1; }
        else { const int l = (it - 568) / 352; seg = 4 + l; r = (it - 568) % 352; WT = (const bf16*)(ws + WS_W + (size_t)l * WL_STRIDE + WL_FFN1); nrows = 2 * DFF; sh = MODS + (size_t)l * 4 * 12288 + 6144; out = BIAS + BIAS_FFN + (size_t)l * 4 * 2 * DFF; }
        if (seg != cur) {
            __syncthreads();
            for (int i = tid_; i < 4 * DM; i += NWAVES * 64) shl[i] = sh[(size_t)(i >> 11) * 12288 + (i & 2047)];
            __syncthreads();
            cur = seg;
        }
        bias_item(WT, nrows, out, r, shl, wave, lane);
    }
    __syncthreads();
}
__device__ __forceinline__ void bias_in_tail(const Frame& F0, int lo, int hi) {
    const int G = F0.G, rem = ((M / 256) * (DSA_NP / 256)) % G, c = (int)blockIdx.x;
    if (rem == 0) bias_range(F0, lo, hi, c, G);
    else if (c >= rem) bias_range(F0, lo, hi, c - rem, G - rem);
}
template <int L, int LO, int HI> __device__ __forceinline__ void run_layer(const Frame& F, const Args& args, const XcdBarrier& bar, unsigned char* lds) {
        unsigned char* const ws = ARG_WS;
        float* const MODS = (float*)(ws + WS_MODS);
        float* const CS128 = (float*)(ws + WS_CS128);
        float* const CS64 = (float*)(ws + WS_CS64);
        float* const SSQ = (float*)(ws + WS_SSQ);
        float* const SSX = (float*)(ws + WS_SSX);
        const float* const BIAS = (const float*)(ws + WS_BIAS);
        bf16* const HB = (bf16*)(ws + WS_H);
        bf16* const XB = (bf16*)(ws + WS_XB);
        bf16* const OB = (bf16*)(ws + WS_O);
        unsigned char* const MIX = ws + WS_MIX;
        const int gw = F.vcu * NWAVES + F.wave, NGW = F.G * NWAVES;
        constexpr int l = L; constexpr int kind = (l == 3) ? 0 : l;
        constexpr int pb = (l == 0) ? 2 : (l == 1) ? 8 : (l == 2) ? 14 : 19;
        constexpr int cb = pb + ((kind == 0) ? 3 : (kind == 1) ? 3 : 2);
        unsigned char* const WL = ws + WS_W + (size_t)l * WL_STRIDE;
        const float* const mods_l = MODS + (size_t)l * 4 * 12288;
        if constexpr (kind == 0) {
            bf16* const DQ = (bf16*)(MIX + MX_DQ); bf16* const DK = (bf16*)(MIX + MX_DK); bf16* const DV = (bf16*)(MIX + MX_DV); bf16* const DIQ = (bf16*)(MIX + MX_DIQ); bf16* const DIK = (bf16*)(MIX + MX_DIK);
            float* const DIW = (float*)(MIX + MX_DIW); unsigned long long* const DMASK = (unsigned long long*)(MIX + MX_DMASK); float* const DSC = (float*)(MIX + MX_DSC);
            if constexpr (SITE(2) && IN(pb)) {
            for (int rep_ = 0; rep_ < NREP(2); ++rep_) {
                pg8::Gemm g{HB, (const bf16*)(ws + WS_WDSA + (size_t)(l == 3) * WDSA_STRIDE), M, DSA_NP, DM}; pg8::StaticOrder S; S.init(M, DSA_NP, F.G, (int)blockIdx.x);
                pg8::EpiDsaIn E{DQ, DK, DV, DIQ, DIK, DIW, pg8::NormIn{SSX, BIAS + (l == 3 ? BIAS_DSA1 : BIAS_DSA0), DSA_NP, (pg8::PG8_LAS_float_ptr)(F.lds + EPI_TAB_OFF)}};
                pg8::gemm_phase<pg8::EpiDsaIn, pg8::StaticOrder, true, true>(F.lds, g, S, E);
            }
                if constexpr (l == 0) bias_in_tail(F, 168, 568 + 1 * 352); else bias_in_tail(F, 568 + 3 * 352, NBIAS_ITEM);
                SEAM(pb);
            }
            if constexpr (SITE(3) && IN(pb + 1)) {
            for (int rep_ = 0; rep_ < NREP(3); ++rep_) {
                int tid_ = threadIdx.x; asm volatile("" : "+v"(tid_)); const int lane_ = tid_ & 63, wave_ = __builtin_amdgcn_readfirstlane(tid_ >> 6);
                att::las_u32* const tbuf = (att::las_u32*)(F.lds + wave_ * 16384);
                for (int idx = F.vcu; idx < 512; idx += F.G) { const int s = idx & 255, r = idx >> 8, b = s >> 6, loc = s & 63, qq = r ? 127 - loc : loc;
                    att::idx_unit(b, qq, DIQ, DIK, DIW, DSC, (char*)lds);
                    const int row0 = b * 4096 + 32 * qq + 4 * wave_, c_ = qq >> 1;
                    unsigned raw[64];
                    att::topk_prefetch(DSC + (size_t)row0 * 4096, c_, tbuf, lane_);
#pragma unroll 1
                    for (int k = 0; k < 4; ++k) {
                        att::topk_fetch(tbuf, c_, raw, lane_);
                        if (k < 3) att::topk_prefetch(DSC + (size_t)(row0 + k + 1) * 4096, c_, tbuf, lane_);
                        att::topk_row(raw, c_, DMASK + (size_t)(row0 + k) * 64, lane_);
                    }
                    __syncthreads();
                }
                asm volatile("s_waitcnt vmcnt(0)" ::: "memory");
            }
                SEAM(pb + 1);
            }
            if constexpr (SITE(5) && IN(pb + 2)) {
            for (int rep_ = 0; rep_ < NREP(5); ++rep_) {
#define DSA_UNIT_C(idx_) (((idx_) >> 8) == 0 ? ((idx_) & 15) : ((idx_) >> 8) == 1 ? 63 - ((idx_) & 15) : ((idx_) >> 8) == 2 ? ((idx_) & 15) + 16 : 47 - ((idx_) & 15))
                att::DsaPre P;
                if ((int)F.vcu < 1024) { const int i0 = F.vcu, bg0 = (i0 & 255) >> 4; att::dsa_preload(P, bg0 >> 2, bg0 & 3, DSA_UNIT_C(i0), DQ, DK, DV, DMASK); }
                for (int idx = F.vcu; idx < 1024; idx += F.G) { const int bg = (idx & 255) >> 4, c = DSA_UNIT_C(idx);
                    const int nidx = idx + F.G; const bool hn = nidx < 1024; const int nbg = (nidx & 255) >> 4, nc = hn ? DSA_UNIT_C(nidx) : 0;
                    if (rep_ == 0) att::dsa_attn_unit<0>(bg >> 2, bg & 3, c, DQ, DK, DV, DMASK, OB, (char*)lds, P, hn, nbg >> 2, nbg & 3, nc);
                    else att::dsa_attn_unit<(REP_VAR ? REP_VAR : 1)>(bg >> 2, bg & 3, c, DQ, DK, DV, DMASK, OB, (char*)lds, P, false, 0, 0, 0); }
#undef DSA_UNIT_C
            }
                SEAM(pb + 2);
            }
        } else if constexpr (kind == 1) {
            bf16* const CQ = (bf16*)(MIX + MX_MCQ); bf16* const CKV = (bf16*)(MIX + MX_MCKV); bf16* const KR = (bf16*)(MIX + MX_MKR); bf16* const QN = (bf16*)(MIX + MX_MQN); bf16* const QR = (bf16*)(MIX + MX_MQR);
            bf16* const KN = (bf16*)(MIX + MX_MKN); bf16* const MV = (bf16*)(MIX + MX_MV);
            if constexpr (SITE(6) && IN(pb)) {
            for (int rep_ = 0; rep_ < NREP(6); ++rep_) {
                pg8::Gemm g{HB, (const bf16*)(ws + WS_WMLA + WMLA_DOWN), M, 1024, DM}; pg8::StaticOrder S; S.init(M, 1024, F.G, (int)blockIdx.x);
                pg8::EpiMlaDown E{CQ, CKV, KR, SSQ, pg8::NormIn{SSX, BIAS + BIAS_MLA, MLA_DOWN_NP, (pg8::PG8_LAS_float_ptr)(F.lds + EPI_TAB_OFF)}, 0};
                pg8::gemm_phase<pg8::EpiMlaDown, pg8::StaticOrder, true, true>(F.lds, g, S, E);
            }
                SEAM(pb);
            }
            if constexpr (SITE(7) && IN(pb + 1)) {
            for (int rep_ = 0; rep_ < NREP(7); ++rep_) {
                const int v = F.vcu; const bool bal = (F.G == 256);
                const int s0 = v < 64 ? 4 * v : 256 + 8 * (v - 64), s1 = s0 + (v < 64 ? 4 : 8);
                { pg8::Gemm g{HB, (const bf16*)(ws + WS_WMLA + WMLA_DOWN) + (size_t)1024 * DM, M, 256, DM};
                  pg8::RangeOrder S{v, 64, bal ? 64 : F.G, 1};
                  pg8::EpiMlaDown E{CQ, CKV, KR, SSQ, pg8::NormIn{SSX, BIAS + BIAS_MLA, MLA_DOWN_NP, (pg8::PG8_LAS_float_ptr)(F.lds + EPI_TAB_OFF)}, 4};
                  pg8::gemm_phase<pg8::EpiMlaDown, pg8::RangeOrder, true, true>(F.lds, g, S, E); }
                { pg8::Gemm g{CQ, (const bf16*)(ws + WS_WMLA + WMLA_UQ), M, 3072, 512};
                  pg8::RangeOrder S{bal ? (s0 < 768 ? s0 : 768) : v, bal ? (s1 < 768 ? s1 : 768) : 768, bal ? 1 : F.G, 12};
                  pg8::EpiMlaUq E{QN, QR, SSQ, (pg8::PG8_LAS_float_ptr)(F.lds + EPI_TAB_OFF)};
                  pg8::gemm_phase<pg8::EpiMlaUq, pg8::RangeOrder, true, true>(F.lds, g, S, E); }
                { pg8::Gemm g{CKV, (const bf16*)(ws + WS_WMLA + WMLA_UKV), M, 4096, 512};
                  pg8::RangeOrder S{bal ? (s0 > 768 ? s0 - 768 : 0) : v, bal ? (s1 > 768 ? s1 - 768 : 0) : 1024, bal ? 1 : F.G, 16};
                  pg8::EpiMlaUkv E{KN, MV, SSQ, (pg8::PG8_LAS_float_ptr)(F.lds + EPI_TAB_OFF)};
                  pg8::gemm_phase<pg8::EpiMlaUkv, pg8::RangeOrder, true, true>(F.lds, g, S, E); }
            }
                SEAM(pb + 1);
            }
            if constexpr (SITE(8) && IN(pb + 2)) {
            for (int rep_ = 0; rep_ < NREP(8); ++rep_) {
                for (int idx = F.vcu; idx < 1024; idx += F.G) { const int s = idx & 255, r = idx >> 8, bh = s >> 2, loc = s & 3;
                    const int qb = (r == 0) ? loc : (r == 1) ? 15 - loc : (r == 2) ? loc + 4 : 11 - loc;
                    att::mla_attn_unit(bh >> 4, bh & 15, qb, QN, QR, KN, KR, MV, OB, (char*)lds); }
            }
                SEAM(pb + 2);
            }
        } else {
            bf16* const SQ = (bf16*)(MIX + MX_SQ); bf16* const SK = (bf16*)(MIX + MX_SK); bf16* const SV = (bf16*)(MIX + MX_SV);
            if constexpr (SITE(9) && IN(pb)) {
            for (int rep_ = 0; rep_ < NREP(9); ++rep_) {
                pg8::Gemm g{HB, (const bf16*)(ws + WS_WSB), M, 3 * DM, DM}; pg8::StaticOrder S; S.init(M, 3 * DM, F.G, (int)blockIdx.x);
                pg8::EpiSplit3 E{SQ, (size_t)(MX_SK - MX_SQ) / 2, pg8::NormIn{SSX, BIAS + BIAS_SB, 3 * DM, (pg8::PG8_LAS_float_ptr)(F.lds + EPI_TAB_OFF)}}; static_assert(MX_SV - MX_SK == MX_SK - MX_SQ, "q | k | v equally spaced");
                pg8::gemm_phase<pg8::EpiSplit3, pg8::StaticOrder, true, true>(F.lds, g, S, E);
            }
                SEAM(pb);
            }
            if constexpr (SITE(10) && IN(pb + 1)) {
            for (int rep_ = 0; rep_ < NREP(10); ++rep_) {
                unsigned* const qhead = (unsigned*)(ARG_WS + WS_CTL) + 2048 + 64;
                for (;;) {
                    if (threadIdx.x == 0) F.MISC[16] = __hip_atomic_fetch_add(qhead, 1u, __ATOMIC_RELAXED, __HIP_MEMORY_SCOPE_AGENT);
                    __syncthreads();
                    const int u = (int)F.MISC[16];
                    __syncthreads();
                    if (u >= 1024) break;
                    att::sb_attn_unit((u & 63) >> 4, u & 15, 15 - (u >> 6), SQ, SK, SV, OB, (char*)lds, DIAG_PTR);
                }
            }
                SEAM(pb + 1);
            }
        }
        pg8::PG8_LAS_float_ptr const part = (pg8::PG8_LAS_float_ptr)(F.lds + EPI_PART_OFF);
        if constexpr (SITE(11) && IN(cb)) {
            const float* gf = (l == 0) ? ARG_IN(5) : (l == 1) ? ARG_IN(13) : (l == 2) ? ARG_IN(25) : ARG_IN(33);
            pg8::Gemm g{OB, (const bf16*)(WL + WL_OUT), M, DM, DM}; pg8::StaticOrder S; S.init(M, DM, F.G, (int)blockIdx.x);
            pg8::EpiResid E{XB, mods_l + 4096, HB, gf, mods_l + 8192, SSX, part};
            pg8::gemm_phase<pg8::EpiResid, pg8::StaticOrder, true, true>(F.lds, g, S, E);
            SEAM(cb);
        }
        if constexpr (SITE(13) && IN(cb + 1)) {
            for (int rep_ = 0; rep_ < NREP(13); ++rep_) {
            pg8::Gemm g{HB, (const bf16*)(WL + WL_FFN1), M, 2 * DFF, DM}; pg8::StaticOrder S; S.init(M, 2 * DFF, F.G, (int)blockIdx.x);
            pg8::EpiSwiglu E{(bf16*)(MIX + MX_ACT), pg8::NormIn{SSX, BIAS + BIAS_FFN + (size_t)l * 4 * 2 * DFF, 2 * DFF, (pg8::PG8_LAS_float_ptr)(F.lds + EPI_TAB_OFF)}};
            pg8::gemm_phase<pg8::EpiSwiglu, pg8::StaticOrder, true, true>(F.lds, g, S, E);
            }
            SEAM(cb + 1);
        }
        if constexpr (SITE(14) && IN(cb + 2)) {
            const float* gm = (l == 0) ? ARG_IN(12) : (l == 1) ? ARG_IN(24) : ARG_IN(32);
            pg8::Gemm g{(const bf16*)(MIX + MX_ACT), (const bf16*)(WL + WL_FFN2), M, DM, DFF}; pg8::StaticOrder S; S.init(M, DM, F.G, (int)blockIdx.x);
            pg8::EpiResid E{XB, mods_l + 10240, (l < 3) ? HB : (bf16*)nullptr, gm, mods_l + 4 * 12288 + 2048, SSX, part};
            pg8::gemm_phase<pg8::EpiResid, pg8::StaticOrder, true, true>(F.lds, g, S, E);
            SEAM(cb + 2);
        }
}
__device__ __forceinline__ void p1_phase(const Frame& F0, const Args& args, bf16* __restrict__ HB, bf16* __restrict__ XB, float* __restrict__ SSX, float* __restrict__ BIAS) {
    int tid_ = threadIdx.x; asm volatile("" : "+v"(tid_)); const int lane = tid_ & 63, wave = __builtin_amdgcn_readfirstlane(tid_ >> 6);
    const int gw = F0.vcu * NWAVES + wave, NGW = F0.G * NWAVES;
    unsigned char* const args_ws = ARG_WS;
    const float* const MODS = (const float*)(args_ws + WS_MODS);
    {
        const float* x = ARG_IN(0); const float* g = ARG_IN(4);
        for (int m = gw; m < M; m += NGW) {
            const GAS f32x4* xr = (const GAS f32x4*)(x + (size_t)m * DM) + lane;
            f32x4 v[8]; float s = 0.f;
#pragma unroll
            for (int j = 0; j < 8; ++j) { v[j] = xr[64 * j]; s += (v[j].x * v[j].x + v[j].y * v[j].y) + (v[j].z * v[j].z + v[j].w * v[j].w); }
            s = wave_sum(s);
            if (lane == 0) { *(f32x4*)(SSX + (size_t)m * 8) = (f32x4){s, 0.f, 0.f, 0.f}; *(f32x4*)(SSX + (size_t)m * 8 + 4) = (f32x4){0.f, 0.f, 0.f, 0.f}; }
            const float* mb = MODS + (size_t)(m >> 12) * 12288;
            GAS unsigned long long* o8 = (GAS unsigned long long*)(HB + (size_t)m * DM) + lane; GAS unsigned long long* x8 = (GAS unsigned long long*)(XB + (size_t)m * DM) + lane;
#pragma unroll
            for (int j = 0; j < 8; ++j) { const int col = 256 * j + 4 * lane;
                const f32x4 g4 = *(const f32x4*)(g + col), sc4 = *(const f32x4*)(mb + 2048 + col);
                const f32x4 r = v[j] * g4 * (sc4 + 1.0f);
                o8[64 * j] = (unsigned long long)pk2(r.x, r.y) | ((unsigned long long)pk2(r.z, r.w) << 32);
                x8[64 * j] = (unsigned long long)pk2(v[j].x, v[j].y) | ((unsigned long long)pk2(v[j].z, v[j].w) << 32); }
        }
    }
    bias_range(F0, 0, 168, F0.vcu, F0.G); bias_range(F0, 568 + 1 * 352, 568 + 3 * 352, F0.vcu, F0.G);
}
template <int LO, int HI> __global__ void __launch_bounds__(NWAVES * 64, 2) trunk_fwd(Args args) {
    extern __shared__ __attribute__((aligned(16))) unsigned char lds[];
    Frame F;
    F.lds = (LAS unsigned char*)lds;
    F.MISC = (volatile LAS unsigned*)(F.lds + MISC_OFF);
    F.tid = threadIdx.x; F.lane = F.tid & 63; F.wave = __builtin_amdgcn_readfirstlane(F.tid >> 6);
    F.G = gridDim.x; { const int bx = blockIdx.x; F.vcu = (F.G % 8 == 0) ? (bx % 8) * (F.G / 8) + bx / 8 : bx; }
    unsigned char* const ws = ARG_WS;
    F.ctl = (gu32*)(ws + WS_CTL);
    for (int u = F.tid; u < (LDS_BYTES - LDSCTL_OFF) / 4; u += NWAVES * 64) ((LAS unsigned*)(F.lds + LDSCTL_OFF))[u] = 0u;
    __syncthreads();
    XcdBarrier bar = xcd_barrier_post((unsigned*)(F.ctl + CW_BAR) + ARG_LI * XCD_BAR_WORDS, F.MISC + 8);
#if DIAG == 2
    if (blockIdx.x == 0 && threadIdx.x == 0) ((unsigned long long*)(ARG_WS + WS_CTL + 0x8000))[0] = __builtin_amdgcn_s_memrealtime();
#endif
    float* const MODS = (float*)(ws + WS_MODS);
    float* const CS128 = (float*)(ws + WS_CS128);
    float* const CS64 = (float*)(ws + WS_CS64);
    float* const SSQ = (float*)(ws + WS_SSQ);
    bf16* const HB = (bf16*)(ws + WS_H);
    bf16* const OB = (bf16*)(ws + WS_O);
    unsigned char* const MIX = ws + WS_MIX;
    const int gw = F.vcu * NWAVES + F.wave, NGW = F.G * NWAVES;

    if constexpr (SITE(0) && IN(0)) {
            for (int rep_ = 0; rep_ < NREP(0); ++rep_) {
            if (rep_) __syncthreads();
        for (int r1_ = 0; r1_ < 1 + (P0_REP & 1); ++r1_) {
            LAS float* silc = (LAS float*)F.lds;
            LAS float* red = (LAS float*)(F.lds + 32768);
            const float* cvec = ARG_IN(1);
            for (int i = F.tid; i < 4 * DM; i += NWAVES * 64) { const float c = cvec[i]; silc[i] = c / (1.0f + __expf(-c)); }
            __syncthreads();
            for (int it = F.vcu; it < 4 * 192; it += F.G) {
                const int l = it / 192, ng = it % 192;
                const float* W = (l == 0) ? ARG_IN(2) : (l == 1) ? ARG_IN(10) : (l == 2) ? ARG_IN(22) : ARG_IN(30);
                const float* Bv = (l == 0) ? ARG_IN(3) : (l == 1) ? ARG_IN(11) : (l == 2) ? ARG_IN(23) : ARG_IN(31);
                const int c4 = F.lane & 15, kr = F.lane >> 4, k0 = 256 * F.wave;
                f32x4 acc[4];
#pragma unroll
                for (int b = 0; b < 4; ++b) acc[b] = (f32x4){0.f, 0.f, 0.f, 0.f};
#pragma unroll 8
                for (int kk = 0; kk < 64; ++kk) { const int k = k0 + 4 * kk + kr;
                    const f32x4 w4 = *(const GAS f32x4*)(W + (size_t)k * 12288 + 64 * ng + 4 * c4);
#pragma unroll
                    for (int b = 0; b < 4; ++b) acc[b] += w4 * silc[b * DM + k]; }
#pragma unroll
                for (int b = 0; b < 4; ++b)
#pragma unroll
                    for (int e = 0; e < 4; ++e) { float v = acc[b][e]; v += __shfl_xor(v, 16); v += __shfl_xor(v, 32); acc[b][e] = v; }
                if (kr == 0) {
#pragma unroll
                    for (int b = 0; b < 4; ++b) *(LAS f32x4*)(red + (F.wave * 4 + b) * 64 + 4 * c4) = acc[b]; }
                __syncthreads();
                if (F.tid < 256) { const int b = F.tid >> 6, col = F.tid & 63; float s = Bv[64 * ng + col];
#pragma unroll
                    for (int w = 0; w < 8; ++w) s += red[(w * 4 + b) * 64 + col];
                    MODS[((size_t)l * 4 + b) * 12288 + 64 * ng + col] = s; }
                __syncthreads();
            }
        }
        for (int r2_ = 0; r2_ < 1 + ((P0_REP >> 1) & 1); ++r2_) {
            LAS unsigned* scr = (LAS unsigned*)(F.lds + F.wave * 16384);
            int it = gw;
#define CONV_SEG(Wp, K_, Nsrc_, Nphys_, kind_, gk_, dst_) do { const int n_items_ = ((K_) / 64) * ((Nphys_) / 64); \
                for (; it < n_items_; it += NGW) conv_item((Wp), (K_), (Nsrc_), (Nphys_), (kind_), (gk_), (bf16*)(dst_), scr, it, F.lane); it -= n_items_; } while (0)
            CONV_SEG(ARG_IN(8),  DM, 2 * DFF, 2 * DFF, KIND_FFN1, (const float*)nullptr, ws + WS_W + 0 * WL_STRIDE + WL_FFN1);
            CONV_SEG(ARG_IN(20), DM, 2 * DFF, 2 * DFF, KIND_FFN1, (const float*)nullptr, ws + WS_W + 1 * WL_STRIDE + WL_FFN1);
            CONV_SEG(ARG_IN(28), DM, 2 * DFF, 2 * DFF, KIND_FFN1, (const float*)nullptr, ws + WS_W + 2 * WL_STRIDE + WL_FFN1);
            CONV_SEG(ARG_IN(36), DM, 2 * DFF, 2 * DFF, KIND_FFN1, (const float*)nullptr, ws + WS_W + 3 * WL_STRIDE + WL_FFN1);
            CONV_SEG(ARG_IN(9),  DFF, DM, DM, KIND_ID, (const float*)nullptr, ws + WS_W + 0 * WL_STRIDE + WL_FFN2);
            CONV_SEG(ARG_IN(21), DFF, DM, DM, KIND_ID, (const float*)nullptr, ws + WS_W + 1 * WL_STRIDE + WL_FFN2);
            CONV_SEG(ARG_IN(29), DFF, DM, DM, KIND_ID, (const float*)nullptr, ws + WS_W + 2 * WL_STRIDE + WL_FFN2);
            CONV_SEG(ARG_IN(37), DFF, DM, DM, KIND_ID, (const float*)nullptr, ws + WS_W + 3 * WL_STRIDE + WL_FFN2);
            CONV_SEG(ARG_IN(7),  DM, DM, DM, KIND_ID, (const float*)nullptr, ws + WS_W + 0 * WL_STRIDE + WL_OUT);
            CONV_SEG(ARG_IN(19), DM, DM, DM, KIND_ID, (const float*)nullptr, ws + WS_W + 1 * WL_STRIDE + WL_OUT);
            CONV_SEG(ARG_IN(27), DM, DM, DM, KIND_ID, (const float*)nullptr, ws + WS_W + 2 * WL_STRIDE + WL_OUT);
            CONV_SEG(ARG_IN(35), DM, DM, DM, KIND_ID, (const float*)nullptr, ws + WS_W + 3 * WL_STRIDE + WL_OUT);
            CONV_SEG(ARG_IN(6),  DM, 5264, DSA_NP, KIND_DSA_IN, (const float*)nullptr, ws + WS_WDSA + 0 * WDSA_STRIDE);
            CONV_SEG(ARG_IN(34), DM, 5264, DSA_NP, KIND_DSA_IN, (const float*)nullptr, ws + WS_WDSA + 1 * WDSA_STRIDE);
            CONV_SEG(ARG_IN(14), DM, 1088, MLA_DOWN_NP, KIND_MLA_DOWN, (const float*)nullptr, ws + WS_WMLA + WMLA_DOWN);
            CONV_SEG(ARG_IN(17), 512, 3072, 3072, KIND_MLA_UQ, ARG_IN(15), ws + WS_WMLA + WMLA_UQ);
            CONV_SEG(ARG_IN(18), 512, 4096, 4096, KIND_ID, ARG_IN(16), ws + WS_WMLA + WMLA_UKV);
            CONV_SEG(ARG_IN(26), DM, 3 * DM, 3 * DM, KIND_ID, (const float*)nullptr, ws + WS_WSB);
#undef CONV_SEG
        }
            }
        SEAM(0);
    }
    if constexpr (SITE(1) && IN(1)) { p1_phase(F, args, (bf16*)(ws + WS_H), (bf16*)(ws + WS_XB), (float*)(ws + WS_SSX), (float*)(ws + WS_BIAS)); SEAM(1); }

    run_layer<0, LO, HI>(F, args, bar, lds); run_layer<1, LO, HI>(F, args, bar, lds); run_layer<2, LO, HI>(F, args, bar, lds); run_layer<3, LO, HI>(F, args, bar, lds);
    if constexpr (SITE(15) && IN(NPH - 1)) {
        finalnorm_phase(F, (const bf16*)(ws + WS_XB), ARG_OUT, ARG_IN(38));
#if DIAG == 2
        __syncthreads(); if (blockIdx.x == 0 && threadIdx.x == 0) { const unsigned long long* st_ = (const unsigned long long*)(ARG_WS + WS_CTL + 0x8000);
            const unsigned long long* pmx_ = (const unsigned long long*)(ARG_WS + WS_CTL + 0x9000); const unsigned long long* pmn_ = (const unsigned long long*)(ARG_WS + WS_CTL + 0xA000);
            float d_ = (float)(st_[DIAG_K1] - st_[DIAG_K0]);
            if (DIAG_SEL == 1) { d_ = 0.f; for (int k = DIAG_K0; k < DIAG_K1; ++k) d_ += (float)(long long)(st_[k + 1] - pmx_[k]); }
            if (DIAG_SEL == 2) { d_ = 0.f; for (int k = DIAG_K0; k < DIAG_K1; ++k) d_ += (float)(long long)(pmx_[k] - ((1ull << 62) - pmn_[k])); }
            ARG_OUT[0] += d_ * (0.01f / DIAG_DIV); }
#elif DIAG
        __syncthreads(); if (blockIdx.x == 0 && threadIdx.x == 0) { const unsigned cnt_ = __hip_atomic_load((unsigned*)(ARG_WS + WS_CTL) + 2048, __ATOMIC_RELAXED, __HIP_MEMORY_SCOPE_AGENT); ARG_OUT[0] += (float)cnt_ * (1.0f / 200.0f); }
#endif
    }
}
#undef IN
#undef SEAM
template <int LO, int HI> static void launch_range(int grid, const Args& a, hipStream_t stream) {
    static bool attr_done = false;
    if (!attr_done) { if (hipFuncSetAttribute((const void*)trunk_fwd<LO, HI>, hipFuncAttributeMaxDynamicSharedMemorySize, LDS_BYTES) != hipSuccess) fprintf(stderr, "kernel_launch: hipFuncSetAttribute failed\n"); attr_done = true; }
    hipLaunchKernelGGL((trunk_fwd<LO, HI>), dim3(grid), dim3(NWAVES * 64), LDS_BYTES, stream, a);
}
template <int P> struct PerPhase { static void go(int grid, const Args& a, hipStream_t stream) { launch_range<P, P + 1>(grid, a, stream); PerPhase<P + 1>::go(grid, a, stream); } };
template <> struct PerPhase<NPH> { static void go(int, const Args&, hipStream_t) {} };
extern "C" void kernel_launch(void* const* d_in, const int* in_sizes, int n_in, void* d_out, int out_size, void* d_ws, size_t ws_size, hipStream_t stream) {
    static int grid = 0;
    if (grid == 0) {
        if (n_in != 39 || in_sizes[0] != M * DM || out_size != M * DM || ws_size < WS_END) { fprintf(stderr, "kernel_launch: shape mismatch (n_in %d, in0 %d, out %d, ws %zu < %zu)\n", n_in, n_in > 0 ? in_sizes[0] : -1, out_size, ws_size, (size_t)WS_END); grid = -1; return; }
        int dev = 0, cus = 0;
        if (hipGetDevice(&dev) != hipSuccess || hipDeviceGetAttribute(&cus, hipDeviceAttributeMultiprocessorCount, dev) != hipSuccess) { grid = -1; return; }
        grid = cus;
    }
    if (grid < 0) return;
    if (hipMemsetAsync((char*)d_ws + WS_CTL, 0, CTL_ZERO_BYTES, stream) != hipSuccess) return;
    Args a{};
    for (int i = 0; i < 39; ++i) a.in[i] = (const float*)d_in[i];
    a.out = (float*)d_out; a.ws = (unsigned char*)d_ws; a.ph_lo = 0; a.ph_hi = NPH; a.li = 0;
#if MK_ONE_LAUNCH
    launch_range<0, NPH>(grid, a, stream);
#else
    PerPhase<0>::go(grid, a, stream);
#endif
    const hipError_t le = hipPeekAtLastError();
    if (le != hipSuccess) fprintf(stderr, "kernel_launch: launch failed: %s\n", hipGetErrorName(le));
}
```

```cpp
#include <hip/hip_runtime.h>
#include <cstdio>
#include <cstdint>
#include <cstddef>
namespace pg8 {
#define PG8_LAS __attribute__((address_space(3)))
typedef unsigned short bf16_t;
typedef short bf16x8 __attribute__((ext_vector_type(8)));
typedef float f32x4 __attribute__((ext_vector_type(4)));
typedef unsigned u32x4 __attribute__((ext_vector_type(4)));
constexpr int BM = 256, BK = 64, HALF = 128, HTB = HALF * BK * 2  , STAGE_BYTES = 8 * HTB, NXCD = 8, WGM = 8;

__host__ __device__ __forceinline__ int lds_byte(int r, int c) { const int st = (r >> 4) * 2 + (c >> 5), rr = r & 15, cc = c & 31, ob = rr * 64 + cc * 2; return st * 1024 + (ob ^ (((ob >> 9) & 1) << 5)); }
__host__ __device__ __forceinline__ void stage_rc(int b, int& R, int& C) { const int st = b / 1024, sb = b % 1024, swz = sb ^ (((sb >> 9) & 1) << 5); R = (st >> 1) * 16 + swz / 64; C = (st & 1) * 32 + (swz % 64) / 2; }
__host__ __device__ __forceinline__ int perm32(int rho) { const int n = rho >> 4, i = rho & 15; return 8 * (i >> 2) + 4 * n + (i & 3); }

struct Unit { int pm, pn; };
struct Gemm { const bf16_t* A; const bf16_t* Bt; int M, N, K; };

struct EpiPre { float __attribute__((ext_vector_type(4))) a, b; };
struct StaticOrder {
    int nM, nN, nwg, G, c;
    __host__ __device__ void init(int M, int N, int G_, int c_) { nM = M / BM; nN = N / BM; nwg = nM * nN; G = G_; c = c_; }
    __host__ __device__ bool next(int i, Unit& u) const {
        const long L = (long)i * G + c; if (L >= nwg) return false;
        int wgid = (int)L; { const int q = nwg / NXCD, r = nwg % NXCD, xcd = wgid % NXCD, off = wgid / NXCD; wgid = (xcd < r ? xcd * (q + 1) : r * (q + 1) + (xcd - r) * q) + off; }
        const int nig = WGM * nN, gid = wgid / nig, fm = gid * WGM, gsz = (nM - fm) < WGM ? (nM - fm) : WGM;
        u.pm = fm + ((wgid % nig) % gsz); u.pn = (wgid % nig) / gsz; return true;
    }
    __device__ __forceinline__ void a_ready(const Unit&) const {}
    __device__ __forceinline__ void done(const Unit&) const {}
};
struct RangeOrder {
    int lo, hi, step, nN;
    __device__ __forceinline__ bool next(int i, Unit& u) const { const int idx = lo + i * step; if (idx >= hi) return false; u.pm = idx / nN; u.pn = idx % nN; return true; }
    __device__ __forceinline__ void a_ready(const Unit&) const {}
    __device__ __forceinline__ void done(const Unit&) const {}
};

__device__ __forceinline__ unsigned cvt_pk_bf16(float lo, float hi) { unsigned r; asm volatile("v_cvt_pk_bf16_f32 %0, %1, %2" : "=v"(r) : "v"(lo), "v"(hi)); return r; }
typedef float f32x2 __attribute__((ext_vector_type(2)));
__device__ __forceinline__ u32x4 pack8(const f32x4 v0, const f32x4 v1) { u32x4 w; w.x = cvt_pk_bf16(v0[0], v0[1]); w.y = cvt_pk_bf16(v0[2], v0[3]); w.z = cvt_pk_bf16(v1[0], v1[1]); w.w = cvt_pk_bf16(v1[2], v1[3]); return w; }
__device__ __forceinline__ void rope_ir(int i0, float l2t_over_half  , f32x4& ir0, f32x4& ir1) {
#pragma unroll
    for (int e = 0; e < 4; ++e) { ir0[e] = __builtin_amdgcn_exp2f(-(float)(i0 + e) * l2t_over_half) * 0.15915494309189535f; ir1[e] = __builtin_amdgcn_exp2f(-(float)(i0 + 4 + e) * l2t_over_half) * 0.15915494309189535f; }
}
__device__ __forceinline__ void rope8(const f32x4 ir0, const f32x4 ir1, float pos, const f32x4 a0, const f32x4 a1, const f32x4 b0, const f32x4 b1, u32x4& o1, u32x4& o2) {
    f32x4 c0, s0, c1, s1;
#pragma unroll
    for (int e = 0; e < 4; ++e) { const float r0 = __builtin_amdgcn_fractf(ir0[e] * pos), r1 = __builtin_amdgcn_fractf(ir1[e] * pos);
        c0[e] = __builtin_amdgcn_cosf(r0); s0[e] = __builtin_amdgcn_sinf(r0); c1[e] = __builtin_amdgcn_cosf(r1); s1[e] = __builtin_amdgcn_sinf(r1); }
    const f32x4 p0 = a0 * c0 - b0 * s0, p1 = a1 * c1 - b1 * s1, q0 = b0 * c0 + a0 * s0, q1 = b1 * c1 + a1 * s1;
    o1 = pack8(p0, p1); o2 = pack8(q0, q1);
}
constexpr float L2T_128 = 13.287712379549449f / 64.0f, L2T_64 = 13.287712379549449f / 32.0f;
typedef PG8_LAS float* PG8_LAS_float_ptr;
struct NormIn { const float* ssx; const float* bias; int nphys; PG8_LAS float* tab; };
__device__ __forceinline__ unsigned rstd_tag(const float* bias, int pm) { return ((((unsigned)((uintptr_t)bias >> 2)) << 6) & 0x3FFFFFC0u) | 0x40000000u | (unsigned)pm; }
__device__ __forceinline__ void rows_rstd(const float* slots, int stride, int off, float inv_n, int pm, PG8_LAS float* tab, unsigned tag, int wr, int wc, int fr, int fq, float (&rs)[2][4]) {
    const int t = (wr * 4 + wc) * 64 + fq * 16 + fr;
    const unsigned have = (unsigned)__builtin_amdgcn_readfirstlane((int)__builtin_bit_cast(unsigned, tab[256]));
    if (have != tag) {
        if (t < 256) { const float* p = slots + (size_t)(pm * BM + t) * stride + off; const f32x4 a = *(const f32x4*)p, b = *(const f32x4*)(p + 4);
            tab[t] = 1.0f / sqrtf((((a[0] + a[1]) + (a[2] + a[3])) + ((b[0] + b[1]) + (b[2] + b[3]))) * inv_n + 1e-6f); }
        asm volatile("s_waitcnt lgkmcnt(0)" ::: "memory"); __builtin_amdgcn_s_barrier(); asm volatile("" ::: "memory");
        if (t == 0) tab[256] = __builtin_bit_cast(float, tag);
    }
#pragma unroll
    for (int ai = 0; ai < 2; ++ai)
#pragma unroll
        for (int m = 0; m < 4; ++m) rs[ai][m] = tab[ai * HALF + wr * 64 + m * 16 + fr];
}
__device__ __forceinline__ void rstd_begin_load(const NormIn& ni, int pm, int t, EpiPre& r) { if (t < 256) { const float* p = ni.ssx + (size_t)(pm * BM + t) * 8; r.a = *(const f32x4*)p; r.b = *(const f32x4*)(p + 4); } }
__device__ __forceinline__ void rstd_begin_store(const NormIn& ni, int pm, int t, const EpiPre& r) {
    if (t < 256) ni.tab[t] = 1.0f / sqrtf((((r.a[0] + r.a[1]) + (r.a[2] + r.a[3])) + ((r.b[0] + r.b[1]) + (r.b[2] + r.b[3]))) * (1.0f / 2048.0f) + 1e-6f);
    if (t == 0) ni.tab[256] = __builtin_bit_cast(float, rstd_tag(ni.bias, pm));
}
__device__ __forceinline__ void bias_prefetch(const NormIn& ni, const Unit& u, int wid, int lane) {
    if (wid == 0) __builtin_amdgcn_global_load_lds((const unsigned*)(ni.bias + (size_t)(u.pm >> 4) * ni.nphys + u.pn * BM + lane * 4), (PG8_LAS unsigned*)(ni.tab + 512), 16, 0, 0);
}
__device__ __forceinline__ void load_bias(const NormIn& ni, const Unit& u, int wc, int fq, f32x4 (&bv)[2][2]) {
    const PG8_LAS float* bp = ni.tab + 512 + wc * 32 + 8 * fq; (void)u;
#pragma unroll
    for (int bj = 0; bj < 2; ++bj)
#pragma unroll
        for (int n = 0; n < 2; ++n) bv[bj][n] = *(const PG8_LAS f32x4*)(bp + bj * HALF + 4 * n);
}
__device__ __forceinline__ void unpack8(const u32x4 w, f32x4& lo, f32x4& hi) {
    lo = (f32x4){__uint_as_float(w.x << 16), __uint_as_float(w.x & 0xffff0000u), __uint_as_float(w.y << 16), __uint_as_float(w.y & 0xffff0000u)};
    hi = (f32x4){__uint_as_float(w.z << 16), __uint_as_float(w.z & 0xffff0000u), __uint_as_float(w.w << 16), __uint_as_float(w.w & 0xffff0000u)};
}
struct EpiResid {
    static constexpr bool PERM = true, AFTER_DRAIN = false;
    bf16_t* x; const float* gate;
    bf16_t* hb; const float* gn; const float* scn; float* ssx; PG8_LAS float* part;
    __device__ __forceinline__ void operator()(const f32x4 (&acc)[2][2][4][2], const Unit& u, int wr, int wc, int fr, int fq) const {
        const int row0 = u.pm * BM + wr * 64 + fr, col0 = u.pn * BM + wc * 32 + 8 * fq;
        const size_t boff = (size_t)(u.pm >> 4) * 12288 + col0;
        f32x4 gv[2][2], mv[2][2];
#pragma unroll
        for (int bj = 0; bj < 2; ++bj)
#pragma unroll
            for (int n = 0; n < 2; ++n) { gv[bj][n] = *(const f32x4*)(gate + boff + bj * HALF + 4 * n);
                if (hb) mv[bj][n] = *(const f32x4*)(gn + col0 + bj * HALF + 4 * n) * (*(const f32x4*)(scn + boff + bj * HALF + 4 * n) + 1.0f); }
#pragma unroll
        for (int ai = 0; ai < 2; ++ai) {
            u32x4 xw[4][2];
#pragma unroll
            for (int m = 0; m < 4; ++m)
#pragma unroll
                for (int bj = 0; bj < 2; ++bj) xw[m][bj] = *(const u32x4*)(x + (size_t)(row0 + ai * HALF + m * 16) * 2048 + col0 + bj * HALF);
#pragma unroll
            for (int m = 0; m < 4; ++m) { const int rl = ai * HALF + wr * 64 + m * 16 + fr; const size_t off = (size_t)(row0 + ai * HALF + m * 16) * 2048 + col0; float s = 0.f;
#pragma unroll
                for (int bj = 0; bj < 2; ++bj) { f32x4 x0, x1; unpack8(xw[m][bj], x0, x1);
                    const f32x4 n0 = x0 + gv[bj][0] * acc[ai][bj][m][0], n1 = x1 + gv[bj][1] * acc[ai][bj][m][1];
                    *(u32x4*)(x + off + bj * HALF) = pack8(n0, n1);
                    s += ((n0[0] * n0[0] + n0[1] * n0[1]) + (n0[2] * n0[2] + n0[3] * n0[3])) + ((n1[0] * n1[0] + n1[1] * n1[1]) + (n1[2] * n1[2] + n1[3] * n1[3]));
                    if (hb) *(u32x4*)(hb + off + bj * HALF) = pack8(n0 * mv[bj][0], n1 * mv[bj][1]); }
                if (hb) { s += __shfl_xor(s, 16); s += __shfl_xor(s, 32); if (fq == 0) part[rl * 4 + wc] = s; } }
        }
        if (hb) {
            asm volatile("s_waitcnt lgkmcnt(0)" ::: "memory"); __builtin_amdgcn_s_barrier(); asm volatile("" ::: "memory");
            const int t = (wr * 4 + wc) * 64 + fq * 16 + fr;
            if (t < 256) { const f32x4 p = *(const PG8_LAS f32x4*)(part + t * 4); ssx[(size_t)(u.pm * BM + t) * 8 + u.pn] = (p[0] + p[1]) + (p[2] + p[3]); }
        }
    }
};
struct EpiSwiglu {
    static constexpr bool PERM = true, AFTER_DRAIN = false;
    bf16_t* act; NormIn ni;
    __device__ __forceinline__ void begin_load(const Unit& u, int t, EpiPre& r) const { rstd_begin_load(ni, u.pm, t, r); }
    __device__ __forceinline__ void begin_store(const Unit& u, int t, const EpiPre& r) const { rstd_begin_store(ni, u.pm, t, r); }
    __device__ __forceinline__ void prefetch(const Unit& u, int wid, int lane) const { bias_prefetch(ni, u, wid, lane); }
    __device__ __forceinline__ void operator()(const f32x4 (&acc)[2][2][4][2], const Unit& u, int wr, int wc, int fr, int fq) const {
        const int row0 = u.pm * BM + wr * 64 + fr, col0 = u.pn * 128 + wc * 32 + 8 * fq;
        f32x4 bv[2][2]; load_bias(ni, u, wc, fq, bv); float rs[2][4]; rows_rstd(ni.ssx, 8, 0, 1.0f / 2048.0f, u.pm, ni.tab, rstd_tag(ni.bias, u.pm), wr, wc, fr, fq, rs);
#pragma unroll
        for (int ai = 0; ai < 2; ++ai)
#pragma unroll
            for (int m = 0; m < 4; ++m) { const int row = row0 + ai * HALF + m * 16; const float rstd = rs[ai][m]; f32x4 r[2];
#pragma unroll
                for (int n = 0; n < 2; ++n)
#pragma unroll
                    for (int i = 0; i < 4; ++i) { const float g = acc[ai][0][m][n][i] * rstd + bv[0][n][i], up = acc[ai][1][m][n][i] * rstd + bv[1][n][i];
                        r[n][i] = g * __builtin_amdgcn_rcpf(1.0f + __builtin_amdgcn_exp2f(-1.4426950408889634f * g)) * up; }
                *(u32x4*)(act + (size_t)row * 5632 + col0) = pack8(r[0], r[1]); }
    }
};
struct EpiSplit3 {
    static constexpr bool PERM = true, AFTER_DRAIN = false;
    bf16_t* O0; size_t stride; NormIn ni;
    __device__ __forceinline__ void begin_load(const Unit& u, int t, EpiPre& r) const { rstd_begin_load(ni, u.pm, t, r); }
    __device__ __forceinline__ void begin_store(const Unit& u, int t, const EpiPre& r) const { rstd_begin_store(ni, u.pm, t, r); }
    __device__ __forceinline__ void prefetch(const Unit& u, int wid, int lane) const { bias_prefetch(ni, u, wid, lane); }
    __device__ __forceinline__ void operator()(const f32x4 (&acc)[2][2][4][2], const Unit& u, int wr, int wc, int fr, int fq) const {
        const int t = u.pn >> 3; bf16_t* base = O0 + (size_t)t * stride;
        const int row0 = u.pm * BM + wr * 64 + fr, col0 = (u.pn & 7) * 256 + wc * 32 + 8 * fq;
        f32x4 bv[2][2]; load_bias(ni, u, wc, fq, bv); float rs[2][4]; rows_rstd(ni.ssx, 8, 0, 1.0f / 2048.0f, u.pm, ni.tab, rstd_tag(ni.bias, u.pm), wr, wc, fr, fq, rs);
#pragma unroll
        for (int ai = 0; ai < 2; ++ai)
#pragma unroll
            for (int m = 0; m < 4; ++m) { const int row = row0 + ai * HALF + m * 16; const float rstd = rs[ai][m]; bf16_t* rowp = base + (size_t)row * 2048 + col0;
#pragma unroll
                for (int bj = 0; bj < 2; ++bj) *(u32x4*)(rowp + bj * HALF) = pack8(acc[ai][bj][m][0] * rstd + bv[bj][0], acc[ai][bj][m][1] * rstd + bv[bj][1]); }
    }
};
#define NI_VALS(ai, m) const int row = row0 + (ai) * HALF + (m) * 16; const float rstd = rs[ai][m]; \
    const f32x4 v00 = acc[ai][0][m][0] * rstd + bv[0][0], v01 = acc[ai][0][m][1] * rstd + bv[0][1], v10 = acc[ai][1][m][0] * rstd + bv[1][0], v11 = acc[ai][1][m][1] * rstd + bv[1][1];
struct EpiDsaIn {
    static constexpr bool PERM = true, AFTER_DRAIN = false;
    bf16_t *Q, *K, *V, *IQ, *IK; float* IW; NormIn ni;
    __device__ __forceinline__ void begin_load(const Unit& u, int t, EpiPre& r) const { rstd_begin_load(ni, u.pm, t, r); }
    __device__ __forceinline__ void begin_store(const Unit& u, int t, const EpiPre& r) const { rstd_begin_store(ni, u.pm, t, r); }
    __device__ __forceinline__ void prefetch(const Unit& u, int wid, int lane) const { bias_prefetch(ni, u, wid, lane); }
    __device__ __forceinline__ void operator()(const f32x4 (&acc)[2][2][4][2], const Unit& u, int wr, int wc, int fr, int fq) const {
        const int pn = u.pn, row0 = u.pm * BM + wr * 64 + fr;
        f32x4 bv[2][2]; load_bias(ni, u, wc, fq, bv); float rs[2][4]; rows_rstd(ni.ssx, 8, 0, 1.0f / 2048.0f, u.pm, ni.tab, rstd_tag(ni.bias, u.pm), wr, wc, fr, fq, rs);
        if (pn < 10) {
            bf16_t* base; int ld, hcol;
            if (pn < 8) { base = Q; ld = 2048; hcol = (2 * pn + (wc >> 1)) * 128; } else { base = K; ld = 512; hcol = (2 * (pn - 8) + (wc >> 1)) * 128; }
            const int dd0 = 32 * (wc & 1) + 8 * fq; f32x4 ir0, ir1; rope_ir(dd0, L2T_128, ir0, ir1);
#pragma unroll
            for (int ai = 0; ai < 2; ++ai)
#pragma unroll
                for (int m = 0; m < 4; ++m) { NI_VALS(ai, m) const float pos = (float)(row & 4095); u32x4 o1, o2;
                    rope8(ir0, ir1, pos, v00, v01, v10, v11, o1, o2);
                    bf16_t* p = base + (size_t)row * ld + hcol + dd0; *(u32x4*)p = o1; *(u32x4*)(p + 64) = o2; }
        } else if (pn < 12) {
            const int col0 = (pn - 10) * 256 + wc * 32 + 8 * fq;
#pragma unroll
            for (int ai = 0; ai < 2; ++ai)
#pragma unroll
                for (int m = 0; m < 4; ++m) { NI_VALS(ai, m) bf16_t* rowp = V + (size_t)row * 512 + col0;
                    *(u32x4*)rowp = pack8(v00, v01); *(u32x4*)(rowp + HALF) = pack8(v10, v11); }
        } else {
            bf16_t* base; int ld, hcol;
            if (pn < 20) { base = IQ; ld = 2048; hcol = (2 * (pn - 12) + (wc >> 1)) * 128; } else { base = IK; ld = 128; hcol = 0; }
            const int sub = (pn < 20) ? (wc & 1) : wc;
            if (sub == 0) {
                const int dd0 = 8 * fq; f32x4 ir0, ir1; rope_ir(dd0, L2T_64, ir0, ir1);
#pragma unroll
                for (int ai = 0; ai < 2; ++ai)
#pragma unroll
                    for (int m = 0; m < 4; ++m) { NI_VALS(ai, m) const float pos = (float)(row & 4095); u32x4 o1, o2;
                        rope8(ir0, ir1, pos, v00, v01, v10, v11, o1, o2);
                        bf16_t* p = base + (size_t)row * ld + hcol + dd0; *(u32x4*)p = o1; *(u32x4*)(p + 32) = o2; }
            } else if (sub == 1) {
#pragma unroll
                for (int ai = 0; ai < 2; ++ai)
#pragma unroll
                    for (int m = 0; m < 4; ++m) { NI_VALS(ai, m) bf16_t* p = base + (size_t)row * ld + hcol + 64 + 8 * fq;
                        *(u32x4*)p = pack8(v00, v01); *(u32x4*)(p + 32) = pack8(v10, v11); }
            } else if (sub == 2 && pn == 20) {
                if (fq < 2) {
#pragma unroll
                    for (int ai = 0; ai < 2; ++ai)
#pragma unroll
                        for (int m = 0; m < 4; ++m) { NI_VALS(ai, m) float* p = IW + (size_t)row * 16 + 8 * fq; *(f32x4*)p = v00; *(f32x4*)(p + 4) = v01; (void)v10; (void)v11; }
                }
            }
        }
    }
};
struct EpiMlaDown {
    static constexpr bool PERM = true, AFTER_DRAIN = false;
    bf16_t *CQ, *CKV, *KR; float* ssq; NormIn ni; int pn_off;
    __device__ __forceinline__ void begin_load(const Unit& u, int t, EpiPre& r) const { rstd_begin_load(ni, u.pm, t, r); }
    __device__ __forceinline__ void begin_store(const Unit& u, int t, const EpiPre& r) const { rstd_begin_store(ni, u.pm, t, r); }
    __device__ __forceinline__ void prefetch(const Unit& u, int wid, int lane) const { Unit ub = u; ub.pn = u.pn + pn_off; bias_prefetch(ni, ub, wid, lane); }
    __device__ __forceinline__ void operator()(const f32x4 (&acc)[2][2][4][2], const Unit& u, int wr, int wc, int fr, int fq) const {
        const int pn = u.pn + pn_off, row0 = u.pm * BM + wr * 64 + fr;
        Unit ub = u; ub.pn = pn;
        f32x4 bv[2][2]; load_bias(ni, ub, wc, fq, bv); float rs[2][4]; rows_rstd(ni.ssx, 8, 0, 1.0f / 2048.0f, u.pm, ni.tab, rstd_tag(ni.bias, u.pm), wr, wc, fr, fq, rs);
        if (pn < 4) {
            bf16_t* base = pn < 2 ? CQ : CKV; const int col0 = (pn & 1) * 256 + wc * 32 + 8 * fq;
#pragma unroll
            for (int ai = 0; ai < 2; ++ai)
#pragma unroll
                for (int m = 0; m < 4; ++m) { NI_VALS(ai, m)
                    float s = ((v00[0] * v00[0] + v00[1] * v00[1]) + (v00[2] * v00[2] + v00[3] * v00[3])) + ((v01[0] * v01[0] + v01[1] * v01[1]) + (v01[2] * v01[2] + v01[3] * v01[3]));
                    s += ((v10[0] * v10[0] + v10[1] * v10[1]) + (v10[2] * v10[2] + v10[3] * v10[3])) + ((v11[0] * v11[0] + v11[1] * v11[1]) + (v11[2] * v11[2] + v11[3] * v11[3]));
                    *(u32x4*)(base + (size_t)row * 512 + col0) = pack8(v00, v01); *(u32x4*)(base + (size_t)row * 512 + col0 + HALF) = pack8(v10, v11);
                    s += __shfl_xor(s, 16); s += __shfl_xor(s, 32);
                    if (fq == 0) ssq[(size_t)row * 16 + pn * 4 + wc] = s; }
        } else if (wc == 0) {
            const int dd0 = 8 * fq; f32x4 ir0, ir1; rope_ir(dd0, L2T_64, ir0, ir1);
#pragma unroll
            for (int ai = 0; ai < 2; ++ai)
#pragma unroll
                for (int m = 0; m < 4; ++m) { NI_VALS(ai, m) const float pos = (float)(row & 4095); u32x4 o1, o2;
                    rope8(ir0, ir1, pos, v00, v01, v10, v11, o1, o2);
                    bf16_t* p = KR + (size_t)row * 64 + dd0; *(u32x4*)p = o1; *(u32x4*)(p + 32) = o2; }
        }
    }
};
#undef NI_VALS
struct EpiMlaUq {
    static constexpr bool PERM = true, AFTER_DRAIN = false;
    bf16_t *QN, *QR; const float* ssq; PG8_LAS float* tab;
    __device__ __forceinline__ void operator()(const f32x4 (&acc)[2][2][4][2], const Unit& u, int wr, int wc, int fr, int fq) const {
        const int pn = u.pn, row0 = u.pm * BM + wr * 64 + fr;
        float rs[2][4]; rows_rstd(ssq, 16, 0, 1.0f / 512.0f, u.pm, tab, 0x80000000u | (unsigned)u.pm, wr, wc, fr, fq, rs);
        f32x4 ir0, ir1; rope_ir(8 * fq, L2T_64, ir0, ir1);
#pragma unroll
        for (int ai = 0; ai < 2; ++ai)
#pragma unroll
            for (int m = 0; m < 4; ++m) { const int row = row0 + ai * HALF + m * 16; const float rstd = rs[ai][m];
                if (pn < 8) { bf16_t* rowp = QN + (size_t)row * 2048 + pn * 256 + wc * 32 + 8 * fq;
#pragma unroll
                    for (int bj = 0; bj < 2; ++bj) *(u32x4*)(rowp + bj * HALF) = pack8(acc[ai][bj][m][0] * rstd, acc[ai][bj][m][1] * rstd);
                } else { u32x4 o1, o2; const int dd0 = 8 * fq;
                    rope8(ir0, ir1, (float)(row & 4095), acc[ai][0][m][0] * rstd, acc[ai][0][m][1] * rstd, acc[ai][1][m][0] * rstd, acc[ai][1][m][1] * rstd, o1, o2);
                    bf16_t* p = QR + (size_t)row * 1024 + (4 * (pn - 8) + wc) * 64 + dd0; *(u32x4*)p = o1; *(u32x4*)(p + 32) = o2; } }
    }
};
struct EpiMlaUkv {
    static constexpr bool PERM = true, AFTER_DRAIN = false;
    bf16_t *KN, *V; const float* ssq; PG8_LAS float* tab;
    __device__ __forceinline__ void operator()(const f32x4 (&acc)[2][2][4][2], const Unit& u, int wr, int wc, int fr, int fq) const {
        const int row0 = u.pm * BM + wr * 64 + fr, col0 = u.pn * 128 + wc * 32 + 8 * fq;
        float rs[2][4]; rows_rstd(ssq, 16, 8, 1.0f / 512.0f, u.pm, tab, 0x80000100u | (unsigned)u.pm, wr, wc, fr, fq, rs);
#pragma unroll
        for (int ai = 0; ai < 2; ++ai)
#pragma unroll
            for (int m = 0; m < 4; ++m) { const int row = row0 + ai * HALF + m * 16; const float rstd = rs[ai][m];
                *(u32x4*)(KN + (size_t)row * 2048 + col0) = pack8(acc[ai][0][m][0] * rstd, acc[ai][0][m][1] * rstd);
                *(u32x4*)(V + (size_t)row * 2048 + col0) = pack8(acc[ai][1][m][0] * rstd, acc[ai][1][m][1] * rstd); }
    }
};

template <class E> __device__ __forceinline__ auto epi_pre(const E& e, const Unit& u, int wid, int lane, int) -> decltype(e.prefetch(u, wid, lane), void()) { e.prefetch(u, wid, lane); }
template <class E> __device__ __forceinline__ void epi_pre(const E&, const Unit&, int, int, long) {}
template <class E> __device__ __forceinline__ auto epi_begin_load(const E& e, const Unit& u, int t, EpiPre& r, int) -> decltype(e.begin_load(u, t, r), void()) { e.begin_load(u, t, r); }
template <class E> __device__ __forceinline__ void epi_begin_load(const E&, const Unit&, int, EpiPre&, long) {}
template <class E> __device__ __forceinline__ auto epi_begin_store(const E& e, const Unit& u, int t, const EpiPre& r, int) -> decltype(e.begin_store(u, t, r), void()) { e.begin_store(u, t, r); }
template <class E> __device__ __forceinline__ void epi_begin_store(const E&, const Unit&, int, const EpiPre&, long) {}
template <class Epi, class Sched, bool ALIGN_EPI = false, bool SP2 = false>
__device__ __forceinline__ void gemm_phase(PG8_LAS unsigned char* lds, const Gemm g, const Sched& S, const Epi& E) {
    int tid = threadIdx.x; asm volatile("" : "+v"(tid));
    const int wid = __builtin_amdgcn_readfirstlane(tid >> 6), lane = tid & 63, wr = wid >> 2, wc = wid & 3, fr = lane & 15, fq = lane >> 4;
    const int K = g.K, nt = K / BK;
    unsigned voffA[2], voffB[2];
#pragma unroll
    for (int i = 0; i < 2; ++i) { int R, C; stage_rc(tid * 16 + i * 8192, R, C); const int Rb = Epi::PERM ? ((R & ~31) + perm32(R & 31)) : R;
        voffA[i] = (unsigned)(R * K + C) * 2u; voffB[i] = (unsigned)(Rb * K + C) * 2u; }
    const size_t kstep = (size_t)(BK * 2);
    const size_t hstep = (size_t)HALF * K * 2;
    const size_t tstep = 2 * hstep;
    const unsigned ldsw = (unsigned)wid * 1024u;
    const int aoff = lds_byte(wr * 64 + fr, fq * 8), boff = lds_byte(wc * 32 + fr, fq * 8);
#define PG8_SA(b, h) (((b) * 2 + (h)) * HTB)
#define PG8_SB(b, h) ((4 + (b) * 2 + (h)) * HTB)
#define PG8_STAGE(bufoff, gbase, voff) do { _Pragma("unroll") for (int _i = 0; _i < 2; ++_i) \
        __builtin_amdgcn_global_load_lds((const unsigned*)((const char*)(gbase) + (voff)[_i]), (PG8_LAS unsigned*)(lds + (bufoff) + ldsw + _i * 8192), 16, 0, 0); } while (0)
#define PG8_LDA(dst, b, h) do { _Pragma("unroll") for (int m = 0; m < 4; ++m) _Pragma("unroll") for (int k = 0; k < 2; ++k) dst[m][k] = *(const PG8_LAS bf16x8*)(lds + PG8_SA(b, h) + aoff + m * 2048 + k * 1024); } while (0)
#define PG8_LDB(dst, b, h) do { _Pragma("unroll") for (int n = 0; n < 2; ++n) _Pragma("unroll") for (int k = 0; k < 2; ++k) dst[n][k] = *(const PG8_LAS bf16x8*)(lds + PG8_SB(b, h) + boff + n * 2048 + k * 1024); } while (0)
#define PG8_MMA(ai, bj, At, Bt) do { __builtin_amdgcn_s_setprio(1); _Pragma("unroll") for (int m = 0; m < 4; ++m) _Pragma("unroll") for (int n = 0; n < 2; ++n) _Pragma("unroll") for (int k = 0; k < 2; ++k) \
        acc[ai][bj][m][n] = __builtin_amdgcn_mfma_f32_16x16x32_bf16(Bt[n][k], At[m][k], acc[ai][bj][m][n], 0, 0, 0); __builtin_amdgcn_s_setprio(0); } while (0)
#define PG8_WAIT_V(n) asm volatile("s_waitcnt vmcnt(" #n ")" ::: "memory")
#define PG8_WAIT_L(n) asm volatile("s_waitcnt lgkmcnt(" #n ")" ::: "memory")
#define PG8_BAR __builtin_amdgcn_s_barrier()
#define PG8_SCHED __builtin_amdgcn_sched_barrier(0)
    Unit cur, nxt; int ui = 0;
    if (!S.next(0, cur)) return;
    f32x4 acc[2][2][4][2];
#pragma unroll
    for (int a = 0; a < 2; ++a)
#pragma unroll
        for (int b = 0; b < 2; ++b)
#pragma unroll
            for (int m = 0; m < 4; ++m)
#pragma unroll
                for (int n = 0; n < 2; ++n) acc[a][b][m][n] = (f32x4){0.f, 0.f, 0.f, 0.f};
    bf16x8 At[4][2], B0[2][2], B1[2][2];
    const char* cA = (const char*)g.A + (size_t)cur.pm * tstep; const char* cB = (const char*)g.Bt + (size_t)cur.pn * tstep;
    S.a_ready(cur);
    if constexpr (SP2) {
        EpiPre pre_; epi_begin_load(E, cur, tid, pre_, 0);
        PG8_STAGE(PG8_SB(0, 0), cB, voffB); PG8_STAGE(PG8_SB(0, 1), cB + hstep, voffB); PG8_STAGE(PG8_SA(0, 0), cA, voffA); PG8_STAGE(PG8_SA(0, 1), cA + hstep, voffA);
        if (wr == 1) PG8_BAR;
        PG8_WAIT_V(2); PG8_BAR;
        epi_begin_store(E, cur, tid, pre_, 0);
        PG8_STAGE(PG8_SB(1, 0), cB + kstep, voffB); PG8_STAGE(PG8_SA(1, 0), cA + kstep, voffA); PG8_STAGE(PG8_SB(1, 1), cB + hstep + kstep, voffB);
        PG8_WAIT_V(6); PG8_BAR;
    } else {
        PG8_STAGE(PG8_SB(0, 0), cB, voffB); PG8_STAGE(PG8_SA(0, 0), cA, voffA); PG8_STAGE(PG8_SB(0, 1), cB + hstep, voffB); PG8_STAGE(PG8_SA(0, 1), cA + hstep, voffA);
        if (wr == 1) PG8_BAR;
        PG8_WAIT_V(4); PG8_BAR;
        PG8_STAGE(PG8_SB(1, 0), cB + kstep, voffB); PG8_STAGE(PG8_SA(1, 0), cA + kstep, voffA); PG8_STAGE(PG8_SB(1, 1), cB + hstep + kstep, voffB);
        PG8_WAIT_V(6); PG8_BAR;
    }
    for (;;) {
        const bool has_next = S.next(ui + 1, nxt);
        const char* nA = has_next ? (const char*)g.A + (size_t)nxt.pm * tstep : cA; const char* nB = has_next ? (const char*)g.Bt + (size_t)nxt.pn * tstep : cB;
        for (int t = 0; t < nt; t += 2) {
            const bool last = (t == nt - 2);
            const char* a1 = cA + (size_t)(t + 1) * kstep;
            const char* a2 = last ? nA : cA + (size_t)(t + 2) * kstep; const char* b2 = last ? nB : cB + (size_t)(t + 2) * kstep;
            const char* a3 = a2 + kstep; const char* b3 = b2 + kstep;
            if (last && has_next) S.a_ready(nxt);
            if (t == (nt >= 4 ? nt - 4 : nt - 2)) epi_pre(E, cur, wid, lane, 0);
            if constexpr (SP2) {
            PG8_LDB(B0, 0, 0); PG8_LDB(B1, 0, 1); PG8_SCHED; PG8_LDA(At, 0, 0); PG8_STAGE(PG8_SA(1, 1), a1 + hstep, voffA);
            PG8_WAIT_V(8); PG8_WAIT_L(0); PG8_BAR; PG8_MMA(0, 0, At, B0); PG8_MMA(0, 1, At, B1); PG8_BAR; PG8_SCHED;
            PG8_LDA(At, 0, 1); PG8_STAGE(PG8_SB(0, 0), b2, voffB); PG8_STAGE(PG8_SB(0, 1), b2 + hstep, voffB); PG8_STAGE(PG8_SA(0, 0), a2, voffA);
            PG8_WAIT_V(8); PG8_WAIT_L(0); PG8_BAR; PG8_MMA(1, 0, At, B0); PG8_MMA(1, 1, At, B1); PG8_BAR; PG8_SCHED;
            PG8_LDB(B0, 1, 0); PG8_LDB(B1, 1, 1); PG8_SCHED; PG8_LDA(At, 1, 0); PG8_STAGE(PG8_SA(0, 1), a2 + hstep, voffA);
            PG8_WAIT_V(8); PG8_WAIT_L(0); PG8_BAR; PG8_MMA(0, 0, At, B0); PG8_MMA(0, 1, At, B1); PG8_BAR; PG8_SCHED;
            PG8_LDA(At, 1, 1); PG8_STAGE(PG8_SB(1, 0), b3, voffB); PG8_STAGE(PG8_SB(1, 1), b3 + hstep, voffB); PG8_STAGE(PG8_SA(1, 0), a3, voffA);
            PG8_WAIT_V(8); PG8_WAIT_L(0); PG8_BAR; PG8_MMA(1, 0, At, B0); PG8_MMA(1, 1, At, B1); PG8_BAR; PG8_SCHED;
            } else {
            PG8_LDB(B0, 0, 0); PG8_SCHED; PG8_LDA(At, 0, 0); PG8_STAGE(PG8_SA(1, 1), a1 + hstep, voffA);
            PG8_WAIT_L(8); PG8_BAR; PG8_WAIT_L(0); PG8_MMA(0, 0, At, B0); PG8_BAR; PG8_SCHED;
            PG8_LDB(B1, 0, 1); PG8_STAGE(PG8_SB(0, 0), b2, voffB);
            PG8_BAR; PG8_WAIT_L(0); PG8_MMA(0, 1, At, B1); PG8_BAR;
            PG8_LDA(At, 0, 1); PG8_STAGE(PG8_SA(0, 0), a2, voffA);
            PG8_BAR; PG8_WAIT_L(0); PG8_MMA(1, 0, At, B0); PG8_BAR; PG8_SCHED;
            PG8_STAGE(PG8_SB(0, 1), b2 + hstep, voffB);
            PG8_WAIT_V(6); PG8_BAR; PG8_MMA(1, 1, At, B1); PG8_BAR;
            PG8_LDB(B0, 1, 0); PG8_SCHED; PG8_LDA(At, 1, 0); PG8_STAGE(PG8_SA(0, 1), a2 + hstep, voffA);
            PG8_WAIT_L(8); PG8_BAR; PG8_WAIT_L(0); PG8_MMA(0, 0, At, B0); PG8_BAR; PG8_SCHED;
            PG8_LDB(B1, 1, 1); PG8_STAGE(PG8_SB(1, 0), b3, voffB);
            PG8_BAR; PG8_WAIT_L(0); PG8_MMA(0, 1, At, B1); PG8_BAR;
            PG8_LDA(At, 1, 1); PG8_STAGE(PG8_SA(1, 0), a3, voffA);
            PG8_BAR; PG8_WAIT_L(0); PG8_MMA(1, 0, At, B0); PG8_BAR; PG8_SCHED;
            PG8_STAGE(PG8_SB(1, 1), b3 + hstep, voffB);
            PG8_WAIT_V(6); PG8_BAR; PG8_MMA(1, 1, At, B1); PG8_BAR;
            }
        }
        if constexpr (ALIGN_EPI) { if (wr == 0) PG8_BAR; }
        if constexpr (!Epi::AFTER_DRAIN) { E(acc, cur, wr, wc, fr, fq); S.done(cur); }
        if (!has_next) break;
#pragma unroll
        for (int a = 0; a < 2; ++a)
#pragma unroll
            for (int b = 0; b < 2; ++b)
#pragma unroll
                for (int m = 0; m < 4; ++m)
#pragma unroll
                    for (int n = 0; n < 2; ++n) acc[a][b][m][n] = (f32x4){0.f, 0.f, 0.f, 0.f};
        cur = nxt; cA = nA; cB = nB; ++ui;
        if constexpr (ALIGN_EPI) { if (wr == 1) PG8_BAR; }
    }
    PG8_WAIT_V(0);
    if constexpr (!ALIGN_EPI) { if (wr == 0) PG8_BAR; }
    PG8_BAR;
    if constexpr (Epi::AFTER_DRAIN) { E.fused(acc, cur, wr, wc, fr, fq, lds, wid, lane); S.done(cur); }
#undef PG8_SA
#undef PG8_SB
#undef PG8_STAGE
#undef PG8_LDA
#undef PG8_LDB
#undef PG8_MMA
#undef PG8_WAIT_V
#undef PG8_WAIT_L
#undef PG8_BAR
#undef PG8_SCHED
}
}
#ifndef LATE_PRIO
#define LATE_PRIO 1
#endif
#ifndef SM_SUM_MFMA
#define SM_SUM_MFMA 0
#endif
#ifndef DSTAMP
#define DSTAMP 0
#define DSTAMP_W 0
#endif
#ifndef DSTAMP_MUL
#define DSTAMP_MUL 1
#endif
#define DST_STAMP(t) do { __builtin_amdgcn_sched_barrier(0); asm volatile("s_memrealtime %0\n\ts_waitcnt lgkmcnt(0)" : "=s"(t) :: "memory"); __builtin_amdgcn_sched_barrier(0); } while (0)
#define DST_A(n) do { if constexpr (DSTAMP == (n)) DST_STAMP(dta_); } while (0)
#define DST_B(n) do { if constexpr (DSTAMP == (n)) { unsigned long long dtb_; DST_STAMP(dtb_); dacc_ += dtb_ - dta_; } } while (0)
namespace att {
typedef unsigned short bf16_t;
using bf16x8 = __attribute__((ext_vector_type(8))) short;
using s16x4  = __attribute__((ext_vector_type(4))) short;
using f32x16 = __attribute__((ext_vector_type(16))) float;
using f32x4  = __attribute__((ext_vector_type(4))) float;
using u32x4  = __attribute__((ext_vector_type(4))) unsigned;
#define KSWZ(row, colB) ((row) * 256 + ((colB) ^ (((row) & 15) << 4)))
#define ATT_SBAR() __builtin_amdgcn_sched_barrier(0)
constexpr int SHM_KV = 16384;
__device__ __forceinline__ int crow(int r, int hi) { return (r & 3) + 8 * (r >> 2) + 4 * hi; }
__device__ __forceinline__ unsigned cvtpk(float lo, float hi) { unsigned r; asm volatile("v_cvt_pk_bf16_f32 %0, %1, %2" : "=v"(r) : "v"(lo), "v"(hi)); return r; }
template <int SC1E9> __device__ __forceinline__ void partialSM(f32x16& p0, f32x16& p1, float& m_reg, float& mn, float& alpha) {
  constexpr float SCALE = (float)(SC1E9 * 1e-9), THR = 8.f, C = SCALE * 1.4426950408889634f;
  float pmax = p0[0];
#pragma unroll
  for (int r = 1; r < 16; ++r) pmax = fmaxf(pmax, p0[r]);
#pragma unroll
  for (int r = 0; r < 16; ++r) pmax = fmaxf(pmax, p1[r]);
  { auto rr = __builtin_amdgcn_permlane32_swap(__float_as_uint(pmax), __float_as_uint(pmax), false, false);
    pmax = fmaxf(__uint_as_float(rr[0]), __uint_as_float(rr[1])); }
  if (__builtin_expect(__all(pmax - m_reg <= THR / SCALE), 1)) { mn = m_reg; alpha = 1.f; }
  else { mn = fmaxf(m_reg, pmax); alpha = __builtin_amdgcn_exp2f((m_reg - mn) * C); m_reg = mn; }
  const float mnC = -mn * C;
#pragma unroll
  for (int r = 0; r < 16; ++r) p0[r] = fmaf(p0[r], C, mnC);
#pragma unroll
  for (int r = 0; r < 16; ++r) p1[r] = fmaf(p1[r], C, mnC);
#pragma unroll
  for (int r = 0; r < 16; ++r) p0[r] = __builtin_amdgcn_exp2f(p0[r]);
}
__device__ __forceinline__ void packP(const f32x16& p0, const f32x16& p1, bf16x8& pa0, bf16x8& pa1, bf16x8& pa2, bf16x8& pa3) {
#define PK4(P, BASE, OUT) do { unsigned a0 = cvtpk(P[BASE + 0], P[BASE + 1]), a1 = cvtpk(P[BASE + 2], P[BASE + 3]);   \
    unsigned b0 = cvtpk(P[BASE + 4], P[BASE + 5]), b1 = cvtpk(P[BASE + 6], P[BASE + 7]);                              \
    auto r0 = __builtin_amdgcn_permlane32_swap(a0, b0, false, false); auto r1 = __builtin_amdgcn_permlane32_swap(a1, b1, false, false); \
    u32x4 w = {r0[0], r1[0], r0[1], r1[1]}; OUT = *reinterpret_cast<bf16x8*>(&w); } while (0)
  PK4(p0, 0, pa0); PK4(p0, 8, pa1); PK4(p1, 0, pa2); PK4(p1, 8, pa3);
#undef PK4
}
__device__ __forceinline__ void finishSM(f32x16& p0, f32x16& p1, float alpha, float& l_reg, bf16x8& pa0, bf16x8& pa1, bf16x8& pa2, bf16x8& pa3) {
#pragma unroll
  for (int r = 0; r < 16; ++r) p1[r] = __builtin_amdgcn_exp2f(p1[r]);
  packP(p0, p1, pa0, pa1, pa2, pa3);
#if SM_SUM_MFMA
  { const u32x4 onesw = {0x3F803F80u, 0x3F803F80u, 0x3F803F80u, 0x3F803F80u}; const bf16x8 ones = *reinterpret_cast<const bf16x8*>(&onesw);
    f32x16 ls = __builtin_amdgcn_mfma_f32_32x32x16_bf16(ones, pa0, f32x16{}, 0, 0, 0);
    ls = __builtin_amdgcn_mfma_f32_32x32x16_bf16(ones, pa1, ls, 0, 0, 0);
    ls = __builtin_amdgcn_mfma_f32_32x32x16_bf16(ones, pa2, ls, 0, 0, 0);
    ls = __builtin_amdgcn_mfma_f32_32x32x16_bf16(ones, pa3, ls, 0, 0, 0);
    l_reg = l_reg * alpha + ls[0]; }
#else
  float ps = 0;
#pragma unroll
  for (int r = 0; r < 16; ++r) ps += p0[r];
#pragma unroll
  for (int r = 0; r < 16; ++r) ps += p1[r];
  { auto rr = __builtin_amdgcn_permlane32_swap(__float_as_uint(ps), __float_as_uint(ps), false, false);
    ps = __uint_as_float(rr[0]) + __uint_as_float(rr[1]); }
  l_reg = l_reg * alpha + ps;
#endif
}
template <int NG = 4>
__device__ __forceinline__ void qkt(f32x16& p0, f32x16& p1, const char* Ks, const bf16x8* qr, int r32, int hi) {
  p0 = f32x16{}; p1 = f32x16{};
  constexpr int DG = 8 / NG;
  bf16x8 kb[2][DG][2];
#define QKT_LOADG(bf, g) do { _Pragma("unroll") for (int d = 0; d < DG; ++d) { const int cb = ((DG * (g) + d) * 16 + hi * 8) * 2; \
    kb[bf][d][0] = *reinterpret_cast<const bf16x8*>(Ks + KSWZ(r32, cb)); kb[bf][d][1] = *reinterpret_cast<const bf16x8*>(Ks + KSWZ(32 + r32, cb)); } } while (0)
  QKT_LOADG(0, 0);
#pragma unroll
  for (int g = 0; g < NG; ++g) {
    if (g + 1 < NG) QKT_LOADG((g + 1) & 1, g + 1);
    ATT_SBAR();
#pragma unroll
    for (int d = 0; d < DG; ++d) {
      p0 = __builtin_amdgcn_mfma_f32_32x32x16_bf16(kb[g & 1][d][0], qr[DG * g + d], p0, 0, 0, 0);
      p1 = __builtin_amdgcn_mfma_f32_32x32x16_bf16(kb[g & 1][d][1], qr[DG * g + d], p1, 0, 0, 0); }
    ATT_SBAR();
  }
#undef QKT_LOADG
}
__device__ __forceinline__ void qkt_rope(f32x16& p0, f32x16& p1, const char* Kr, const bf16x8* qr, int r32, int hi) {
#pragma unroll
  for (int d0 = 0; d0 < 4; ++d0) { const int cb = ((d0 * 16 + hi * 8) * 2) ^ (((r32 >> 1) & 7) << 4);
    const bf16x8 b0 = *reinterpret_cast<const bf16x8*>(Kr + r32 * 128 + cb);
    const bf16x8 b1 = *reinterpret_cast<const bf16x8*>(Kr + (32 + r32) * 128 + cb);
    p0 = __builtin_amdgcn_mfma_f32_32x32x16_bf16(b0, qr[d0], p0, 0, 0, 0);
    p1 = __builtin_amdgcn_mfma_f32_32x32x16_bf16(b1, qr[d0], p1, 0, 0, 0); }
}
__device__ __forceinline__ int v_st(int k, int c) { const int kk = (k & ~0xC) | ((k & 4) << 1) | ((k & 8) >> 1); return ((kk >> 3) * 4 + (c >> 5)) * 512 + ((kk & 7) * 32 + (c & 31)) * 2; }
__device__ __forceinline__ int v_rd_base(int lane) { return ((lane & 3) << 3) | (((lane >> 2) & 3) << 6) | (((lane >> 4) & 1) << 5) | (((lane >> 5) & 1) << 8); }
constexpr int v_rd_off(int d0, int ks, int half) { return d0 * 512 + ks * 4096 + half * 2048; }
template <int OFF> __device__ __forceinline__ s16x4 tr_read(int vb) {
  s16x4 r; asm volatile("ds_read_b64_tr_b16 %0, %1 offset:%2" : "=&v"(r) : "v"(vb), "i"(OFF) : "memory"); return r;
}
template <int D0> __device__ __forceinline__ void pv_read(int vb, s16x4 (&f)[8]) {
  f[0] = tr_read<v_rd_off(D0, 0, 0)>(vb); f[1] = tr_read<v_rd_off(D0, 0, 1)>(vb); f[2] = tr_read<v_rd_off(D0, 1, 0)>(vb); f[3] = tr_read<v_rd_off(D0, 1, 1)>(vb);
  f[4] = tr_read<v_rd_off(D0, 2, 0)>(vb); f[5] = tr_read<v_rd_off(D0, 2, 1)>(vb); f[6] = tr_read<v_rd_off(D0, 3, 0)>(vb); f[7] = tr_read<v_rd_off(D0, 3, 1)>(vb);
}
__device__ __forceinline__ void pv_mma(f32x16& od, const s16x4 (&f)[8], bf16x8 pa0, bf16x8 pa1, bf16x8 pa2, bf16x8 pa3) {
#define PK(L, H) (bf16x8){L[0], L[1], L[2], L[3], H[0], H[1], H[2], H[3]}
  od = __builtin_amdgcn_mfma_f32_32x32x16_bf16(pa0, PK(f[0], f[1]), od, 0, 0, 0);
  od = __builtin_amdgcn_mfma_f32_32x32x16_bf16(pa1, PK(f[2], f[3]), od, 0, 0, 0);
  od = __builtin_amdgcn_mfma_f32_32x32x16_bf16(pa2, PK(f[4], f[5]), od, 0, 0, 0);
  od = __builtin_amdgcn_mfma_f32_32x32x16_bf16(pa3, PK(f[6], f[7]), od, 0, 0, 0);
#undef PK
}
template <bool PIPE = true>
__device__ __forceinline__ void pv_d0(f32x16* o, int vb, bf16x8 pa0, bf16x8 pa1, bf16x8 pa2, bf16x8 pa3) {
  if constexpr (!PIPE) {
    s16x4 f[8];
    pv_read<0>(vb, f); asm volatile("s_waitcnt lgkmcnt(0)" ::: "memory"); ATT_SBAR(); pv_mma(o[0], f, pa0, pa1, pa2, pa3); ATT_SBAR();
    pv_read<1>(vb, f); asm volatile("s_waitcnt lgkmcnt(0)" ::: "memory"); ATT_SBAR(); pv_mma(o[1], f, pa0, pa1, pa2, pa3); ATT_SBAR();
    pv_read<2>(vb, f); asm volatile("s_waitcnt lgkmcnt(0)" ::: "memory"); ATT_SBAR(); pv_mma(o[2], f, pa0, pa1, pa2, pa3); ATT_SBAR();
    pv_read<3>(vb, f); asm volatile("s_waitcnt lgkmcnt(0)" ::: "memory"); ATT_SBAR(); pv_mma(o[3], f, pa0, pa1, pa2, pa3);
    return;
  }
  s16x4 fa[8], fb[8];
  pv_read<0>(vb, fa);
  pv_read<1>(vb, fb); asm volatile("s_waitcnt lgkmcnt(8)" ::: "memory"); ATT_SBAR(); pv_mma(o[0], fa, pa0, pa1, pa2, pa3); ATT_SBAR();
  pv_read<2>(vb, fa); asm volatile("s_waitcnt lgkmcnt(8)" ::: "memory"); ATT_SBAR(); pv_mma(o[1], fb, pa0, pa1, pa2, pa3); ATT_SBAR();
  pv_read<3>(vb, fb); asm volatile("s_waitcnt lgkmcnt(8)" ::: "memory"); ATT_SBAR(); pv_mma(o[2], fa, pa0, pa1, pa2, pa3); ATT_SBAR();
  asm volatile("s_waitcnt lgkmcnt(0)" ::: "memory"); ATT_SBAR(); pv_mma(o[3], fb, pa0, pa1, pa2, pa3);
}
#define ATT_RESC(a) do { if (__any((a) < 1.f)) { if (hi == 0) al_l[r32] = (a); asm volatile("s_waitcnt lgkmcnt(0)" ::: "memory"); \
    _Pragma("unroll") for (int d = 0; d < 4; ++d) _Pragma("unroll") for (int r = 0; r < 16; ++r) o[d][r] *= al_l[crow(r, hi)]; } } while (0)
__device__ __forceinline__ void store_o(const f32x16* o, const float* rli, bf16_t* stg, bf16_t* Og  , int ldo, int lane, int r32, int hi) {
#pragma unroll
  for (int r = 0; r < 16; ++r) { const int orow = crow(r, hi);
#pragma unroll
    for (int d0 = 0; d0 < 4; ++d0) stg[orow * 128 + d0 * 32 + r32] = (bf16_t)(cvtpk(o[d0][r] * rli[r], 0.f) & 0xffffu); }
  asm volatile("s_waitcnt lgkmcnt(0)" ::: "memory");
#pragma unroll
  for (int i = 0; i < 8; ++i) { const int row = i * 4 + (lane >> 4), ch = lane & 15; const u32x4 v = *(const u32x4*)(stg + row * 128 + ch * 8); *(u32x4*)(Og + (size_t)row * ldo + ch * 8) = v; }
}

template <int MODE>
__device__ __forceinline__ void attn_sm_unit(int b, int hx, int ux, const bf16_t* __restrict__ Q, const bf16_t* __restrict__ QR, const bf16_t* __restrict__ K, const bf16_t* __restrict__ KR,
                                             const bf16_t* __restrict__ V, const unsigned long long* __restrict__ MASK, bf16_t* __restrict__ O, char* lds) {
  int tid = threadIdx.x; asm volatile("" : "+v"(tid));
  const int wid = __builtin_amdgcn_readfirstlane(tid >> 6), lane = tid & 63, r32 = lane & 31, hi = lane >> 5;
  constexpr int NQ = MODE ? 12 : 8, LDK = MODE ? 2048 : 512;
  char* V_lds = lds; char* K_lds = lds + 2 * SHM_KV; char* R_lds = lds + 4 * SHM_KV;
  float* ws = (float*)(lds + 4 * SHM_KV + 16384) + wid * 64; float* li_l = ws; float* al_l = ws + 32;
  const int head = MODE ? hx : 4 * hx + (wid >> 1);
  const long qrow0 = MODE ? (long)b * 4096 + 256 * ux + 32 * wid : (long)b * 4096 + 64 * ux + 32 * (wid & 1);
  const long qrow = qrow0 + r32;
  const int NT = MODE ? 4 * ux + 4 : ux + 1, NTw = MODE ? 4 * ux + (wid >> 1) + 1 : NT;
  bf16x8 qr[NQ];
  { const bf16_t* Qw = Q + qrow * 2048 + head * 128 + hi * 8;
#pragma unroll
    for (int d0 = 0; d0 < 8; ++d0) qr[d0] = *reinterpret_cast<const bf16x8*>(Qw + d0 * 16);
    if constexpr (MODE == 1) { const bf16_t* Qx = QR + qrow * 1024 + head * 64 + hi * 8;
#pragma unroll
      for (int d0 = 0; d0 < 4; ++d0) qr[8 + d0] = *reinterpret_cast<const bf16x8*>(Qx + d0 * 16); } }
  const int sr = tid >> 4, sc = (tid & 15) * 8, vst0 = v_st(sr, sc), vst1 = v_st(32 + sr, sc);
  const int rr_ = tid >> 3, rc = (tid & 7) * 8, rst = rr_ * 128 + ((rc * 2) ^ (((rr_ >> 1) & 7) << 4));
  const int vb0 = (int)(uintptr_t)V_lds + v_rd_base(lane);
  const bf16_t* Kh = K + (long)b * 4096 * LDK + hx * 128; const bf16_t* Vh = V + (long)b * 4096 * LDK + hx * 128; const bf16_t* Rh = MODE ? KR + (long)b * 4096 * 64 : nullptr;
  const unsigned long long* mrow = MODE ? nullptr : MASK + qrow * 64;
  bf16x8 vs0, vs1, ks0, ks1, rs0;
#define SLOAD(k0) do { vs0 = *reinterpret_cast<const bf16x8*>(Vh + (long)((k0) + sr) * LDK + sc); vs1 = *reinterpret_cast<const bf16x8*>(Vh + (long)((k0) + 32 + sr) * LDK + sc); \
    ks0 = *reinterpret_cast<const bf16x8*>(Kh + (long)((k0) + sr) * LDK + sc); ks1 = *reinterpret_cast<const bf16x8*>(Kh + (long)((k0) + 32 + sr) * LDK + sc); \
    if constexpr (MODE == 1) rs0 = *reinterpret_cast<const bf16x8*>(Rh + (long)((k0) + rr_) * 64 + rc); } while (0)
#define SWRITE(bf) do { *(bf16x8*)(V_lds + (bf) * SHM_KV + vst0) = vs0; *(bf16x8*)(V_lds + (bf) * SHM_KV + vst1) = vs1; \
    *(bf16x8*)(K_lds + (bf) * SHM_KV + KSWZ(sr, sc * 2)) = ks0; *(bf16x8*)(K_lds + (bf) * SHM_KV + KSWZ(32 + sr, sc * 2)) = ks1; \
    if constexpr (MODE == 1) *(bf16x8*)(R_lds + (bf) * 8192 + rst) = rs0; } while (0)
#define QK(P0, P1, t) do { qkt(P0, P1, K_lds + ((t) & 1) * SHM_KV, qr, r32, hi); \
    if constexpr (MODE == 1) qkt_rope(P0, P1, R_lds + ((t) & 1) * 8192, qr + 8, r32, hi); \
    if constexpr (MODE == 0) { const int mlo = (int)((unsigned)mwc >> (4 * hi)), mhi = (int)((unsigned)(mwc >> 32) >> (4 * hi)); \
      _Pragma("unroll") for (int r = 0; r < 16; ++r) { const int cb = (r & 3) + 8 * (r >> 2); \
        const unsigned t0_ = (unsigned)__builtin_amdgcn_sbfe(mlo, cb, 1), t1_ = (unsigned)__builtin_amdgcn_sbfe(mhi, cb, 1);     \
        P0[r] = __uint_as_float((__float_as_uint(P0[r]) & t0_) | (~t0_ & 0xFF800000u)); P1[r] = __uint_as_float((__float_as_uint(P1[r]) & t1_) | (~t1_ & 0xFF800000u)); } } } while (0)
  constexpr int SC9 = MODE ? 72168784 : 88388348;
  float m_reg = -1e30f, l_reg = 0.f; f32x16 o[4];
#pragma unroll
  for (int d = 0; d < 4; ++d) o[d] = f32x16{};
  f32x16 pA0, pA1, pB0, pB1; float mnA, mnB, alA = 1.f, alB = 1.f; bf16x8 pa0, pa1, pa2, pa3;
  unsigned long long mwc = 0ull, mwn = 0ull;
#define STEP(N0, N1, mnN, alN, E0, E1, alE, t) do { const bool an_ = (t) < NTw, ap_ = (t) - 1 < NTw; \
    if constexpr (MODE == 0) mwn = ((t) + 1 < NT) ? mrow[(t) + 1] : 0ull; \
    ATT_SBAR(); if (an_) { QK(N0, N1, t); } \
    if (ap_) { finishSM(E0, E1, alE, l_reg, pa0, pa1, pa2, pa3); } ATT_SBAR(); \
    if (ap_) { pv_d0(o, vb0 + (((t) - 1) & 1) * SHM_KV, pa0, pa1, pa2, pa3); } \
    if (an_) { partialSM<SC9>(N0, N1, m_reg, mnN, alN); } \
    __syncthreads(); \
    if ((t) + 1 < NT) SWRITE(((t) + 1) & 1); \
    if ((t) + 2 < NT) SLOAD(((t) + 2) * 64); \
    if (an_) { ATT_RESC(alN); } mwc = mwn; \
    __syncthreads(); } while (0)
  SLOAD(0); SWRITE(0); if (NT > 1) SLOAD(64);
  if constexpr (MODE == 0) { mwc = mrow[0]; }
  __syncthreads();
  QK(pA0, pA1, 0); partialSM<SC9>(pA0, pA1, m_reg, mnA, alA);
  if constexpr (MODE == 0) { mwc = (NT > 1) ? mrow[1] : 0ull; }
  if (NT > 1) { SWRITE(1); if (NT > 2) SLOAD(128); }
  __syncthreads();
  int t = 1;
  for (; t + 1 < NT; t += 2) {
    STEP(pB0, pB1, mnB, alB, pA0, pA1, alA, t);
    STEP(pA0, pA1, mnA, alA, pB0, pB1, alB, t + 1);
  }
  if (t < NT) {
    STEP(pB0, pB1, mnB, alB, pA0, pA1, alA, t);
    if (t < NTw) { finishSM(pB0, pB1, alB, l_reg, pa0, pa1, pa2, pa3); ATT_SBAR(); pv_d0(o, vb0 + (t & 1) * SHM_KV, pa0, pa1, pa2, pa3); }
  } else {
    if (NT - 1 < NTw) { finishSM(pA0, pA1, alA, l_reg, pa0, pa1, pa2, pa3); ATT_SBAR(); pv_d0(o, vb0 + ((NT - 1) & 1) * SHM_KV, pa0, pa1, pa2, pa3); }
  }
  if (hi == 0) li_l[r32] = l_reg; asm volatile("s_waitcnt lgkmcnt(0)" ::: "memory");
  float rli[16];
#pragma unroll
  for (int r = 0; r < 16; ++r) rli[r] = __builtin_amdgcn_rcpf(li_l[crow(r, hi)]);
  __syncthreads();
  store_o(o, rli, (bf16_t*)(lds + wid * 8192), O + qrow0 * 2048 + head * 128, 2048, lane, r32, hi);
  __syncthreads();
#undef SLOAD
#undef SWRITE
#undef QK
#undef STEP
}

template <int VAR = 0>
__device__ __forceinline__ void dsa_attn_unit(int b, int g, int c, const bf16_t* __restrict__ Q, const bf16_t* __restrict__ K, const bf16_t* __restrict__ V,
                                              const unsigned long long* __restrict__ MASK, bf16_t* __restrict__ O, char* lds, unsigned* dstamp = nullptr) {
  int tid = threadIdx.x; asm volatile("" : "+v"(tid));
  const int wid = __builtin_amdgcn_readfirstlane(tid >> 6), lane = tid & 63, r32 = lane & 31, hi = lane >> 5;
  unsigned long long dta_ = 0, dacc_ = 0; (void)dta_;
  char* V_lds = lds; char* K_lds = lds + 3 * SHM_KV;
  float* ws = (float*)(lds + 6 * SHM_KV) + wid * 64; float* li_l = ws; float* al_l = ws + 32;
  const bool late = wid >= 4;
  const int head = 4 * g + (wid >> 1);
  const long qrow0 = (long)b * 4096 + 64 * c + 32 * (wid & 1), qrow = qrow0 + r32;
  bf16x8 qr[8];
  { const bf16_t* Qw = Q + qrow * 2048 + head * 128 + hi * 8;
#pragma unroll
    for (int d0 = 0; d0 < 8; ++d0) qr[d0] = *reinterpret_cast<const bf16x8*>(Qw + d0 * 16); }
  const int sr = tid >> 4, sc = (tid & 15) * 8, vst0 = v_st(sr, sc), vst1 = v_st(32 + sr, sc);
  const int vb0 = (int)(uintptr_t)V_lds + v_rd_base(lane);
  const bf16_t* Kh = K + (long)b * 4096 * 512 + g * 128; const bf16_t* Vh = V + (long)b * 4096 * 512 + g * 128;
  bf16x8 vs0, vs1, ks0, ks1;
#define SLOAD(k0) do { vs0 = *reinterpret_cast<const bf16x8*>(Vh + (long)((k0) + sr) * 512 + sc); vs1 = *reinterpret_cast<const bf16x8*>(Vh + (long)((k0) + 32 + sr) * 512 + sc); \
    ks0 = *reinterpret_cast<const bf16x8*>(Kh + (long)((k0) + sr) * 512 + sc); ks1 = *reinterpret_cast<const bf16x8*>(Kh + (long)((k0) + 32 + sr) * 512 + sc); } while (0)
#define SWRITE(bo) do { *(bf16x8*)(V_lds + (bo) + vst0) = vs0; *(bf16x8*)(V_lds + (bo) + vst1) = vs1; \
    *(bf16x8*)(K_lds + (bo) + KSWZ(sr, sc * 2)) = ks0; *(bf16x8*)(K_lds + (bo) + KSWZ(32 + sr, sc * 2)) = ks1; } while (0)
#define QKM() do { if constexpr (VAR < 4) qkt(p0, p1, K_lds + cur, qr, r32, hi);     \
    { const int mlo = (int)((unsigned)mw >> (4 * hi)), mhi = (int)((unsigned)(mw >> 32) >> (4 * hi)); \
      _Pragma("unroll") for (int r = 0; r < 16; ++r) { const int cb = (r & 3) + 8 * (r >> 2); \
        const unsigned t0_ = (unsigned)__builtin_amdgcn_sbfe(mlo, cb, 1), t1_ = (unsigned)__builtin_amdgcn_sbfe(mhi, cb, 1); \
        p0[r] = __uint_as_float((__float_as_uint(p0[r]) & t0_) | (~t0_ & 0xFF800000u)); p1[r] = __uint_as_float((__float_as_uint(p1[r]) & t1_) | (~t1_ & 0xFF800000u)); } } } while (0)
#define SMPV(vbo) do { if constexpr (VAR < 3) { float mn, alpha; partialSM<88388348>(p0, p1, m_reg, mn, alpha); \
    bf16x8 pa0, pa1, pa2, pa3; finishSM(p0, p1, alpha, l_reg, pa0, pa1, pa2, pa3); ATT_RESC(alpha); \
    if constexpr (VAR < 2) pv_d0(o, vb0 + (vbo), pa0, pa1, pa2, pa3); else { asm volatile("" :: "v"(pa0), "v"(pa1), "v"(pa2), "v"(pa3)); } } else { asm volatile("" : "+v"(p0), "+v"(p1)); } } while (0)
  const int NT = c + 1;
  float m_reg = -1e30f, l_reg = 0.f; f32x16 o[4];
#pragma unroll
  for (int d = 0; d < 4; ++d) o[d] = f32x16{};
  const unsigned long long* mrow = MASK + qrow * 64;
  SLOAD(0); SWRITE(0); if (NT > 1) SLOAD(64);
  unsigned long long mw = mrow[0];
  f32x16 p0 = f32x16{}, p1 = f32x16{};
  int prv = 2 * SHM_KV, cur = 0, nxt = SHM_KV;
#define TILE_HEAD() __syncthreads(); if (j + 1 < NT) SWRITE(nxt); if (j + 2 < NT) SLOAD((j + 2) * 64); const unsigned long long mw_next = (j + 1 < NT) ? mrow[j + 1] : 0ull
#define TILE_TAIL() mw = mw_next; prv = cur; cur = nxt; nxt = (nxt == 2 * SHM_KV) ? 0 : nxt + SHM_KV
  if (!late) {
#if DSTAMP
    DST_A(5);
    for (int j = 0; j <= NT; ++j) {
      DST_A(1); __syncthreads(); DST_B(1);
      DST_A(6); if (j + 1 < NT) SWRITE(nxt); if (j + 2 < NT) SLOAD((j + 2) * 64); const unsigned long long mw_next = (j + 1 < NT) ? mrow[j + 1] : 0ull; DST_B(6);
      if (j < NT) { DST_A(2); QKM(); DST_B(2);
        DST_A(3); float mn, alpha; partialSM<88388348>(p0, p1, m_reg, mn, alpha); bf16x8 pa0, pa1, pa2, pa3; finishSM(p0, p1, alpha, l_reg, pa0, pa1, pa2, pa3); ATT_RESC(alpha); DST_B(3);
        DST_A(4); pv_d0(o, vb0 + cur, pa0, pa1, pa2, pa3); DST_B(4); }
      TILE_TAIL(); }
    DST_B(5);
#else
    for (int j = 0; j <= NT; ++j) { TILE_HEAD(); if (j < NT) { QKM(); SMPV(cur); } TILE_TAIL(); }
#endif
  } else {
    __builtin_amdgcn_s_setprio(LATE_PRIO);
#if DSTAMP
    DST_A(5);
    for (int j = 0; j <= NT; ++j) {
      DST_A(1); __syncthreads(); DST_B(1);
      DST_A(6); if (j + 1 < NT) SWRITE(nxt); if (j + 2 < NT) SLOAD((j + 2) * 64); const unsigned long long mw_next = (j + 1 < NT) ? mrow[j + 1] : 0ull; DST_B(6);
      if (j > 0) {
        DST_A(3); float mn, alpha; partialSM<88388348>(p0, p1, m_reg, mn, alpha); bf16x8 pa0, pa1, pa2, pa3; finishSM(p0, p1, alpha, l_reg, pa0, pa1, pa2, pa3); ATT_RESC(alpha); DST_B(3);
        DST_A(4); pv_d0(o, vb0 + prv, pa0, pa1, pa2, pa3); DST_B(4); }
      if (j < NT) { DST_A(2); QKM(); DST_B(2); }
      TILE_TAIL(); }
    DST_B(5);
#else
    for (int j = 0; j <= NT; ++j) { TILE_HEAD(); if (j > 0) SMPV(prv); if (j < NT) QKM(); TILE_TAIL(); }
#endif
    __builtin_amdgcn_s_setprio(0);
  }
#undef TILE_HEAD
#undef TILE_TAIL
  if (hi == 0) li_l[r32] = l_reg; asm volatile("s_waitcnt lgkmcnt(0)" ::: "memory");
  float rli[16];
#pragma unroll
  for (int r = 0; r < 16; ++r) rli[r] = __builtin_amdgcn_rcpf(li_l[crow(r, hi)]);
  __syncthreads();
  if constexpr (DSTAMP != 0) { if (dstamp && blockIdx.x == 0 && wid == DSTAMP_W && lane == 0) atomicAdd(dstamp, (unsigned)dacc_); }
  if constexpr (VAR == 0) store_o(o, rli, (bf16_t*)(lds + wid * 8192), O + qrow0 * 2048 + head * 128, 2048, lane, r32, hi); else { asm volatile("" :: "v"(o[0]), "v"(o[1]), "v"(o[2]), "v"(o[3]), "v"(rli[0]), "v"(l_reg), "v"(m_reg)); }
  __syncthreads();
#undef SLOAD
#undef SWRITE
#undef QKM
#undef SMPV
}

__device__ __forceinline__ void mla_attn_unit(int b, int h, int qb, const bf16_t* __restrict__ QN, const bf16_t* __restrict__ QR, const bf16_t* __restrict__ KN, const bf16_t* __restrict__ KR,
                                              const bf16_t* __restrict__ V, bf16_t* __restrict__ O, char* lds) {
  int tid = threadIdx.x; asm volatile("" : "+v"(tid));
  const int wid = __builtin_amdgcn_readfirstlane(tid >> 6), lane = tid & 63, r32 = lane & 31, hi = lane >> 5;
  char* V_lds = lds; char* K_lds = lds + 3 * SHM_KV; char* R_lds = lds + 6 * SHM_KV;
  float* ws = (float*)(lds + 6 * SHM_KV + 3 * 8192) + wid * 64; float* li_l = ws; float* al_l = ws + 32;
  const bool late = wid >= 4;
  const long qrow0 = (long)b * 4096 + 256 * qb + 32 * wid, qrow = qrow0 + r32;
  bf16x8 qr[12];
  { const bf16_t* Qw = QN + qrow * 2048 + h * 128 + hi * 8;
#pragma unroll
    for (int d0 = 0; d0 < 8; ++d0) qr[d0] = *reinterpret_cast<const bf16x8*>(Qw + d0 * 16);
    const bf16_t* Qx = QR + qrow * 1024 + h * 64 + hi * 8;
#pragma unroll
    for (int d0 = 0; d0 < 4; ++d0) qr[8 + d0] = *reinterpret_cast<const bf16x8*>(Qx + d0 * 16); }
  const int sr = tid >> 4, sc = (tid & 15) * 8, vst0 = v_st(sr, sc), vst1 = v_st(32 + sr, sc);
  const int rr_ = tid >> 3, rc = (tid & 7) * 8, rst = rr_ * 128 + ((rc * 2) ^ (((rr_ >> 1) & 7) << 4));
  const int vb0 = (int)(uintptr_t)V_lds + v_rd_base(lane);
  const bf16_t* Kh = KN + (long)b * 4096 * 2048 + h * 128; const bf16_t* Vh = V + (long)b * 4096 * 2048 + h * 128; const bf16_t* Rh = KR + (long)b * 4096 * 64;
  bf16x8 vs0, vs1, ks0, ks1, rs0;
#define SLOAD(k0) do { vs0 = *reinterpret_cast<const bf16x8*>(Vh + (long)((k0) + sr) * 2048 + sc); vs1 = *reinterpret_cast<const bf16x8*>(Vh + (long)((k0) + 32 + sr) * 2048 + sc); \
    ks0 = *reinterpret_cast<const bf16x8*>(Kh + (long)((k0) + sr) * 2048 + sc); ks1 = *reinterpret_cast<const bf16x8*>(Kh + (long)((k0) + 32 + sr) * 2048 + sc); \
    rs0 = *reinterpret_cast<const bf16x8*>(Rh + (long)((k0) + rr_) * 64 + rc); } while (0)
#define SWRITE(bo) do { *(bf16x8*)(V_lds + (bo) + vst0) = vs0; *(bf16x8*)(V_lds + (bo) + vst1) = vs1; \
    *(bf16x8*)(K_lds + (bo) + KSWZ(sr, sc * 2)) = ks0; *(bf16x8*)(K_lds + (bo) + KSWZ(32 + sr, sc * 2)) = ks1; \
    *(bf16x8*)(R_lds + ((bo) >> 1) + rst) = rs0; } while (0)
#define QKM() do { qkt<8>(p0, p1, K_lds + cur, qr, r32, hi); qkt_rope(p0, p1, R_lds + (cur >> 1), qr + 8, r32, hi); } while (0)
#define SMPV(vbo) do { float mn, alpha; partialSM<72168784>(p0, p1, m_reg, mn, alpha); \
    bf16x8 pa0, pa1, pa2, pa3; finishSM(p0, p1, alpha, l_reg, pa0, pa1, pa2, pa3); ATT_RESC(alpha); \
    pv_d0<false>(o, vb0 + (vbo), pa0, pa1, pa2, pa3); } while (0)
  const int NT = 4 * qb + 4, NTw = 4 * qb + (wid >> 1) + 1;
  float m_reg = -1e30f, l_reg = 0.f; f32x16 o[4];
#pragma unroll
  for (int d = 0; d < 4; ++d) o[d] = f32x16{};
  SLOAD(0); SWRITE(0); SLOAD(64);
  f32x16 p0 = f32x16{}, p1 = f32x16{};
  int prv = 2 * SHM_KV, cur = 0, nxt = SHM_KV;
#define TILE_HEAD() __syncthreads(); if (j + 1 < NT) SWRITE(nxt); if (j + 2 < NT) SLOAD((j + 2) * 64)
#define TILE_TAIL() prv = cur; cur = nxt; nxt = (nxt == 2 * SHM_KV) ? 0 : nxt + SHM_KV
  if (!late) {
    for (int j = 0; j <= NT; ++j) { TILE_HEAD(); if (j < NTw) { QKM(); SMPV(cur); } TILE_TAIL(); }
  } else {
    __builtin_amdgcn_s_setprio(LATE_PRIO);
    for (int j = 0; j <= NT; ++j) { TILE_HEAD(); if (j > 0 && j - 1 < NTw) SMPV(prv); if (j < NTw) QKM(); TILE_TAIL(); }
    __builtin_amdgcn_s_setprio(0);
  }
#undef TILE_HEAD
#undef TILE_TAIL
  if (hi == 0) li_l[r32] = l_reg; asm volatile("s_waitcnt lgkmcnt(0)" ::: "memory");
  float rli[16];
#pragma unroll
  for (int r = 0; r < 16; ++r) rli[r] = __builtin_amdgcn_rcpf(li_l[crow(r, hi)]);
  __syncthreads();
  store_o(o, rli, (bf16_t*)(lds + wid * 8192), O + qrow0 * 2048 + h * 128, 2048, lane, r32, hi);
  __syncthreads();
#undef SLOAD
#undef SWRITE
#undef QKM
#undef SMPV
}

__device__ __forceinline__ void sb_attn_unit(int b, int h, int qb, const bf16_t* __restrict__ Q, const bf16_t* __restrict__ K, const bf16_t* __restrict__ V, bf16_t* __restrict__ O, char* lds, unsigned* diag = nullptr) {
  int tid = threadIdx.x; asm volatile("" : "+v"(tid));
  const int wid = __builtin_amdgcn_readfirstlane(tid >> 6), lane = tid & 63, r32 = lane & 31, hi = lane >> 5;
  char* V_lds = lds; char* K_lds = lds + 2 * SHM_KV;
  volatile __attribute__((address_space(3))) int* fl = (volatile __attribute__((address_space(3))) int*)(lds + 4 * SHM_KV + 2048);
  const int tw0 = 256 * qb + 32 * wid, t = tw0 + r32;
  const long qrow0 = (long)b * 4096 + tw0, qrow = qrow0 + r32;
  bf16x8 qr[8];
  { const bf16_t* Qw = Q + qrow * 2048 + h * 128 + hi * 8;
#pragma unroll
    for (int d0 = 0; d0 < 8; ++d0) qr[d0] = *reinterpret_cast<const bf16x8*>(Qw + d0 * 16); }
  constexpr float C = 0.08838834764831845f * 1.4426950408889634f;
#pragma unroll
  for (int d0 = 0; d0 < 8; ++d0) { u32x4 w = *reinterpret_cast<u32x4*>(&qr[d0]);
#pragma unroll
    for (int k = 0; k < 4; ++k) w[k] = cvtpk(__uint_as_float(w[k] << 16) * C, __uint_as_float(w[k] & 0xffff0000u) * C);
    qr[d0] = *reinterpret_cast<bf16x8*>(&w); }
  const int sr = tid >> 4, sc = (tid & 15) * 8, vst0 = v_st(sr, sc), vst1 = v_st(32 + sr, sc);
  const int vb0 = (int)(uintptr_t)V_lds + v_rd_base(lane);
  const bf16_t* Kh = K + (long)b * 4096 * 2048 + h * 128; const bf16_t* Vh = V + (long)b * 4096 * 2048 + h * 128;
  bf16x8 vs0, vs1, ks0, ks1;
#define SLOAD(k0) do { vs0 = *reinterpret_cast<const bf16x8*>(Vh + (long)((k0) + sr) * 2048 + sc); vs1 = *reinterpret_cast<const bf16x8*>(Vh + (long)((k0) + 32 + sr) * 2048 + sc); \
    ks0 = *reinterpret_cast<const bf16x8*>(Kh + (long)((k0) + sr) * 2048 + sc); ks1 = *reinterpret_cast<const bf16x8*>(Kh + (long)((k0) + 32 + sr) * 2048 + sc); } while (0)
#define SWRITE(bf) do { *(bf16x8*)(V_lds + (bf) * SHM_KV + vst0) = vs0; *(bf16x8*)(V_lds + (bf) * SHM_KV + vst1) = vs1; \
    *(bf16x8*)(K_lds + (bf) * SHM_KV + KSWZ(sr, sc * 2)) = ks0; *(bf16x8*)(K_lds + (bf) * SHM_KV + KSWZ(32 + sr, sc * 2)) = ks1; } while (0)
  const int NT = 4 * qb + 4;
  float Rp = 1.f; bool wdone = false; f32x16 o[4];
#pragma unroll
  for (int d = 0; d < 4; ++d) o[d] = f32x16{};
  SLOAD((NT - 1) * 64); SWRITE(0); SLOAD((NT - 2) * 64);
  int j = 0;
  for (; j < NT; ++j) {
    __syncthreads();
    if (j > 0) { int all = 1;
#pragma unroll
      for (int w = 0; w < 8; ++w) all &= fl[((j - 1) & 1) * 8 + w];
      if (all) break; }
    if (j + 1 < NT) SWRITE((j + 1) & 1);
    if (j + 2 < NT) SLOAD((NT - 3 - j) * 64);
    const int T = NT - 1 - j;
    if (64 * T <= tw0 + 30 && !wdone) {
      f32x16 p0, p1; qkt(p0, p1, K_lds + (j & 1) * SHM_KV, qr, r32, hi);
      f32x16 k0, k1;
#define SB_SIG(P, K) do { const float e_ = __builtin_amdgcn_exp2f(-P), r_ = __builtin_amdgcn_rcpf(1.f + e_); P = r_; K = 1.f - r_; } while (0)
      if (64 * T + 63 >= tw0) {
#pragma unroll
        for (int r = 0; r < 16; ++r) { SB_SIG(p0[r], k0[r]); SB_SIG(p1[r], k1[r]);
          if (64 * T + crow(r, hi) >= t) { p0[r] = 0.f; k0[r] = 1.f; }
          if (64 * T + 32 + crow(r, hi) >= t) { p1[r] = 0.f; k1[r] = 1.f; } }
      } else {
#pragma unroll
        for (int r = 0; r < 16; ++r) { SB_SIG(p0[r], k0[r]); SB_SIG(p1[r], k1[r]); }
      }
#undef SB_SIG
      float GP[16];
#pragma unroll
      for (int q = 0; q < 4; ++q) {
        const float g0 = (k0[4 * q] * k0[4 * q + 1]) * (k0[4 * q + 2] * k0[4 * q + 3]), g1 = (k1[4 * q] * k1[4 * q + 1]) * (k1[4 * q + 2] * k1[4 * q + 3]);
        auto x0 = __builtin_amdgcn_permlane32_swap(__float_as_uint(g0), __float_as_uint(g0), false, false);
        auto x1 = __builtin_amdgcn_permlane32_swap(__float_as_uint(g1), __float_as_uint(g1), false, false);
        GP[2 * q] = __uint_as_float(x0[0]); GP[2 * q + 1] = __uint_as_float(x0[1]); GP[8 + 2 * q] = __uint_as_float(x1[0]); GP[8 + 2 * q + 1] = __uint_as_float(x1[1]);
      }
      float SG[16]; SG[15] = 1.f;
#pragma unroll
      for (int g = 14; g >= 0; --g) SG[g] = SG[g + 1] * GP[g + 1];
      const float tileprod = SG[0] * GP[0];
#pragma unroll
      for (int q = 0; q < 4; ++q) {
        { const float base = Rp * (hi ? SG[2 * q + 1] : SG[2 * q]); const float w2 = k0[4 * q + 3], w1 = w2 * k0[4 * q + 2], w0 = w1 * k0[4 * q + 1];
          p0[4 * q + 3] *= base; p0[4 * q + 2] *= base * w2; p0[4 * q + 1] *= base * w1; p0[4 * q] *= base * w0; }
        { const float base = Rp * (hi ? SG[8 + 2 * q + 1] : SG[8 + 2 * q]); const float w2 = k1[4 * q + 3], w1 = w2 * k1[4 * q + 2], w0 = w1 * k1[4 * q + 1];
          p1[4 * q + 3] *= base; p1[4 * q + 2] *= base * w2; p1[4 * q + 1] *= base * w1; p1[4 * q] *= base * w0; }
      }
      Rp *= tileprod;
      bf16x8 pa0, pa1, pa2, pa3; packP(p0, p1, pa0, pa1, pa2, pa3);
      pv_d0(o, vb0 + (j & 1) * SHM_KV, pa0, pa1, pa2, pa3);
      wdone = __all(Rp == 0.f);
    }
    if (lane == 0) fl[(j & 1) * 8 + wid] = wdone ? 1 : 0;
  }
  if (diag && tid == 0) atomicAdd(diag, (unsigned)j);
  float rli[16];
#pragma unroll
  for (int r = 0; r < 16; ++r) rli[r] = 1.f;
  __syncthreads();
  store_o(o, rli, (bf16_t*)(lds + wid * 8192), O + qrow0 * 2048 + h * 128, 2048, lane, r32, hi);
  __syncthreads();
#undef SLOAD
#undef SWRITE
}

__device__ __forceinline__ void idx_unit(int b, int qq, const bf16_t* __restrict__ IQ, const bf16_t* __restrict__ IK, const float* __restrict__ IW, float* __restrict__ SC, char* lds) {
  int tid = threadIdx.x; asm volatile("" : "+v"(tid));
  const int wid = __builtin_amdgcn_readfirstlane(tid >> 6), lane = tid & 63, r32 = lane & 31, hi = lane >> 5;
  char* K_lds = lds;
  const int c = qq >> 1, NT = c + 1;
  const long t0 = (long)b * 4096 + 32 * qq + 4 * wid;
  bf16x8 a[2][8]; float wgt[2][16];
#pragma unroll
  for (int rt = 0; rt < 2; ++rt) {
    const long qa = t0 + 2 * rt + ((r32 >> 2) & 1); const int ha = (r32 & 3) + 4 * (r32 >> 3);
    const bf16_t* p = IQ + qa * 2048 + ha * 128 + hi * 8;
#pragma unroll
    for (int ks = 0; ks < 8; ++ks) a[rt][ks] = *reinterpret_cast<const bf16x8*>(p + ks * 16);
    const float* wp = IW + (t0 + 2 * rt + hi) * 16;
#pragma unroll
    for (int i4 = 0; i4 < 4; ++i4) { const f32x4 w4 = *(const f32x4*)(wp + 4 * i4); wgt[rt][4 * i4] = w4[0]; wgt[rt][4 * i4 + 1] = w4[1]; wgt[rt][4 * i4 + 2] = w4[2]; wgt[rt][4 * i4 + 3] = w4[3]; }
  }
  const int sr = tid >> 4, sc = (tid & 15) * 8;
  const bf16_t* Kb = IK + (long)b * 4096 * 128;
  bf16x8 ks0, ks1;
#define SLOAD(k0) do { ks0 = *reinterpret_cast<const bf16x8*>(Kb + (long)((k0) + sr) * 128 + sc); ks1 = *reinterpret_cast<const bf16x8*>(Kb + (long)((k0) + 32 + sr) * 128 + sc); } while (0)
#define SWRITE(bf) do { *(bf16x8*)(K_lds + (bf) * SHM_KV + KSWZ(sr, sc * 2)) = ks0; *(bf16x8*)(K_lds + (bf) * SHM_KV + KSWZ(32 + sr, sc * 2)) = ks1; } while (0)
  SLOAD(0); SWRITE(0); if (NT > 1) SLOAD(64);
  for (int j = 0; j < NT; ++j) {
    __syncthreads();
    if (j + 1 < NT) SWRITE((j + 1) & 1);
    if (j + 2 < NT) SLOAD((j + 2) * 64);
    const char* Kt = K_lds + (j & 1) * SHM_KV;
#pragma unroll
    for (int kh = 0; kh < 2; ++kh) {
      bf16x8 bfr[8];
#pragma unroll
      for (int ks = 0; ks < 8; ++ks) bfr[ks] = *reinterpret_cast<const bf16x8*>(Kt + KSWZ(32 * kh + r32, (ks * 16 + hi * 8) * 2));
#pragma unroll
      for (int rt = 0; rt < 2; ++rt) {
        f32x16 acc = f32x16{};
#pragma unroll
        for (int ks = 0; ks < 8; ++ks) acc = __builtin_amdgcn_mfma_f32_32x32x16_bf16(a[rt][ks], bfr[ks], acc, 0, 0, 0);
        float s = 0.f;
#pragma unroll
        for (int i = 0; i < 16; ++i) s += wgt[rt][i] * fmaxf(acc[i], 0.f);
        SC[(t0 + 2 * rt + hi) * 4096 + 64 * j + 32 * kh + r32] = s;
      }
    }
  }
  asm volatile("s_waitcnt vmcnt(0)" ::: "memory");
  __syncthreads();
#undef SLOAD
#undef SWRITE
}

__device__ __forceinline__ int wave_sum_i(int v) {
#pragma unroll
  for (int o = 1; o < 64; o <<= 1) v += __shfl_xor(v, o);
  return v;
}
__device__ __forceinline__ unsigned f2key(float v) { const unsigned u = __float_as_uint(v); return (u & 0x80000000u) ? ~u : (u | 0x80000000u); }
__device__ __forceinline__ float key2f(unsigned k) { return __uint_as_float((k & 0x80000000u) ? (k & 0x7fffffffu) : ~k); }
__device__ __forceinline__ float wave_sum_f(float v) {
#pragma unroll
  for (int o = 1; o < 64; o <<= 1) v += __shfl_xor(v, o);
  return v;
}
typedef __attribute__((address_space(3))) unsigned las_u32;
__device__ __forceinline__ void topk_prefetch(const float* __restrict__ sc_row, int c, las_u32* buf, int lane) {
#pragma unroll
  for (int g4 = 0; g4 < 4; ++g4) {
    if (16 * g4 <= c) {
#pragma unroll
      for (int p = 4 * g4; p < 4 * g4 + 4; ++p) __builtin_amdgcn_global_load_lds((const unsigned*)(sc_row + p * 256 + lane * 4), buf + p * 256, 16, 0, 0);
    }
  }
}
__device__ __forceinline__ void topk_fetch(const las_u32* buf, int c, unsigned (&raw)[64], int lane) {
  asm volatile("s_waitcnt vmcnt(0)" ::: "memory");
#pragma unroll
  for (int g4 = 0; g4 < 4; ++g4) {
    if (16 * g4 <= c) {
#pragma unroll
      for (int j = 16 * g4; j < 16 * g4 + 16; ++j) raw[j] = buf[j * 64 + lane];
    } else {
#pragma unroll
      for (int j = 16 * g4; j < 16 * g4 + 16; ++j) raw[j] = 0u;
    }
  }
  asm volatile("s_waitcnt lgkmcnt(0)" ::: "memory");
}
__device__ __forceinline__ void topk_row(const unsigned (&raw)[64], int c, unsigned long long* __restrict__ mask_row, int lane) {
  unsigned key[64];
  int cv = c; asm volatile("" : "+v"(cv));
#pragma unroll
  for (int j = 0; j < 64; ++j) key[j] = raw[j];
  float s1 = 0.f, s2 = 0.f;
#pragma unroll
  for (int j = 0; j < 64; ++j) { const unsigned u = key[j]; const float v = (j <= cv) ? __uint_as_float(u) : 0.f; s1 += v; s2 = fmaf(v, v, s2);
    const unsigned k = (u & 0x80000000u) ? ~u : (u | 0x80000000u); key[j] = (j <= cv) ? k : 0u; }
  unsigned long long mine = 0ull; unsigned mlo = 0u, mhi = 0u;
  if (c < 4) {
    mine = (lane <= c) ? ~0ull : 0ull;
  } else {
    const float fN = (float)(64 * (c + 1));
    const float mean = __int_as_float(__builtin_amdgcn_readfirstlane(__float_as_int(wave_sum_f(s1)))) / fN;
    const float ex2 = __int_as_float(__builtin_amdgcn_readfirstlane(__float_as_int(wave_sum_f(s2)))) / fN;
    const float sd = sqrtf(fmaxf(ex2 - mean * mean, 1e-30f));
    float T;
    { const float q = 0.5f - 256.f / fN, r = q * q;
      const float num = (((((-3.969683028665376e+01f * r + 2.209460984245205e+02f) * r - 2.759285104469687e+02f) * r + 1.383577518672690e+02f) * r - 3.066479806614716e+01f) * r + 2.506628277459239e+00f) * q;
      const float den = ((((-5.447609879822406e+01f * r + 1.615858368580409e+02f) * r - 1.556989798598866e+02f) * r + 6.680131188771972e+01f) * r - 1.328068155288572e+01f) * r + 1.f;
      T = mean + (num / den) * sd; }
    unsigned Klo = 1u, Khi = 0xFFFFFFFFu; int clo = 64 * (c + 1), chi = 0; bool exact = false; unsigned Tk = 0u;
    for (int it = 0; it < 128; ++it) {
      unsigned cand = f2key(T);
      if (!(cand > Klo && cand < Khi) || (it % 3) == 2) cand = Klo + ((Khi - Klo) >> 1);
      cand = (unsigned)__builtin_amdgcn_readfirstlane((int)cand);
      if (cand == Klo) break;
      int cnt = 0;
#pragma unroll
      for (int g8 = 0; g8 < 8; ++g8) {
        if (8 * g8 <= c) {
#pragma unroll
          for (int j = 8 * g8; j < 8 * g8 + 8; ++j) cnt += __builtin_popcountll(__ballot(key[j] >= cand));
        }
        ATT_SBAR();
      }
      if (cnt == 256) { exact = true; Tk = cand; break; }
      const float Tc = key2f(cand);
      if (cnt > 256) { Klo = cand; clo = cnt; } else { Khi = cand; chi = cnt; }
      if (Klo != 1u && Khi != 0xFFFFFFFFu) {
        const float flo = key2f(Klo), fhi = key2f(Khi);
        T = flo + (fhi - flo) * (((float)(clo - 256) - 0.5f) / (float)(clo - chi));
      } else {
        const float z = (Tc - mean) / sd, dens = fN * 0.3989423f * __expf(-0.5f * z * z) / sd;
        T = Tc + 1.3f * (float)(cnt - 256) / fmaxf(dens, 1e-3f * fN / sd);
      }
    }
    if (!exact) Tk = Klo;
    asm volatile("" : "+v"(Tk));
    if (exact) {
#pragma unroll
      for (int j = 0; j < 64; ++j) { const unsigned long long m = __ballot(key[j] >= Tk);
        asm volatile("s_nop 3\n\tv_writelane_b32 %0, %2, %4\n\tv_writelane_b32 %1, %3, %4" : "+v"(mlo), "+v"(mhi) : "s"((unsigned)m), "s"((unsigned)(m >> 32)), "i"(j));     ATT_SBAR(); }
    } else {
      int gt = 0;
#pragma unroll
      for (int g8 = 0; g8 < 8; ++g8) {
#pragma unroll
        for (int j = 8 * g8; j < 8 * g8 + 8; ++j) gt += __builtin_popcountll(__ballot(key[j] > Tk));
        ATT_SBAR();
      }
      int need = 256 - gt;
      asm volatile("" : "+v"(Tk));
#pragma unroll
      for (int j = 0; j < 64; ++j) {
        const unsigned long long g = __ballot(key[j] > Tk); unsigned long long e = __ballot(key[j] == Tk), take = 0ull;
        const int pe = __popcll(e);
        if (pe <= need) { take = e; need -= pe; } else { while (need > 0) { const unsigned long long lowb = e & (~e + 1ull); take |= lowb; e ^= lowb; --need; } }
        const unsigned long long m = g | take;
        asm volatile("s_nop 3\n\tv_writelane_b32 %0, %2, %4\n\tv_writelane_b32 %1, %3, %4" : "+v"(mlo), "+v"(mhi) : "s"((unsigned)m), "s"((unsigned)(m >> 32)), "i"(j));
        ATT_SBAR();
      }
    }
  }
  if (c >= 4) mine = (unsigned long long)mlo | ((unsigned long long)mhi << 32);
  mask_row[lane] = mine;
}
#undef KSWZ
}

constexpr int NWAVES = 8;
constexpr int BATCH = 4, SEQ = 4096, DM = 2048, DFF = 5632, M = BATCH * SEQ;
constexpr int DSA_NP = 5376, MLA_DOWN_NP = 1280;
constexpr int NPH = 26;
#ifndef MK_ONE_LAUNCH
#define MK_ONE_LAUNCH 1
#endif
constexpr size_t MiB = 1u << 20;
constexpr size_t WS_CTL = 0, CTL_ZERO_BYTES = 1 * MiB;
constexpr size_t WS_MODS = 1 * MiB;
constexpr size_t WS_CS128 = 2 * MiB;
constexpr size_t WS_CS64 = 4 * MiB;
constexpr size_t WS_SSQ = 5 * MiB;
constexpr size_t WS_W = 6 * MiB;
constexpr size_t WL_STRIDE = 74 * MiB, WL_FFN1 = 0, WL_FFN2 = 44 * MiB, WL_OUT = 66 * MiB;
constexpr size_t WS_WDSA = WS_W + 4 * WL_STRIDE, WDSA_STRIDE = 21 * MiB;
constexpr size_t WS_WMLA = WS_WDSA + 2 * WDSA_STRIDE, WMLA_DOWN = 0, WMLA_UQ = 5 * MiB, WMLA_UKV = 8 * MiB;
constexpr size_t WS_WSB = WS_WMLA + 12 * MiB;
constexpr size_t WS_H = WS_WSB + 24 * MiB;
constexpr size_t WS_O = WS_H + 64 * MiB;
constexpr size_t WS_MIX = WS_O + 64 * MiB;
constexpr size_t MX_ACT = 0;
constexpr size_t MX_DQ = 0, MX_DK = 64 * MiB, MX_DV = 80 * MiB, MX_DIQ = 96 * MiB, MX_DIK = 160 * MiB, MX_DIW = 164 * MiB, MX_DMASK = 165 * MiB, MX_DSC = 176 * MiB;
constexpr size_t MX_MCQ = 0, MX_MCKV = 16 * MiB, MX_MKR = 32 * MiB, MX_MQN = 34 * MiB, MX_MQR = 98 * MiB, MX_MKN = 130 * MiB, MX_MV = 194 * MiB;
constexpr size_t MX_SQ = 0, MX_SK = 64 * MiB, MX_SV = 128 * MiB;
constexpr size_t WS_SSX = WS_MIX + 432 * MiB;
constexpr size_t WS_BIAS = WS_SSX + 1 * MiB;
constexpr size_t BIAS_DSA0 = 0, BIAS_DSA1 = 4 * 5376, BIAS_MLA = 8 * 5376, BIAS_SB = BIAS_MLA + 4 * 1280, BIAS_FFN = BIAS_SB + 4 * 6144;
static_assert((BIAS_FFN + 4 * 4 * 11264) * 4 <= 1 * MiB, "bias rows fit 1 MiB");
constexpr size_t WS_XB = WS_BIAS + 1 * MiB;
constexpr size_t WS_END = WS_XB + 64 * MiB;
static_assert(WS_W + 380 * MiB - 6 * MiB == WS_H, "weight map");
constexpr int CW_TMO = 0, CW_BAR = 4096;
constexpr int RING_BYTES = 131072, LDSCTL_OFF = RING_BYTES, MISC_OFF = LDSCTL_OFF + 320, EPI_PART_OFF = RING_BYTES + 1024  , EPI_TAB_OFF = RING_BYTES + 6144  , LDS_BYTES = 147456;

#define GAS __attribute__((address_space(1)))
#define LAS __attribute__((address_space(3)))
typedef unsigned short bf16;
typedef unsigned v4u __attribute__((ext_vector_type(4)));
typedef float f32x4 __attribute__((ext_vector_type(4)));
typedef GAS unsigned gu32;
#define RLX_AGENT __ATOMIC_RELAXED, __HIP_MEMORY_SCOPE_AGENT
#define LDS_WAIT() asm volatile("s_waitcnt lgkmcnt(0)" ::: "memory")
__device__ __forceinline__ unsigned f2bf(float f) { unsigned u = __builtin_bit_cast(unsigned, f); return (u + 0x7fffu + ((u >> 16) & 1u)) >> 16; }
__device__ __forceinline__ unsigned pk2(float lo, float hi) { return f2bf(lo) | (f2bf(hi) << 16); }

#define XB_TMO      128
#define XB_XCNT(j)  (256  + 64 * (j))
#define XB_XSUB(j)  (1280 + 64 * (j))
#define XB_XGEN(j)  (2304 + 64 * (j))
#define XB_TOP      3328
#define XB_TOPGEN   3392
#define XCD_BAR_WORDS 3456
#define XB_SPIN_CAP (1u << 18)

__device__ __forceinline__ unsigned xb_ld(unsigned* p)              { return __hip_atomic_load(p, __ATOMIC_RELAXED, __HIP_MEMORY_SCOPE_AGENT); }
__device__ __forceinline__ unsigned xb_add(unsigned* p, unsigned v) { return __hip_atomic_fetch_add(p, v, __ATOMIC_RELAXED, __HIP_MEMORY_SCOPE_AGENT); }
__device__ __forceinline__ unsigned xb_xcc_id() { return (unsigned)__builtin_amdgcn_s_getreg((3 << 11) | 20) & 0xFu; }
#define XB_SPIN(cond, bar) do { unsigned _sp = 0; while (cond) { __builtin_amdgcn_s_sleep(1); \
    if ((++_sp & 255u) == 0u) { if (xb_ld(&(bar)[XB_TMO])) break; if (_sp > XB_SPIN_CAP) { atomicAdd(&(bar)[XB_TMO], 1u); break; } } } } while (0)

struct XcdBarrier {
    unsigned* bar; unsigned x;
    volatile LAS unsigned* st;
};

__device__ __forceinline__ XcdBarrier xcd_barrier_post(unsigned* bar, volatile LAS unsigned* st) {
    XcdBarrier b; b.bar = bar; b.x = xb_xcc_id(); b.st = st;
    if (threadIdx.x == 0) (void)xb_add(&bar[XB_XCNT(b.x)], 1u);
    return b;
}
__device__ __forceinline__ void xcd_barrier_complete(unsigned* bar, unsigned x, unsigned& nloc, unsigned& nx) {
    const unsigned G = gridDim.x * gridDim.y * gridDim.z;
    unsigned sum, cnt, mine, sp = 0u;
    for (;;) {
        sum = 0u; cnt = 0u; mine = 0u;
#pragma unroll
        for (unsigned j = 0; j < 16; ++j) { const unsigned c = xb_ld(&bar[XB_XCNT(j)]); sum += c; cnt += (c > 0u) ? 1u : 0u; mine = (j == x) ? c : mine; }
        if (sum == G) break;
        __builtin_amdgcn_s_sleep(1);
        if ((++sp & 255u) == 0u) { if (xb_ld(&bar[XB_TMO])) break; if (sp > XB_SPIN_CAP) { atomicAdd(&bar[XB_TMO], 1u); break; } }
    }
    nloc = mine > 0u ? mine : 1u; nx = cnt > 0u ? cnt : 1u;
}

__device__ __forceinline__ void xcd_barrier(const XcdBarrier& b) {
    asm volatile("s_waitcnt vmcnt(0)" ::: "memory");
    __syncthreads();
    if (threadIdx.x == 0) {
        unsigned* bar = b.bar;
        __builtin_amdgcn_s_waitcnt(0);
        unsigned nloc = b.st[0], nx = b.st[1];
        if (nloc == 0u) { xcd_barrier_complete(bar, b.x, nloc, nx); b.st[0] = nloc; b.st[1] = nx; }
        const unsigned old = xb_add(&bar[XB_XSUB(b.x)], 1u);
        const unsigned gen = old / nloc;
        if (old + 1u == (gen + 1u) * nloc) {
            __builtin_amdgcn_fence(__ATOMIC_RELEASE, "agent");
            asm volatile("s_waitcnt vmcnt(0)" ::: "memory");
            const unsigned og = xb_add(&bar[XB_TOP], 1u);
            const unsigned tg = og / nx;
            if (og + 1u == (tg + 1u) * nx) xb_add(&bar[XB_TOPGEN], 1u);
            else XB_SPIN(xb_ld(&bar[XB_TOPGEN]) == tg, bar);
            __builtin_amdgcn_fence(__ATOMIC_ACQUIRE, "agent");
            xb_add(&bar[XB_XGEN(b.x)], 1u);
            asm volatile("s_waitcnt vmcnt(0)" ::: "memory");
        } else {
            XB_SPIN(xb_ld(&bar[XB_XGEN(b.x)]) == gen, bar);
            __builtin_amdgcn_fence(__ATOMIC_ACQUIRE, "agent");
            asm volatile("s_waitcnt vmcnt(0)" ::: "memory");
        }
    }
    __syncthreads();
}


struct Frame {
    LAS unsigned char* lds;
    volatile LAS unsigned* MISC;
    gu32* ctl;
    int tid, lane, wave;
    int vcu, G;
};
__device__ __forceinline__ float wave_sum(float v) {
#pragma unroll
    for (int o = 1; o < 64; o <<= 1) v += __shfl_xor(v, o);
    return v;
}
enum { KIND_ID = 0, KIND_DSA_IN = 1, KIND_MLA_DOWN = 2, KIND_MLA_UQ = 3, KIND_FFN1 = 4 };
__host__ __device__ __forceinline__ int srcblk(int kind, int nb, int& nvalid) {
    nvalid = 32;
    const int pn = nb >> 3, pb = nb & 7, bj = pb >> 2, wc = pb & 3;
    if (kind == KIND_ID) return nb * 32;
    if (kind == KIND_DSA_IN) {
        if (pn < 8)  return (2 * pn + (wc >> 1)) * 128 + 64 * bj + 32 * (wc & 1);
        if (pn < 10) return 2048 + (2 * (pn - 8) + (wc >> 1)) * 128 + 64 * bj + 32 * (wc & 1);
        if (pn < 12) return 2560 + (pn - 10) * 256 + 32 * pb;
        if (pn < 20) return 3072 + (2 * (pn - 12) + (wc >> 1)) * 128 + (wc & 1) * 64 + bj * 32;
        if (wc == 0) return 5120 + bj * 32;
        if (wc == 1) return 5120 + 64 + bj * 32;
        if (wc == 2 && bj == 0) { nvalid = 16; return 5248; }
        return -1;
    }
    if (kind == KIND_MLA_DOWN) { if (pn < 4) return nb * 32; if (wc == 0) return 1024 + 32 * bj; return -1; }
    if (kind == KIND_MLA_UQ) { if (pn < 8) return (2 * pn + bj) * 192 + 32 * wc; return (4 * (pn - 8) + wc) * 192 + 128 + 32 * bj; }
      return (bj ? 5632 : 0) + 128 * pn + 32 * wc;
}
__device__ __forceinline__ void conv_item(const float* __restrict__ W, int K, int Nsrc, int Nphys, int kind, const float* __restrict__ gk, bf16* __restrict__ WT, LAS unsigned* scr, int item, int lane) {
    const int nblk = Nphys / 64, kb = item / nblk, ib = item % nblk, k0 = 64 * kb, n0 = 64 * ib;
    const int c4 = lane & 15, kr = lane >> 4;
    int nvalid; const int sb = srcblk(kind, 2 * ib + (c4 >> 3), nvalid);
    const int col = 4 * (c4 & 7);
    const bool valid = (sb >= 0) && (col < nvalid);
    const float* src = W + (size_t)(k0 + 2 * kr) * Nsrc + (valid ? sb + col : 0);
    f32x4 va[8], vb[8];
#pragma unroll
    for (int kk = 0; kk < 8; ++kk) { va[kk] = *(const GAS f32x4*)(src + (size_t)(8 * kk) * Nsrc); vb[kk] = *(const GAS f32x4*)(src + (size_t)(8 * kk + 1) * Nsrc); }
    if (gk) {
#pragma unroll
        for (int kk = 0; kk < 8; ++kk) { va[kk] *= gk[k0 + 8 * kk + 2 * kr]; vb[kk] *= gk[k0 + 8 * kk + 2 * kr + 1]; } }
    if (!valid) {
#pragma unroll
        for (int kk = 0; kk < 8; ++kk) { va[kk] = (f32x4){0.f, 0.f, 0.f, 0.f}; vb[kk] = (f32x4){0.f, 0.f, 0.f, 0.f}; } }
#pragma unroll
    for (int kk = 0; kk < 8; ++kk)
#pragma unroll
        for (int i = 0; i < 4; ++i) scr[(4 * c4 + i) * 33 + 4 * kk + kr] = pg8::cvt_pk_bf16(va[kk][i], vb[kk][i]);
    LDS_WAIT(); asm volatile("" ::: "memory");
    const int c = lane & 7;
#pragma unroll
    for (int j = 0; j < 8; ++j) { const int n = (lane >> 3) + 8 * j; const LAS unsigned* s = scr + n * 33 + 4 * c;
        v4u o; o.x = s[0]; o.y = s[1]; o.z = s[2]; o.w = s[3];
        *(GAS v4u*)(WT + (size_t)(n0 + n) * K + k0 + 8 * c) = o; }
    LDS_WAIT(); asm volatile("" ::: "memory");
}
__device__ __forceinline__ void cs_entry(int pos, int i, const double* rp  , float& co, float& si) {
    double inv = 1.0;
#pragma unroll
    for (int k = 0; k < 6; ++k) if ((i >> k) & 1) inv *= rp[k];
    const double a = (double)pos * inv;
    const double n = __builtin_rint(a * 0.63661977236758134308);
    double y = a - n * 1.5707963267948966; y -= n * 6.123233995736766e-17;
    const double y2 = y * y;
    double s = -7.6471637318198164759e-13;
    s = s * y2 + 1.6059043836821614599e-10; s = s * y2 - 2.5052108385441718775e-08; s = s * y2 + 2.7557319223985890653e-06; s = s * y2 - 1.9841269841269841270e-04;
    s = s * y2 + 8.3333333333333333333e-03; s = s * y2 - 1.6666666666666666667e-01; s = y + y * y2 * s;
    double c = 4.7794773323873852974e-14;
    c = c * y2 - 1.1470745597729724714e-11; c = c * y2 + 2.0876756987868098979e-09; c = c * y2 - 2.7557319223985890653e-07; c = c * y2 + 2.4801587301587301587e-05;
    c = c * y2 - 1.3888888888888888889e-03; c = c * y2 + 4.1666666666666666667e-02; c = c * y2 - 0.5; c = 1.0 + y2 * c;
    const int q = ((int)n) & 3;
    const double cc = (q == 0) ? c : (q == 1) ? -s : (q == 2) ? -c : s;
    const double ss = (q == 0) ? s : (q == 1) ? c : (q == 2) ? -s : -c;
    co = (float)cc; si = (float)ss;
}
__device__ __forceinline__ void modnorm_phase(const Frame& F0, const float* __restrict__ x, const float* __restrict__ g, const float* __restrict__ mods_l, int sh_off, int sc_off, bf16* __restrict__ H) {
    int tid_ = threadIdx.x; asm volatile("" : "+v"(tid_)); struct { int lane, wave, vcu, G; } F{tid_ & 63, __builtin_amdgcn_readfirstlane(tid_ >> 6), F0.vcu, F0.G};
    const int gw = F.vcu * NWAVES + F.wave, NGW = F.G * NWAVES;
    for (int m = gw; m < M; m += NGW) {
        const GAS f32x4* xr = (const GAS f32x4*)(x + (size_t)m * DM) + F.lane;
        f32x4 v[8]; float s = 0.f;
#pragma unroll
        for (int j = 0; j < 8; ++j) { v[j] = xr[64 * j]; s += (v[j].x * v[j].x + v[j].y * v[j].y) + (v[j].z * v[j].z + v[j].w * v[j].w); }
        const float rstd = 1.0f / sqrtf(wave_sum(s) * (1.0f / DM) + 1e-6f);
        const float* mb = mods_l + (size_t)(m >> 12) * 12288;
        GAS unsigned long long* o8 = (GAS unsigned long long*)(H + (size_t)m * DM) + F.lane;
#pragma unroll
        for (int j = 0; j < 8; ++j) { const int col = 256 * j + 4 * F.lane;
            const f32x4 g4 = *(const f32x4*)(g + col), sc4 = *(const f32x4*)(mb + sc_off + col), sh4 = *(const f32x4*)(mb + sh_off + col);
            const f32x4 r = v[j] * rstd * g4 * (sc4 + 1.0f) + sh4;
            o8[64 * j] = (unsigned long long)pk2(r.x, r.y) | ((unsigned long long)pk2(r.z, r.w) << 32); }
    }
}
__device__ __forceinline__ void finalnorm_phase(const Frame& F0, const bf16* __restrict__ xb, float* __restrict__ out, const float* __restrict__ g) {
    int tid_ = threadIdx.x; asm volatile("" : "+v"(tid_)); struct { int lane, wave, vcu, G; } F{tid_ & 63, __builtin_amdgcn_readfirstlane(tid_ >> 6), F0.vcu, F0.G};
    const int gw = F.vcu * NWAVES + F.wave, NGW = F.G * NWAVES;
    for (int m = gw; m < M; m += NGW) {
        const GAS v4u* xr = (const GAS v4u*)(xb + (size_t)m * DM) + F.lane;
        v4u w[4]; float s = 0.f; float v[4][8];
#pragma unroll
        for (int j = 0; j < 4; ++j) w[j] = xr[64 * j];
#pragma unroll
        for (int j = 0; j < 4; ++j)
#pragma unroll
            for (int e = 0; e < 4; ++e) { const unsigned d = w[j][e]; v[j][2 * e] = __uint_as_float(d << 16); v[j][2 * e + 1] = __uint_as_float(d & 0xffff0000u); s += v[j][2 * e] * v[j][2 * e] + v[j][2 * e + 1] * v[j][2 * e + 1]; }
        const float rstd = 1.0f / sqrtf(wave_sum(s) * (1.0f / DM) + 1e-6f);
        GAS f32x4* orow = (GAS f32x4*)(out + (size_t)m * DM);
#pragma unroll
        for (int j = 0; j < 4; ++j) { const int col = 8 * (F.lane + 64 * j); const f32x4 g0 = *(const f32x4*)(g + col), g1 = *(const f32x4*)(g + col + 4);
            orow[col / 4] = (f32x4){v[j][0], v[j][1], v[j][2], v[j][3]} * rstd * g0; orow[col / 4 + 1] = (f32x4){v[j][4], v[j][5], v[j][6], v[j][7]} * rstd * g1; }
    }
}

#ifndef SITE_MASK
#define SITE_MASK 0xFFFFu
#endif
#define SITE(s_) ((((unsigned)(SITE_MASK)) >> (s_)) & 1u)
#ifndef DIAG
#define DIAG 0
#endif
#ifndef DIAG_K0
#define DIAG_K0 0
#define DIAG_K1 1
#define DIAG_DIV 4.0f
#endif
#ifndef DIAG_SEL
#define DIAG_SEL 0
#endif
#define DIAG_PTR (DIAG ? (unsigned*)(ARG_WS + WS_CTL) + 2048 : (unsigned*)nullptr)
#ifndef REP_VAR
#define REP_VAR 0
#endif
#ifndef P0_REP
#define P0_REP 0
#endif
#ifndef REPEAT_MASK
#define REPEAT_MASK 0u
#endif
#define NREP(s_) (1 + (int)((((unsigned)(REPEAT_MASK)) >> (s_)) & 1u))
#define IN(k) (LO <= (k) && (k) < HI)
#if DIAG == 2
#define SEAM(k) do { if constexpr (IN(k) && IN((k) + 1)) { if (threadIdx.x == 0) { const unsigned long long t_ = __builtin_amdgcn_s_memrealtime(); \
        __hip_atomic_fetch_max((unsigned long long*)(ARG_WS + WS_CTL + 0x9000) + (k), t_, __ATOMIC_RELAXED, __HIP_MEMORY_SCOPE_AGENT); \
        __hip_atomic_fetch_max((unsigned long long*)(ARG_WS + WS_CTL + 0xA000) + (k), (1ull << 62) - t_, __ATOMIC_RELAXED, __HIP_MEMORY_SCOPE_AGENT); } \
      xcd_barrier(bar); } if (blockIdx.x == 0 && threadIdx.x == 0) ((unsigned long long*)(ARG_WS + WS_CTL + 0x8000))[(k) + 1] = __builtin_amdgcn_s_memrealtime(); } while (0)
#else
#define SEAM(k) do { if constexpr (IN(k) && IN((k) + 1)) xcd_barrier(bar); } while (0)
#endif
struct Args { const float* in[39]; float* out; unsigned char* ws; int ph_lo, ph_hi, li, pad; };
static_assert(offsetof(Args, out) == 39 * 8 && offsetof(Args, ws) == 40 * 8 && offsetof(Args, li) == 84 * 4, "kernarg layout");
typedef const float* __attribute__((address_space(4))) const* kargp_t;
#define ARG_IN(i_) (((kargp_t)__builtin_amdgcn_kernarg_segment_ptr())[(i_)])
#define ARG_OUT ((float*)((kargp_t)__builtin_amdgcn_kernarg_segment_ptr())[39])
#define ARG_WS ((unsigned char*)((kargp_t)__builtin_amdgcn_kernarg_segment_ptr())[40])
#define ARG_LI (((const int __attribute__((address_space(4)))*)__builtin_amdgcn_kernarg_segment_ptr())[84])

__device__ __forceinline__ void bias_item(const bf16* __restrict__ WT, int nrows, float* __restrict__ out, int r32item, const LAS float* shl, int wave, int lane) {
    const int n0 = 32 * r32item + 4 * wave;
    const GAS v4u* wp = (const GAS v4u*)(WT + (size_t)n0 * DM) + lane;
    v4u w[16];
#pragma unroll
    for (int j = 0; j < 16; ++j) w[j] = wp[64 * j];
    float acc[4][4];
#pragma unroll
    for (int q = 0; q < 4; ++q)
#pragma unroll
        for (int b = 0; b < 4; ++b) acc[q][b] = 0.f;
#pragma unroll
    for (int jj = 0; jj < 4; ++jj) {
        f32x4 sa[4], sb[4];
#pragma unroll
        for (int b = 0; b < 4; ++b) { sa[b] = *(const LAS f32x4*)(shl + b * DM + 8 * (lane + 64 * jj)); sb[b] = *(const LAS f32x4*)(shl + b * DM + 8 * (lane + 64 * jj) + 4); }
#pragma unroll
        for (int q = 0; q < 4; ++q) { const v4u d = w[4 * q + jj];
            const float e0 = __uint_as_float(d.x << 16), e1 = __uint_as_float(d.x & 0xffff0000u), e2 = __uint_as_float(d.y << 16), e3 = __uint_as_float(d.y & 0xffff0000u);
            const float e4 = __uint_as_float(d.z << 16), e5 = __uint_as_float(d.z & 0xffff0000u), e6 = __uint_as_float(d.w << 16), e7 = __uint_as_float(d.w & 0xffff0000u);
#pragma unroll
            for (int b = 0; b < 4; ++b) { float t = acc[q][b];
                t = fmaf(e0, sa[b][0], t); t = fmaf(e1, sa[b][1], t); t = fmaf(e2, sa[b][2], t); t = fmaf(e3, sa[b][3], t);
                t = fmaf(e4, sb[b][0], t); t = fmaf(e5, sb[b][1], t); t = fmaf(e6, sb[b][2], t); t = fmaf(e7, sb[b][3], t); acc[q][b] = t; } }
    }
#pragma unroll
    for (int q = 0; q < 4; ++q)
#pragma unroll
        for (int b = 0; b < 4; ++b) { const float t = wave_sum(acc[q][b]); if (lane == 0) out[(size_t)b * nrows + n0 + q] = t; }
}
constexpr int NBIAS_ITEM = 168 + 40 + 192 + 168 + 4 * 352;
__device__ __forceinline__ void bias_range(const Frame& F0, int lo, int hi, int vb, int nb) {
    int tid_ = threadIdx.x; asm volatile("" : "+v"(tid_)); const int lane = tid_ & 63, wave = __builtin_amdgcn_readfirstlane(tid_ >> 6);
    unsigned char* const ws = ARG_WS;
    const float* const MODS = (const float*)(ws + WS_MODS); float* const BIAS = (float*)(ws + WS_BIAS);
    LAS float* const shl = (LAS float*)F0.lds;
    const int i0 = lo + (int)(((long)vb * (hi - lo)) / nb), i1 = lo + (int)(((long)(vb + 1) * (hi - lo)) / nb);
    int cur = -1;
    for (int it = i0; it < i1; ++it) {
        int seg, r; const bf16* WT; int nrows; const float* sh; float* out;
        if (it < 168) { seg = 0; r = it; WT = (const bf16*)(ws + WS_WDSA); nrows = DSA_NP; sh = MODS + 0 * 4 * 12288; out = BIAS + BIAS_DSA0; }
        else if (it < 208) { seg = 1; r = it - 168; WT = (const bf16*)(ws + WS_WMLA + WMLA_DOWN); nrows = MLA_DOWN_NP; sh = MODS + 1 * 4 * 12288; out = BIAS + BIAS_MLA; }
        else if (it < 400) { seg = 2; r = it - 208; WT = (const bf16*)(ws + WS_WSB); nrows = 3 * DM; sh = MODS + 2 * 4 * 12288; out = BIAS + BIAS_SB; }
        else if (it < 568) { seg = 3; r = it - 400; WT = (const bf16*)(ws + WS_WDSA + WDSA_STRIDE); nrows = DSA_NP; sh = MODS + 3 * 4 * 12288; out = BIAS + BIAS_DSA1; }
        else { const int l = (it - 568) / 352; seg = 4 + l; r = (it - 568) % 352; WT = (const bf16*)(ws + WS_W + (size_t)l * WL_STRIDE + WL_FFN1); nrows = 2 * DFF; sh = MODS + (size_t)l * 4 * 12288 + 6144; out = BIAS + BIAS_FFN + (size_t)l * 4 * 2 * DFF; }
        if (seg != cur) {
            __syncthreads();
            for (int i = tid_; i < 4 * DM; i += NWAVES * 64) shl[i] = sh[(size_t)(i >> 11) * 12288 + (i & 2047)];
            __syncthreads();
            cur = seg;
        }
        bias_item(WT, nrows, out, r, shl, wave, lane);
    }
    __syncthreads();
}
__device__ __forceinline__ void bias_in_tail(const Frame& F0, int lo, int hi) {
    const int G = F0.G, rem = ((M / 256) * (DSA_NP / 256)) % G, c = (int)blockIdx.x;
    if (rem == 0) bias_range(F0, lo, hi, c, G);
    else if (c >= rem) bias_range(F0, lo, hi, c - rem, G - rem);
}
template <int L, int LO, int HI> __device__ __forceinline__ void run_layer(const Frame& F, const Args& args, const XcdBarrier& bar, unsigned char* lds) {
        unsigned char* const ws = ARG_WS;
        float* const MODS = (float*)(ws + WS_MODS);
        float* const CS128 = (float*)(ws + WS_CS128);
        float* const CS64 = (float*)(ws + WS_CS64);
        float* const SSQ = (float*)(ws + WS_SSQ);
        float* const SSX = (float*)(ws + WS_SSX);
        const float* const BIAS = (const float*)(ws + WS_BIAS);
        bf16* const HB = (bf16*)(ws + WS_H);
        bf16* const XB = (bf16*)(ws + WS_XB);
        bf16* const OB = (bf16*)(ws + WS_O);
        unsigned char* const MIX = ws + WS_MIX;
        const int gw = F.vcu * NWAVES + F.wave, NGW = F.G * NWAVES;
        constexpr int l = L; constexpr int kind = (l == 3) ? 0 : l;
        constexpr int pb = (l == 0) ? 2 : (l == 1) ? 8 : (l == 2) ? 14 : 19;
        constexpr int cb = pb + ((kind == 0) ? 3 : (kind == 1) ? 3 : 2);
        unsigned char* const WL = ws + WS_W + (size_t)l * WL_STRIDE;
        const float* const mods_l = MODS + (size_t)l * 4 * 12288;
        if constexpr (kind == 0) {
            bf16* const DQ = (bf16*)(MIX + MX_DQ); bf16* const DK = (bf16*)(MIX + MX_DK); bf16* const DV = (bf16*)(MIX + MX_DV); bf16* const DIQ = (bf16*)(MIX + MX_DIQ); bf16* const DIK = (bf16*)(MIX + MX_DIK);
            float* const DIW = (float*)(MIX + MX_DIW); unsigned long long* const DMASK = (unsigned long long*)(MIX + MX_DMASK); float* const DSC = (float*)(MIX + MX_DSC);
            if constexpr (SITE(2) && IN(pb)) {
            for (int rep_ = 0; rep_ < NREP(2); ++rep_) {
                pg8::Gemm g{HB, (const bf16*)(ws + WS_WDSA + (size_t)(l == 3) * WDSA_STRIDE), M, DSA_NP, DM}; pg8::StaticOrder S; S.init(M, DSA_NP, F.G, (int)blockIdx.x);
                pg8::EpiDsaIn E{DQ, DK, DV, DIQ, DIK, DIW, pg8::NormIn{SSX, BIAS + (l == 3 ? BIAS_DSA1 : BIAS_DSA0), DSA_NP, (pg8::PG8_LAS_float_ptr)(F.lds + EPI_TAB_OFF)}};
                pg8::gemm_phase<pg8::EpiDsaIn, pg8::StaticOrder, true, true>(F.lds, g, S, E);
            }
                if constexpr (l == 0) bias_in_tail(F, 168, 568 + 1 * 352); else bias_in_tail(F, 568 + 3 * 352, NBIAS_ITEM);
                SEAM(pb);
            }
            if constexpr (SITE(3) && IN(pb + 1)) {
            for (int rep_ = 0; rep_ < NREP(3); ++rep_) {
                int tid_ = threadIdx.x; asm volatile("" : "+v"(tid_)); const int lane_ = tid_ & 63, wave_ = __builtin_amdgcn_readfirstlane(tid_ >> 6);
                att::las_u32* const tbuf = (att::las_u32*)(F.lds + wave_ * 16384);
                for (int idx = F.vcu; idx < 512; idx += F.G) { const int s = idx & 255, r = idx >> 8, b = s >> 6, loc = s & 63, qq = r ? 127 - loc : loc;
                    att::idx_unit(b, qq, DIQ, DIK, DIW, DSC, (char*)lds);
                    const int row0 = b * 4096 + 32 * qq + 4 * wave_, c_ = qq >> 1;
                    unsigned raw[64];
                    att::topk_prefetch(DSC + (size_t)row0 * 4096, c_, tbuf, lane_);
#pragma unroll 1
                    for (int k = 0; k < 4; ++k) {
                        att::topk_fetch(tbuf, c_, raw, lane_);
                        if (k < 3) att::topk_prefetch(DSC + (size_t)(row0 + k + 1) * 4096, c_, tbuf, lane_);
                        att::topk_row(raw, c_, DMASK + (size_t)(row0 + k) * 64, lane_);
                    }
                    __syncthreads();
                }
                asm volatile("s_waitcnt vmcnt(0)" ::: "memory");
            }
                SEAM(pb + 1);
            }
            if constexpr (SITE(5) && IN(pb + 2)) {
            for (int rep_ = 0; rep_ < NREP(5); ++rep_) {
                for (int idx = F.vcu; idx < 1024; idx += F.G) { const int s = idx & 255, r = idx >> 8, bg = s >> 4, loc = s & 15;
                    const int c = (r == 0) ? loc : (r == 1) ? 63 - loc : (r == 2) ? loc + 16 : 47 - loc;
                    if (rep_ == 0) att::dsa_attn_unit<0>(bg >> 2, bg & 3, c, DQ, DK, DV, DMASK, OB, (char*)lds); else att::dsa_attn_unit<(REP_VAR ? REP_VAR : 1)>(bg >> 2, bg & 3, c, DQ, DK, DV, DMASK, OB, (char*)lds); }
            }
                SEAM(pb + 2);
            }
        } else if constexpr (kind == 1) {
            bf16* const CQ = (bf16*)(MIX + MX_MCQ); bf16* const CKV = (bf16*)(MIX + MX_MCKV); bf16* const KR = (bf16*)(MIX + MX_MKR); bf16* const QN = (bf16*)(MIX + MX_MQN); bf16* const QR = (bf16*)(MIX + MX_MQR);
            bf16* const KN = (bf16*)(MIX + MX_MKN); bf16* const MV = (bf16*)(MIX + MX_MV);
            if constexpr (SITE(6) && IN(pb)) {
            for (int rep_ = 0; rep_ < NREP(6); ++rep_) {
                pg8::Gemm g{HB, (const bf16*)(ws + WS_WMLA + WMLA_DOWN), M, 1024, DM}; pg8::StaticOrder S; S.init(M, 1024, F.G, (int)blockIdx.x);
                pg8::EpiMlaDown E{CQ, CKV, KR, SSQ, pg8::NormIn{SSX, BIAS + BIAS_MLA, MLA_DOWN_NP, (pg8::PG8_LAS_float_ptr)(F.lds + EPI_TAB_OFF)}, 0};
                pg8::gemm_phase<pg8::EpiMlaDown, pg8::StaticOrder, true, true>(F.lds, g, S, E);
            }
                SEAM(pb);
            }
            if constexpr (SITE(7) && IN(pb + 1)) {
            for (int rep_ = 0; rep_ < NREP(7); ++rep_) {
                const int v = F.vcu; const bool bal = (F.G == 256);
                const int s0 = v < 64 ? 4 * v : 256 + 8 * (v - 64), s1 = s0 + (v < 64 ? 4 : 8);
                { pg8::Gemm g{HB, (const bf16*)(ws + WS_WMLA + WMLA_DOWN) + (size_t)1024 * DM, M, 256, DM};
                  pg8::RangeOrder S{v, 64, bal ? 64 : F.G, 1};
                  pg8::EpiMlaDown E{CQ, CKV, KR, SSQ, pg8::NormIn{SSX, BIAS + BIAS_MLA, MLA_DOWN_NP, (pg8::PG8_LAS_float_ptr)(F.lds + EPI_TAB_OFF)}, 4};
                  pg8::gemm_phase<pg8::EpiMlaDown, pg8::RangeOrder, true, true>(F.lds, g, S, E); }
                { pg8::Gemm g{CQ, (const bf16*)(ws + WS_WMLA + WMLA_UQ), M, 3072, 512};
                  pg8::RangeOrder S{bal ? (s0 < 768 ? s0 : 768) : v, bal ? (s1 < 768 ? s1 : 768) : 768, bal ? 1 : F.G, 12};
                  pg8::EpiMlaUq E{QN, QR, SSQ, (pg8::PG8_LAS_float_ptr)(F.lds + EPI_TAB_OFF)};
                  pg8::gemm_phase<pg8::EpiMlaUq, pg8::RangeOrder, true, true>(F.lds, g, S, E); }
                { pg8::Gemm g{CKV, (const bf16*)(ws + WS_WMLA + WMLA_UKV), M, 4096, 512};
                  pg8::RangeOrder S{bal ? (s0 > 768 ? s0 - 768 : 0) : v, bal ? (s1 > 768 ? s1 - 768 : 0) : 1024, bal ? 1 : F.G, 16};
                  pg8::EpiMlaUkv E{KN, MV, SSQ, (pg8::PG8_LAS_float_ptr)(F.lds + EPI_TAB_OFF)};
                  pg8::gemm_phase<pg8::EpiMlaUkv, pg8::RangeOrder, true, true>(F.lds, g, S, E); }
            }
                SEAM(pb + 1);
            }
            if constexpr (SITE(8) && IN(pb + 2)) {
            for (int rep_ = 0; rep_ < NREP(8); ++rep_) {
                for (int idx = F.vcu; idx < 1024; idx += F.G) { const int s = idx & 255, r = idx >> 8, bh = s >> 2, loc = s & 3;
                    const int qb = (r == 0) ? loc : (r == 1) ? 15 - loc : (r == 2) ? loc + 4 : 11 - loc;
                    att::mla_attn_unit(bh >> 4, bh & 15, qb, QN, QR, KN, KR, MV, OB, (char*)lds); }
            }
                SEAM(pb + 2);
            }
        } else {
            bf16* const SQ = (bf16*)(MIX + MX_SQ); bf16* const SK = (bf16*)(MIX + MX_SK); bf16* const SV = (bf16*)(MIX + MX_SV);
            if constexpr (SITE(9) && IN(pb)) {
            for (int rep_ = 0; rep_ < NREP(9); ++rep_) {
                pg8::Gemm g{HB, (const bf16*)(ws + WS_WSB), M, 3 * DM, DM}; pg8::StaticOrder S; S.init(M, 3 * DM, F.G, (int)blockIdx.x);
                pg8::EpiSplit3 E{SQ, (size_t)(MX_SK - MX_SQ) / 2, pg8::NormIn{SSX, BIAS + BIAS_SB, 3 * DM, (pg8::PG8_LAS_float_ptr)(F.lds + EPI_TAB_OFF)}}; static_assert(MX_SV - MX_SK == MX_SK - MX_SQ, "q | k | v equally spaced");
                pg8::gemm_phase<pg8::EpiSplit3, pg8::StaticOrder, true, true>(F.lds, g, S, E);
            }
                SEAM(pb);
            }
            if constexpr (SITE(10) && IN(pb + 1)) {
            for (int rep_ = 0; rep_ < NREP(10); ++rep_) {
                unsigned* const qhead = (unsigned*)(ARG_WS + WS_CTL) + 2048 + 64;
                for (;;) {
                    if (threadIdx.x == 0) F.MISC[16] = __hip_atomic_fetch_add(qhead, 1u, __ATOMIC_RELAXED, __HIP_MEMORY_SCOPE_AGENT);
                    __syncthreads();
                    const int u = (int)F.MISC[16];
                    __syncthreads();
                    if (u >= 1024) break;
                    att::sb_attn_unit((u & 63) >> 4, u & 15, 15 - (u >> 6), SQ, SK, SV, OB, (char*)lds, DIAG_PTR);
                }
            }
                SEAM(pb + 1);
            }
        }
        pg8::PG8_LAS_float_ptr const part = (pg8::PG8_LAS_float_ptr)(F.lds + EPI_PART_OFF);
        if constexpr (SITE(11) && IN(cb)) {
            const float* gf = (l == 0) ? ARG_IN(5) : (l == 1) ? ARG_IN(13) : (l == 2) ? ARG_IN(25) : ARG_IN(33);
            pg8::Gemm g{OB, (const bf16*)(WL + WL_OUT), M, DM, DM}; pg8::StaticOrder S; S.init(M, DM, F.G, (int)blockIdx.x);
            pg8::EpiResid E{XB, mods_l + 4096, HB, gf, mods_l + 8192, SSX, part};
            pg8::gemm_phase<pg8::EpiResid, pg8::StaticOrder, true, true>(F.lds, g, S, E);
            SEAM(cb);
        }
        if constexpr (SITE(13) && IN(cb + 1)) {
            for (int rep_ = 0; rep_ < NREP(13); ++rep_) {
            pg8::Gemm g{HB, (const bf16*)(WL + WL_FFN1), M, 2 * DFF, DM}; pg8::StaticOrder S; S.init(M, 2 * DFF, F.G, (int)blockIdx.x);
            pg8::EpiSwiglu E{(bf16*)(MIX + MX_ACT), pg8::NormIn{SSX, BIAS + BIAS_FFN + (size_t)l * 4 * 2 * DFF, 2 * DFF, (pg8::PG8_LAS_float_ptr)(F.lds + EPI_TAB_OFF)}};
            pg8::gemm_phase<pg8::EpiSwiglu, pg8::StaticOrder, true, true>(F.lds, g, S, E);
            }
            SEAM(cb + 1);
        }
        if constexpr (SITE(14) && IN(cb + 2)) {
            const float* gm = (l == 0) ? ARG_IN(12) : (l == 1) ? ARG_IN(24) : ARG_IN(32);
            pg8::Gemm g{(const bf16*)(MIX + MX_ACT), (const bf16*)(WL + WL_FFN2), M, DM, DFF}; pg8::StaticOrder S; S.init(M, DM, F.G, (int)blockIdx.x);
            pg8::EpiResid E{XB, mods_l + 10240, (l < 3) ? HB : (bf16*)nullptr, gm, mods_l + 4 * 12288 + 2048, SSX, part};
            pg8::gemm_phase<pg8::EpiResid, pg8::StaticOrder, true, true>(F.lds, g, S, E);
            SEAM(cb + 2);
        }
}
__device__ __forceinline__ void p1_phase(const Frame& F0, const Args& args, bf16* __restrict__ HB, bf16* __restrict__ XB, float* __restrict__ SSX, float* __restrict__ BIAS) {
    int tid_ = threadIdx.x; asm volatile("" : "+v"(tid_)); const int lane = tid_ & 63, wave = __builtin_amdgcn_readfirstlane(tid_ >> 6);
    const int gw = F0.vcu * NWAVES + wave, NGW = F0.G * NWAVES;
    unsigned char* const args_ws = ARG_WS;
    const float* const MODS = (const float*)(args_ws + WS_MODS);
    {
        const float* x = ARG_IN(0); const float* g = ARG_IN(4);
        for (int m = gw; m < M; m += NGW) {
            const GAS f32x4* xr = (const GAS f32x4*)(x + (size_t)m * DM) + lane;
            f32x4 v[8]; float s = 0.f;
#pragma unroll
            for (int j = 0; j < 8; ++j) { v[j] = xr[64 * j]; s += (v[j].x * v[j].x + v[j].y * v[j].y) + (v[j].z * v[j].z + v[j].w * v[j].w); }
            s = wave_sum(s);
            if (lane == 0) { *(f32x4*)(SSX + (size_t)m * 8) = (f32x4){s, 0.f, 0.f, 0.f}; *(f32x4*)(SSX + (size_t)m * 8 + 4) = (f32x4){0.f, 0.f, 0.f, 0.f}; }
            const float* mb = MODS + (size_t)(m >> 12) * 12288;
            GAS unsigned long long* o8 = (GAS unsigned long long*)(HB + (size_t)m * DM) + lane; GAS unsigned long long* x8 = (GAS unsigned long long*)(XB + (size_t)m * DM) + lane;
#pragma unroll
            for (int j = 0; j < 8; ++j) { const int col = 256 * j + 4 * lane;
                const f32x4 g4 = *(const f32x4*)(g + col), sc4 = *(const f32x4*)(mb + 2048 + col);
                const f32x4 r = v[j] * g4 * (sc4 + 1.0f);
                o8[64 * j] = (unsigned long long)pk2(r.x, r.y) | ((unsigned long long)pk2(r.z, r.w) << 32);
                x8[64 * j] = (unsigned long long)pk2(v[j].x, v[j].y) | ((unsigned long long)pk2(v[j].z, v[j].w) << 32); }
        }
    }
    bias_range(F0, 0, 168, F0.vcu, F0.G); bias_range(F0, 568 + 1 * 352, 568 + 3 * 352, F0.vcu, F0.G);
}
template <int LO, int HI> __global__ void __launch_bounds__(NWAVES * 64, 2) trunk_fwd(Args args) {
    extern __shared__ __attribute__((aligned(16))) unsigned char lds[];
    Frame F;
    F.lds = (LAS unsigned char*)lds;
    F.MISC = (volatile LAS unsigned*)(F.lds + MISC_OFF);
    F.tid = threadIdx.x; F.lane = F.tid & 63; F.wave = __builtin_amdgcn_readfirstlane(F.tid >> 6);
    F.G = gridDim.x; { const int bx = blockIdx.x; F.vcu = (F.G % 8 == 0) ? (bx % 8) * (F.G / 8) + bx / 8 : bx; }
    unsigned char* const ws = ARG_WS;
    F.ctl = (gu32*)(ws + WS_CTL);
    for (int u = F.tid; u < (LDS_BYTES - LDSCTL_OFF) / 4; u += NWAVES * 64) ((LAS unsigned*)(F.lds + LDSCTL_OFF))[u] = 0u;
    __syncthreads();
    XcdBarrier bar = xcd_barrier_post((unsigned*)(F.ctl + CW_BAR) + ARG_LI * XCD_BAR_WORDS, F.MISC + 8);
#if DIAG == 2
    if (blockIdx.x == 0 && threadIdx.x == 0) ((unsigned long long*)(ARG_WS + WS_CTL + 0x8000))[0] = __builtin_amdgcn_s_memrealtime();
#endif
    float* const MODS = (float*)(ws + WS_MODS);
    float* const CS128 = (float*)(ws + WS_CS128);
    float* const CS64 = (float*)(ws + WS_CS64);
    float* const SSQ = (float*)(ws + WS_SSQ);
    bf16* const HB = (bf16*)(ws + WS_H);
    bf16* const OB = (bf16*)(ws + WS_O);
    unsigned char* const MIX = ws + WS_MIX;
    const int gw = F.vcu * NWAVES + F.wave, NGW = F.G * NWAVES;

    if constexpr (SITE(0) && IN(0)) {
            for (int rep_ = 0; rep_ < NREP(0); ++rep_) {
            if (rep_) __syncthreads();
        for (int r1_ = 0; r1_ < 1 + (P0_REP & 1); ++r1_) {
            LAS float* silc = (LAS float*)F.lds;
            LAS float* red = (LAS float*)(F.lds + 32768);
            const float* cvec = ARG_IN(1);
            for (int i = F.tid; i < 4 * DM; i += NWAVES * 64) { const float c = cvec[i]; silc[i] = c / (1.0f + __expf(-c)); }
            __syncthreads();
            for (int it = F.vcu; it < 4 * 192; it += F.G) {
                const int l = it / 192, ng = it % 192;
                const float* W = (l == 0) ? ARG_IN(2) : (l == 1) ? ARG_IN(10) : (l == 2) ? ARG_IN(22) : ARG_IN(30);
                const float* Bv = (l == 0) ? ARG_IN(3) : (l == 1) ? ARG_IN(11) : (l == 2) ? ARG_IN(23) : ARG_IN(31);
                const int c4 = F.lane & 15, kr = F.lane >> 4, k0 = 256 * F.wave;
                f32x4 acc[4];
#pragma unroll
                for (int b = 0; b < 4; ++b) acc[b] = (f32x4){0.f, 0.f, 0.f, 0.f};
#pragma unroll 8
                for (int kk = 0; kk < 64; ++kk) { const int k = k0 + 4 * kk + kr;
                    const f32x4 w4 = *(const GAS f32x4*)(W + (size_t)k * 12288 + 64 * ng + 4 * c4);
#pragma unroll
                    for (int b = 0; b < 4; ++b) acc[b] += w4 * silc[b * DM + k]; }
#pragma unroll
                for (int b = 0; b < 4; ++b)
#pragma unroll
                    for (int e = 0; e < 4; ++e) { float v = acc[b][e]; v += __shfl_xor(v, 16); v += __shfl_xor(v, 32); acc[b][e] = v; }
                if (kr == 0) {
#pragma unroll
                    for (int b = 0; b < 4; ++b) *(LAS f32x4*)(red + (F.wave * 4 + b) * 64 + 4 * c4) = acc[b]; }
                __syncthreads();
                if (F.tid < 256) { const int b = F.tid >> 6, col = F.tid & 63; float s = Bv[64 * ng + col];
#pragma unroll
                    for (int w = 0; w < 8; ++w) s += red[(w * 4 + b) * 64 + col];
                    MODS[((size_t)l * 4 + b) * 12288 + 64 * ng + col] = s; }
                __syncthreads();
            }
        }
        for (int r2_ = 0; r2_ < 1 + ((P0_REP >> 1) & 1); ++r2_) {
            LAS unsigned* scr = (LAS unsigned*)(F.lds + F.wave * 16384);
            int it = gw;
#define CONV_SEG(Wp, K_, Nsrc_, Nphys_, kind_, gk_, dst_) do { const int n_items_ = ((K_) / 64) * ((Nphys_) / 64); \
                for (; it < n_items_; it += NGW) conv_item((Wp), (K_), (Nsrc_), (Nphys_), (kind_), (gk_), (bf16*)(dst_), scr, it, F.lane); it -= n_items_; } while (0)
            CONV_SEG(ARG_IN(8),  DM, 2 * DFF, 2 * DFF, KIND_FFN1, (const float*)nullptr, ws + WS_W + 0 * WL_STRIDE + WL_FFN1);
            CONV_SEG(ARG_IN(20), DM, 2 * DFF, 2 * DFF, KIND_FFN1, (const float*)nullptr, ws + WS_W + 1 * WL_STRIDE + WL_FFN1);
            CONV_SEG(ARG_IN(28), DM, 2 * DFF, 2 * DFF, KIND_FFN1, (const float*)nullptr, ws + WS_W + 2 * WL_STRIDE + WL_FFN1);
            CONV_SEG(ARG_IN(36), DM, 2 * DFF, 2 * DFF, KIND_FFN1, (const float*)nullptr, ws + WS_W + 3 * WL_STRIDE + WL_FFN1);
            CONV_SEG(ARG_IN(9),  DFF, DM, DM, KIND_ID, (const float*)nullptr, ws + WS_W + 0 * WL_STRIDE + WL_FFN2);
            CONV_SEG(ARG_IN(21), DFF, DM, DM, KIND_ID, (const float*)nullptr, ws + WS_W + 1 * WL_STRIDE + WL_FFN2);
            CONV_SEG(ARG_IN(29), DFF, DM, DM, KIND_ID, (const float*)nullptr, ws + WS_W + 2 * WL_STRIDE + WL_FFN2);
            CONV_SEG(ARG_IN(37), DFF, DM, DM, KIND_ID, (const float*)nullptr, ws + WS_W + 3 * WL_STRIDE + WL_FFN2);
            CONV_SEG(ARG_IN(7),  DM, DM, DM, KIND_ID, (const float*)nullptr, ws + WS_W + 0 * WL_STRIDE + WL_OUT);
            CONV_SEG(ARG_IN(19), DM, DM, DM, KIND_ID, (const float*)nullptr, ws + WS_W + 1 * WL_STRIDE + WL_OUT);
            CONV_SEG(ARG_IN(27), DM, DM, DM, KIND_ID, (const float*)nullptr, ws + WS_W + 2 * WL_STRIDE + WL_OUT);
            CONV_SEG(ARG_IN(35), DM, DM, DM, KIND_ID, (const float*)nullptr, ws + WS_W + 3 * WL_STRIDE + WL_OUT);
            CONV_SEG(ARG_IN(6),  DM, 5264, DSA_NP, KIND_DSA_IN, (const float*)nullptr, ws + WS_WDSA + 0 * WDSA_STRIDE);
            CONV_SEG(ARG_IN(34), DM, 5264, DSA_NP, KIND_DSA_IN, (const float*)nullptr, ws + WS_WDSA + 1 * WDSA_STRIDE);
            CONV_SEG(ARG_IN(14), DM, 1088, MLA_DOWN_NP, KIND_MLA_DOWN, (const float*)nullptr, ws + WS_WMLA + WMLA_DOWN);
            CONV_SEG(ARG_IN(17), 512, 3072, 3072, KIND_MLA_UQ, ARG_IN(15), ws + WS_WMLA + WMLA_UQ);
            CONV_SEG(ARG_IN(18), 512, 4096, 4096, KIND_ID, ARG_IN(16), ws + WS_WMLA + WMLA_UKV);
            CONV_SEG(ARG_IN(26), DM, 3 * DM, 3 * DM, KIND_ID, (const float*)nullptr, ws + WS_WSB);
#undef CONV_SEG
        }
            }
        SEAM(0);
    }
    if constexpr (SITE(1) && IN(1)) { p1_phase(F, args, (bf16*)(ws + WS_H), (bf16*)(ws + WS_XB), (float*)(ws + WS_SSX), (float*)(ws + WS_BIAS)); SEAM(1); }

    run_layer<0, LO, HI>(F, args, bar, lds); run_layer<1, LO, HI>(F, args, bar, lds); run_layer<2, LO, HI>(F, args, bar, lds); run_layer<3, LO, HI>(F, args, bar, lds);
    if constexpr (SITE(15) && IN(NPH - 1)) {
        finalnorm_phase(F, (const bf16*)(ws + WS_XB), ARG_OUT, ARG_IN(38));
#if DIAG == 2
        __syncthreads(); if (blockIdx.x == 0 && threadIdx.x == 0) { const unsigned long long* st_ = (const unsigned long long*)(ARG_WS + WS_CTL + 0x8000);
            const unsigned long long* pmx_ = (const unsigned long long*)(ARG_WS + WS_CTL + 0x9000); const unsigned long long* pmn_ = (const unsigned long long*)(ARG_WS + WS_CTL + 0xA000);
            float d_ = (float)(st_[DIAG_K1] - st_[DIAG_K0]);
            if (DIAG_SEL == 1) { d_ = 0.f; for (int k = DIAG_K0; k < DIAG_K1; ++k) d_ += (float)(long long)(st_[k + 1] - pmx_[k]); }
            if (DIAG_SEL == 2) { d_ = 0.f; for (int k = DIAG_K0; k < DIAG_K1; ++k) d_ += (float)(long long)(pmx_[k] - ((1ull << 62) - pmn_[k])); }
            ARG_OUT[0] += d_ * (0.01f / DIAG_DIV); }
#elif DIAG
        __syncthreads(); if (blockIdx.x == 0 && threadIdx.x == 0) { const unsigned cnt_ = __hip_atomic_load((unsigned*)(ARG_WS + WS_CTL) + 2048, __ATOMIC_RELAXED, __HIP_MEMORY_SCOPE_AGENT); ARG_OUT[0] += (float)cnt_ * (1.0f / 200.0f); }
#endif
    }
}
#undef IN
#undef SEAM
template <int LO, int HI> static void launch_range(int grid, const Args& a, hipStream_t stream) {
    static bool attr_done = false;
    if (!attr_done) { if (hipFuncSetAttribute((const void*)trunk_fwd<LO, HI>, hipFuncAttributeMaxDynamicSharedMemorySize, LDS_BYTES) != hipSuccess) fprintf(stderr, "kernel_launch: hipFuncSetAttribute failed\n"); attr_done = true; }
    hipLaunchKernelGGL((trunk_fwd<LO, HI>), dim3(grid), dim3(NWAVES * 64), LDS_BYTES, stream, a);
}
template <int P> struct PerPhase { static void go(int grid, const Args& a, hipStream_t stream) { launch_range<P, P + 1>(grid, a, stream); PerPhase<P + 1>::go(grid, a, stream); } };
template <> struct PerPhase<NPH> { static void go(int, const Args&, hipStream_t) {} };
extern "C" void kernel_launch(void* const* d_in, const int* in_sizes, int n_in, void* d_out, int out_size, void* d_ws, size_t ws_size, hipStream_t stream) {
    static int grid = 0;
    if (grid == 0) {
        if (n_in != 39 || in_sizes[0] != M * DM || out_size != M * DM || ws_size < WS_END) { fprintf(stderr, "kernel_launch: shape mismatch (n_in %d, in0 %d, out %d, ws %zu < %zu)\n", n_in, n_in > 0 ? in_sizes[0] : -1, out_size, ws_size, (size_t)WS_END); grid = -1; return; }
        int dev = 0, cus = 0;
        if (hipGetDevice(&dev) != hipSuccess || hipDeviceGetAttribute(&cus, hipDeviceAttributeMultiprocessorCount, dev) != hipSuccess) { grid = -1; return; }
        grid = cus;
    }
    if (grid < 0) return;
    if (hipMemsetAsync((char*)d_ws + WS_CTL, 0, CTL_ZERO_BYTES, stream) != hipSuccess) return;
    Args a{};
    for (int i = 0; i < 39; ++i) a.in[i] = (const float*)d_in[i];
    a.out = (float*)d_out; a.ws = (unsigned char*)d_ws; a.ph_lo = 0; a.ph_hi = NPH; a.li = 0;
#if MK_ONE_LAUNCH
    launch_range<0, NPH>(grid, a, stream);
#else
    PerPhase<0>::go(grid, a, stream);
#endif
    const hipError_t le = hipPeekAtLastError();
    if (le != hipSuccess) fprintf(stderr, "kernel_launch: launch failed: %s\n", hipGetErrorName(le));
}
```

```cpp
#include <hip/hip_runtime.h>
#include <cstdio>
#include <cstdint>
#include <cstddef>
namespace pg8 {
#define PG8_LAS __attribute__((address_space(3)))
typedef unsigned short bf16_t;
typedef short bf16x8 __attribute__((ext_vector_type(8)));
typedef float f32x4 __attribute__((ext_vector_type(4)));
typedef unsigned u32x4 __attribute__((ext_vector_type(4)));
constexpr int BM = 256, BK = 64, HALF = 128, HTB = HALF * BK * 2  , STAGE_BYTES = 8 * HTB, NXCD = 8, WGM = 8;

__host__ __device__ __forceinline__ int lds_byte(int r, int c) { const int st = (r >> 4) * 2 + (c >> 5), rr = r & 15, cc = c & 31, ob = rr * 64 + cc * 2; return st * 1024 + (ob ^ (((ob >> 9) & 1) << 5)); }
__host__ __device__ __forceinline__ void stage_rc(int b, int& R, int& C) { const int st = b / 1024, sb = b % 1024, swz = sb ^ (((sb >> 9) & 1) << 5); R = (st >> 1) * 16 + swz / 64; C = (st & 1) * 32 + (swz % 64) / 2; }
__host__ __device__ __forceinline__ int perm32(int rho) { const int n = rho >> 4, i = rho & 15; return 8 * (i >> 2) + 4 * n + (i & 3); }

struct Unit { int pm, pn; };
struct Gemm { const bf16_t* A; const bf16_t* Bt; int M, N, K; };

struct StaticOrder {
    int nM, nN, nwg, G, c;
    __host__ __device__ void init(int M, int N, int G_, int c_) { nM = M / BM; nN = N / BM; nwg = nM * nN; G = G_; c = c_; }
    __host__ __device__ bool next(int i, Unit& u) const {
        const long L = (long)i * G + c; if (L >= nwg) return false;
        int wgid = (int)L; { const int q = nwg / NXCD, r = nwg % NXCD, xcd = wgid % NXCD, off = wgid / NXCD; wgid = (xcd < r ? xcd * (q + 1) : r * (q + 1) + (xcd - r) * q) + off; }
        const int nig = WGM * nN, gid = wgid / nig, fm = gid * WGM, gsz = (nM - fm) < WGM ? (nM - fm) : WGM;
        u.pm = fm + ((wgid % nig) % gsz); u.pn = (wgid % nig) / gsz; return true;
    }
    __device__ __forceinline__ void a_ready(const Unit&) const {}
    __device__ __forceinline__ void done(const Unit&) const {}
};
struct RangeOrder {
    int lo, hi, step, nN;
    __device__ __forceinline__ bool next(int i, Unit& u) const { const int idx = lo + i * step; if (idx >= hi) return false; u.pm = idx / nN; u.pn = idx % nN; return true; }
    __device__ __forceinline__ void a_ready(const Unit&) const {}
    __device__ __forceinline__ void done(const Unit&) const {}
};

__device__ __forceinline__ unsigned cvt_pk_bf16(float lo, float hi) { unsigned r; asm volatile("v_cvt_pk_bf16_f32 %0, %1, %2" : "=v"(r) : "v"(lo), "v"(hi)); return r; }
typedef float f32x2 __attribute__((ext_vector_type(2)));
__device__ __forceinline__ u32x4 pack8(const f32x4 v0, const f32x4 v1) { u32x4 w; w.x = cvt_pk_bf16(v0[0], v0[1]); w.y = cvt_pk_bf16(v0[2], v0[3]); w.z = cvt_pk_bf16(v1[0], v1[1]); w.w = cvt_pk_bf16(v1[2], v1[3]); return w; }
__device__ __forceinline__ void rope_ir(int i0, float l2t_over_half  , f32x4& ir0, f32x4& ir1) {
#pragma unroll
    for (int e = 0; e < 4; ++e) { ir0[e] = __builtin_amdgcn_exp2f(-(float)(i0 + e) * l2t_over_half) * 0.15915494309189535f; ir1[e] = __builtin_amdgcn_exp2f(-(float)(i0 + 4 + e) * l2t_over_half) * 0.15915494309189535f; }
}
__device__ __forceinline__ void rope8(const f32x4 ir0, const f32x4 ir1, float pos, const f32x4 a0, const f32x4 a1, const f32x4 b0, const f32x4 b1, u32x4& o1, u32x4& o2) {
    f32x4 c0, s0, c1, s1;
#pragma unroll
    for (int e = 0; e < 4; ++e) { const float r0 = __builtin_amdgcn_fractf(ir0[e] * pos), r1 = __builtin_amdgcn_fractf(ir1[e] * pos);
        c0[e] = __builtin_amdgcn_cosf(r0); s0[e] = __builtin_amdgcn_sinf(r0); c1[e] = __builtin_amdgcn_cosf(r1); s1[e] = __builtin_amdgcn_sinf(r1); }
    const f32x4 p0 = a0 * c0 - b0 * s0, p1 = a1 * c1 - b1 * s1, q0 = b0 * c0 + a0 * s0, q1 = b1 * c1 + a1 * s1;
    o1 = pack8(p0, p1); o2 = pack8(q0, q1);
}
constexpr float L2T_128 = 13.287712379549449f / 64.0f, L2T_64 = 13.287712379549449f / 32.0f;
typedef PG8_LAS float* PG8_LAS_float_ptr;
struct NormIn { const float* ssx; const float* bias; int nphys; PG8_LAS float* tab; };
__device__ __forceinline__ unsigned rstd_tag(const float* bias, int pm) { return ((((unsigned)((uintptr_t)bias >> 2)) << 6) & 0x3FFFFFC0u) | 0x40000000u | (unsigned)pm; }
__device__ __forceinline__ void rows_rstd(const float* slots, int stride, int off, float inv_n, int pm, PG8_LAS float* tab, unsigned tag, int wr, int wc, int fr, int fq, float (&rs)[2][4]) {
    const int t = (wr * 4 + wc) * 64 + fq * 16 + fr;
    const unsigned have = (unsigned)__builtin_amdgcn_readfirstlane((int)__builtin_bit_cast(unsigned, tab[256]));
    if (have != tag) {
        if (t < 256) { const float* p = slots + (size_t)(pm * BM + t) * stride + off; const f32x4 a = *(const f32x4*)p, b = *(const f32x4*)(p + 4);
            tab[t] = 1.0f / sqrtf((((a[0] + a[1]) + (a[2] + a[3])) + ((b[0] + b[1]) + (b[2] + b[3]))) * inv_n + 1e-6f); }
        asm volatile("s_waitcnt lgkmcnt(0)" ::: "memory"); __builtin_amdgcn_s_barrier(); asm volatile("" ::: "memory");
        if (t == 0) tab[256] = __builtin_bit_cast(float, tag);
    }
#pragma unroll
    for (int ai = 0; ai < 2; ++ai)
#pragma unroll
        for (int m = 0; m < 4; ++m) rs[ai][m] = tab[ai * HALF + wr * 64 + m * 16 + fr];
}
__device__ __forceinline__ void bias_prefetch(const NormIn& ni, const Unit& u, int wid, int lane) {
    if (wid == 0) __builtin_amdgcn_global_load_lds((const unsigned*)(ni.bias + (size_t)(u.pm >> 4) * ni.nphys + u.pn * BM + lane * 4), (PG8_LAS unsigned*)(ni.tab + 512), 16, 0, 0);
}
__device__ __forceinline__ void load_bias(const NormIn& ni, const Unit& u, int wc, int fq, f32x4 (&bv)[2][2]) {
    const PG8_LAS float* bp = ni.tab + 512 + wc * 32 + 8 * fq; (void)u;
#pragma unroll
    for (int bj = 0; bj < 2; ++bj)
#pragma unroll
        for (int n = 0; n < 2; ++n) bv[bj][n] = *(const PG8_LAS f32x4*)(bp + bj * HALF + 4 * n);
}
__device__ __forceinline__ void unpack8(const u32x4 w, f32x4& lo, f32x4& hi) {
    lo = (f32x4){__uint_as_float(w.x << 16), __uint_as_float(w.x & 0xffff0000u), __uint_as_float(w.y << 16), __uint_as_float(w.y & 0xffff0000u)};
    hi = (f32x4){__uint_as_float(w.z << 16), __uint_as_float(w.z & 0xffff0000u), __uint_as_float(w.w << 16), __uint_as_float(w.w & 0xffff0000u)};
}
struct EpiResid {
    static constexpr bool PERM = true, AFTER_DRAIN = false;
    bf16_t* x; const float* gate;
    bf16_t* hb; const float* gn; const float* scn; float* ssx; PG8_LAS float* part;
    __device__ __forceinline__ void operator()(const f32x4 (&acc)[2][2][4][2], const Unit& u, int wr, int wc, int fr, int fq) const {
        const int row0 = u.pm * BM + wr * 64 + fr, col0 = u.pn * BM + wc * 32 + 8 * fq;
        const size_t boff = (size_t)(u.pm >> 4) * 12288 + col0;
        f32x4 gv[2][2], mv[2][2];
#pragma unroll
        for (int bj = 0; bj < 2; ++bj)
#pragma unroll
            for (int n = 0; n < 2; ++n) { gv[bj][n] = *(const f32x4*)(gate + boff + bj * HALF + 4 * n);
                if (hb) mv[bj][n] = *(const f32x4*)(gn + col0 + bj * HALF + 4 * n) * (*(const f32x4*)(scn + boff + bj * HALF + 4 * n) + 1.0f); }
#pragma unroll
        for (int ai = 0; ai < 2; ++ai) {
            u32x4 xw[4][2];
#pragma unroll
            for (int m = 0; m < 4; ++m)
#pragma unroll
                for (int bj = 0; bj < 2; ++bj) xw[m][bj] = *(const u32x4*)(x + (size_t)(row0 + ai * HALF + m * 16) * 2048 + col0 + bj * HALF);
#pragma unroll
            for (int m = 0; m < 4; ++m) { const int rl = ai * HALF + wr * 64 + m * 16 + fr; const size_t off = (size_t)(row0 + ai * HALF + m * 16) * 2048 + col0; float s = 0.f;
#pragma unroll
                for (int bj = 0; bj < 2; ++bj) { f32x4 x0, x1; unpack8(xw[m][bj], x0, x1);
                    const f32x4 n0 = x0 + gv[bj][0] * acc[ai][bj][m][0], n1 = x1 + gv[bj][1] * acc[ai][bj][m][1];
                    *(u32x4*)(x + off + bj * HALF) = pack8(n0, n1);
                    s += ((n0[0] * n0[0] + n0[1] * n0[1]) + (n0[2] * n0[2] + n0[3] * n0[3])) + ((n1[0] * n1[0] + n1[1] * n1[1]) + (n1[2] * n1[2] + n1[3] * n1[3]));
                    if (hb) *(u32x4*)(hb + off + bj * HALF) = pack8(n0 * mv[bj][0], n1 * mv[bj][1]); }
                if (hb) { s += __shfl_xor(s, 16); s += __shfl_xor(s, 32); if (fq == 0) part[rl * 4 + wc] = s; } }
        }
        if (hb) {
            asm volatile("s_waitcnt lgkmcnt(0)" ::: "memory"); __builtin_amdgcn_s_barrier(); asm volatile("" ::: "memory");
            const int t = (wr * 4 + wc) * 64 + fq * 16 + fr;
            if (t < 256) { const f32x4 p = *(const PG8_LAS f32x4*)(part + t * 4); ssx[(size_t)(u.pm * BM + t) * 8 + u.pn] = (p[0] + p[1]) + (p[2] + p[3]); }
        }
    }
};
struct EpiSwiglu {
    static constexpr bool PERM = true, AFTER_DRAIN = false;
    bf16_t* act; NormIn ni;
    __device__ __forceinline__ void prefetch(const Unit& u, int wid, int lane) const { bias_prefetch(ni, u, wid, lane); }
    __device__ __forceinline__ void operator()(const f32x4 (&acc)[2][2][4][2], const Unit& u, int wr, int wc, int fr, int fq) const {
        const int row0 = u.pm * BM + wr * 64 + fr, col0 = u.pn * 128 + wc * 32 + 8 * fq;
        f32x4 bv[2][2]; load_bias(ni, u, wc, fq, bv); float rs[2][4]; rows_rstd(ni.ssx, 8, 0, 1.0f / 2048.0f, u.pm, ni.tab, rstd_tag(ni.bias, u.pm), wr, wc, fr, fq, rs);
#pragma unroll
        for (int ai = 0; ai < 2; ++ai)
#pragma unroll
            for (int m = 0; m < 4; ++m) { const int row = row0 + ai * HALF + m * 16; const float rstd = rs[ai][m]; f32x4 r[2];
#pragma unroll
                for (int n = 0; n < 2; ++n)
#pragma unroll
                    for (int i = 0; i < 4; ++i) { const float g = acc[ai][0][m][n][i] * rstd + bv[0][n][i], up = acc[ai][1][m][n][i] * rstd + bv[1][n][i];
                        r[n][i] = g * __builtin_amdgcn_rcpf(1.0f + __builtin_amdgcn_exp2f(-1.4426950408889634f * g)) * up; }
                *(u32x4*)(act + (size_t)row * 5632 + col0) = pack8(r[0], r[1]); }
    }
};
struct EpiSplit3 {
    static constexpr bool PERM = true, AFTER_DRAIN = false;
    bf16_t* O0; size_t stride; NormIn ni;
    __device__ __forceinline__ void prefetch(const Unit& u, int wid, int lane) const { bias_prefetch(ni, u, wid, lane); }
    __device__ __forceinline__ void operator()(const f32x4 (&acc)[2][2][4][2], const Unit& u, int wr, int wc, int fr, int fq) const {
        const int t = u.pn >> 3; bf16_t* base = O0 + (size_t)t * stride;
        const int row0 = u.pm * BM + wr * 64 + fr, col0 = (u.pn & 7) * 256 + wc * 32 + 8 * fq;
        f32x4 bv[2][2]; load_bias(ni, u, wc, fq, bv); float rs[2][4]; rows_rstd(ni.ssx, 8, 0, 1.0f / 2048.0f, u.pm, ni.tab, rstd_tag(ni.bias, u.pm), wr, wc, fr, fq, rs);
#pragma unroll
        for (int ai = 0; ai < 2; ++ai)
#pragma unroll
            for (int m = 0; m < 4; ++m) { const int row = row0 + ai * HALF + m * 16; const float rstd = rs[ai][m]; bf16_t* rowp = base + (size_t)row * 2048 + col0;
#pragma unroll
                for (int bj = 0; bj < 2; ++bj) *(u32x4*)(rowp + bj * HALF) = pack8(acc[ai][bj][m][0] * rstd + bv[bj][0], acc[ai][bj][m][1] * rstd + bv[bj][1]); }
    }
};
#define NI_VALS(ai, m) const int row = row0 + (ai) * HALF + (m) * 16; const float rstd = rs[ai][m]; \
    const f32x4 v00 = acc[ai][0][m][0] * rstd + bv[0][0], v01 = acc[ai][0][m][1] * rstd + bv[0][1], v10 = acc[ai][1][m][0] * rstd + bv[1][0], v11 = acc[ai][1][m][1] * rstd + bv[1][1];
struct EpiDsaIn {
    static constexpr bool PERM = true, AFTER_DRAIN = false;
    bf16_t *Q, *K, *V, *IQ, *IK; float* IW; NormIn ni;
    __device__ __forceinline__ void prefetch(const Unit& u, int wid, int lane) const { bias_prefetch(ni, u, wid, lane); }
    __device__ __forceinline__ void operator()(const f32x4 (&acc)[2][2][4][2], const Unit& u, int wr, int wc, int fr, int fq) const {
        const int pn = u.pn, row0 = u.pm * BM + wr * 64 + fr;
        f32x4 bv[2][2]; load_bias(ni, u, wc, fq, bv); float rs[2][4]; rows_rstd(ni.ssx, 8, 0, 1.0f / 2048.0f, u.pm, ni.tab, rstd_tag(ni.bias, u.pm), wr, wc, fr, fq, rs);
        if (pn < 10) {
            bf16_t* base; int ld, hcol;
            if (pn < 8) { base = Q; ld = 2048; hcol = (2 * pn + (wc >> 1)) * 128; } else { base = K; ld = 512; hcol = (2 * (pn - 8) + (wc >> 1)) * 128; }
            const int dd0 = 32 * (wc & 1) + 8 * fq; f32x4 ir0, ir1; rope_ir(dd0, L2T_128, ir0, ir1);
#pragma unroll
            for (int ai = 0; ai < 2; ++ai)
#pragma unroll
                for (int m = 0; m < 4; ++m) { NI_VALS(ai, m) const float pos = (float)(row & 4095); u32x4 o1, o2;
                    rope8(ir0, ir1, pos, v00, v01, v10, v11, o1, o2);
                    bf16_t* p = base + (size_t)row * ld + hcol + dd0; *(u32x4*)p = o1; *(u32x4*)(p + 64) = o2; }
        } else if (pn < 12) {
            const int col0 = (pn - 10) * 256 + wc * 32 + 8 * fq;
#pragma unroll
            for (int ai = 0; ai < 2; ++ai)
#pragma unroll
                for (int m = 0; m < 4; ++m) { NI_VALS(ai, m) bf16_t* rowp = V + (size_t)row * 512 + col0;
                    *(u32x4*)rowp = pack8(v00, v01); *(u32x4*)(rowp + HALF) = pack8(v10, v11); }
        } else {
            bf16_t* base; int ld, hcol;
            if (pn < 20) { base = IQ; ld = 2048; hcol = (2 * (pn - 12) + (wc >> 1)) * 128; } else { base = IK; ld = 128; hcol = 0; }
            const int sub = (pn < 20) ? (wc & 1) : wc;
            if (sub == 0) {
                const int dd0 = 8 * fq; f32x4 ir0, ir1; rope_ir(dd0, L2T_64, ir0, ir1);
#pragma unroll
                for (int ai = 0; ai < 2; ++ai)
#pragma unroll
                    for (int m = 0; m < 4; ++m) { NI_VALS(ai, m) const float pos = (float)(row & 4095); u32x4 o1, o2;
                        rope8(ir0, ir1, pos, v00, v01, v10, v11, o1, o2);
                        bf16_t* p = base + (size_t)row * ld + hcol + dd0; *(u32x4*)p = o1; *(u32x4*)(p + 32) = o2; }
            } else if (sub == 1) {
#pragma unroll
                for (int ai = 0; ai < 2; ++ai)
#pragma unroll
                    for (int m = 0; m < 4; ++m) { NI_VALS(ai, m) bf16_t* p = base + (size_t)row * ld + hcol + 64 + 8 * fq;
                        *(u32x4*)p = pack8(v00, v01); *(u32x4*)(p + 32) = pack8(v10, v11); }
            } else if (sub == 2 && pn == 20) {
                if (fq < 2) {
#pragma unroll
                    for (int ai = 0; ai < 2; ++ai)
#pragma unroll
                        for (int m = 0; m < 4; ++m) { NI_VALS(ai, m) float* p = IW + (size_t)row * 16 + 8 * fq; *(f32x4*)p = v00; *(f32x4*)(p + 4) = v01; (void)v10; (void)v11; }
                }
            }
        }
    }
};
struct EpiMlaDown {
    static constexpr bool PERM = true, AFTER_DRAIN = false;
    bf16_t *CQ, *CKV, *KR; float* ssq; NormIn ni; int pn_off;
    __device__ __forceinline__ void prefetch(const Unit& u, int wid, int lane) const { Unit ub = u; ub.pn = u.pn + pn_off; bias_prefetch(ni, ub, wid, lane); }
    __device__ __forceinline__ void operator()(const f32x4 (&acc)[2][2][4][2], const Unit& u, int wr, int wc, int fr, int fq) const {
        const int pn = u.pn + pn_off, row0 = u.pm * BM + wr * 64 + fr;
        Unit ub = u; ub.pn = pn;
        f32x4 bv[2][2]; load_bias(ni, ub, wc, fq, bv); float rs[2][4]; rows_rstd(ni.ssx, 8, 0, 1.0f / 2048.0f, u.pm, ni.tab, rstd_tag(ni.bias, u.pm), wr, wc, fr, fq, rs);
        if (pn < 4) {
            bf16_t* base = pn < 2 ? CQ : CKV; const int col0 = (pn & 1) * 256 + wc * 32 + 8 * fq;
#pragma unroll
            for (int ai = 0; ai < 2; ++ai)
#pragma unroll
                for (int m = 0; m < 4; ++m) { NI_VALS(ai, m)
                    float s = ((v00[0] * v00[0] + v00[1] * v00[1]) + (v00[2] * v00[2] + v00[3] * v00[3])) + ((v01[0] * v01[0] + v01[1] * v01[1]) + (v01[2] * v01[2] + v01[3] * v01[3]));
                    s += ((v10[0] * v10[0] + v10[1] * v10[1]) + (v10[2] * v10[2] + v10[3] * v10[3])) + ((v11[0] * v11[0] + v11[1] * v11[1]) + (v11[2] * v11[2] + v11[3] * v11[3]));
                    *(u32x4*)(base + (size_t)row * 512 + col0) = pack8(v00, v01); *(u32x4*)(base + (size_t)row * 512 + col0 + HALF) = pack8(v10, v11);
                    s += __shfl_xor(s, 16); s += __shfl_xor(s, 32);
                    if (fq == 0) ssq[(size_t)row * 16 + pn * 4 + wc] = s; }
        } else if (wc == 0) {
            const int dd0 = 8 * fq; f32x4 ir0, ir1; rope_ir(dd0, L2T_64, ir0, ir1);
#pragma unroll
            for (int ai = 0; ai < 2; ++ai)
#pragma unroll
                for (int m = 0; m < 4; ++m) { NI_VALS(ai, m) const float pos = (float)(row & 4095); u32x4 o1, o2;
                    rope8(ir0, ir1, pos, v00, v01, v10, v11, o1, o2);
                    bf16_t* p = KR + (size_t)row * 64 + dd0; *(u32x4*)p = o1; *(u32x4*)(p + 32) = o2; }
        }
    }
};
#undef NI_VALS
struct EpiMlaUq {
    static constexpr bool PERM = true, AFTER_DRAIN = false;
    bf16_t *QN, *QR; const float* ssq; PG8_LAS float* tab;
    __device__ __forceinline__ void operator()(const f32x4 (&acc)[2][2][4][2], const Unit& u, int wr, int wc, int fr, int fq) const {
        const int pn = u.pn, row0 = u.pm * BM + wr * 64 + fr;
        float rs[2][4]; rows_rstd(ssq, 16, 0, 1.0f / 512.0f, u.pm, tab, 0x80000000u | (unsigned)u.pm, wr, wc, fr, fq, rs);
        f32x4 ir0, ir1; rope_ir(8 * fq, L2T_64, ir0, ir1);
#pragma unroll
        for (int ai = 0; ai < 2; ++ai)
#pragma unroll
            for (int m = 0; m < 4; ++m) { const int row = row0 + ai * HALF + m * 16; const float rstd = rs[ai][m];
                if (pn < 8) { bf16_t* rowp = QN + (size_t)row * 2048 + pn * 256 + wc * 32 + 8 * fq;
#pragma unroll
                    for (int bj = 0; bj < 2; ++bj) *(u32x4*)(rowp + bj * HALF) = pack8(acc[ai][bj][m][0] * rstd, acc[ai][bj][m][1] * rstd);
                } else { u32x4 o1, o2; const int dd0 = 8 * fq;
                    rope8(ir0, ir1, (float)(row & 4095), acc[ai][0][m][0] * rstd, acc[ai][0][m][1] * rstd, acc[ai][1][m][0] * rstd, acc[ai][1][m][1] * rstd, o1, o2);
                    bf16_t* p = QR + (size_t)row * 1024 + (4 * (pn - 8) + wc) * 64 + dd0; *(u32x4*)p = o1; *(u32x4*)(p + 32) = o2; } }
    }
};
struct EpiMlaUkv {
    static constexpr bool PERM = true, AFTER_DRAIN = false;
    bf16_t *KN, *V; const float* ssq; PG8_LAS float* tab;
    __device__ __forceinline__ void operator()(const f32x4 (&acc)[2][2][4][2], const Unit& u, int wr, int wc, int fr, int fq) const {
        const int row0 = u.pm * BM + wr * 64 + fr, col0 = u.pn * 128 + wc * 32 + 8 * fq;
        float rs[2][4]; rows_rstd(ssq, 16, 8, 1.0f / 512.0f, u.pm, tab, 0x80000100u | (unsigned)u.pm, wr, wc, fr, fq, rs);
#pragma unroll
        for (int ai = 0; ai < 2; ++ai)
#pragma unroll
            for (int m = 0; m < 4; ++m) { const int row = row0 + ai * HALF + m * 16; const float rstd = rs[ai][m];
                *(u32x4*)(KN + (size_t)row * 2048 + col0) = pack8(acc[ai][0][m][0] * rstd, acc[ai][0][m][1] * rstd);
                *(u32x4*)(V + (size_t)row * 2048 + col0) = pack8(acc[ai][1][m][0] * rstd, acc[ai][1][m][1] * rstd); }
    }
};

template <class E> __device__ __forceinline__ auto epi_pre(const E& e, const Unit& u, int wid, int lane, int) -> decltype(e.prefetch(u, wid, lane), void()) { e.prefetch(u, wid, lane); }
template <class E> __device__ __forceinline__ void epi_pre(const E&, const Unit&, int, int, long) {}
template <class Epi, class Sched, bool ALIGN_EPI = false, bool SP2 = false>
__device__ __forceinline__ void gemm_phase(PG8_LAS unsigned char* lds, const Gemm g, const Sched& S, const Epi& E) {
    int tid = threadIdx.x; asm volatile("" : "+v"(tid));
    const int wid = __builtin_amdgcn_readfirstlane(tid >> 6), lane = tid & 63, wr = wid >> 2, wc = wid & 3, fr = lane & 15, fq = lane >> 4;
    const int K = g.K, nt = K / BK;
    unsigned voffA[2], voffB[2];
#pragma unroll
    for (int i = 0; i < 2; ++i) { int R, C; stage_rc(tid * 16 + i * 8192, R, C); const int Rb = Epi::PERM ? ((R & ~31) + perm32(R & 31)) : R;
        voffA[i] = (unsigned)(R * K + C) * 2u; voffB[i] = (unsigned)(Rb * K + C) * 2u; }
    const size_t kstep = (size_t)(BK * 2);
    const size_t hstep = (size_t)HALF * K * 2;
    const size_t tstep = 2 * hstep;
    const unsigned ldsw = (unsigned)wid * 1024u;
    const int aoff = lds_byte(wr * 64 + fr, fq * 8), boff = lds_byte(wc * 32 + fr, fq * 8);
#define PG8_SA(b, h) (((b) * 2 + (h)) * HTB)
#define PG8_SB(b, h) ((4 + (b) * 2 + (h)) * HTB)
#define PG8_STAGE(bufoff, gbase, voff) do { _Pragma("unroll") for (int _i = 0; _i < 2; ++_i) \
        __builtin_amdgcn_global_load_lds((const unsigned*)((const char*)(gbase) + (voff)[_i]), (PG8_LAS unsigned*)(lds + (bufoff) + ldsw + _i * 8192), 16, 0, 0); } while (0)
#define PG8_LDA(dst, b, h) do { _Pragma("unroll") for (int m = 0; m < 4; ++m) _Pragma("unroll") for (int k = 0; k < 2; ++k) dst[m][k] = *(const PG8_LAS bf16x8*)(lds + PG8_SA(b, h) + aoff + m * 2048 + k * 1024); } while (0)
#define PG8_LDB(dst, b, h) do { _Pragma("unroll") for (int n = 0; n < 2; ++n) _Pragma("unroll") for (int k = 0; k < 2; ++k) dst[n][k] = *(const PG8_LAS bf16x8*)(lds + PG8_SB(b, h) + boff + n * 2048 + k * 1024); } while (0)
#define PG8_MMA(ai, bj, At, Bt) do { __builtin_amdgcn_s_setprio(1); _Pragma("unroll") for (int m = 0; m < 4; ++m) _Pragma("unroll") for (int n = 0; n < 2; ++n) _Pragma("unroll") for (int k = 0; k < 2; ++k) \
        acc[ai][bj][m][n] = __builtin_amdgcn_mfma_f32_16x16x32_bf16(Bt[n][k], At[m][k], acc[ai][bj][m][n], 0, 0, 0); __builtin_amdgcn_s_setprio(0); } while (0)
#define PG8_WAIT_V(n) asm volatile("s_waitcnt vmcnt(" #n ")" ::: "memory")
#define PG8_WAIT_L(n) asm volatile("s_waitcnt lgkmcnt(" #n ")" ::: "memory")
#define PG8_BAR __builtin_amdgcn_s_barrier()
#define PG8_SCHED __builtin_amdgcn_sched_barrier(0)
    Unit cur, nxt; int ui = 0;
    if (!S.next(0, cur)) return;
    f32x4 acc[2][2][4][2];
#pragma unroll
    for (int a = 0; a < 2; ++a)
#pragma unroll
        for (int b = 0; b < 2; ++b)
#pragma unroll
            for (int m = 0; m < 4; ++m)
#pragma unroll
                for (int n = 0; n < 2; ++n) acc[a][b][m][n] = (f32x4){0.f, 0.f, 0.f, 0.f};
    bf16x8 At[4][2], B0[2][2], B1[2][2];
    const char* cA = (const char*)g.A + (size_t)cur.pm * tstep; const char* cB = (const char*)g.Bt + (size_t)cur.pn * tstep;
    S.a_ready(cur);
    if constexpr (SP2) {
        PG8_STAGE(PG8_SB(0, 0), cB, voffB); PG8_STAGE(PG8_SB(0, 1), cB + hstep, voffB); PG8_STAGE(PG8_SA(0, 0), cA, voffA); PG8_STAGE(PG8_SA(0, 1), cA + hstep, voffA);
        if (wr == 1) PG8_BAR;
        PG8_WAIT_V(2); PG8_BAR;
        PG8_STAGE(PG8_SB(1, 0), cB + kstep, voffB); PG8_STAGE(PG8_SA(1, 0), cA + kstep, voffA); PG8_STAGE(PG8_SB(1, 1), cB + hstep + kstep, voffB);
        PG8_WAIT_V(6); PG8_BAR;
    } else {
        PG8_STAGE(PG8_SB(0, 0), cB, voffB); PG8_STAGE(PG8_SA(0, 0), cA, voffA); PG8_STAGE(PG8_SB(0, 1), cB + hstep, voffB); PG8_STAGE(PG8_SA(0, 1), cA + hstep, voffA);
        if (wr == 1) PG8_BAR;
        PG8_WAIT_V(4); PG8_BAR;
        PG8_STAGE(PG8_SB(1, 0), cB + kstep, voffB); PG8_STAGE(PG8_SA(1, 0), cA + kstep, voffA); PG8_STAGE(PG8_SB(1, 1), cB + hstep + kstep, voffB);
        PG8_WAIT_V(6); PG8_BAR;
    }
    for (;;) {
        const bool has_next = S.next(ui + 1, nxt);
        const char* nA = has_next ? (const char*)g.A + (size_t)nxt.pm * tstep : cA; const char* nB = has_next ? (const char*)g.Bt + (size_t)nxt.pn * tstep : cB;
        for (int t = 0; t < nt; t += 2) {
            const bool last = (t == nt - 2);
            const char* a1 = cA + (size_t)(t + 1) * kstep;
            const char* a2 = last ? nA : cA + (size_t)(t + 2) * kstep; const char* b2 = last ? nB : cB + (size_t)(t + 2) * kstep;
            const char* a3 = a2 + kstep; const char* b3 = b2 + kstep;
            if (last && has_next) S.a_ready(nxt);
            if (last) epi_pre(E, cur, wid, lane, 0);
            if constexpr (SP2) {
            PG8_LDB(B0, 0, 0); PG8_LDB(B1, 0, 1); PG8_SCHED; PG8_LDA(At, 0, 0); PG8_STAGE(PG8_SA(1, 1), a1 + hstep, voffA);
            PG8_WAIT_V(8); PG8_WAIT_L(0); PG8_BAR; PG8_MMA(0, 0, At, B0); PG8_MMA(0, 1, At, B1); PG8_BAR; PG8_SCHED;
            PG8_LDA(At, 0, 1); PG8_STAGE(PG8_SB(0, 0), b2, voffB); PG8_STAGE(PG8_SB(0, 1), b2 + hstep, voffB); PG8_STAGE(PG8_SA(0, 0), a2, voffA);
            PG8_WAIT_V(8); PG8_WAIT_L(0); PG8_BAR; PG8_MMA(1, 0, At, B0); PG8_MMA(1, 1, At, B1); PG8_BAR; PG8_SCHED;
            PG8_LDB(B0, 1, 0); PG8_LDB(B1, 1, 1); PG8_SCHED; PG8_LDA(At, 1, 0); PG8_STAGE(PG8_SA(0, 1), a2 + hstep, voffA);
            PG8_WAIT_V(8); PG8_WAIT_L(0); PG8_BAR; PG8_MMA(0, 0, At, B0); PG8_MMA(0, 1, At, B1); PG8_BAR; PG8_SCHED;
            PG8_LDA(At, 1, 1); PG8_STAGE(PG8_SB(1, 0), b3, voffB); PG8_STAGE(PG8_SB(1, 1), b3 + hstep, voffB); PG8_STAGE(PG8_SA(1, 0), a3, voffA);
            PG8_WAIT_V(8); PG8_WAIT_L(0); PG8_BAR; PG8_MMA(1, 0, At, B0); PG8_MMA(1, 1, At, B1); PG8_BAR; PG8_SCHED;
            } else {
            PG8_LDB(B0, 0, 0); PG8_SCHED; PG8_LDA(At, 0, 0); PG8_STAGE(PG8_SA(1, 1), a1 + hstep, voffA);
            PG8_WAIT_L(8); PG8_BAR; PG8_WAIT_L(0); PG8_MMA(0, 0, At, B0); PG8_BAR; PG8_SCHED;
            PG8_LDB(B1, 0, 1); PG8_STAGE(PG8_SB(0, 0), b2, voffB);
            PG8_BAR; PG8_WAIT_L(0); PG8_MMA(0, 1, At, B1); PG8_BAR;
            PG8_LDA(At, 0, 1); PG8_STAGE(PG8_SA(0, 0), a2, voffA);
            PG8_BAR; PG8_WAIT_L(0); PG8_MMA(1, 0, At, B0); PG8_BAR; PG8_SCHED;
            PG8_STAGE(PG8_SB(0, 1), b2 + hstep, voffB);
            PG8_WAIT_V(6); PG8_BAR; PG8_MMA(1, 1, At, B1); PG8_BAR;
            PG8_LDB(B0, 1, 0); PG8_SCHED; PG8_LDA(At, 1, 0); PG8_STAGE(PG8_SA(0, 1), a2 + hstep, voffA);
            PG8_WAIT_L(8); PG8_BAR; PG8_WAIT_L(0); PG8_MMA(0, 0, At, B0); PG8_BAR; PG8_SCHED;
            PG8_LDB(B1, 1, 1); PG8_STAGE(PG8_SB(1, 0), b3, voffB);
            PG8_BAR; PG8_WAIT_L(0); PG8_MMA(0, 1, At, B1); PG8_BAR;
            PG8_LDA(At, 1, 1); PG8_STAGE(PG8_SA(1, 0), a3, voffA);
            PG8_BAR; PG8_WAIT_L(0); PG8_MMA(1, 0, At, B0); PG8_BAR; PG8_SCHED;
            PG8_STAGE(PG8_SB(1, 1), b3 + hstep, voffB);
            PG8_WAIT_V(6); PG8_BAR; PG8_MMA(1, 1, At, B1); PG8_BAR;
            }
        }
        if constexpr (ALIGN_EPI) { if (wr == 0) PG8_BAR; }
        if constexpr (!Epi::AFTER_DRAIN) { E(acc, cur, wr, wc, fr, fq); S.done(cur); }
        if (!has_next) break;
#pragma unroll
        for (int a = 0; a < 2; ++a)
#pragma unroll
            for (int b = 0; b < 2; ++b)
#pragma unroll
                for (int m = 0; m < 4; ++m)
#pragma unroll
                    for (int n = 0; n < 2; ++n) acc[a][b][m][n] = (f32x4){0.f, 0.f, 0.f, 0.f};
        cur = nxt; cA = nA; cB = nB; ++ui;
        if constexpr (ALIGN_EPI) { if (wr == 1) PG8_BAR; }
    }
    PG8_WAIT_V(0);
    if constexpr (!ALIGN_EPI) { if (wr == 0) PG8_BAR; }
    PG8_BAR;
    if constexpr (Epi::AFTER_DRAIN) { E.fused(acc, cur, wr, wc, fr, fq, lds, wid, lane); S.done(cur); }
#undef PG8_SA
#undef PG8_SB
#undef PG8_STAGE
#undef PG8_LDA
#undef PG8_LDB
#undef PG8_MMA
#undef PG8_WAIT_V
#undef PG8_WAIT_L
#undef PG8_BAR
#undef PG8_SCHED
}
}
#ifndef LATE_PRIO
#define LATE_PRIO 1
#endif
#ifndef SM_SUM_MFMA
#define SM_SUM_MFMA 0
#endif
#ifndef DSTAMP
#define DSTAMP 0
#define DSTAMP_W 0
#endif
#ifndef DSTAMP_MUL
#define DSTAMP_MUL 1
#endif
#define DST_STAMP(t) do { __builtin_amdgcn_sched_barrier(0); asm volatile("s_memrealtime %0\n\ts_waitcnt lgkmcnt(0)" : "=s"(t) :: "memory"); __builtin_amdgcn_sched_barrier(0); } while (0)
#define DST_A(n) do { if constexpr (DSTAMP == (n)) DST_STAMP(dta_); } while (0)
#define DST_B(n) do { if constexpr (DSTAMP == (n)) { unsigned long long dtb_; DST_STAMP(dtb_); dacc_ += dtb_ - dta_; } } while (0)
namespace att {
typedef unsigned short bf16_t;
using bf16x8 = __attribute__((ext_vector_type(8))) short;
using s16x4  = __attribute__((ext_vector_type(4))) short;
using f32x16 = __attribute__((ext_vector_type(16))) float;
using f32x4  = __attribute__((ext_vector_type(4))) float;
using u32x4  = __attribute__((ext_vector_type(4))) unsigned;
#define KSWZ(row, colB) ((row) * 256 + ((colB) ^ (((row) & 15) << 4)))
#define ATT_SBAR() __builtin_amdgcn_sched_barrier(0)
constexpr int SHM_KV = 16384;
__device__ __forceinline__ int crow(int r, int hi) { return (r & 3) + 8 * (r >> 2) + 4 * hi; }
__device__ __forceinline__ unsigned cvtpk(float lo, float hi) { unsigned r; asm volatile("v_cvt_pk_bf16_f32 %0, %1, %2" : "=v"(r) : "v"(lo), "v"(hi)); return r; }
template <int SC1E9> __device__ __forceinline__ void partialSM(f32x16& p0, f32x16& p1, float& m_reg, float& mn, float& alpha) {
  constexpr float SCALE = (float)(SC1E9 * 1e-9), THR = 8.f, C = SCALE * 1.4426950408889634f;
  float pmax = p0[0];
#pragma unroll
  for (int r = 1; r < 16; ++r) pmax = fmaxf(pmax, p0[r]);
#pragma unroll
  for (int r = 0; r < 16; ++r) pmax = fmaxf(pmax, p1[r]);
  { auto rr = __builtin_amdgcn_permlane32_swap(__float_as_uint(pmax), __float_as_uint(pmax), false, false);
    pmax = fmaxf(__uint_as_float(rr[0]), __uint_as_float(rr[1])); }
  if (__builtin_expect(__all(pmax - m_reg <= THR / SCALE), 1)) { mn = m_reg; alpha = 1.f; }
  else { mn = fmaxf(m_reg, pmax); alpha = __builtin_amdgcn_exp2f((m_reg - mn) * C); m_reg = mn; }
  const float mnC = -mn * C;
#pragma unroll
  for (int r = 0; r < 16; ++r) p0[r] = fmaf(p0[r], C, mnC);
#pragma unroll
  for (int r = 0; r < 16; ++r) p1[r] = fmaf(p1[r], C, mnC);
#pragma unroll
  for (int r = 0; r < 16; ++r) p0[r] = __builtin_amdgcn_exp2f(p0[r]);
}
__device__ __forceinline__ void packP(const f32x16& p0, const f32x16& p1, bf16x8& pa0, bf16x8& pa1, bf16x8& pa2, bf16x8& pa3) {
#define PK4(P, BASE, OUT) do { unsigned a0 = cvtpk(P[BASE + 0], P[BASE + 1]), a1 = cvtpk(P[BASE + 2], P[BASE + 3]);   \
    unsigned b0 = cvtpk(P[BASE + 4], P[BASE + 5]), b1 = cvtpk(P[BASE + 6], P[BASE + 7]);                              \
    auto r0 = __builtin_amdgcn_permlane32_swap(a0, b0, false, false); auto r1 = __builtin_amdgcn_permlane32_swap(a1, b1, false, false); \
    u32x4 w = {r0[0], r1[0], r0[1], r1[1]}; OUT = *reinterpret_cast<bf16x8*>(&w); } while (0)
  PK4(p0, 0, pa0); PK4(p0, 8, pa1); PK4(p1, 0, pa2); PK4(p1, 8, pa3);
#undef PK4
}
__device__ __forceinline__ void finishSM(f32x16& p0, f32x16& p1, float alpha, float& l_reg, bf16x8& pa0, bf16x8& pa1, bf16x8& pa2, bf16x8& pa3) {
#pragma unroll
  for (int r = 0; r < 16; ++r) p1[r] = __builtin_amdgcn_exp2f(p1[r]);
  packP(p0, p1, pa0, pa1, pa2, pa3);
#if SM_SUM_MFMA
  { const u32x4 onesw = {0x3F803F80u, 0x3F803F80u, 0x3F803F80u, 0x3F803F80u}; const bf16x8 ones = *reinterpret_cast<const bf16x8*>(&onesw);
    f32x16 ls = __builtin_amdgcn_mfma_f32_32x32x16_bf16(ones, pa0, f32x16{}, 0, 0, 0);
    ls = __builtin_amdgcn_mfma_f32_32x32x16_bf16(ones, pa1, ls, 0, 0, 0);
    ls = __builtin_amdgcn_mfma_f32_32x32x16_bf16(ones, pa2, ls, 0, 0, 0);
    ls = __builtin_amdgcn_mfma_f32_32x32x16_bf16(ones, pa3, ls, 0, 0, 0);
    l_reg = l_reg * alpha + ls[0]; }
#else
  float ps = 0;
#pragma unroll
  for (int r = 0; r < 16; ++r) ps += p0[r];
#pragma unroll
  for (int r = 0; r < 16; ++r) ps += p1[r];
  { auto rr = __builtin_amdgcn_permlane32_swap(__float_as_uint(ps), __float_as_uint(ps), false, false);
    ps = __uint_as_float(rr[0]) + __uint_as_float(rr[1]); }
  l_reg = l_reg * alpha + ps;
#endif
}
template <int NG = 4>
__device__ __forceinline__ void qkt(f32x16& p0, f32x16& p1, const char* Ks, const bf16x8* qr, int r32, int hi) {
  p0 = f32x16{}; p1 = f32x16{};
  constexpr int DG = 8 / NG;
  bf16x8 kb[2][DG][2];
#define QKT_LOADG(bf, g) do { _Pragma("unroll") for (int d = 0; d < DG; ++d) { const int cb = ((DG * (g) + d) * 16 + hi * 8) * 2; \
    kb[bf][d][0] = *reinterpret_cast<const bf16x8*>(Ks + KSWZ(r32, cb)); kb[bf][d][1] = *reinterpret_cast<const bf16x8*>(Ks + KSWZ(32 + r32, cb)); } } while (0)
  QKT_LOADG(0, 0);
#pragma unroll
  for (int g = 0; g < NG; ++g) {
    if (g + 1 < NG) QKT_LOADG((g + 1) & 1, g + 1);
    ATT_SBAR();
#pragma unroll
    for (int d = 0; d < DG; ++d) {
      p0 = __builtin_amdgcn_mfma_f32_32x32x16_bf16(kb[g & 1][d][0], qr[DG * g + d], p0, 0, 0, 0);
      p1 = __builtin_amdgcn_mfma_f32_32x32x16_bf16(kb[g & 1][d][1], qr[DG * g + d], p1, 0, 0, 0); }
    ATT_SBAR();
  }
#undef QKT_LOADG
}
__device__ __forceinline__ void qkt_rope(f32x16& p0, f32x16& p1, const char* Kr, const bf16x8* qr, int r32, int hi) {
#pragma unroll
  for (int d0 = 0; d0 < 4; ++d0) { const int cb = ((d0 * 16 + hi * 8) * 2) ^ (((r32 >> 1) & 7) << 4);
    const bf16x8 b0 = *reinterpret_cast<const bf16x8*>(Kr + r32 * 128 + cb);
    const bf16x8 b1 = *reinterpret_cast<const bf16x8*>(Kr + (32 + r32) * 128 + cb);
    p0 = __builtin_amdgcn_mfma_f32_32x32x16_bf16(b0, qr[d0], p0, 0, 0, 0);
    p1 = __builtin_amdgcn_mfma_f32_32x32x16_bf16(b1, qr[d0], p1, 0, 0, 0); }
}
__device__ __forceinline__ int v_st(int k, int c) { const int kk = (k & ~0xC) | ((k & 4) << 1) | ((k & 8) >> 1); return ((kk >> 3) * 4 + (c >> 5)) * 512 + ((kk & 7) * 32 + (c & 31)) * 2; }
__device__ __forceinline__ int v_rd_base(int lane) { return ((lane & 3) << 3) | (((lane >> 2) & 3) << 6) | (((lane >> 4) & 1) << 5) | (((lane >> 5) & 1) << 8); }
constexpr int v_rd_off(int d0, int ks, int half) { return d0 * 512 + ks * 4096 + half * 2048; }
template <int OFF> __device__ __forceinline__ s16x4 tr_read(int vb) {
  s16x4 r; asm volatile("ds_read_b64_tr_b16 %0, %1 offset:%2" : "=&v"(r) : "v"(vb), "i"(OFF) : "memory"); return r;
}
template <int D0> __device__ __forceinline__ void pv_read(int vb, s16x4 (&f)[8]) {
  f[0] = tr_read<v_rd_off(D0, 0, 0)>(vb); f[1] = tr_read<v_rd_off(D0, 0, 1)>(vb); f[2] = tr_read<v_rd_off(D0, 1, 0)>(vb); f[3] = tr_read<v_rd_off(D0, 1, 1)>(vb);
  f[4] = tr_read<v_rd_off(D0, 2, 0)>(vb); f[5] = tr_read<v_rd_off(D0, 2, 1)>(vb); f[6] = tr_read<v_rd_off(D0, 3, 0)>(vb); f[7] = tr_read<v_rd_off(D0, 3, 1)>(vb);
}
__device__ __forceinline__ void pv_mma(f32x16& od, const s16x4 (&f)[8], bf16x8 pa0, bf16x8 pa1, bf16x8 pa2, bf16x8 pa3) {
#define PK(L, H) (bf16x8){L[0], L[1], L[2], L[3], H[0], H[1], H[2], H[3]}
  od = __builtin_amdgcn_mfma_f32_32x32x16_bf16(pa0, PK(f[0], f[1]), od, 0, 0, 0);
  od = __builtin_amdgcn_mfma_f32_32x32x16_bf16(pa1, PK(f[2], f[3]), od, 0, 0, 0);
  od = __builtin_amdgcn_mfma_f32_32x32x16_bf16(pa2, PK(f[4], f[5]), od, 0, 0, 0);
  od = __builtin_amdgcn_mfma_f32_32x32x16_bf16(pa3, PK(f[6], f[7]), od, 0, 0, 0);
#undef PK
}
template <bool PIPE = true>
__device__ __forceinline__ void pv_d0(f32x16* o, int vb, bf16x8 pa0, bf16x8 pa1, bf16x8 pa2, bf16x8 pa3) {
  if constexpr (!PIPE) {
    s16x4 f[8];
    pv_read<0>(vb, f); asm volatile("s_waitcnt lgkmcnt(0)" ::: "memory"); ATT_SBAR(); pv_mma(o[0], f, pa0, pa1, pa2, pa3); ATT_SBAR();
    pv_read<1>(vb, f); asm volatile("s_waitcnt lgkmcnt(0)" ::: "memory"); ATT_SBAR(); pv_mma(o[1], f, pa0, pa1, pa2, pa3); ATT_SBAR();
    pv_read<2>(vb, f); asm volatile("s_waitcnt lgkmcnt(0)" ::: "memory"); ATT_SBAR(); pv_mma(o[2], f, pa0, pa1, pa2, pa3); ATT_SBAR();
    pv_read<3>(vb, f); asm volatile("s_waitcnt lgkmcnt(0)" ::: "memory"); ATT_SBAR(); pv_mma(o[3], f, pa0, pa1, pa2, pa3);
    return;
  }
  s16x4 fa[8], fb[8];
  pv_read<0>(vb, fa);
  pv_read<1>(vb, fb); asm volatile("s_waitcnt lgkmcnt(8)" ::: "memory"); ATT_SBAR(); pv_mma(o[0], fa, pa0, pa1, pa2, pa3); ATT_SBAR();
  pv_read<2>(vb, fa); asm volatile("s_waitcnt lgkmcnt(8)" ::: "memory"); ATT_SBAR(); pv_mma(o[1], fb, pa0, pa1, pa2, pa3); ATT_SBAR();
  pv_read<3>(vb, fb); asm volatile("s_waitcnt lgkmcnt(8)" ::: "memory"); ATT_SBAR(); pv_mma(o[2], fa, pa0, pa1, pa2, pa3); ATT_SBAR();
  asm volatile("s_waitcnt lgkmcnt(0)" ::: "memory"); ATT_SBAR(); pv_mma(o[3], fb, pa0, pa1, pa2, pa3);
}
#define ATT_RESC(a) do { if (__any((a) < 1.f)) { if (hi == 0) al_l[r32] = (a); asm volatile("s_waitcnt lgkmcnt(0)" ::: "memory"); \
    _Pragma("unroll") for (int d = 0; d < 4; ++d) _Pragma("unroll") for (int r = 0; r < 16; ++r) o[d][r] *= al_l[crow(r, hi)]; } } while (0)
__device__ __forceinline__ void store_o(const f32x16* o, const float* rli, bf16_t* stg, bf16_t* Og  , int ldo, int lane, int r32, int hi) {
#pragma unroll
  for (int r = 0; r < 16; ++r) { const int orow = crow(r, hi);
#pragma unroll
    for (int d0 = 0; d0 < 4; ++d0) stg[orow * 128 + d0 * 32 + r32] = (bf16_t)(cvtpk(o[d0][r] * rli[r], 0.f) & 0xffffu); }
  asm volatile("s_waitcnt lgkmcnt(0)" ::: "memory");
#pragma unroll
  for (int i = 0; i < 8; ++i) { const int row = i * 4 + (lane >> 4), ch = lane & 15; const u32x4 v = *(const u32x4*)(stg + row * 128 + ch * 8); *(u32x4*)(Og + (size_t)row * ldo + ch * 8) = v; }
}

template <int MODE>
__device__ __forceinline__ void attn_sm_unit(int b, int hx, int ux, const bf16_t* __restrict__ Q, const bf16_t* __restrict__ QR, const bf16_t* __restrict__ K, const bf16_t* __restrict__ KR,
                                             const bf16_t* __restrict__ V, const unsigned long long* __restrict__ MASK, bf16_t* __restrict__ O, char* lds) {
  int tid = threadIdx.x; asm volatile("" : "+v"(tid));
  const int wid = __builtin_amdgcn_readfirstlane(tid >> 6), lane = tid & 63, r32 = lane & 31, hi = lane >> 5;
  constexpr int NQ = MODE ? 12 : 8, LDK = MODE ? 2048 : 512;
  char* V_lds = lds; char* K_lds = lds + 2 * SHM_KV; char* R_lds = lds + 4 * SHM_KV;
  float* ws = (float*)(lds + 4 * SHM_KV + 16384) + wid * 64; float* li_l = ws; float* al_l = ws + 32;
  const int head = MODE ? hx : 4 * hx + (wid >> 1);
  const long qrow0 = MODE ? (long)b * 4096 + 256 * ux + 32 * wid : (long)b * 4096 + 64 * ux + 32 * (wid & 1);
  const long qrow = qrow0 + r32;
  const int NT = MODE ? 4 * ux + 4 : ux + 1, NTw = MODE ? 4 * ux + (wid >> 1) + 1 : NT;
  bf16x8 qr[NQ];
  { const bf16_t* Qw = Q + qrow * 2048 + head * 128 + hi * 8;
#pragma unroll
    for (int d0 = 0; d0 < 8; ++d0) qr[d0] = *reinterpret_cast<const bf16x8*>(Qw + d0 * 16);
    if constexpr (MODE == 1) { const bf16_t* Qx = QR + qrow * 1024 + head * 64 + hi * 8;
#pragma unroll
      for (int d0 = 0; d0 < 4; ++d0) qr[8 + d0] = *reinterpret_cast<const bf16x8*>(Qx + d0 * 16); } }
  const int sr = tid >> 4, sc = (tid & 15) * 8, vst0 = v_st(sr, sc), vst1 = v_st(32 + sr, sc);
  const int rr_ = tid >> 3, rc = (tid & 7) * 8, rst = rr_ * 128 + ((rc * 2) ^ (((rr_ >> 1) & 7) << 4));
  const int vb0 = (int)(uintptr_t)V_lds + v_rd_base(lane);
  const bf16_t* Kh = K + (long)b * 4096 * LDK + hx * 128; const bf16_t* Vh = V + (long)b * 4096 * LDK + hx * 128; const bf16_t* Rh = MODE ? KR + (long)b * 4096 * 64 : nullptr;
  const unsigned long long* mrow = MODE ? nullptr : MASK + qrow * 64;
  bf16x8 vs0, vs1, ks0, ks1, rs0;
#define SLOAD(k0) do { vs0 = *reinterpret_cast<const bf16x8*>(Vh + (long)((k0) + sr) * LDK + sc); vs1 = *reinterpret_cast<const bf16x8*>(Vh + (long)((k0) + 32 + sr) * LDK + sc); \
    ks0 = *reinterpret_cast<const bf16x8*>(Kh + (long)((k0) + sr) * LDK + sc); ks1 = *reinterpret_cast<const bf16x8*>(Kh + (long)((k0) + 32 + sr) * LDK + sc); \
    if constexpr (MODE == 1) rs0 = *reinterpret_cast<const bf16x8*>(Rh + (long)((k0) + rr_) * 64 + rc); } while (0)
#define SWRITE(bf) do { *(bf16x8*)(V_lds + (bf) * SHM_KV + vst0) = vs0; *(bf16x8*)(V_lds + (bf) * SHM_KV + vst1) = vs1; \
    *(bf16x8*)(K_lds + (bf) * SHM_KV + KSWZ(sr, sc * 2)) = ks0; *(bf16x8*)(K_lds + (bf) * SHM_KV + KSWZ(32 + sr, sc * 2)) = ks1; \
    if constexpr (MODE == 1) *(bf16x8*)(R_lds + (bf) * 8192 + rst) = rs0; } while (0)
#define QK(P0, P1, t) do { qkt(P0, P1, K_lds + ((t) & 1) * SHM_KV, qr, r32, hi); \
    if constexpr (MODE == 1) qkt_rope(P0, P1, R_lds + ((t) & 1) * 8192, qr + 8, r32, hi); \
    if constexpr (MODE == 0) { const int mlo = (int)((unsigned)mwc >> (4 * hi)), mhi = (int)((unsigned)(mwc >> 32) >> (4 * hi)); \
      _Pragma("unroll") for (int r = 0; r < 16; ++r) { const int cb = (r & 3) + 8 * (r >> 2); \
        const unsigned t0_ = (unsigned)__builtin_amdgcn_sbfe(mlo, cb, 1), t1_ = (unsigned)__builtin_amdgcn_sbfe(mhi, cb, 1);     \
        P0[r] = __uint_as_float((__float_as_uint(P0[r]) & t0_) | (~t0_ & 0xFF800000u)); P1[r] = __uint_as_float((__float_as_uint(P1[r]) & t1_) | (~t1_ & 0xFF800000u)); } } } while (0)
  constexpr int SC9 = MODE ? 72168784 : 88388348;
  float m_reg = -1e30f, l_reg = 0.f; f32x16 o[4];
#pragma unroll
  for (int d = 0; d < 4; ++d) o[d] = f32x16{};
  f32x16 pA0, pA1, pB0, pB1; float mnA, mnB, alA = 1.f, alB = 1.f; bf16x8 pa0, pa1, pa2, pa3;
  unsigned long long mwc = 0ull, mwn = 0ull;
#define STEP(N0, N1, mnN, alN, E0, E1, alE, t) do { const bool an_ = (t) < NTw, ap_ = (t) - 1 < NTw; \
    if constexpr (MODE == 0) mwn = ((t) + 1 < NT) ? mrow[(t) + 1] : 0ull; \
    ATT_SBAR(); if (an_) { QK(N0, N1, t); } \
    if (ap_) { finishSM(E0, E1, alE, l_reg, pa0, pa1, pa2, pa3); } ATT_SBAR(); \
    if (ap_) { pv_d0(o, vb0 + (((t) - 1) & 1) * SHM_KV, pa0, pa1, pa2, pa3); } \
    if (an_) { partialSM<SC9>(N0, N1, m_reg, mnN, alN); } \
    __syncthreads(); \
    if ((t) + 1 < NT) SWRITE(((t) + 1) & 1); \
    if ((t) + 2 < NT) SLOAD(((t) + 2) * 64); \
    if (an_) { ATT_RESC(alN); } mwc = mwn; \
    __syncthreads(); } while (0)
  SLOAD(0); SWRITE(0); if (NT > 1) SLOAD(64);
  if constexpr (MODE == 0) { mwc = mrow[0]; }
  __syncthreads();
  QK(pA0, pA1, 0); partialSM<SC9>(pA0, pA1, m_reg, mnA, alA);
  if constexpr (MODE == 0) { mwc = (NT > 1) ? mrow[1] : 0ull; }
  if (NT > 1) { SWRITE(1); if (NT > 2) SLOAD(128); }
  __syncthreads();
  int t = 1;
  for (; t + 1 < NT; t += 2) {
    STEP(pB0, pB1, mnB, alB, pA0, pA1, alA, t);
    STEP(pA0, pA1, mnA, alA, pB0, pB1, alB, t + 1);
  }
  if (t < NT) {
    STEP(pB0, pB1, mnB, alB, pA0, pA1, alA, t);
    if (t < NTw) { finishSM(pB0, pB1, alB, l_reg, pa0, pa1, pa2, pa3); ATT_SBAR(); pv_d0(o, vb0 + (t & 1) * SHM_KV, pa0, pa1, pa2, pa3); }
  } else {
    if (NT - 1 < NTw) { finishSM(pA0, pA1, alA, l_reg, pa0, pa1, pa2, pa3); ATT_SBAR(); pv_d0(o, vb0 + ((NT - 1) & 1) * SHM_KV, pa0, pa1, pa2, pa3); }
  }
  if (hi == 0) li_l[r32] = l_reg; asm volatile("s_waitcnt lgkmcnt(0)" ::: "memory");
  float rli[16];
#pragma unroll
  for (int r = 0; r < 16; ++r) rli[r] = __builtin_amdgcn_rcpf(li_l[crow(r, hi)]);
  __syncthreads();
  store_o(o, rli, (bf16_t*)(lds + wid * 8192), O + qrow0 * 2048 + head * 128, 2048, lane, r32, hi);
  __syncthreads();
#undef SLOAD
#undef SWRITE
#undef QK
#undef STEP
}

template <int VAR = 0>
__device__ __forceinline__ void dsa_attn_unit(int b, int g, int c, const bf16_t* __restrict__ Q, const bf16_t* __restrict__ K, const bf16_t* __restrict__ V,
                                              const unsigned long long* __restrict__ MASK, bf16_t* __restrict__ O, char* lds, unsigned* dstamp = nullptr) {
  int tid = threadIdx.x; asm volatile("" : "+v"(tid));
  const int wid = __builtin_amdgcn_readfirstlane(tid >> 6), lane = tid & 63, r32 = lane & 31, hi = lane >> 5;
  unsigned long long dta_ = 0, dacc_ = 0; (void)dta_;
  char* V_lds = lds; char* K_lds = lds + 3 * SHM_KV;
  float* ws = (float*)(lds + 6 * SHM_KV) + wid * 64; float* li_l = ws; float* al_l = ws + 32;
  const bool late = wid >= 4;
  const int head = 4 * g + (wid >> 1);
  const long qrow0 = (long)b * 4096 + 64 * c + 32 * (wid & 1), qrow = qrow0 + r32;
  bf16x8 qr[8];
  { const bf16_t* Qw = Q + qrow * 2048 + head * 128 + hi * 8;
#pragma unroll
    for (int d0 = 0; d0 < 8; ++d0) qr[d0] = *reinterpret_cast<const bf16x8*>(Qw + d0 * 16); }
  const int sr = tid >> 4, sc = (tid & 15) * 8, vst0 = v_st(sr, sc), vst1 = v_st(32 + sr, sc);
  const int vb0 = (int)(uintptr_t)V_lds + v_rd_base(lane);
  const bf16_t* Kh = K + (long)b * 4096 * 512 + g * 128; const bf16_t* Vh = V + (long)b * 4096 * 512 + g * 128;
  bf16x8 vs0, vs1, ks0, ks1;
#define SLOAD(k0) do { vs0 = *reinterpret_cast<const bf16x8*>(Vh + (long)((k0) + sr) * 512 + sc); vs1 = *reinterpret_cast<const bf16x8*>(Vh + (long)((k0) + 32 + sr) * 512 + sc); \
    ks0 = *reinterpret_cast<const bf16x8*>(Kh + (long)((k0) + sr) * 512 + sc); ks1 = *reinterpret_cast<const bf16x8*>(Kh + (long)((k0) + 32 + sr) * 512 + sc); } while (0)
#define SWRITE(bo) do { *(bf16x8*)(V_lds + (bo) + vst0) = vs0; *(bf16x8*)(V_lds + (bo) + vst1) = vs1; \
    *(bf16x8*)(K_lds + (bo) + KSWZ(sr, sc * 2)) = ks0; *(bf16x8*)(K_lds + (bo) + KSWZ(32 + sr, sc * 2)) = ks1; } while (0)
#define QKM() do { if constexpr (VAR < 4) qkt(p0, p1, K_lds + cur, qr, r32, hi);     \
    { const int mlo = (int)((unsigned)mw >> (4 * hi)), mhi = (int)((unsigned)(mw >> 32) >> (4 * hi)); \
      _Pragma("unroll") for (int r = 0; r < 16; ++r) { const int cb = (r & 3) + 8 * (r >> 2); \
        const unsigned t0_ = (unsigned)__builtin_amdgcn_sbfe(mlo, cb, 1), t1_ = (unsigned)__builtin_amdgcn_sbfe(mhi, cb, 1); \
        p0[r] = __uint_as_float((__float_as_uint(p0[r]) & t0_) | (~t0_ & 0xFF800000u)); p1[r] = __uint_as_float((__float_as_uint(p1[r]) & t1_) | (~t1_ & 0xFF800000u)); } } } while (0)
#define SMPV(vbo) do { if constexpr (VAR < 3) { float mn, alpha; partialSM<88388348>(p0, p1, m_reg, mn, alpha); \
    bf16x8 pa0, pa1, pa2, pa3; finishSM(p0, p1, alpha, l_reg, pa0, pa1, pa2, pa3); ATT_RESC(alpha); \
    if constexpr (VAR < 2) pv_d0(o, vb0 + (vbo), pa0, pa1, pa2, pa3); else { asm volatile("" :: "v"(pa0), "v"(pa1), "v"(pa2), "v"(pa3)); } } else { asm volatile("" : "+v"(p0), "+v"(p1)); } } while (0)
  const int NT = c + 1;
  float m_reg = -1e30f, l_reg = 0.f; f32x16 o[4];
#pragma unroll
  for (int d = 0; d < 4; ++d) o[d] = f32x16{};
  const unsigned long long* mrow = MASK + qrow * 64;
  SLOAD(0); SWRITE(0); if (NT > 1) SLOAD(64);
  unsigned long long mw = mrow[0];
  f32x16 p0 = f32x16{}, p1 = f32x16{};
  int prv = 2 * SHM_KV, cur = 0, nxt = SHM_KV;
#define TILE_HEAD() __syncthreads(); if (j + 1 < NT) SWRITE(nxt); if (j + 2 < NT) SLOAD((j + 2) * 64); const unsigned long long mw_next = (j + 1 < NT) ? mrow[j + 1] : 0ull
#define TILE_TAIL() mw = mw_next; prv = cur; cur = nxt; nxt = (nxt == 2 * SHM_KV) ? 0 : nxt + SHM_KV
  if (!late) {
#if DSTAMP
    DST_A(5);
    for (int j = 0; j <= NT; ++j) {
      DST_A(1); __syncthreads(); DST_B(1);
      DST_A(6); if (j + 1 < NT) SWRITE(nxt); if (j + 2 < NT) SLOAD((j + 2) * 64); const unsigned long long mw_next = (j + 1 < NT) ? mrow[j + 1] : 0ull; DST_B(6);
      if (j < NT) { DST_A(2); QKM(); DST_B(2);
        DST_A(3); float mn, alpha; partialSM<88388348>(p0, p1, m_reg, mn, alpha); bf16x8 pa0, pa1, pa2, pa3; finishSM(p0, p1, alpha, l_reg, pa0, pa1, pa2, pa3); ATT_RESC(alpha); DST_B(3);
        DST_A(4); pv_d0(o, vb0 + cur, pa0, pa1, pa2, pa3); DST_B(4); }
      TILE_TAIL(); }
    DST_B(5);
#else
    for (int j = 0; j <= NT; ++j) { TILE_HEAD(); if (j < NT) { QKM(); SMPV(cur); } TILE_TAIL(); }
#endif
  } else {
    __builtin_amdgcn_s_setprio(LATE_PRIO);
#if DSTAMP
    DST_A(5);
    for (int j = 0; j <= NT; ++j) {
      DST_A(1); __syncthreads(); DST_B(1);
      DST_A(6); if (j + 1 < NT) SWRITE(nxt); if (j + 2 < NT) SLOAD((j + 2) * 64); const unsigned long long mw_next = (j + 1 < NT) ? mrow[j + 1] : 0ull; DST_B(6);
      if (j > 0) {
        DST_A(3); float mn, alpha; partialSM<88388348>(p0, p1, m_reg, mn, alpha); bf16x8 pa0, pa1, pa2, pa3; finishSM(p0, p1, alpha, l_reg, pa0, pa1, pa2, pa3); ATT_RESC(alpha); DST_B(3);
        DST_A(4); pv_d0(o, vb0 + prv, pa0, pa1, pa2, pa3); DST_B(4); }
      if (j < NT) { DST_A(2); QKM(); DST_B(2); }
      TILE_TAIL(); }
    DST_B(5);
#else
    for (int j = 0; j <= NT; ++j) { TILE_HEAD(); if (j > 0) SMPV(prv); if (j < NT) QKM(); TILE_TAIL(); }
#endif
    __builtin_amdgcn_s_setprio(0);
  }
#undef TILE_HEAD
#undef TILE_TAIL
  if (hi == 0) li_l[r32] = l_reg; asm volatile("s_waitcnt lgkmcnt(0)" ::: "memory");
  float rli[16];
#pragma unroll
  for (int r = 0; r < 16; ++r) rli[r] = __builtin_amdgcn_rcpf(li_l[crow(r, hi)]);
  __syncthreads();
  if constexpr (DSTAMP != 0) { if (dstamp && blockIdx.x == 0 && wid == DSTAMP_W && lane == 0) atomicAdd(dstamp, (unsigned)dacc_); }
  if constexpr (VAR == 0) store_o(o, rli, (bf16_t*)(lds + wid * 8192), O + qrow0 * 2048 + head * 128, 2048, lane, r32, hi); else { asm volatile("" :: "v"(o[0]), "v"(o[1]), "v"(o[2]), "v"(o[3]), "v"(rli[0]), "v"(l_reg), "v"(m_reg)); }
  __syncthreads();
#undef SLOAD
#undef SWRITE
#undef QKM
#undef SMPV
}

__device__ __forceinline__ void mla_attn_unit(int b, int h, int qb, const bf16_t* __restrict__ QN, const bf16_t* __restrict__ QR, const bf16_t* __restrict__ KN, const bf16_t* __restrict__ KR,
                                              const bf16_t* __restrict__ V, bf16_t* __restrict__ O, char* lds) {
  int tid = threadIdx.x; asm volatile("" : "+v"(tid));
  const int wid = __builtin_amdgcn_readfirstlane(tid >> 6), lane = tid & 63, r32 = lane & 31, hi = lane >> 5;
  char* V_lds = lds; char* K_lds = lds + 3 * SHM_KV; char* R_lds = lds + 6 * SHM_KV;
  float* ws = (float*)(lds + 6 * SHM_KV + 3 * 8192) + wid * 64; float* li_l = ws; float* al_l = ws + 32;
  const bool late = wid >= 4;
  const long qrow0 = (long)b * 4096 + 256 * qb + 32 * wid, qrow = qrow0 + r32;
  bf16x8 qr[12];
  { const bf16_t* Qw = QN + qrow * 2048 + h * 128 + hi * 8;
#pragma unroll
    for (int d0 = 0; d0 < 8; ++d0) qr[d0] = *reinterpret_cast<const bf16x8*>(Qw + d0 * 16);
    const bf16_t* Qx = QR + qrow * 1024 + h * 64 + hi * 8;
#pragma unroll
    for (int d0 = 0; d0 < 4; ++d0) qr[8 + d0] = *reinterpret_cast<const bf16x8*>(Qx + d0 * 16); }
  const int sr = tid >> 4, sc = (tid & 15) * 8, vst0 = v_st(sr, sc), vst1 = v_st(32 + sr, sc);
  const int rr_ = tid >> 3, rc = (tid & 7) * 8, rst = rr_ * 128 + ((rc * 2) ^ (((rr_ >> 1) & 7) << 4));
  const int vb0 = (int)(uintptr_t)V_lds + v_rd_base(lane);
  const bf16_t* Kh = KN + (long)b * 4096 * 2048 + h * 128; const bf16_t* Vh = V + (long)b * 4096 * 2048 + h * 128; const bf16_t* Rh = KR + (long)b * 4096 * 64;
  bf16x8 vs0, vs1, ks0, ks1, rs0;
#define SLOAD(k0) do { vs0 = *reinterpret_cast<const bf16x8*>(Vh + (long)((k0) + sr) * 2048 + sc); vs1 = *reinterpret_cast<const bf16x8*>(Vh + (long)((k0) + 32 + sr) * 2048 + sc); \
    ks0 = *reinterpret_cast<const bf16x8*>(Kh + (long)((k0) + sr) * 2048 + sc); ks1 = *reinterpret_cast<const bf16x8*>(Kh + (long)((k0) + 32 + sr) * 2048 + sc); \
    rs0 = *reinterpret_cast<const bf16x8*>(Rh + (long)((k0) + rr_) * 64 + rc); } while (0)
#define SWRITE(bo) do { *(bf16x8*)(V_lds + (bo) + vst0) = vs0; *(bf16x8*)(V_lds + (bo) + vst1) = vs1; \
    *(bf16x8*)(K_lds + (bo) + KSWZ(sr, sc * 2)) = ks0; *(bf16x8*)(K_lds + (bo) + KSWZ(32 + sr, sc * 2)) = ks1; \
    *(bf16x8*)(R_lds + ((bo) >> 1) + rst) = rs0; } while (0)
#define QKM() do { qkt<8>(p0, p1, K_lds + cur, qr, r32, hi); qkt_rope(p0, p1, R_lds + (cur >> 1), qr + 8, r32, hi); } while (0)
#define SMPV(vbo) do { float mn, alpha; partialSM<72168784>(p0, p1, m_reg, mn, alpha); \
    bf16x8 pa0, pa1, pa2, pa3; finishSM(p0, p1, alpha, l_reg, pa0, pa1, pa2, pa3); ATT_RESC(alpha); \
    pv_d0<false>(o, vb0 + (vbo), pa0, pa1, pa2, pa3); } while (0)
  const int NT = 4 * qb + 4, NTw = 4 * qb + (wid >> 1) + 1;
  float m_reg = -1e30f, l_reg = 0.f; f32x16 o[4];
#pragma unroll
  for (int d = 0; d < 4; ++d) o[d] = f32x16{};
  SLOAD(0); SWRITE(0); SLOAD(64);
  f32x16 p0 = f32x16{}, p1 = f32x16{};
  int prv = 2 * SHM_KV, cur = 0, nxt = SHM_KV;
#define TILE_HEAD() __syncthreads(); if (j + 1 < NT) SWRITE(nxt); if (j + 2 < NT) SLOAD((j + 2) * 64)
#define TILE_TAIL() prv = cur; cur = nxt; nxt = (nxt == 2 * SHM_KV) ? 0 : nxt + SHM_KV
  if (!late) {
    for (int j = 0; j <= NT; ++j) { TILE_HEAD(); if (j < NTw) { QKM(); SMPV(cur); } TILE_TAIL(); }
  } else {
    __builtin_amdgcn_s_setprio(LATE_PRIO);
    for (int j = 0; j <= NT; ++j) { TILE_HEAD(); if (j > 0 && j - 1 < NTw) SMPV(prv); if (j < NTw) QKM(); TILE_TAIL(); }
    __builtin_amdgcn_s_setprio(0);
  }
#undef TILE_HEAD
#undef TILE_TAIL
  if (hi == 0) li_l[r32] = l_reg; asm volatile("s_waitcnt lgkmcnt(0)" ::: "memory");
  float rli[16];
#pragma unroll
  for (int r = 0; r < 16; ++r) rli[r] = __builtin_amdgcn_rcpf(li_l[crow(r, hi)]);
  __syncthreads();
  store_o(o, rli, (bf16_t*)(lds + wid * 8192), O + qrow0 * 2048 + h * 128, 2048, lane, r32, hi);
  __syncthreads();
#undef SLOAD
#undef SWRITE
#undef QKM
#undef SMPV
}

__device__ __forceinline__ void sb_attn_unit(int b, int h, int qb, const bf16_t* __restrict__ Q, const bf16_t* __restrict__ K, const bf16_t* __restrict__ V, bf16_t* __restrict__ O, char* lds, unsigned* diag = nullptr) {
  int tid = threadIdx.x; asm volatile("" : "+v"(tid));
  const int wid = __builtin_amdgcn_readfirstlane(tid >> 6), lane = tid & 63, r32 = lane & 31, hi = lane >> 5;
  char* V_lds = lds; char* K_lds = lds + 2 * SHM_KV;
  volatile __attribute__((address_space(3))) int* fl = (volatile __attribute__((address_space(3))) int*)(lds + 4 * SHM_KV + 2048);
  const int tw0 = 256 * qb + 32 * wid, t = tw0 + r32;
  const long qrow0 = (long)b * 4096 + tw0, qrow = qrow0 + r32;
  bf16x8 qr[8];
  { const bf16_t* Qw = Q + qrow * 2048 + h * 128 + hi * 8;
#pragma unroll
    for (int d0 = 0; d0 < 8; ++d0) qr[d0] = *reinterpret_cast<const bf16x8*>(Qw + d0 * 16); }
  constexpr float C = 0.08838834764831845f * 1.4426950408889634f;
#pragma unroll
  for (int d0 = 0; d0 < 8; ++d0) { u32x4 w = *reinterpret_cast<u32x4*>(&qr[d0]);
#pragma unroll
    for (int k = 0; k < 4; ++k) w[k] = cvtpk(__uint_as_float(w[k] << 16) * C, __uint_as_float(w[k] & 0xffff0000u) * C);
    qr[d0] = *reinterpret_cast<bf16x8*>(&w); }
  const int sr = tid >> 4, sc = (tid & 15) * 8, vst0 = v_st(sr, sc), vst1 = v_st(32 + sr, sc);
  const int vb0 = (int)(uintptr_t)V_lds + v_rd_base(lane);
  const bf16_t* Kh = K + (long)b * 4096 * 2048 + h * 128; const bf16_t* Vh = V + (long)b * 4096 * 2048 + h * 128;
  bf16x8 vs0, vs1, ks0, ks1;
#define SLOAD(k0) do { vs0 = *reinterpret_cast<const bf16x8*>(Vh + (long)((k0) + sr) * 2048 + sc); vs1 = *reinterpret_cast<const bf16x8*>(Vh + (long)((k0) + 32 + sr) * 2048 + sc); \
    ks0 = *reinterpret_cast<const bf16x8*>(Kh + (long)((k0) + sr) * 2048 + sc); ks1 = *reinterpret_cast<const bf16x8*>(Kh + (long)((k0) + 32 + sr) * 2048 + sc); } while (0)
#define SWRITE(bf) do { *(bf16x8*)(V_lds + (bf) * SHM_KV + vst0) = vs0; *(bf16x8*)(V_lds + (bf) * SHM_KV + vst1) = vs1; \
    *(bf16x8*)(K_lds + (bf) * SHM_KV + KSWZ(sr, sc * 2)) = ks0; *(bf16x8*)(K_lds + (bf) * SHM_KV + KSWZ(32 + sr, sc * 2)) = ks1; } while (0)
  const int NT = 4 * qb + 4;
  float Rp = 1.f; bool wdone = false; f32x16 o[4];
#pragma unroll
  for (int d = 0; d < 4; ++d) o[d] = f32x16{};
  SLOAD((NT - 1) * 64); SWRITE(0); SLOAD((NT - 2) * 64);
  int j = 0;
  for (; j < NT; ++j) {
    __syncthreads();
    if (j > 0) { int all = 1;
#pragma unroll
      for (int w = 0; w < 8; ++w) all &= fl[((j - 1) & 1) * 8 + w];
      if (all) break; }
    if (j + 1 < NT) SWRITE((j + 1) & 1);
    if (j + 2 < NT) SLOAD((NT - 3 - j) * 64);
    const int T = NT - 1 - j;
    if (64 * T <= tw0 + 30 && !wdone) {
      f32x16 p0, p1; qkt(p0, p1, K_lds + (j & 1) * SHM_KV, qr, r32, hi);
      f32x16 k0, k1;
#define SB_SIG(P, K) do { const float e_ = __builtin_amdgcn_exp2f(-P), r_ = __builtin_amdgcn_rcpf(1.f + e_); P = r_; K = 1.f - r_; } while (0)
      if (64 * T + 63 >= tw0) {
#pragma unroll
        for (int r = 0; r < 16; ++r) { SB_SIG(p0[r], k0[r]); SB_SIG(p1[r], k1[r]);
          if (64 * T + crow(r, hi) >= t) { p0[r] = 0.f; k0[r] = 1.f; }
          if (64 * T + 32 + crow(r, hi) >= t) { p1[r] = 0.f; k1[r] = 1.f; } }
      } else {
#pragma unroll
        for (int r = 0; r < 16; ++r) { SB_SIG(p0[r], k0[r]); SB_SIG(p1[r], k1[r]); }
      }
#undef SB_SIG
      float GP[16];
#pragma unroll
      for (int q = 0; q < 4; ++q) {
        const float g0 = (k0[4 * q] * k0[4 * q + 1]) * (k0[4 * q + 2] * k0[4 * q + 3]), g1 = (k1[4 * q] * k1[4 * q + 1]) * (k1[4 * q + 2] * k1[4 * q + 3]);
        auto x0 = __builtin_amdgcn_permlane32_swap(__float_as_uint(g0), __float_as_uint(g0), false, false);
        auto x1 = __builtin_amdgcn_permlane32_swap(__float_as_uint(g1), __float_as_uint(g1), false, false);
        GP[2 * q] = __uint_as_float(x0[0]); GP[2 * q + 1] = __uint_as_float(x0[1]); GP[8 + 2 * q] = __uint_as_float(x1[0]); GP[8 + 2 * q + 1] = __uint_as_float(x1[1]);
      }
      float SG[16]; SG[15] = 1.f;
#pragma unroll
      for (int g = 14; g >= 0; --g) SG[g] = SG[g + 1] * GP[g + 1];
      const float tileprod = SG[0] * GP[0];
#pragma unroll
      for (int q = 0; q < 4; ++q) {
        { const float base = Rp * (hi ? SG[2 * q + 1] : SG[2 * q]); const float w2 = k0[4 * q + 3], w1 = w2 * k0[4 * q + 2], w0 = w1 * k0[4 * q + 1];
          p0[4 * q + 3] *= base; p0[4 * q + 2] *= base * w2; p0[4 * q + 1] *= base * w1; p0[4 * q] *= base * w0; }
        { const float base = Rp * (hi ? SG[8 + 2 * q + 1] : SG[8 + 2 * q]); const float w2 = k1[4 * q + 3], w1 = w2 * k1[4 * q + 2], w0 = w1 * k1[4 * q + 1];
          p1[4 * q + 3] *= base; p1[4 * q + 2] *= base * w2; p1[4 * q + 1] *= base * w1; p1[4 * q] *= base * w0; }
      }
      Rp *= tileprod;
      bf16x8 pa0, pa1, pa2, pa3; packP(p0, p1, pa0, pa1, pa2, pa3);
      pv_d0(o, vb0 + (j & 1) * SHM_KV, pa0, pa1, pa2, pa3);
      wdone = __all(Rp == 0.f);
    }
    if (lane == 0) fl[(j & 1) * 8 + wid] = wdone ? 1 : 0;
  }
  if (diag && tid == 0) atomicAdd(diag, (unsigned)j);
  float rli[16];
#pragma unroll
  for (int r = 0; r < 16; ++r) rli[r] = 1.f;
  __syncthreads();
  store_o(o, rli, (bf16_t*)(lds + wid * 8192), O + qrow0 * 2048 + h * 128, 2048, lane, r32, hi);
  __syncthreads();
#undef SLOAD
#undef SWRITE
}

__device__ __forceinline__ void idx_unit(int b, int qq, const bf16_t* __restrict__ IQ, const bf16_t* __restrict__ IK, const float* __restrict__ IW, float* __restrict__ SC, char* lds) {
  int tid = threadIdx.x; asm volatile("" : "+v"(tid));
  const int wid = __builtin_amdgcn_readfirstlane(tid >> 6), lane = tid & 63, r32 = lane & 31, hi = lane >> 5;
  char* K_lds = lds;
  const int c = qq >> 1, NT = c + 1;
  const long t0 = (long)b * 4096 + 32 * qq + 4 * wid;
  bf16x8 a[2][8]; float wgt[2][16];
#pragma unroll
  for (int rt = 0; rt < 2; ++rt) {
    const long qa = t0 + 2 * rt + ((r32 >> 2) & 1); const int ha = (r32 & 3) + 4 * (r32 >> 3);
    const bf16_t* p = IQ + qa * 2048 + ha * 128 + hi * 8;
#pragma unroll
    for (int ks = 0; ks < 8; ++ks) a[rt][ks] = *reinterpret_cast<const bf16x8*>(p + ks * 16);
    const float* wp = IW + (t0 + 2 * rt + hi) * 16;
#pragma unroll
    for (int i4 = 0; i4 < 4; ++i4) { const f32x4 w4 = *(const f32x4*)(wp + 4 * i4); wgt[rt][4 * i4] = w4[0]; wgt[rt][4 * i4 + 1] = w4[1]; wgt[rt][4 * i4 + 2] = w4[2]; wgt[rt][4 * i4 + 3] = w4[3]; }
  }
  const int sr = tid >> 4, sc = (tid & 15) * 8;
  const bf16_t* Kb = IK + (long)b * 4096 * 128;
  bf16x8 ks0, ks1;
#define SLOAD(k0) do { ks0 = *reinterpret_cast<const bf16x8*>(Kb + (long)((k0) + sr) * 128 + sc); ks1 = *reinterpret_cast<const bf16x8*>(Kb + (long)((k0) + 32 + sr) * 128 + sc); } while (0)
#define SWRITE(bf) do { *(bf16x8*)(K_lds + (bf) * SHM_KV + KSWZ(sr, sc * 2)) = ks0; *(bf16x8*)(K_lds + (bf) * SHM_KV + KSWZ(32 + sr, sc * 2)) = ks1; } while (0)
  SLOAD(0); SWRITE(0); if (NT > 1) SLOAD(64);
  for (int j = 0; j < NT; ++j) {
    __syncthreads();
    if (j + 1 < NT) SWRITE((j + 1) & 1);
    if (j + 2 < NT) SLOAD((j + 2) * 64);
    const char* Kt = K_lds + (j & 1) * SHM_KV;
#pragma unroll
    for (int kh = 0; kh < 2; ++kh) {
      bf16x8 bfr[8];
#pragma unroll
      for (int ks = 0; ks < 8; ++ks) bfr[ks] = *reinterpret_cast<const bf16x8*>(Kt + KSWZ(32 * kh + r32, (ks * 16 + hi * 8) * 2));
#pragma unroll
      for (int rt = 0; rt < 2; ++rt) {
        f32x16 acc = f32x16{};
#pragma unroll
        for (int ks = 0; ks < 8; ++ks) acc = __builtin_amdgcn_mfma_f32_32x32x16_bf16(a[rt][ks], bfr[ks], acc, 0, 0, 0);
        float s = 0.f;
#pragma unroll
        for (int i = 0; i < 16; ++i) s += wgt[rt][i] * fmaxf(acc[i], 0.f);
        SC[(t0 + 2 * rt + hi) * 4096 + 64 * j + 32 * kh + r32] = s;
      }
    }
  }
  asm volatile("s_waitcnt vmcnt(0)" ::: "memory");
  __syncthreads();
#undef SLOAD
#undef SWRITE
}

__device__ __forceinline__ int wave_sum_i(int v) {
#pragma unroll
  for (int o = 1; o < 64; o <<= 1) v += __shfl_xor(v, o);
  return v;
}
__device__ __forceinline__ unsigned f2key(float v) { const unsigned u = __float_as_uint(v); return (u & 0x80000000u) ? ~u : (u | 0x80000000u); }
__device__ __forceinline__ float key2f(unsigned k) { return __uint_as_float((k & 0x80000000u) ? (k & 0x7fffffffu) : ~k); }
__device__ __forceinline__ float wave_sum_f(float v) {
#pragma unroll
  for (int o = 1; o < 64; o <<= 1) v += __shfl_xor(v, o);
  return v;
}
typedef __attribute__((address_space(3))) unsigned las_u32;
__device__ __forceinline__ void topk_prefetch(const float* __restrict__ sc_row, int c, las_u32* buf, int lane) {
#pragma unroll
  for (int g4 = 0; g4 < 4; ++g4) {
    if (16 * g4 <= c) {
#pragma unroll
      for (int p = 4 * g4; p < 4 * g4 + 4; ++p) __builtin_amdgcn_global_load_lds((const unsigned*)(sc_row + p * 256 + lane * 4), buf + p * 256, 16, 0, 0);
    }
  }
}
__device__ __forceinline__ void topk_fetch(const las_u32* buf, int c, unsigned (&raw)[64], int lane) {
  asm volatile("s_waitcnt vmcnt(0)" ::: "memory");
#pragma unroll
  for (int g4 = 0; g4 < 4; ++g4) {
    if (16 * g4 <= c) {
#pragma unroll
      for (int j = 16 * g4; j < 16 * g4 + 16; ++j) raw[j] = buf[j * 64 + lane];
    } else {
#pragma unroll
      for (int j = 16 * g4; j < 16 * g4 + 16; ++j) raw[j] = 0u;
    }
  }
  asm volatile("s_waitcnt lgkmcnt(0)" ::: "memory");
}
__device__ __forceinline__ void topk_row(const unsigned (&raw)[64], int c, unsigned long long* __restrict__ mask_row, int lane) {
  unsigned key[64];
  int cv = c; asm volatile("" : "+v"(cv));
#pragma unroll
  for (int j = 0; j < 64; ++j) key[j] = raw[j];
  float s1 = 0.f, s2 = 0.f;
#pragma unroll
  for (int j = 0; j < 64; ++j) { const unsigned u = key[j]; const float v = (j <= cv) ? __uint_as_float(u) : 0.f; s1 += v; s2 = fmaf(v, v, s2);
    const unsigned k = (u & 0x80000000u) ? ~u : (u | 0x80000000u); key[j] = (j <= cv) ? k : 0u; }
  unsigned long long mine = 0ull; unsigned mlo = 0u, mhi = 0u;
  if (c < 4) {
    mine = (lane <= c) ? ~0ull : 0ull;
  } else {
    const float fN = (float)(64 * (c + 1));
    const float mean = __int_as_float(__builtin_amdgcn_readfirstlane(__float_as_int(wave_sum_f(s1)))) / fN;
    const float ex2 = __int_as_float(__builtin_amdgcn_readfirstlane(__float_as_int(wave_sum_f(s2)))) / fN;
    const float sd = sqrtf(fmaxf(ex2 - mean * mean, 1e-30f));
    float T;
    { const float q = 0.5f - 256.f / fN, r = q * q;
      const float num = (((((-3.969683028665376e+01f * r + 2.209460984245205e+02f) * r - 2.759285104469687e+02f) * r + 1.383577518672690e+02f) * r - 3.066479806614716e+01f) * r + 2.506628277459239e+00f) * q;
      const float den = ((((-5.447609879822406e+01f * r + 1.615858368580409e+02f) * r - 1.556989798598866e+02f) * r + 6.680131188771972e+01f) * r - 1.328068155288572e+01f) * r + 1.f;
      T = mean + (num / den) * sd; }
    unsigned Klo = 1u, Khi = 0xFFFFFFFFu; int clo = 64 * (c + 1), chi = 0; bool exact = false; unsigned Tk = 0u;
    for (int it = 0; it < 128; ++it) {
      unsigned cand = f2key(T);
      if (!(cand > Klo && cand < Khi) || (it % 3) == 2) cand = Klo + ((Khi - Klo) >> 1);
      cand = (unsigned)__builtin_amdgcn_readfirstlane((int)cand);
      if (cand == Klo) break;
      int cnt = 0;
#pragma unroll
      for (int g8 = 0; g8 < 8; ++g8) {
        if (8 * g8 <= c) {
#pragma unroll
          for (int j = 8 * g8; j < 8 * g8 + 8; ++j) cnt += __builtin_popcountll(__ballot(key[j] >= cand));
        }
        ATT_SBAR();
      }
      if (cnt == 256) { exact = true; Tk = cand; break; }
      const float Tc = key2f(cand);
      if (cnt > 256) { Klo = cand; clo = cnt; } else { Khi = cand; chi = cnt; }
      if (Klo != 1u && Khi != 0xFFFFFFFFu) {
        const float flo = key2f(Klo), fhi = key2f(Khi);
        T = flo + (fhi - flo) * (((float)(clo - 256) - 0.5f) / (float)(clo - chi));
      } else {
        const float z = (Tc - mean) / sd, dens = fN * 0.3989423f * __expf(-0.5f * z * z) / sd;
        T = Tc + 1.3f * (float)(cnt - 256) / fmaxf(dens, 1e-3f * fN / sd);
      }
    }
    if (!exact) Tk = Klo;
    asm volatile("" : "+v"(Tk));
    if (exact) {
#pragma unroll
      for (int j = 0; j < 64; ++j) { const unsigned long long m = __ballot(key[j] >= Tk);
        asm volatile("s_nop 3\n\tv_writelane_b32 %0, %2, %4\n\tv_writelane_b32 %1, %3, %4" : "+v"(mlo), "+v"(mhi) : "s"((unsigned)m), "s"((unsigned)(m >> 32)), "i"(j));     ATT_SBAR(); }
    } else {
      int gt = 0;
#pragma unroll
      for (int g8 = 0; g8 < 8; ++g8) {
#pragma unroll
        for (int j = 8 * g8; j < 8 * g8 + 8; ++j) gt += __builtin_popcountll(__ballot(key[j] > Tk));
        ATT_SBAR();
      }
      int need = 256 - gt;
      asm volatile("" : "+v"(Tk));
#pragma unroll
      for (int j = 0; j < 64; ++j) {
        const unsigned long long g = __ballot(key[j] > Tk); unsigned long long e = __ballot(key[j] == Tk), take = 0ull;
        const int pe = __popcll(e);
        if (pe <= need) { take = e; need -= pe; } else { while (need > 0) { const unsigned long long lowb = e & (~e + 1ull); take |= lowb; e ^= lowb; --need; } }
        const unsigned long long m = g | take;
        asm volatile("s_nop 3\n\tv_writelane_b32 %0, %2, %4\n\tv_writelane_b32 %1, %3, %4" : "+v"(mlo), "+v"(mhi) : "s"((unsigned)m), "s"((unsigned)(m >> 32)), "i"(j));
        ATT_SBAR();
      }
    }
  }
  if (c >= 4) mine = (unsigned long long)mlo | ((unsigned long long)mhi << 32);
  mask_row[lane] = mine;
}
#undef KSWZ
}

constexpr int NWAVES = 8;
constexpr int BATCH = 4, SEQ = 4096, DM = 2048, DFF = 5632, M = BATCH * SEQ;
constexpr int DSA_NP = 5376, MLA_DOWN_NP = 1280;
constexpr int NPH = 26;
#ifndef MK_ONE_LAUNCH
#define MK_ONE_LAUNCH 1
#endif
constexpr size_t MiB = 1u << 20;
constexpr size_t WS_CTL = 0, CTL_ZERO_BYTES = 1 * MiB;
constexpr size_t WS_MODS = 1 * MiB;
constexpr size_t WS_CS128 = 2 * MiB;
constexpr size_t WS_CS64 = 4 * MiB;
constexpr size_t WS_SSQ = 5 * MiB;
constexpr size_t WS_W = 6 * MiB;
constexpr size_t WL_STRIDE = 74 * MiB, WL_FFN1 = 0, WL_FFN2 = 44 * MiB, WL_OUT = 66 * MiB;
constexpr size_t WS_WDSA = WS_W + 4 * WL_STRIDE, WDSA_STRIDE = 21 * MiB;
constexpr size_t WS_WMLA = WS_WDSA + 2 * WDSA_STRIDE, WMLA_DOWN = 0, WMLA_UQ = 5 * MiB, WMLA_UKV = 8 * MiB;
constexpr size_t WS_WSB = WS_WMLA + 12 * MiB;
constexpr size_t WS_H = WS_WSB + 24 * MiB;
constexpr size_t WS_O = WS_H + 64 * MiB;
constexpr size_t WS_MIX = WS_O + 64 * MiB;
constexpr size_t MX_ACT = 0;
constexpr size_t MX_DQ = 0, MX_DK = 64 * MiB, MX_DV = 80 * MiB, MX_DIQ = 96 * MiB, MX_DIK = 160 * MiB, MX_DIW = 164 * MiB, MX_DMASK = 165 * MiB, MX_DSC = 176 * MiB;
constexpr size_t MX_MCQ = 0, MX_MCKV = 16 * MiB, MX_MKR = 32 * MiB, MX_MQN = 34 * MiB, MX_MQR = 98 * MiB, MX_MKN = 130 * MiB, MX_MV = 194 * MiB;
constexpr size_t MX_SQ = 0, MX_SK = 64 * MiB, MX_SV = 128 * MiB;
constexpr size_t WS_SSX = WS_MIX + 432 * MiB;
constexpr size_t WS_BIAS = WS_SSX + 1 * MiB;
constexpr size_t BIAS_DSA0 = 0, BIAS_DSA1 = 4 * 5376, BIAS_MLA = 8 * 5376, BIAS_SB = BIAS_MLA + 4 * 1280, BIAS_FFN = BIAS_SB + 4 * 6144;
static_assert((BIAS_FFN + 4 * 4 * 11264) * 4 <= 1 * MiB, "bias rows fit 1 MiB");
constexpr size_t WS_XB = WS_BIAS + 1 * MiB;
constexpr size_t WS_END = WS_XB + 64 * MiB;
static_assert(WS_W + 380 * MiB - 6 * MiB == WS_H, "weight map");
constexpr int CW_TMO = 0, CW_BAR = 4096;
constexpr int RING_BYTES = 131072, LDSCTL_OFF = RING_BYTES, MISC_OFF = LDSCTL_OFF + 320, EPI_PART_OFF = RING_BYTES + 1024  , EPI_TAB_OFF = RING_BYTES + 6144  , LDS_BYTES = 147456;

#define GAS __attribute__((address_space(1)))
#define LAS __attribute__((address_space(3)))
typedef unsigned short bf16;
typedef unsigned v4u __attribute__((ext_vector_type(4)));
typedef float f32x4 __attribute__((ext_vector_type(4)));
typedef GAS unsigned gu32;
#define RLX_AGENT __ATOMIC_RELAXED, __HIP_MEMORY_SCOPE_AGENT
#define LDS_WAIT() asm volatile("s_waitcnt lgkmcnt(0)" ::: "memory")
__device__ __forceinline__ unsigned f2bf(float f) { unsigned u = __builtin_bit_cast(unsigned, f); return (u + 0x7fffu + ((u >> 16) & 1u)) >> 16; }
__device__ __forceinline__ unsigned pk2(float lo, float hi) { return f2bf(lo) | (f2bf(hi) << 16); }

#define XB_TMO      128
#define XB_XCNT(j)  (256  + 64 * (j))
#define XB_XSUB(j)  (1280 + 64 * (j))
#define XB_XGEN(j)  (2304 + 64 * (j))
#define XB_TOP      3328
#define XB_TOPGEN   3392
#define XCD_BAR_WORDS 3456
#define XB_SPIN_CAP (1u << 18)

__device__ __forceinline__ unsigned xb_ld(unsigned* p)              { return __hip_atomic_load(p, __ATOMIC_RELAXED, __HIP_MEMORY_SCOPE_AGENT); }
__device__ __forceinline__ unsigned xb_add(unsigned* p, unsigned v) { return __hip_atomic_fetch_add(p, v, __ATOMIC_RELAXED, __HIP_MEMORY_SCOPE_AGENT); }
__device__ __forceinline__ unsigned xb_xcc_id() { return (unsigned)__builtin_amdgcn_s_getreg((3 << 11) | 20) & 0xFu; }
#define XB_SPIN(cond, bar) do { unsigned _sp = 0; while (cond) { __builtin_amdgcn_s_sleep(1); \
    if ((++_sp & 255u) == 0u) { if (xb_ld(&(bar)[XB_TMO])) break; if (_sp > XB_SPIN_CAP) { atomicAdd(&(bar)[XB_TMO], 1u); break; } } } } while (0)

struct XcdBarrier {
    unsigned* bar; unsigned x;
    volatile LAS unsigned* st;
};

__device__ __forceinline__ XcdBarrier xcd_barrier_post(unsigned* bar, volatile LAS unsigned* st) {
    XcdBarrier b; b.bar = bar; b.x = xb_xcc_id(); b.st = st;
    if (threadIdx.x == 0) (void)xb_add(&bar[XB_XCNT(b.x)], 1u);
    return b;
}
__device__ __forceinline__ void xcd_barrier_complete(unsigned* bar, unsigned x, unsigned& nloc, unsigned& nx) {
    const unsigned G = gridDim.x * gridDim.y * gridDim.z;
    unsigned sum, cnt, mine, sp = 0u;
    for (;;) {
        sum = 0u; cnt = 0u; mine = 0u;
#pragma unroll
        for (unsigned j = 0; j < 16; ++j) { const unsigned c = xb_ld(&bar[XB_XCNT(j)]); sum += c; cnt += (c > 0u) ? 1u : 0u; mine = (j == x) ? c : mine; }
        if (sum == G) break;
        __builtin_amdgcn_s_sleep(1);
        if ((++sp & 255u) == 0u) { if (xb_ld(&bar[XB_TMO])) break; if (sp > XB_SPIN_CAP) { atomicAdd(&bar[XB_TMO], 1u); break; } }
    }
    nloc = mine > 0u ? mine : 1u; nx = cnt > 0u ? cnt : 1u;
}

__device__ __forceinline__ void xcd_barrier(const XcdBarrier& b) {
    asm volatile("s_waitcnt vmcnt(0)" ::: "memory");
    __syncthreads();
    if (threadIdx.x == 0) {
        unsigned* bar = b.bar;
        __builtin_amdgcn_s_waitcnt(0);
        unsigned nloc = b.st[0], nx = b.st[1];
        if (nloc == 0u) { xcd_barrier_complete(bar, b.x, nloc, nx); b.st[0] = nloc; b.st[1] = nx; }
        const unsigned old = xb_add(&bar[XB_XSUB(b.x)], 1u);
        const unsigned gen = old / nloc;
        if (old + 1u == (gen + 1u) * nloc) {
            __builtin_amdgcn_fence(__ATOMIC_RELEASE, "agent");
            asm volatile("s_waitcnt vmcnt(0)" ::: "memory");
            const unsigned og = xb_add(&bar[XB_TOP], 1u);
            const unsigned tg = og / nx;
            if (og + 1u == (tg + 1u) * nx) xb_add(&bar[XB_TOPGEN], 1u);
            else XB_SPIN(xb_ld(&bar[XB_TOPGEN]) == tg, bar);
            __builtin_amdgcn_fence(__ATOMIC_ACQUIRE, "agent");
            xb_add(&bar[XB_XGEN(b.x)], 1u);
            asm volatile("s_waitcnt vmcnt(0)" ::: "memory");
        } else {
            XB_SPIN(xb_ld(&bar[XB_XGEN(b.x)]) == gen, bar);
            __builtin_amdgcn_fence(__ATOMIC_ACQUIRE, "agent");
            asm volatile("s_waitcnt vmcnt(0)" ::: "memory");
        }
    }
    __syncthreads();
}


struct Frame {
    LAS unsigned char* lds;
    volatile LAS unsigned* MISC;
    gu32* ctl;
    int tid, lane, wave;
    int vcu, G;
};
__device__ __forceinline__ float wave_sum(float v) {
#pragma unroll
    for (int o = 1; o < 64; o <<= 1) v += __shfl_xor(v, o);
    return v;
}
enum { KIND_ID = 0, KIND_DSA_IN = 1, KIND_MLA_DOWN = 2, KIND_MLA_UQ = 3, KIND_FFN1 = 4 };
__host__ __device__ __forceinline__ int srcblk(int kind, int nb, int& nvalid) {
    nvalid = 32;
    const int pn = nb >> 3, pb = nb & 7, bj = pb >> 2, wc = pb & 3;
    if (kind == KIND_ID) return nb * 32;
    if (kind == KIND_DSA_IN) {
        if (pn < 8)  return (2 * pn + (wc >> 1)) * 128 + 64 * bj + 32 * (wc & 1);
        if (pn < 10) return 2048 + (2 * (pn - 8) + (wc >> 1)) * 128 + 64 * bj + 32 * (wc & 1);
        if (pn < 12) return 2560 + (pn - 10) * 256 + 32 * pb;
        if (pn < 20) return 3072 + (2 * (pn - 12) + (wc >> 1)) * 128 + (wc & 1) * 64 + bj * 32;
        if (wc == 0) return 5120 + bj * 32;
        if (wc == 1) return 5120 + 64 + bj * 32;
        if (wc == 2 && bj == 0) { nvalid = 16; return 5248; }
        return -1;
    }
    if (kind == KIND_MLA_DOWN) { if (pn < 4) return nb * 32; if (wc == 0) return 1024 + 32 * bj; return -1; }
    if (kind == KIND_MLA_UQ) { if (pn < 8) return (2 * pn + bj) * 192 + 32 * wc; return (4 * (pn - 8) + wc) * 192 + 128 + 32 * bj; }
      return (bj ? 5632 : 0) + 128 * pn + 32 * wc;
}
__device__ __forceinline__ void conv_item(const float* __restrict__ W, int K, int Nsrc, int Nphys, int kind, const float* __restrict__ gk, bf16* __restrict__ WT, LAS unsigned* scr, int item, int lane) {
    const int nblk = Nphys / 64, kb = item / nblk, ib = item % nblk, k0 = 64 * kb, n0 = 64 * ib;
    const int c4 = lane & 15, kr = lane >> 4;
    int nvalid; const int sb = srcblk(kind, 2 * ib + (c4 >> 3), nvalid);
    const int col = 4 * (c4 & 7);
    const bool valid = (sb >= 0) && (col < nvalid);
    const float* src = W + (size_t)(k0 + 2 * kr) * Nsrc + (valid ? sb + col : 0);
    f32x4 va[8], vb[8];
#pragma unroll
    for (int kk = 0; kk < 8; ++kk) { va[kk] = __builtin_nontemporal_load((const GAS f32x4*)(src + (size_t)(8 * kk) * Nsrc)); vb[kk] = __builtin_nontemporal_load((const GAS f32x4*)(src + (size_t)(8 * kk + 1) * Nsrc)); }
    if (gk) {
#pragma unroll
        for (int kk = 0; kk < 8; ++kk) { va[kk] *= gk[k0 + 8 * kk + 2 * kr]; vb[kk] *= gk[k0 + 8 * kk + 2 * kr + 1]; } }
    if (!valid) {
#pragma unroll
        for (int kk = 0; kk < 8; ++kk) { va[kk] = (f32x4){0.f, 0.f, 0.f, 0.f}; vb[kk] = (f32x4){0.f, 0.f, 0.f, 0.f}; } }
#pragma unroll
    for (int kk = 0; kk < 8; ++kk)
#pragma unroll
        for (int i = 0; i < 4; ++i) scr[(4 * c4 + i) * 33 + 4 * kk + kr] = pg8::cvt_pk_bf16(va[kk][i], vb[kk][i]);
    LDS_WAIT(); asm volatile("" ::: "memory");
    const int c = lane & 7;
#pragma unroll
    for (int j = 0; j < 8; ++j) { const int n = (lane >> 3) + 8 * j; const LAS unsigned* s = scr + n * 33 + 4 * c;
        v4u o; o.x = s[0]; o.y = s[1]; o.z = s[2]; o.w = s[3];
        *(GAS v4u*)(WT + (size_t)(n0 + n) * K + k0 + 8 * c) = o; }
    LDS_WAIT(); asm volatile("" ::: "memory");
}
__device__ __forceinline__ void cs_entry(int pos, int i, const double* rp  , float& co, float& si) {
    double inv = 1.0;
#pragma unroll
    for (int k = 0; k < 6; ++k) if ((i >> k) & 1) inv *= rp[k];
    const double a = (double)pos * inv;
    const double n = __builtin_rint(a * 0.63661977236758134308);
    double y = a - n * 1.5707963267948966; y -= n * 6.123233995736766e-17;
    const double y2 = y * y;
    double s = -7.6471637318198164759e-13;
    s = s * y2 + 1.6059043836821614599e-10; s = s * y2 - 2.5052108385441718775e-08; s = s * y2 + 2.7557319223985890653e-06; s = s * y2 - 1.9841269841269841270e-04;
    s = s * y2 + 8.3333333333333333333e-03; s = s * y2 - 1.6666666666666666667e-01; s = y + y * y2 * s;
    double c = 4.7794773323873852974e-14;
    c = c * y2 - 1.1470745597729724714e-11; c = c * y2 + 2.0876756987868098979e-09; c = c * y2 - 2.7557319223985890653e-07; c = c * y2 + 2.4801587301587301587e-05;
    c = c * y2 - 1.3888888888888888889e-03; c = c * y2 + 4.1666666666666666667e-02; c = c * y2 - 0.5; c = 1.0 + y2 * c;
    const int q = ((int)n) & 3;
    const double cc = (q == 0) ? c : (q == 1) ? -s : (q == 2) ? -c : s;
    const double ss = (q == 0) ? s : (q == 1) ? c : (q == 2) ? -s : -c;
    co = (float)cc; si = (float)ss;
}
__device__ __forceinline__ void modnorm_phase(const Frame& F0, const float* __restrict__ x, const float* __restrict__ g, const float* __restrict__ mods_l, int sh_off, int sc_off, bf16* __restrict__ H) {
    int tid_ = threadIdx.x; asm volatile("" : "+v"(tid_)); struct { int lane, wave, vcu, G; } F{tid_ & 63, __builtin_amdgcn_readfirstlane(tid_ >> 6), F0.vcu, F0.G};
    const int gw = F.vcu * NWAVES + F.wave, NGW = F.G * NWAVES;
    for (int m = gw; m < M; m += NGW) {
        const GAS f32x4* xr = (const GAS f32x4*)(x + (size_t)m * DM) + F.lane;
        f32x4 v[8]; float s = 0.f;
#pragma unroll
        for (int j = 0; j < 8; ++j) { v[j] = xr[64 * j]; s += (v[j].x * v[j].x + v[j].y * v[j].y) + (v[j].z * v[j].z + v[j].w * v[j].w); }
        const float rstd = 1.0f / sqrtf(wave_sum(s) * (1.0f / DM) + 1e-6f);
        const float* mb = mods_l + (size_t)(m >> 12) * 12288;
        GAS unsigned long long* o8 = (GAS unsigned long long*)(H + (size_t)m * DM) + F.lane;
#pragma unroll
        for (int j = 0; j < 8; ++j) { const int col = 256 * j + 4 * F.lane;
            const f32x4 g4 = *(const f32x4*)(g + col), sc4 = *(const f32x4*)(mb + sc_off + col), sh4 = *(const f32x4*)(mb + sh_off + col);
            const f32x4 r = v[j] * rstd * g4 * (sc4 + 1.0f) + sh4;
            o8[64 * j] = (unsigned long long)pk2(r.x, r.y) | ((unsigned long long)pk2(r.z, r.w) << 32); }
    }
}
__device__ __forceinline__ void finalnorm_phase(const Frame& F0, const bf16* __restrict__ xb, float* __restrict__ out, const float* __restrict__ g) {
    int tid_ = threadIdx.x; asm volatile("" : "+v"(tid_)); struct { int lane, wave, vcu, G; } F{tid_ & 63, __builtin_amdgcn_readfirstlane(tid_ >> 6), F0.vcu, F0.G};
    const int gw = F.vcu * NWAVES + F.wave, NGW = F.G * NWAVES;
    for (int m = gw; m < M; m += NGW) {
        const GAS v4u* xr = (const GAS v4u*)(xb + (size_t)m * DM) + F.lane;
        v4u w[4]; float s = 0.f; float v[4][8];
#pragma unroll
        for (int j = 0; j < 4; ++j) w[j] = xr[64 * j];
#pragma unroll
        for (int j = 0; j < 4; ++j)
#pragma unroll
            for (int e = 0; e < 4; ++e) { const unsigned d = w[j][e]; v[j][2 * e] = __uint_as_float(d << 16); v[j][2 * e + 1] = __uint_as_float(d & 0xffff0000u); s += v[j][2 * e] * v[j][2 * e] + v[j][2 * e + 1] * v[j][2 * e + 1]; }
        const float rstd = 1.0f / sqrtf(wave_sum(s) * (1.0f / DM) + 1e-6f);
        GAS f32x4* orow = (GAS f32x4*)(out + (size_t)m * DM);
#pragma unroll
        for (int j = 0; j < 4; ++j) { const int col = 8 * (F.lane + 64 * j); const f32x4 g0 = *(const f32x4*)(g + col), g1 = *(const f32x4*)(g + col + 4);
            __builtin_nontemporal_store((f32x4){v[j][0], v[j][1], v[j][2], v[j][3]} * rstd * g0, orow + col / 4); __builtin_nontemporal_store((f32x4){v[j][4], v[j][5], v[j][6], v[j][7]} * rstd * g1, orow + col / 4 + 1); }
    }
}

#ifndef SITE_MASK
#define SITE_MASK 0xFFFFu
#endif
#define SITE(s_) ((((unsigned)(SITE_MASK)) >> (s_)) & 1u)
#ifndef DIAG
#define DIAG 0
#endif
#ifndef DIAG_K0
#define DIAG_K0 0
#define DIAG_K1 1
#define DIAG_DIV 4.0f
#endif
#ifndef DIAG_SEL
#define DIAG_SEL 0
#endif
#define DIAG_PTR (DIAG ? (unsigned*)(ARG_WS + WS_CTL) + 2048 : (unsigned*)nullptr)
#ifndef REP_VAR
#define REP_VAR 0
#endif
#ifndef P0_REP
#define P0_REP 0
#endif
#ifndef REPEAT_MASK
#define REPEAT_MASK 0u
#endif
#define NREP(s_) (1 + (int)((((unsigned)(REPEAT_MASK)) >> (s_)) & 1u))
#define IN(k) (LO <= (k) && (k) < HI)
#if DIAG == 2
#define SEAM(k) do { if constexpr (IN(k) && IN((k) + 1)) { if (threadIdx.x == 0) { const unsigned long long t_ = __builtin_amdgcn_s_memrealtime(); \
        __hip_atomic_fetch_max((unsigned long long*)(ARG_WS + WS_CTL + 0x9000) + (k), t_, __ATOMIC_RELAXED, __HIP_MEMORY_SCOPE_AGENT); \
        __hip_atomic_fetch_max((unsigned long long*)(ARG_WS + WS_CTL + 0xA000) + (k), (1ull << 62) - t_, __ATOMIC_RELAXED, __HIP_MEMORY_SCOPE_AGENT); } \
      xcd_barrier(bar); } if (blockIdx.x == 0 && threadIdx.x == 0) ((unsigned long long*)(ARG_WS + WS_CTL + 0x8000))[(k) + 1] = __builtin_amdgcn_s_memrealtime(); } while (0)
#else
#define SEAM(k) do { if constexpr (IN(k) && IN((k) + 1)) xcd_barrier(bar); } while (0)
#endif
struct Args { const float* in[39]; float* out; unsigned char* ws; int ph_lo, ph_hi, li, pad; };
static_assert(offsetof(Args, out) == 39 * 8 && offsetof(Args, ws) == 40 * 8 && offsetof(Args, li) == 84 * 4, "kernarg layout");
typedef const float* __attribute__((address_space(4))) const* kargp_t;
#define ARG_IN(i_) (((kargp_t)__builtin_amdgcn_kernarg_segment_ptr())[(i_)])
#define ARG_OUT ((float*)((kargp_t)__builtin_amdgcn_kernarg_segment_ptr())[39])
#define ARG_WS ((unsigned char*)((kargp_t)__builtin_amdgcn_kernarg_segment_ptr())[40])
#define ARG_LI (((const int __attribute__((address_space(4)))*)__builtin_amdgcn_kernarg_segment_ptr())[84])

__device__ __forceinline__ void bias_item(const bf16* __restrict__ WT, int nrows, float* __restrict__ out, int r32item, const LAS float* shl, int wave, int lane) {
    const int n0 = 32 * r32item + 4 * wave;
    const GAS v4u* wp = (const GAS v4u*)(WT + (size_t)n0 * DM) + lane;
    v4u w[16];
#pragma unroll
    for (int j = 0; j < 16; ++j) w[j] = wp[64 * j];
    float acc[4][4];
#pragma unroll
    for (int q = 0; q < 4; ++q)
#pragma unroll
        for (int b = 0; b < 4; ++b) acc[q][b] = 0.f;
#pragma unroll
    for (int jj = 0; jj < 4; ++jj) {
        f32x4 sa[4], sb[4];
#pragma unroll
        for (int b = 0; b < 4; ++b) { sa[b] = *(const LAS f32x4*)(shl + b * DM + 8 * (lane + 64 * jj)); sb[b] = *(const LAS f32x4*)(shl + b * DM + 8 * (lane + 64 * jj) + 4); }
#pragma unroll
        for (int q = 0; q < 4; ++q) { const v4u d = w[4 * q + jj];
            const float e0 = __uint_as_float(d.x << 16), e1 = __uint_as_float(d.x & 0xffff0000u), e2 = __uint_as_float(d.y << 16), e3 = __uint_as_float(d.y & 0xffff0000u);
            const float e4 = __uint_as_float(d.z << 16), e5 = __uint_as_float(d.z & 0xffff0000u), e6 = __uint_as_float(d.w << 16), e7 = __uint_as_float(d.w & 0xffff0000u);
#pragma unroll
            for (int b = 0; b < 4; ++b) { float t = acc[q][b];
                t = fmaf(e0, sa[b][0], t); t = fmaf(e1, sa[b][1], t); t = fmaf(e2, sa[b][2], t); t = fmaf(e3, sa[b][3], t);
                t = fmaf(e4, sb[b][0], t); t = fmaf(e5, sb[b][1], t); t = fmaf(e6, sb[b][2], t); t = fmaf(e7, sb[b][3], t); acc[q][b] = t; } }
    }
#pragma unroll
    for (int q = 0; q < 4; ++q)
#pragma unroll
        for (int b = 0; b < 4; ++b) { const float t = wave_sum(acc[q][b]); if (lane == 0) out[(size_t)b * nrows + n0 + q] = t; }
}
constexpr int NBIAS_ITEM = 168 + 40 + 192 + 168 + 4 * 352;
__device__ __forceinline__ void bias_range(const Frame& F0, int lo, int hi, int vb, int nb) {
    int tid_ = threadIdx.x; asm volatile("" : "+v"(tid_)); const int lane = tid_ & 63, wave = __builtin_amdgcn_readfirstlane(tid_ >> 6);
    unsigned char* const ws = ARG_WS;
    const float* const MODS = (const float*)(ws + WS_MODS); float* const BIAS = (float*)(ws + WS_BIAS);
    LAS float* const shl = (LAS float*)F0.lds;
    const int i0 = lo + (int)(((long)vb * (hi - lo)) / nb), i1 = lo + (int)(((long)(vb + 1) * (hi - lo)) / nb);
    int cur = -1;
    for (int it = i0; it < i1; ++it) {
        int seg, r; const bf16* WT; int nrows; const float* sh; float* out;
        if (it < 168) { seg = 0; r = it; WT = (const bf16*)(ws + WS_WDSA); nrows = DSA_NP; sh = MODS + 0 * 4 * 12288; out = BIAS + BIAS_DSA0; }
        else if (it < 208) { seg = 1; r = it - 168; WT = (const bf16*)(ws + WS_WMLA + WMLA_DOWN); nrows = MLA_DOWN_NP; sh = MODS + 1 * 4 * 12288; out = BIAS + BIAS_MLA; }
        else if (it < 400) { seg = 2; r = it - 208; WT = (const bf16*)(ws + WS_WSB); nrows = 3 * DM; sh = MODS + 2 * 4 * 12288; out = BIAS + BIAS_SB; }
        else if (it < 568) { seg = 3; r = it - 400; WT = (const bf16*)(ws + WS_WDSA + WDSA_STRIDE); nrows = DSA_NP; sh = MODS + 3 * 4 * 12288; out = BIAS + BIAS_DSA1; }
        else { const int l = (it - 568) / 352; seg = 4 + l; r = (it - 568) % 352; WT = (const bf16*)(ws + WS_W + (size_t)l * WL_STRIDE + WL_FFN1); nrows = 2 * DFF; sh = MODS + (size_t)l * 4 * 12288 + 6144; out = BIAS + BIAS_FFN + (size_t)l * 4 * 2 * DFF; }
        if (seg != cur) {
            __syncthreads();
            for (int i = tid_; i < 4 * DM; i += NWAVES * 64) shl[i] = sh[(size_t)(i >> 11) * 12288 + (i & 2047)];
            __syncthreads();
            cur = seg;
        }
        bias_item(WT, nrows, out, r, shl, wave, lane);
    }
    __syncthreads();
}
__device__ __forceinline__ void bias_in_tail(const Frame& F0, int lo, int hi) {
    const int G = F0.G, rem = ((M / 256) * (DSA_NP / 256)) % G, c = (int)blockIdx.x;
    if (rem == 0) bias_range(F0, lo, hi, c, G);
    else if (c >= rem) bias_range(F0, lo, hi, c - rem, G - rem);
}
template <int L, int LO, int HI> __device__ __forceinline__ void run_layer(const Frame& F, const Args& args, const XcdBarrier& bar, unsigned char* lds) {
        unsigned char* const ws = ARG_WS;
        float* const MODS = (float*)(ws + WS_MODS);
        float* const CS128 = (float*)(ws + WS_CS128);
        float* const CS64 = (float*)(ws + WS_CS64);
        float* const SSQ = (float*)(ws + WS_SSQ);
        float* const SSX = (float*)(ws + WS_SSX);
        const float* const BIAS = (const float*)(ws + WS_BIAS);
        bf16* const HB = (bf16*)(ws + WS_H);
        bf16* const XB = (bf16*)(ws + WS_XB);
        bf16* const OB = (bf16*)(ws + WS_O);
        unsigned char* const MIX = ws + WS_MIX;
        const int gw = F.vcu * NWAVES + F.wave, NGW = F.G * NWAVES;
        constexpr int l = L; constexpr int kind = (l == 3) ? 0 : l;
        constexpr int pb = (l == 0) ? 2 : (l == 1) ? 8 : (l == 2) ? 14 : 19;
        constexpr int cb = pb + ((kind == 0) ? 3 : (kind == 1) ? 3 : 2);
        unsigned char* const WL = ws + WS_W + (size_t)l * WL_STRIDE;
        const float* const mods_l = MODS + (size_t)l * 4 * 12288;
        if constexpr (kind == 0) {
            bf16* const DQ = (bf16*)(MIX + MX_DQ); bf16* const DK = (bf16*)(MIX + MX_DK); bf16* const DV = (bf16*)(MIX + MX_DV); bf16* const DIQ = (bf16*)(MIX + MX_DIQ); bf16* const DIK = (bf16*)(MIX + MX_DIK);
            float* const DIW = (float*)(MIX + MX_DIW); unsigned long long* const DMASK = (unsigned long long*)(MIX + MX_DMASK); float* const DSC = (float*)(MIX + MX_DSC);
            if constexpr (SITE(2) && IN(pb)) {
            for (int rep_ = 0; rep_ < NREP(2); ++rep_) {
                pg8::Gemm g{HB, (const bf16*)(ws + WS_WDSA + (size_t)(l == 3) * WDSA_STRIDE), M, DSA_NP, DM}; pg8::StaticOrder S; S.init(M, DSA_NP, F.G, (int)blockIdx.x);
                pg8::EpiDsaIn E{DQ, DK, DV, DIQ, DIK, DIW, pg8::NormIn{SSX, BIAS + (l == 3 ? BIAS_DSA1 : BIAS_DSA0), DSA_NP, (pg8::PG8_LAS_float_ptr)(F.lds + EPI_TAB_OFF)}};
                pg8::gemm_phase<pg8::EpiDsaIn, pg8::StaticOrder, true, true>(F.lds, g, S, E);
            }
                if constexpr (l == 0) bias_in_tail(F, 168, 568 + 1 * 352); else bias_in_tail(F, 568 + 3 * 352, NBIAS_ITEM);
                SEAM(pb);
            }
            if constexpr (SITE(3) && IN(pb + 1)) {
            for (int rep_ = 0; rep_ < NREP(3); ++rep_) {
                int tid_ = threadIdx.x; asm volatile("" : "+v"(tid_)); const int lane_ = tid_ & 63, wave_ = __builtin_amdgcn_readfirstlane(tid_ >> 6);
                att::las_u32* const tbuf = (att::las_u32*)(F.lds + wave_ * 16384);
                for (int idx = F.vcu; idx < 512; idx += F.G) { const int s = idx & 255, r = idx >> 8, b = s >> 6, loc = s & 63, qq = r ? 127 - loc : loc;
                    att::idx_unit(b, qq, DIQ, DIK, DIW, DSC, (char*)lds);
                    const int row0 = b * 4096 + 32 * qq + 4 * wave_, c_ = qq >> 1;
                    unsigned raw[64];
                    att::topk_prefetch(DSC + (size_t)row0 * 4096, c_, tbuf, lane_);
#pragma unroll 1
                    for (int k = 0; k < 4; ++k) {
                        att::topk_fetch(tbuf, c_, raw, lane_);
                        if (k < 3) att::topk_prefetch(DSC + (size_t)(row0 + k + 1) * 4096, c_, tbuf, lane_);
                        att::topk_row(raw, c_, DMASK + (size_t)(row0 + k) * 64, lane_);
                    }
                    __syncthreads();
                }
                asm volatile("s_waitcnt vmcnt(0)" ::: "memory");
            }
                SEAM(pb + 1);
            }
            if constexpr (SITE(5) && IN(pb + 2)) {
            for (int rep_ = 0; rep_ < NREP(5); ++rep_) {
                for (int idx = F.vcu; idx < 1024; idx += F.G) { const int s = idx & 255, r = idx >> 8, bg = s >> 4, loc = s & 15;
                    const int c = (r == 0) ? loc : (r == 1) ? 63 - loc : (r == 2) ? loc + 16 : 47 - loc;
                    if (rep_ == 0) att::dsa_attn_unit<0>(bg >> 2, bg & 3, c, DQ, DK, DV, DMASK, OB, (char*)lds); else att::dsa_attn_unit<(REP_VAR ? REP_VAR : 1)>(bg >> 2, bg & 3, c, DQ, DK, DV, DMASK, OB, (char*)lds); }
            }
                SEAM(pb + 2);
            }
        } else if constexpr (kind == 1) {
            bf16* const CQ = (bf16*)(MIX + MX_MCQ); bf16* const CKV = (bf16*)(MIX + MX_MCKV); bf16* const KR = (bf16*)(MIX + MX_MKR); bf16* const QN = (bf16*)(MIX + MX_MQN); bf16* const QR = (bf16*)(MIX + MX_MQR);
            bf16* const KN = (bf16*)(MIX + MX_MKN); bf16* const MV = (bf16*)(MIX + MX_MV);
            if constexpr (SITE(6) && IN(pb)) {
            for (int rep_ = 0; rep_ < NREP(6); ++rep_) {
                pg8::Gemm g{HB, (const bf16*)(ws + WS_WMLA + WMLA_DOWN), M, 1024, DM}; pg8::StaticOrder S; S.init(M, 1024, F.G, (int)blockIdx.x);
                pg8::EpiMlaDown E{CQ, CKV, KR, SSQ, pg8::NormIn{SSX, BIAS + BIAS_MLA, MLA_DOWN_NP, (pg8::PG8_LAS_float_ptr)(F.lds + EPI_TAB_OFF)}, 0};
                pg8::gemm_phase<pg8::EpiMlaDown, pg8::StaticOrder, true, true>(F.lds, g, S, E);
            }
                SEAM(pb);
            }
            if constexpr (SITE(7) && IN(pb + 1)) {
            for (int rep_ = 0; rep_ < NREP(7); ++rep_) {
                const int v = F.vcu; const bool bal = (F.G == 256);
                const int s0 = v < 64 ? 4 * v : 256 + 8 * (v - 64), s1 = s0 + (v < 64 ? 4 : 8);
                { pg8::Gemm g{HB, (const bf16*)(ws + WS_WMLA + WMLA_DOWN) + (size_t)1024 * DM, M, 256, DM};
                  pg8::RangeOrder S{v, 64, bal ? 64 : F.G, 1};
                  pg8::EpiMlaDown E{CQ, CKV, KR, SSQ, pg8::NormIn{SSX, BIAS + BIAS_MLA, MLA_DOWN_NP, (pg8::PG8_LAS_float_ptr)(F.lds + EPI_TAB_OFF)}, 4};
                  pg8::gemm_phase<pg8::EpiMlaDown, pg8::RangeOrder, true, true>(F.lds, g, S, E); }
                { pg8::Gemm g{CQ, (const bf16*)(ws + WS_WMLA + WMLA_UQ), M, 3072, 512};
                  pg8::RangeOrder S{bal ? (s0 < 768 ? s0 : 768) : v, bal ? (s1 < 768 ? s1 : 768) : 768, bal ? 1 : F.G, 12};
                  pg8::EpiMlaUq E{QN, QR, SSQ, (pg8::PG8_LAS_float_ptr)(F.lds + EPI_TAB_OFF)};
                  pg8::gemm_phase<pg8::EpiMlaUq, pg8::RangeOrder, true, true>(F.lds, g, S, E); }
                { pg8::Gemm g{CKV, (const bf16*)(ws + WS_WMLA + WMLA_UKV), M, 4096, 512};
                  pg8::RangeOrder S{bal ? (s0 > 768 ? s0 - 768 : 0) : v, bal ? (s1 > 768 ? s1 - 768 : 0) : 1024, bal ? 1 : F.G, 16};
                  pg8::EpiMlaUkv E{KN, MV, SSQ, (pg8::PG8_LAS_float_ptr)(F.lds + EPI_TAB_OFF)};
                  pg8::gemm_phase<pg8::EpiMlaUkv, pg8::RangeOrder, true, true>(F.lds, g, S, E); }
            }
                SEAM(pb + 1);
            }
            if constexpr (SITE(8) && IN(pb + 2)) {
            for (int rep_ = 0; rep_ < NREP(8); ++rep_) {
                for (int idx = F.vcu; idx < 1024; idx += F.G) { const int s = idx & 255, r = idx >> 8, bh = s >> 2, loc = s & 3;
                    const int qb = (r == 0) ? loc : (r == 1) ? 15 - loc : (r == 2) ? loc + 4 : 11 - loc;
                    att::mla_attn_unit(bh >> 4, bh & 15, qb, QN, QR, KN, KR, MV, OB, (char*)lds); }
            }
                SEAM(pb + 2);
            }
        } else {
            bf16* const SQ = (bf16*)(MIX + MX_SQ); bf16* const SK = (bf16*)(MIX + MX_SK); bf16* const SV = (bf16*)(MIX + MX_SV);
            if constexpr (SITE(9) && IN(pb)) {
            for (int rep_ = 0; rep_ < NREP(9); ++rep_) {
                pg8::Gemm g{HB, (const bf16*)(ws + WS_WSB), M, 3 * DM, DM}; pg8::StaticOrder S; S.init(M, 3 * DM, F.G, (int)blockIdx.x);
                pg8::EpiSplit3 E{SQ, (size_t)(MX_SK - MX_SQ) / 2, pg8::NormIn{SSX, BIAS + BIAS_SB, 3 * DM, (pg8::PG8_LAS_float_ptr)(F.lds + EPI_TAB_OFF)}}; static_assert(MX_SV - MX_SK == MX_SK - MX_SQ, "q | k | v equally spaced");
                pg8::gemm_phase<pg8::EpiSplit3, pg8::StaticOrder, true, true>(F.lds, g, S, E);
            }
                SEAM(pb);
            }
            if constexpr (SITE(10) && IN(pb + 1)) {
            for (int rep_ = 0; rep_ < NREP(10); ++rep_) {
                unsigned* const qhead = (unsigned*)(ARG_WS + WS_CTL) + 2048 + 64;
                for (;;) {
                    if (threadIdx.x == 0) F.MISC[16] = __hip_atomic_fetch_add(qhead, 1u, __ATOMIC_RELAXED, __HIP_MEMORY_SCOPE_AGENT);
                    __syncthreads();
                    const int u = (int)F.MISC[16];
                    __syncthreads();
                    if (u >= 1024) break;
                    att::sb_attn_unit((u & 63) >> 4, u & 15, 15 - (u >> 6), SQ, SK, SV, OB, (char*)lds, DIAG_PTR);
                }
            }
                SEAM(pb + 1);
            }
        }
        pg8::PG8_LAS_float_ptr const part = (pg8::PG8_LAS_float_ptr)(F.lds + EPI_PART_OFF);
        if constexpr (SITE(11) && IN(cb)) {
            const float* gf = (l == 0) ? ARG_IN(5) : (l == 1) ? ARG_IN(13) : (l == 2) ? ARG_IN(25) : ARG_IN(33);
            pg8::Gemm g{OB, (const bf16*)(WL + WL_OUT), M, DM, DM}; pg8::StaticOrder S; S.init(M, DM, F.G, (int)blockIdx.x);
            pg8::EpiResid E{XB, mods_l + 4096, HB, gf, mods_l + 8192, SSX, part};
            pg8::gemm_phase<pg8::EpiResid, pg8::StaticOrder, true, true>(F.lds, g, S, E);
            SEAM(cb);
        }
        if constexpr (SITE(13) && IN(cb + 1)) {
            for (int rep_ = 0; rep_ < NREP(13); ++rep_) {
            pg8::Gemm g{HB, (const bf16*)(WL + WL_FFN1), M, 2 * DFF, DM}; pg8::StaticOrder S; S.init(M, 2 * DFF, F.G, (int)blockIdx.x);
            pg8::EpiSwiglu E{(bf16*)(MIX + MX_ACT), pg8::NormIn{SSX, BIAS + BIAS_FFN + (size_t)l * 4 * 2 * DFF, 2 * DFF, (pg8::PG8_LAS_float_ptr)(F.lds + EPI_TAB_OFF)}};
            pg8::gemm_phase<pg8::EpiSwiglu, pg8::StaticOrder, true, true>(F.lds, g, S, E);
            }
            SEAM(cb + 1);
        }
        if constexpr (SITE(14) && IN(cb + 2)) {
            const float* gm = (l == 0) ? ARG_IN(12) : (l == 1) ? ARG_IN(24) : ARG_IN(32);
            pg8::Gemm g{(const bf16*)(MIX + MX_ACT), (const bf16*)(WL + WL_FFN2), M, DM, DFF}; pg8::StaticOrder S; S.init(M, DM, F.G, (int)blockIdx.x);
            pg8::EpiResid E{XB, mods_l + 10240, (l < 3) ? HB : (bf16*)nullptr, gm, mods_l + 4 * 12288 + 2048, SSX, part};
            pg8::gemm_phase<pg8::EpiResid, pg8::StaticOrder, true, true>(F.lds, g, S, E);
            SEAM(cb + 2);
        }
}
__device__ __forceinline__ void p1_phase(const Frame& F0, const Args& args, bf16* __restrict__ HB, bf16* __restrict__ XB, float* __restrict__ SSX, float* __restrict__ BIAS) {
    int tid_ = threadIdx.x; asm volatile("" : "+v"(tid_)); const int lane = tid_ & 63, wave = __builtin_amdgcn_readfirstlane(tid_ >> 6);
    const int gw = F0.vcu * NWAVES + wave, NGW = F0.G * NWAVES;
    unsigned char* const args_ws = ARG_WS;
    const float* const MODS = (const float*)(args_ws + WS_MODS);
    {
        const float* x = ARG_IN(0); const float* g = ARG_IN(4);
        for (int m = gw; m < M; m += NGW) {
            const GAS f32x4* xr = (const GAS f32x4*)(x + (size_t)m * DM) + lane;
            f32x4 v[8]; float s = 0.f;
#pragma unroll
            for (int j = 0; j < 8; ++j) { v[j] = __builtin_nontemporal_load(xr + 64 * j); s += (v[j].x * v[j].x + v[j].y * v[j].y) + (v[j].z * v[j].z + v[j].w * v[j].w); }
            s = wave_sum(s);
            if (lane == 0) { *(f32x4*)(SSX + (size_t)m * 8) = (f32x4){s, 0.f, 0.f, 0.f}; *(f32x4*)(SSX + (size_t)m * 8 + 4) = (f32x4){0.f, 0.f, 0.f, 0.f}; }
            const float* mb = MODS + (size_t)(m >> 12) * 12288;
            GAS unsigned long long* o8 = (GAS unsigned long long*)(HB + (size_t)m * DM) + lane; GAS unsigned long long* x8 = (GAS unsigned long long*)(XB + (size_t)m * DM) + lane;
#pragma unroll
            for (int j = 0; j < 8; ++j) { const int col = 256 * j + 4 * lane;
                const f32x4 g4 = *(const f32x4*)(g + col), sc4 = *(const f32x4*)(mb + 2048 + col);
                const f32x4 r = v[j] * g4 * (sc4 + 1.0f);
                o8[64 * j] = (unsigned long long)pk2(r.x, r.y) | ((unsigned long long)pk2(r.z, r.w) << 32);
                x8[64 * j] = (unsigned long long)pk2(v[j].x, v[j].y) | ((unsigned long long)pk2(v[j].z, v[j].w) << 32); }
        }
    }
    bias_range(F0, 0, 168, F0.vcu, F0.G); bias_range(F0, 568 + 1 * 352, 568 + 3 * 352, F0.vcu, F0.G);
}
template <int LO, int HI> __global__ void __launch_bounds__(NWAVES * 64, 2) trunk_fwd(Args args) {
    extern __shared__ __attribute__((aligned(16))) unsigned char lds[];
    Frame F;
    F.lds = (LAS unsigned char*)lds;
    F.MISC = (volatile LAS unsigned*)(F.lds + MISC_OFF);
    F.tid = threadIdx.x; F.lane = F.tid & 63; F.wave = __builtin_amdgcn_readfirstlane(F.tid >> 6);
    F.G = gridDim.x; { const int bx = blockIdx.x; F.vcu = (F.G % 8 == 0) ? (bx % 8) * (F.G / 8) + bx / 8 : bx; }
    unsigned char* const ws = ARG_WS;
    F.ctl = (gu32*)(ws + WS_CTL);
    for (int u = F.tid; u < (LDS_BYTES - LDSCTL_OFF) / 4; u += NWAVES * 64) ((LAS unsigned*)(F.lds + LDSCTL_OFF))[u] = 0u;
    __syncthreads();
    XcdBarrier bar = xcd_barrier_post((unsigned*)(F.ctl + CW_BAR) + ARG_LI * XCD_BAR_WORDS, F.MISC + 8);
#if DIAG == 2
    if (blockIdx.x == 0 && threadIdx.x == 0) ((unsigned long long*)(ARG_WS + WS_CTL + 0x8000))[0] = __builtin_amdgcn_s_memrealtime();
#endif
    float* const MODS = (float*)(ws + WS_MODS);
    float* const CS128 = (float*)(ws + WS_CS128);
    float* const CS64 = (float*)(ws + WS_CS64);
    float* const SSQ = (float*)(ws + WS_SSQ);
    bf16* const HB = (bf16*)(ws + WS_H);
    bf16* const OB = (bf16*)(ws + WS_O);
    unsigned char* const MIX = ws + WS_MIX;
    const int gw = F.vcu * NWAVES + F.wave, NGW = F.G * NWAVES;

    if constexpr (SITE(0) && IN(0)) {
            for (int rep_ = 0; rep_ < NREP(0); ++rep_) {
            if (rep_) __syncthreads();
        for (int r1_ = 0; r1_ < 1 + (P0_REP & 1); ++r1_) {
            LAS float* silc = (LAS float*)F.lds;
            LAS float* red = (LAS float*)(F.lds + 32768);
            const float* cvec = ARG_IN(1);
            for (int i = F.tid; i < 4 * DM; i += NWAVES * 64) { const float c = cvec[i]; silc[i] = c / (1.0f + __expf(-c)); }
            __syncthreads();
            for (int it = F.vcu; it < 4 * 192; it += F.G) {
                const int l = it / 192, ng = it % 192;
                const float* W = (l == 0) ? ARG_IN(2) : (l == 1) ? ARG_IN(10) : (l == 2) ? ARG_IN(22) : ARG_IN(30);
                const float* Bv = (l == 0) ? ARG_IN(3) : (l == 1) ? ARG_IN(11) : (l == 2) ? ARG_IN(23) : ARG_IN(31);
                const int c4 = F.lane & 15, kr = F.lane >> 4, k0 = 256 * F.wave;
                f32x4 acc[4];
#pragma unroll
                for (int b = 0; b < 4; ++b) acc[b] = (f32x4){0.f, 0.f, 0.f, 0.f};
#pragma unroll 8
                for (int kk = 0; kk < 64; ++kk) { const int k = k0 + 4 * kk + kr;
                    const f32x4 w4 = __builtin_nontemporal_load((const GAS f32x4*)(W + (size_t)k * 12288 + 64 * ng + 4 * c4));
#pragma unroll
                    for (int b = 0; b < 4; ++b) acc[b] += w4 * silc[b * DM + k]; }
#pragma unroll
                for (int b = 0; b < 4; ++b)
#pragma unroll
                    for (int e = 0; e < 4; ++e) { float v = acc[b][e]; v += __shfl_xor(v, 16); v += __shfl_xor(v, 32); acc[b][e] = v; }
                if (kr == 0) {
#pragma unroll
                    for (int b = 0; b < 4; ++b) *(LAS f32x4*)(red + (F.wave * 4 + b) * 64 + 4 * c4) = acc[b]; }
                __syncthreads();
                if (F.tid < 256) { const int b = F.tid >> 6, col = F.tid & 63; float s = Bv[64 * ng + col];
#pragma unroll
                    for (int w = 0; w < 8; ++w) s += red[(w * 4 + b) * 64 + col];
                    MODS[((size_t)l * 4 + b) * 12288 + 64 * ng + col] = s; }
                __syncthreads();
            }
        }
        for (int r2_ = 0; r2_ < 1 + ((P0_REP >> 1) & 1); ++r2_) {
            LAS unsigned* scr = (LAS unsigned*)(F.lds + F.wave * 16384);
            int it = gw;
#define CONV_SEG(Wp, K_, Nsrc_, Nphys_, kind_, gk_, dst_) do { const int n_items_ = ((K_) / 64) * ((Nphys_) / 64); \
                for (; it < n_items_; it += NGW) conv_item((Wp), (K_), (Nsrc_), (Nphys_), (kind_), (gk_), (bf16*)(dst_), scr, it, F.lane); it -= n_items_; } while (0)
            CONV_SEG(ARG_IN(8),  DM, 2 * DFF, 2 * DFF, KIND_FFN1, (const float*)nullptr, ws + WS_W + 0 * WL_STRIDE + WL_FFN1);
            CONV_SEG(ARG_IN(20), DM, 2 * DFF, 2 * DFF, KIND_FFN1, (const float*)nullptr, ws + WS_W + 1 * WL_STRIDE + WL_FFN1);
            CONV_SEG(ARG_IN(28), DM, 2 * DFF, 2 * DFF, KIND_FFN1, (const float*)nullptr, ws + WS_W + 2 * WL_STRIDE + WL_FFN1);
            CONV_SEG(ARG_IN(36), DM, 2 * DFF, 2 * DFF, KIND_FFN1, (const float*)nullptr, ws + WS_W + 3 * WL_STRIDE + WL_FFN1);
            CONV_SEG(ARG_IN(9),  DFF, DM, DM, KIND_ID, (const float*)nullptr, ws + WS_W + 0 * WL_STRIDE + WL_FFN2);
            CONV_SEG(ARG_IN(21), DFF, DM, DM, KIND_ID, (const float*)nullptr, ws + WS_W + 1 * WL_STRIDE + WL_FFN2);
            CONV_SEG(ARG_IN(29), DFF, DM, DM, KIND_ID, (const float*)nullptr, ws + WS_W + 2 * WL_STRIDE + WL_FFN2);
            CONV_SEG(ARG_IN(37), DFF, DM, DM, KIND_ID, (const float*)nullptr, ws + WS_W + 3 * WL_STRIDE + WL_FFN2);
            CONV_SEG(ARG_IN(7),  DM, DM, DM, KIND_ID, (const float*)nullptr, ws + WS_W + 0 * WL_STRIDE + WL_OUT);
            CONV_SEG(ARG_IN(19), DM, DM, DM, KIND_ID, (const float*)nullptr, ws + WS_W + 1 * WL_STRIDE + WL_OUT);
            CONV_SEG(ARG_IN(27), DM, DM, DM, KIND_ID, (const float*)nullptr, ws + WS_W + 2 * WL_STRIDE + WL_OUT);
            CONV_SEG(ARG_IN(35), DM, DM, DM, KIND_ID, (const float*)nullptr, ws + WS_W + 3 * WL_STRIDE + WL_OUT);
            CONV_SEG(ARG_IN(6),  DM, 5264, DSA_NP, KIND_DSA_IN, (const float*)nullptr, ws + WS_WDSA + 0 * WDSA_STRIDE);
            CONV_SEG(ARG_IN(34), DM, 5264, DSA_NP, KIND_DSA_IN, (const float*)nullptr, ws + WS_WDSA + 1 * WDSA_STRIDE);
            CONV_SEG(ARG_IN(14), DM, 1088, MLA_DOWN_NP, KIND_MLA_DOWN, (const float*)nullptr, ws + WS_WMLA + WMLA_DOWN);
            CONV_SEG(ARG_IN(17), 512, 3072, 3072, KIND_MLA_UQ, ARG_IN(15), ws + WS_WMLA + WMLA_UQ);
            CONV_SEG(ARG_IN(18), 512, 4096, 4096, KIND_ID, ARG_IN(16), ws + WS_WMLA + WMLA_UKV);
            CONV_SEG(ARG_IN(26), DM, 3 * DM, 3 * DM, KIND_ID, (const float*)nullptr, ws + WS_WSB);
#undef CONV_SEG
        }
            }
        SEAM(0);
    }
    if constexpr (SITE(1) && IN(1)) { p1_phase(F, args, (bf16*)(ws + WS_H), (bf16*)(ws + WS_XB), (float*)(ws + WS_SSX), (float*)(ws + WS_BIAS)); SEAM(1); }

    run_layer<0, LO, HI>(F, args, bar, lds); run_layer<1, LO, HI>(F, args, bar, lds); run_layer<2, LO, HI>(F, args, bar, lds); run_layer<3, LO, HI>(F, args, bar, lds);
    if constexpr (SITE(15) && IN(NPH - 1)) {
        finalnorm_phase(F, (const bf16*)(ws + WS_XB), ARG_OUT, ARG_IN(38));
#if DIAG == 2
        __syncthreads(); if (blockIdx.x == 0 && threadIdx.x == 0) { const unsigned long long* st_ = (const unsigned long long*)(ARG_WS + WS_CTL + 0x8000);
            const unsigned long long* pmx_ = (const unsigned long long*)(ARG_WS + WS_CTL + 0x9000); const unsigned long long* pmn_ = (const unsigned long long*)(ARG_WS + WS_CTL + 0xA000);
            float d_ = (float)(st_[DIAG_K1] - st_[DIAG_K0]);
            if (DIAG_SEL == 1) { d_ = 0.f; for (int k = DIAG_K0; k < DIAG_K1; ++k) d_ += (float)(long long)(st_[k + 1] - pmx_[k]); }
            if (DIAG_SEL == 2) { d_ = 0.f; for (int k = DIAG_K0; k < DIAG_K1; ++k) d_ += (float)(long long)(pmx_[k] - ((1ull << 62) - pmn_[k])); }
            ARG_OUT[0] += d_ * (0.01f / DIAG_DIV); }
#elif DIAG
        __syncthreads(); if (blockIdx.x == 0 && threadIdx.x == 0) { const unsigned cnt_ = __hip_atomic_load((unsigned*)(ARG_WS + WS_CTL) + 2048, __ATOMIC_RELAXED, __HIP_MEMORY_SCOPE_AGENT); ARG_OUT[0] += (float)cnt_ * (1.0f / 200.0f); }
#endif
    }
}
#undef IN
#undef SEAM
template <int LO, int HI> static void launch_range(int grid, const Args& a, hipStream_t stream) {
    static bool attr_done = false;
    if (!attr_done) { if (hipFuncSetAttribute((const void*)trunk_fwd<LO, HI>, hipFuncAttributeMaxDynamicSharedMemorySize, LDS_BYTES) != hipSuccess) fprintf(stderr, "kernel_launch: hipFuncSetAttribute failed\n"); attr_done = true; }
    hipLaunchKernelGGL((trunk_fwd<LO, HI>), dim3(grid), dim3(NWAVES * 64), LDS_BYTES, stream, a);
}
template <int P> struct PerPhase { static void go(int grid, const Args& a, hipStream_t stream) { launch_range<P, P + 1>(grid, a, stream); PerPhase<P + 1>::go(grid, a, stream); } };
template <> struct PerPhase<NPH> { static void go(int, const Args&, hipStream_t) {} };
extern "C" void kernel_launch(void* const* d_in, const int* in_sizes, int n_in, void* d_out, int out_size, void* d_ws, size_t ws_size, hipStream_t stream) {
    static int grid = 0;
    if (grid == 0) {
        if (n_in != 39 || in_sizes[0] != M * DM || out_size != M * DM || ws_size < WS_END) { fprintf(stderr, "kernel_launch: shape mismatch (n_in %d, in0 %d, out %d, ws %zu < %zu)\n", n_in, n_in > 0 ? in_sizes[0] : -1, out_size, ws_size, (size_t)WS_END); grid = -1; return; }
        int dev = 0, cus = 0;
        if (hipGetDevice(&dev) != hipSuccess || hipDeviceGetAttribute(&cus, hipDeviceAttributeMultiprocessorCount, dev) != hipSuccess) { grid = -1; return; }
        grid = cus;
    }
    if (grid < 0) return;
    if (hipMemsetAsync((char*)d_ws + WS_CTL, 0, CTL_ZERO_BYTES, stream) != hipSuccess) return;
    Args a{};
    for (int i = 0; i < 39; ++i) a.in[i] = (const float*)d_in[i];
    a.out = (float*)d_out; a.ws = (unsigned char*)d_ws; a.ph_lo = 0; a.ph_hi = NPH; a.li = 0;
#if MK_ONE_LAUNCH
    launch_range<0, NPH>(grid, a, stream);
#else
    PerPhase<0>::go(grid, a, stream);
#endif
    const hipError_t le = hipPeekAtLastError();
    if (le != hipSuccess) fprintf(stderr, "kernel_launch: launch failed: %s\n", hipGetErrorName(le));
}
```
